# Optimizing an MI355X kernel written in HIP

```python
import math
import jax
import jax.numpy as jnp
from jax import lax
import numpy as np

D_MODEL = 1024
BATCH = 8
SEQ = 4096
DEPTH = 4

GRID_W = 64
CTX_LEN = 256
N_MIXERS = 2
HEAD_DIM = 64
RWKV_HEADS = D_MODEL // HEAD_DIM
DECAY_LORA = 64
AAA_LORA = 64
MV_LORA = 32
GATE_LORA = 160
N_MIX_COEF = 6
DIFF_HEADS = D_MODEL // (2 * HEAD_DIM)
D_FF = 4 * D_MODEL
Q_BLOCK = 128
ROPE_THETA = 10000.0
ROPE_PAIRS = HEAD_DIM // 4
NORM_EPS = 1e-6
SUBLN_EPS = 1e-5
GN_EPS = 64e-5
N_RWKV = (DEPTH + 1) // 2
N_DIFF = DEPTH // 2
N_VRES = N_RWKV - 1

kernel_name = 'hybrid_rwkv7_diffattn_dit'


def _rmsnorm(x, g, eps=NORM_EPS):
    xf = x.astype(jnp.float32)
    y = xf * lax.rsqrt(jnp.mean(jnp.square(xf), axis=-1, keepdims=True) + eps)
    return (y * g).astype(x.dtype)


def _modulate(h, shift, scale):
    return h * (1 + scale) + shift


def _sqrelu_mlp(h, w1, w2):
    return jnp.square(jax.nn.relu(h @ w1)) @ w2


def _rope_tables(L):
    rows = L // GRID_W
    row = jnp.repeat(jnp.arange(rows, dtype=jnp.int32), GRID_W)
    col = jnp.tile(jnp.arange(GRID_W, dtype=jnp.int32), rows)
    inv = ROPE_THETA ** (-jnp.arange(ROPE_PAIRS, dtype=jnp.float32) / ROPE_PAIRS)
    ang_r = row.astype(jnp.float32)[:, None] * inv[None, :]
    ang_c = col.astype(jnp.float32)[:, None] * inv[None, :]
    return (jnp.cos(ang_r), jnp.sin(ang_r), jnp.cos(ang_c), jnp.sin(ang_c))


def _rope_half(x, cos, sin):
    x1, x2 = jnp.split(x, 2, axis=-1)
    return jnp.concatenate([x1 * cos - x2 * sin, x1 * sin + x2 * cos], axis=-1)


def _rope2d(x, rope):
    cos_r, sin_r, cos_c, sin_c = rope
    xr, xc = jnp.split(x, 2, axis=-1)
    return jnp.concatenate([_rope_half(xr, cos_r, sin_r), _rope_half(xc, cos_c, sin_c)], axis=-1).astype(x.dtype)


def _token_shift(h):
    z = jnp.zeros_like(h[:, :1])
    prev = jnp.concatenate([z, h[:, :-1]], axis=1)
    nxt = jnp.concatenate([h[:, 1:], z], axis=1)
    return 0.5 * (prev + nxt) - h


def _rwkv_features(h, mix, w_rkv, w0, w1, w2, a0, a1, a2, g1, g2, k_k, k_a, vres):
    B, T, _ = h.shape
    xx = _token_shift(h)
    xr, xw, xk, xv, xa, xg = (h + xx * mix[m] for m in range(N_MIX_COEF))
    r, k, v = jnp.einsum('sbtd,sde->sbte', jnp.stack([xr, xk, xv]), w_rkv)
    decays = tuple(
        jnp.exp(-jnp.exp(-jax.nn.softplus(-(w0[d] + jnp.tanh(xw @ w1[d]) @ w2[d]).astype(jnp.float32)) - 0.5))
        for d in range(2))
    gates = tuple(jax.nn.sigmoid(xg @ g1[d]) @ g2[d] for d in range(2))
    a = jax.nn.sigmoid(a0 + (xa @ a1) @ a2)
    if vres is not None:
        v_first, v0, v1, v2 = vres
        v = v + (v_first - v) * jax.nn.sigmoid(v0 + (xv @ v1) @ v2)
    kk = (k * k_k).reshape(B, T, RWKV_HEADS, HEAD_DIM)
    inv_norm = lax.rsqrt(jnp.maximum(jnp.sum(jnp.square(kk.astype(jnp.float32)), -1, keepdims=True), 1e-24))
    kk = (kk * inv_norm.astype(kk.dtype)).reshape(B, T, D_MODEL)
    k = k * (1 + (a - 1) * k_a)
    return (r, k, v, kk, a, decays, gates)


def _wkv_scan(r, decay, k, v, a_vec, b_vec, s0, reverse):
    B, T, _ = r.shape

    def to_steps(t):
        return jnp.moveaxis(t.astype(jnp.float32).reshape(B, T, RWKV_HEADS, HEAD_DIM), 1, 0)

    def step(S, inp):
        r_t, w_t, k_t, v_t, a_t, b_t = inp
        sa = jnp.einsum('bhvk,bhk->bhv', S, a_t)
        S = S * w_t[:, :, None, :] + sa[..., None] * b_t[:, :, None, :] + v_t[..., None] * k_t[:, :, None, :]
        return S, jnp.einsum('bhvk,bhk->bhv', S, r_t)

    s_fin, o = lax.scan(step, s0, tuple(to_steps(t) for t in (r, decay, k, v, a_vec, b_vec)), reverse=reverse)
    return s_fin, jnp.moveaxis(o, 0, 1).reshape(B, T, D_MODEL)


def _group_norm(o, g, b):
    B, T, _ = o.shape
    oh = o.astype(jnp.float32).reshape(B, T, RWKV_HEADS, HEAD_DIM)
    mu = jnp.mean(oh, axis=-1, keepdims=True)
    var = jnp.mean(jnp.square(oh - mu), axis=-1, keepdims=True)
    on = ((oh - mu) * lax.rsqrt(var + GN_EPS)).reshape(B, T, D_MODEL)
    return on * g + b


def _rwkv_output(f, o_f, o_b, r_k, ln_g, ln_b, w_o):
    r, k, v, _, _, _, gates = f
    B, T, _ = r.shape
    hs = (B, T, RWKV_HEADS, HEAD_DIM)
    bonus = (jnp.sum((r * k).reshape(hs) * r_k, axis=-1, keepdims=True) * v.reshape(hs)).reshape(B, T, D_MODEL)
    y_f = (_group_norm(o_f, ln_g, ln_b).astype(r.dtype) + bonus) * gates[0]
    y_b = (_group_norm(o_b, ln_g, ln_b).astype(r.dtype) + bonus) * gates[1]
    return (y_f + y_b) @ w_o


def _scan_dir(f, d, s_init, reverse):
    r, k, v, kk, a, decays, _ = f
    return _wkv_scan(r, decays[d], k, v, -kk, kk * a, s_init, reverse)


def _rwkv_mixer(h_lat, h_ctx, feat_params, out_params, vres_lat, vres_ctx, need_ctx_out):
    f_ctx = _rwkv_features(h_ctx, *feat_params, vres_ctx)
    f_lat = _rwkv_features(h_lat, *feat_params, vres_lat)
    s0 = jnp.zeros((h_lat.shape[0], RWKV_HEADS, HEAD_DIM, HEAD_DIM), jnp.float32)
    s_cf, o_cf = _scan_dir(f_ctx, 0, s0, False)
    _, o_lf = _scan_dir(f_lat, 0, s_cf, False)
    s_cb, o_cb = _scan_dir(f_ctx, 1, s0, True)
    _, o_lb = _scan_dir(f_lat, 1, s_cb, True)
    y_lat = _rwkv_output(f_lat, o_lf.astype(h_lat.dtype), o_lb.astype(h_lat.dtype), *out_params)
    y_ctx = _rwkv_output(f_ctx, o_cf.astype(h_ctx.dtype), o_cb.astype(h_ctx.dtype), *out_params) if need_ctx_out else None
    return y_lat, y_ctx, f_lat[2], f_ctx[2]


def _diff_attention(h_lat, h_ctx, w_qkv, w_o, lq1, lk1, lq2, lk2, subln_g, lambda_init, rope, need_ctx_out):
    B, L, _ = h_lat.shape

    def project(h):
        T = h.shape[1]
        q, k, v = jnp.split(h @ w_qkv, 3, axis=-1)
        q = q.reshape(B, T, DIFF_HEADS, 2, HEAD_DIM).transpose(0, 2, 3, 1, 4)
        k = k.reshape(B, T, DIFF_HEADS, 2, HEAD_DIM).transpose(0, 2, 3, 1, 4)
        v = v.reshape(B, T, DIFF_HEADS, 2 * HEAD_DIM).transpose(0, 2, 1, 3)
        return q, k, v

    q_l, k_l, v_l = project(h_lat)
    _, k_c, v_c = project(h_ctx) if not need_ctx_out else (None, None, None)
    if need_ctx_out:
        q_c, k_c, v_c = project(h_ctx)
    q_l = _rope2d(q_l, rope)
    k_l = _rope2d(k_l, rope)
    lam = (jnp.exp(jnp.sum(lq1 * lk1).astype(jnp.float32)) - jnp.exp(jnp.sum(lq2 * lk2).astype(jnp.float32))
           + lambda_init)
    scale = HEAD_DIM ** -0.5

    def combine(s):
        p = jax.nn.softmax(s.astype(jnp.float32) * scale, axis=-1)
        return p[:, :, 0] - lam * p[:, :, 1]

    def head_out(o):
        T = o.shape[1]
        o = _rmsnorm(o, subln_g, SUBLN_EPS) * (1 - lambda_init)
        return o.reshape(B, T, D_MODEL) @ w_o

    k_all = jnp.concatenate([k_l, k_c], axis=3)
    v_all = jnp.concatenate([v_l, v_c], axis=2)
    nb = L // Q_BLOCK
    q_blocks = q_l.reshape(B, DIFF_HEADS, 2, nb, Q_BLOCK, HEAD_DIM).transpose(3, 0, 1, 2, 4, 5)

    def block(qb):
        a = combine(jnp.einsum('bhsqd,bhskd->bhsqk', qb, k_all))
        return jnp.einsum('bhqk,bhkv->bhqv', a.astype(v_all.dtype), v_all)

    o_l = lax.map(block, q_blocks)
    o_l = o_l.transpose(1, 0, 3, 2, 4).reshape(B, L, DIFF_HEADS, 2 * HEAD_DIM)
    y_lat = head_out(o_l)
    y_ctx = None
    if need_ctx_out:
        a_c = combine(jnp.einsum('bhsqd,bhskd->bhsqk', q_c, k_c))
        o_c = jnp.einsum('bhqk,bhkv->bhqv', a_c.astype(v_c.dtype), v_c).transpose(0, 2, 1, 3)
        y_ctx = head_out(o_c)
    return y_lat, y_ctx


def setup_inputs(seed: int = 0) -> dict:
    key = jax.random.key(seed)
    ks = iter(jax.random.split(key, 48))
    D = D_MODEL

    def nrm(shape, s):
        return jax.random.normal(next(ks), shape, jnp.float32) * s

    def uni(shape, lo, hi):
        return jax.random.uniform(next(ks), shape, jnp.float32, lo, hi)

    return {
        'x': nrm((BATCH, SEQ, D), 1.0),
        'c': nrm((BATCH, D), 1.0),
        'ctx': nrm((BATCH, CTX_LEN, D), 1.0),
        'c_ctx': nrm((D,), 1.0),
        'ada_w': nrm((DEPTH, D, 6 * D), 0.5 * D ** -0.5),
        'ada_b': nrm((DEPTH, 6 * D), 0.01),
        'norm_g': 1.0 + nrm((DEPTH, 2, D), 0.02),
        'final_g': 1.0 + nrm((D,), 0.02),
        'rw_mix': uni((N_RWKV, N_MIX_COEF, D), 0.0, 1.0),
        'rw_w_rkv': nrm((N_RWKV, 3, D, D), D ** -0.5),
        'rw_w0': uni((N_RWKV, 2, D), -6.0, -1.0),
        'rw_w1': nrm((N_RWKV, 2, D, DECAY_LORA), D ** -0.5),
        'rw_w2': nrm((N_RWKV, 2, DECAY_LORA, D), 0.1 * DECAY_LORA ** -0.5),
        'rw_a0': nrm((N_RWKV, D), 0.1),
        'rw_a1': nrm((N_RWKV, D, AAA_LORA), D ** -0.5),
        'rw_a2': nrm((N_RWKV, AAA_LORA, D), 0.1 * AAA_LORA ** -0.5),
        'rw_g1': nrm((N_RWKV, 2, D, GATE_LORA), D ** -0.5),
        'rw_g2': nrm((N_RWKV, 2, GATE_LORA, D), GATE_LORA ** -0.5),
        'rw_kk': 0.85 + nrm((N_RWKV, D), 0.02),
        'rw_ka': 1.0 + nrm((N_RWKV, D), 0.02),
        'rw_rk': nrm((N_RWKV, RWKV_HEADS, HEAD_DIM), 0.1),
        'rw_ln_g': 1.0 + nrm((N_RWKV, D), 0.02),
        'rw_ln_b': nrm((N_RWKV, D), 0.01),
        'rw_w_o': nrm((N_RWKV, D, D), D ** -0.5),
        'rw_v0': 1.0 + nrm((N_VRES, D), 0.02),
        'rw_v1': nrm((N_VRES, D, MV_LORA), D ** -0.5),
        'rw_v2': nrm((N_VRES, MV_LORA, D), 0.1 * MV_LORA ** -0.5),
        'da_w_qkv': nrm((N_DIFF, D, 3 * D), D ** -0.5),
        'da_w_o': nrm((N_DIFF, D, D), D ** -0.5),
        'da_lq1': nrm((N_DIFF, HEAD_DIM), 0.1),
        'da_lk1': nrm((N_DIFF, HEAD_DIM), 0.1),
        'da_lq2': nrm((N_DIFF, HEAD_DIM), 0.1),
        'da_lk2': nrm((N_DIFF, HEAD_DIM), 0.1),
        'da_subln_g': 1.0 + nrm((N_DIFF, 2 * HEAD_DIM), 0.02),
        'mlp_w1': nrm((DEPTH, D, D_FF), D ** -0.5),
        'mlp_w2': nrm((DEPTH, D_FF, D), D_FF ** -0.5),
    }


def reference(x, c, ctx, c_ctx, ada_w, ada_b, norm_g, final_g,
              rw_mix, rw_w_rkv, rw_w0, rw_w1, rw_w2, rw_a0, rw_a1, rw_a2,
              rw_g1, rw_g2, rw_kk, rw_ka, rw_rk, rw_ln_g, rw_ln_b, rw_w_o,
              rw_v0, rw_v1, rw_v2,
              da_w_qkv, da_w_o, da_lq1, da_lk1, da_lq2, da_lk2, da_subln_g,
              mlp_w1, mlp_w2):
    L = x.shape[1]
    rope = _rope_tables(L)
    xc = ctx
    v_first_lat = None
    v_first_ctx = None
    for i in range(DEPTH):
        last = i == DEPTH - 1
        mod_lat = (jax.nn.silu(c) @ ada_w[i] + ada_b[i])[:, None, :]
        mod_ctx = jax.nn.silu(c_ctx) @ ada_w[i] + ada_b[i]
        sh1, sc1, g1, sh2, sc2, g2 = jnp.split(mod_lat, 6, axis=-1)
        csh1, csc1, cg1, csh2, csc2, cg2 = jnp.split(mod_ctx, 6, axis=-1)
        h_lat = _modulate(_rmsnorm(x, norm_g[i, 0]), sh1, sc1)
        h_ctx = _modulate(_rmsnorm(xc, norm_g[i, 0]), csh1, csc1)
        j = i // N_MIXERS
        if i % N_MIXERS == 0:
            vres_lat = None
            vres_ctx = None
            if j > 0:
                vres_lat = (v_first_lat, rw_v0[j - 1], rw_v1[j - 1], rw_v2[j - 1])
                vres_ctx = (v_first_ctx, rw_v0[j - 1], rw_v1[j - 1], rw_v2[j - 1])
            feat_params = (rw_mix[j], rw_w_rkv[j], rw_w0[j], rw_w1[j], rw_w2[j], rw_a0[j], rw_a1[j], rw_a2[j],
                           rw_g1[j], rw_g2[j], rw_kk[j], rw_ka[j])
            out_params = (rw_rk[j], rw_ln_g[j], rw_ln_b[j], rw_w_o[j])
            y_lat, y_ctx, v_lat, v_ctx = _rwkv_mixer(h_lat, h_ctx, feat_params, out_params,
                                                     vres_lat, vres_ctx, not last)
            if j == 0:
                v_first_lat = v_lat
                v_first_ctx = v_ctx
        else:
            lambda_init = 0.8 - 0.6 * math.exp(-0.3 * i)
            y_lat, y_ctx = _diff_attention(h_lat, h_ctx, da_w_qkv[j], da_w_o[j], da_lq1[j], da_lk1[j],
                                           da_lq2[j], da_lk2[j], da_subln_g[j], lambda_init, rope, not last)
        x = x + g1 * y_lat
        h = _modulate(_rmsnorm(x, norm_g[i, 1]), sh2, sc2)
        x = x + g2 * _sqrelu_mlp(h, mlp_w1[i], mlp_w2[i])
        if not last:
            xc = xc + cg1 * y_ctx
            hc = _modulate(_rmsnorm(xc, norm_g[i, 1]), csh2, csc2)
            xc = xc + cg2 * _sqrelu_mlp(hc, mlp_w1[i], mlp_w2[i])
    return _rmsnorm(x, final_g)
```

```cpp
#include <hip/hip_runtime.h>
#include <hip/hip_cooperative_groups.h>
#include <cstdio>
namespace cg = cooperative_groups;

#define DI __device__ __forceinline__
typedef unsigned short bf16_t;
using bf16x8 = __attribute__((ext_vector_type(8))) short;
using f32x16 = __attribute__((ext_vector_type(16))) float;
typedef __bf16 bfv2 __attribute__((ext_vector_type(2)));
typedef float fv2 __attribute__((ext_vector_type(2)));
#define MFMA32(a, b, c) __builtin_amdgcn_mfma_f32_32x32x16_bf16((a), (b), (c), 0, 0, 0)

constexpr int D = 1024, NB = 8, SL = 4096, CL = 256;
constexpr int NLAT = NB * SL, NCTX = NB * CL, NTOK = NLAT + NCTX;
constexpr int HROWS = NTOK / 2;
constexpr int TK = SL + CL;
constexpr size_t MiB = 1048576;
constexpr size_t OFF_W = 0, OFF_XC = 36 * MiB, OFF_MODS = 44 * MiB, OFF_MISC = 45 * MiB, OFF_VF = 46 * MiB, OFF_TR = 114 * MiB;
constexpr size_t W_RKV = 0;
constexpr size_t W_L1 = W_RKV + 3072ull * 2048;
constexpr size_t W_W2 = W_L1 + 640ull * 2048;
constexpr size_t W_A2 = W_W2 + 2ull * 65536;
constexpr size_t W_G2 = W_A2 + 65536;
constexpr size_t W_V2 = W_G2 + 2ull * 196608;
constexpr size_t W_WO = W_V2 + 65536;
constexpr size_t W_M1 = W_WO + 1048576;
constexpr size_t W_M2 = W_M1 + 4194304;
constexpr size_t W_QKV = 0;
constexpr size_t HALF_ARR = (size_t)HROWS * 1024 * 2;
constexpr size_t TR_HX = 0;
constexpr size_t TR_T1 = 2 * HALF_ARR;
constexpr size_t TR_R = TR_T1 + (size_t)HROWS * 640 * 2;
constexpr size_t TR_K = TR_R + HALF_ARR, TR_V = TR_K + HALF_ARR, TR_A = TR_V + HALF_ARR;
constexpr size_t TR_WL0 = TR_A + HALF_ARR, TR_WL1 = TR_WL0 + HALF_ARR, TR_G0 = TR_WL1 + HALF_ARR, TR_G1 = TR_G0 + HALF_ARR;
constexpr size_t FULL_ARR = (size_t)NTOK * 1024 * 2;
constexpr size_t TR_H = 0, TR_Q = FULL_ARR, TR_KK = 2 * FULL_ARR, TR_VT = 3 * FULL_ARR;
constexpr size_t TR_H2 = 0, TR_HID = FULL_ARR;

struct P {
  const float *x, *c, *ctx, *c_ctx, *ada_w, *ada_b, *norm_g, *final_g;
  const float *rw_mix, *rw_w_rkv, *rw_w0, *rw_w1, *rw_w2, *rw_a0, *rw_a1, *rw_a2, *rw_g1, *rw_g2, *rw_kk, *rw_ka, *rw_rk, *rw_ln_g, *rw_ln_b, *rw_w_o, *rw_v0, *rw_v1, *rw_v2;
  const float *da_w_qkv, *da_w_o, *da_lq1, *da_lk1, *da_lq2, *da_lk2, *da_subln_g, *mlp_w1, *mlp_w2;
  float* out;
  char* ws;
  int only;
  int pad;
};

DI float bf2f(bf16_t h) { return __uint_as_float(((unsigned)h) << 16); }
DI unsigned pack2(float a, float b) { fv2 v = {a, b}; bfv2 r = __builtin_convertvector(v, bfv2); return __builtin_bit_cast(unsigned, r); }
DI bf16_t f2bf(float a) { return (bf16_t)(pack2(a, 0.f) & 0xffffu); }
DI float lo_bf(unsigned u) { return __uint_as_float(u << 16); }
DI float hi_bf(unsigned u) { return __uint_as_float(u & 0xffff0000u); }
DI float sigmoidf_(float x) { return 1.f / (1.f + __expf(-x)); }
DI float wave_sum(float v) {
#pragma unroll
  for (int o = 32; o > 0; o >>= 1) v += __shfl_xor(v, o);
  return v;
}
template <int N> DI float ror_add(float x) { return x + __builtin_bit_cast(float, __builtin_amdgcn_mov_dpp(__builtin_bit_cast(int, x), 0x120 + N, 0xf, 0xf, true)); }
DI float rowsum16(float x) { x = ror_add<8>(x); x = ror_add<4>(x); x = ror_add<2>(x); x = ror_add<1>(x); return x; }

DI int opaque_tid() { int t = threadIdx.x; asm volatile("" : "+v"(t)); return t; }
DI float* resid_row(const P& p, int gr) { return gr < NLAT ? p.out + (size_t)gr * D : (float*)(p.ws + OFF_XC) + (size_t)(gr - NLAT) * D; }
DI int mod_row(int gr) { return gr < NLAT ? gr / SL : 8; }
DI const float* mods_ptr(const P& p, int layer, int mrow) { return (const float*)(p.ws + OFF_MODS) + ((size_t)layer * 9 + mrow) * 6144; }
DI int half_gtile(int hf, int lt) { return lt < 128 ? hf * 128 + lt : 256 + hf * 8 + (lt - 128); }
DI int first_tile(int base) { int g = gridDim.x; int s = (int)blockIdx.x - (base % g); if (s < 0) s += g; return s; }
DI float lambda_init(int layer) { return 0.8f - 0.6f * expf(-0.3f * (float)layer); }

DI void phase_init(const P& p, char* smem) {
  const int tidx = opaque_tid();
  const int tid = tidx;
  float* sc = (float*)smem;
  float* mods = (float*)(p.ws + OFF_MODS);
  for (int item = blockIdx.x; item < 96; item += gridDim.x) {
    const int layer = item / 24, cb = item % 24;
    __syncthreads();
    for (int i = tid; i < 9 * 1024; i += 256) {
      int r = i >> 10, k = i & 1023;
      float v = r < 8 ? p.c[r * 1024 + k] : p.c_ctx[k];
      sc[i] = v / (1.f + expf(-v));
    }
    __syncthreads();
    const int w = tid >> 6, q = tid & 63;
    float4 acc[9];
#pragma unroll
    for (int r = 0; r < 9; r++) acc[r] = make_float4(0.f, 0.f, 0.f, 0.f);
    const float* wp = p.ada_w + (size_t)layer * 1024 * 6144 + cb * 256 + q * 4;
    for (int k = w * 256; k < w * 256 + 256; k++) {
      float4 wv = *(const float4*)(wp + (size_t)k * 6144);
#pragma unroll
      for (int r = 0; r < 9; r++) {
        float s = sc[r * 1024 + k];
        acc[r].x += s * wv.x; acc[r].y += s * wv.y; acc[r].z += s * wv.z; acc[r].w += s * wv.w;
      }
    }
    __syncthreads();
    float4* red = (float4*)smem;
#pragma unroll
    for (int r = 0; r < 9; r++) red[(w * 9 + r) * 64 + q] = acc[r];
    __syncthreads();
    for (int i = tid; i < 9 * 64; i += 256) {
      int r = i / 64, qq = i % 64;
      float4 s0 = red[(0 * 9 + r) * 64 + qq], s1 = red[(1 * 9 + r) * 64 + qq], s2 = red[(2 * 9 + r) * 64 + qq], s3 = red[(3 * 9 + r) * 64 + qq];
      float4 bb = *(const float4*)(p.ada_b + layer * 6144 + cb * 256 + qq * 4);
      float4 o = make_float4(s0.x + s1.x + s2.x + s3.x + bb.x, s0.y + s1.y + s2.y + s3.y + bb.y, s0.z + s1.z + s2.z + s3.z + bb.z, s0.w + s1.w + s2.w + s3.w + bb.w);
      *(float4*)(mods + ((size_t)layer * 9 + r) * 6144 + cb * 256 + qq * 4) = o;
    }
  }
  if (blockIdx.x == gridDim.x - 1) {
    float* misc = (float*)(p.ws + OFF_MISC);
    for (int i = tid; i < 1024; i += 256) {
      int pos = i / 16, f = i % 16;
      float inv = powf(10000.f, -(float)f / 16.f);
      float ang = (float)pos * inv;
      misc[i] = cosf(ang);
      misc[1024 + i] = sinf(ang);
    }
    if (tid < 2) {
      float s1 = 0.f, s2 = 0.f;
      for (int k = 0; k < 64; k++) { s1 += p.da_lq1[tid * 64 + k] * p.da_lk1[tid * 64 + k]; s2 += p.da_lq2[tid * 64 + k] * p.da_lk2[tid * 64 + k]; }
      misc[2048 + tid] = expf(s1) - expf(s2) + lambda_init(2 * tid + 1);
    }
  }
  const size_t n4 = (size_t)NLAT * D / 4, c4 = (size_t)NCTX * D / 4;
  const float4* xs = (const float4*)p.x; float4* xo = (float4*)p.out;
  for (size_t i = (size_t)blockIdx.x * 256 + tid; i < n4; i += (size_t)gridDim.x * 256) xo[i] = xs[i];
  const float4* cs = (const float4*)p.ctx; float4* co = (float4*)(p.ws + OFF_XC);
  for (size_t i = (size_t)blockIdx.x * 256 + tid; i < c4; i += (size_t)gridDim.x * 256) co[i] = cs[i];
}

DI void conv_mat(const float* __restrict__ src, int K, int N, bf16_t* __restrict__ dst, int ldd, int koff, const float* __restrict__ scale,
                 int Kp, int Np, float* sm, int& base) {
  const int tidx = opaque_tid();
  const int tid = tidx;
  const int tk = Kp / 64, tn = Np / 64, nt = tk * tn;
  for (int t = first_tile(base); t < nt; t += gridDim.x) {
    const int k0 = (t / tn) * 64, n0 = (t % tn) * 64;
    __syncthreads();
#pragma unroll
    for (int i = 0; i < 4; i++) {
      int kr = (tid >> 4) + 16 * i, nc = (tid & 15) * 4;
      float4 v = make_float4(0.f, 0.f, 0.f, 0.f);
      if (src != nullptr && k0 + kr < K && n0 + nc < N) {
        v = *(const float4*)(src + (size_t)(k0 + kr) * N + n0 + nc);
        if (scale) { float s = scale[k0 + kr]; v.x *= s; v.y *= s; v.z *= s; v.w *= s; }
      }
      sm[kr * 65 + nc + 0] = v.x; sm[kr * 65 + nc + 1] = v.y; sm[kr * 65 + nc + 2] = v.z; sm[kr * 65 + nc + 3] = v.w;
    }
    __syncthreads();
    const int n = tid >> 2, kb = (tid & 3) * 16;
    unsigned o[8];
#pragma unroll
    for (int i = 0; i < 8; i++) o[i] = pack2(sm[(kb + 2 * i) * 65 + n], sm[(kb + 2 * i + 1) * 65 + n]);
    uint4* dp = (uint4*)(dst + (size_t)(n0 + n) * ldd + koff + k0 + kb);
    dp[0] = make_uint4(o[0], o[1], o[2], o[3]);
    dp[1] = make_uint4(o[4], o[5], o[6], o[7]);
  }
  base += nt;
}

DI void phase_conv(const P& p, int layer, char* smem) {
  float* sm = (float*)smem;
  bf16_t* W = (bf16_t*)(p.ws + OFF_W);
  int base = 0;
  const int j = layer / 2;
  if ((layer & 1) == 0) {
    const int mixsel[3] = {0, 2, 3};
    for (int s = 0; s < 3; s++) {
      const float* src = p.rw_w_rkv + ((size_t)j * 3 + s) * 1048576;
      conv_mat(src, 1024, 1024, W + W_RKV + (size_t)s * 1024 * 2048, 2048, 0, nullptr, 1024, 1024, sm, base);
      conv_mat(src, 1024, 1024, W + W_RKV + (size_t)s * 1024 * 2048, 2048, 1024, p.rw_mix + ((size_t)j * 6 + mixsel[s]) * 1024, 1024, 1024, sm, base);
    }
    for (int pass = 0; pass < 2; pass++) {
      const int ko = pass * 1024;
      const float* m1 = pass ? p.rw_mix + ((size_t)j * 6 + 1) * 1024 : nullptr;
      const float* m4 = pass ? p.rw_mix + ((size_t)j * 6 + 4) * 1024 : nullptr;
      const float* m5 = pass ? p.rw_mix + ((size_t)j * 6 + 5) * 1024 : nullptr;
      const float* m3 = pass ? p.rw_mix + ((size_t)j * 6 + 3) * 1024 : nullptr;
      bf16_t* L1 = W + W_L1;
      conv_mat(p.rw_w1 + ((size_t)j * 2 + 0) * 65536, 1024, 64, L1 + 0ull * 2048, 2048, ko, m1, 1024, 64, sm, base);
      conv_mat(p.rw_w1 + ((size_t)j * 2 + 1) * 65536, 1024, 64, L1 + 64ull * 2048, 2048, ko, m1, 1024, 64, sm, base);
      conv_mat(p.rw_a1 + (size_t)j * 65536, 1024, 64, L1 + 128ull * 2048, 2048, ko, m4, 1024, 64, sm, base);
      conv_mat(p.rw_g1 + ((size_t)j * 2 + 0) * 163840, 1024, 160, L1 + 192ull * 2048, 2048, ko, m5, 1024, 192, sm, base);
      conv_mat(p.rw_g1 + ((size_t)j * 2 + 1) * 163840, 1024, 160, L1 + 384ull * 2048, 2048, ko, m5, 1024, 192, sm, base);
      conv_mat(j > 0 ? p.rw_v1 + (size_t)(j - 1) * 32768 : nullptr, 1024, 32, L1 + 576ull * 2048, 2048, ko, m3, 1024, 64, sm, base);
    }
    conv_mat(p.rw_w2 + ((size_t)j * 2 + 0) * 65536, 64, 1024, W + W_W2, 64, 0, nullptr, 64, 1024, sm, base);
    conv_mat(p.rw_w2 + ((size_t)j * 2 + 1) * 65536, 64, 1024, W + W_W2 + 65536, 64, 0, nullptr, 64, 1024, sm, base);
    conv_mat(p.rw_a2 + (size_t)j * 65536, 64, 1024, W + W_A2, 64, 0, nullptr, 64, 1024, sm, base);
    conv_mat(p.rw_g2 + ((size_t)j * 2 + 0) * 163840, 160, 1024, W + W_G2, 192, 0, nullptr, 192, 1024, sm, base);
    conv_mat(p.rw_g2 + ((size_t)j * 2 + 1) * 163840, 160, 1024, W + W_G2 + 196608, 192, 0, nullptr, 192, 1024, sm, base);
    conv_mat(j > 0 ? p.rw_v2 + (size_t)(j - 1) * 32768 : nullptr, 32, 1024, W + W_V2, 64, 0, nullptr, 64, 1024, sm, base);
    conv_mat(p.rw_w_o + (size_t)j * 1048576, 1024, 1024, W + W_WO, 1024, 0, nullptr, 1024, 1024, sm, base);
  } else {
    conv_mat(p.da_w_qkv + (size_t)j * 3145728, 1024, 3072, W + W_QKV, 1024, 0, nullptr, 1024, 3072, sm, base);
    conv_mat(p.da_w_o + (size_t)j * 1048576, 1024, 1024, W + W_WO, 1024, 0, nullptr, 1024, 1024, sm, base);
  }
  conv_mat(p.mlp_w1 + (size_t)layer * 4194304, 1024, 4096, W + W_M1, 1024, 0, nullptr, 1024, 4096, sm, base);
  conv_mat(p.mlp_w2 + (size_t)layer * 4194304, 4096, 1024, W + W_M2, 4096, 0, nullptr, 4096, 1024, sm, base);
}

DI void phase_prep(const P& p, int layer, int sub, int hf, bool shift, bf16_t* H, int ldh, bool skip_ctx) {
  const int tidx = opaque_tid();
  const int lane = tidx & 63, wv = tidx >> 6;
  const int nrows = hf < 0 ? (skip_ctx ? NLAT : NTOK) : HROWS;
  const int nseg = nrows / 8;
  const float* ng = p.norm_g + ((size_t)layer * 2 + sub) * 1024;
  for (int seg = blockIdx.x * 4 + wv; seg < nseg; seg += gridDim.x * 4) {
    const int lr0 = seg * 8;
    const int gr0 = hf < 0 ? lr0 : (lr0 < 16384 ? hf * 16384 + lr0 : NLAT + hf * 1024 + (lr0 - 16384));
    const bool lat = gr0 < NLAT;
    const int T = lat ? SL : CL;
    const int t0 = lat ? (gr0 % SL) : ((gr0 - NLAT) % CL);
    const float* xbase = resid_row(p, gr0);
    const float* md = mods_ptr(p, layer, mod_row(gr0));
    float4 g4[4], sc4[4], sh4[4];
#pragma unroll
    for (int jx = 0; jx < 4; jx++) {
      int ch = jx * 256 + lane * 4;
      g4[jx] = *(const float4*)(ng + ch);
      sh4[jx] = *(const float4*)(md + sub * 3072 + ch);
      sc4[jx] = *(const float4*)(md + sub * 3072 + 1024 + ch);
      g4[jx].x *= (1.f + sc4[jx].x); g4[jx].y *= (1.f + sc4[jx].y); g4[jx].z *= (1.f + sc4[jx].z); g4[jx].w *= (1.f + sc4[jx].w);
    }
    float4 hp[4], hc[4], hn[4];
    const int tb = shift ? -1 : 0, te = shift ? 9 : 8;
    for (int tt = tb; tt < te; tt++) {
      const int t = t0 + tt;
      if (t >= 0 && t < T) {
        const float* xr = xbase + (ptrdiff_t)tt * D;
        float ss = 0.f;
#pragma unroll
        for (int jx = 0; jx < 4; jx++) {
          hn[jx] = *(const float4*)(xr + jx * 256 + lane * 4);
          ss += hn[jx].x * hn[jx].x + hn[jx].y * hn[jx].y + hn[jx].z * hn[jx].z + hn[jx].w * hn[jx].w;
        }
        ss = wave_sum(ss);
        const float rs = rsqrtf(ss * (1.f / 1024.f) + 1e-6f);
#pragma unroll
        for (int jx = 0; jx < 4; jx++) {
          hn[jx].x = hn[jx].x * rs * g4[jx].x + sh4[jx].x; hn[jx].y = hn[jx].y * rs * g4[jx].y + sh4[jx].y;
          hn[jx].z = hn[jx].z * rs * g4[jx].z + sh4[jx].z; hn[jx].w = hn[jx].w * rs * g4[jx].w + sh4[jx].w;
        }
      } else {
#pragma unroll
        for (int jx = 0; jx < 4; jx++) hn[jx] = make_float4(0.f, 0.f, 0.f, 0.f);
      }
      if (!shift) {
        bf16_t* hr = H + (size_t)(lr0 + tt) * ldh;
#pragma unroll
        for (int jx = 0; jx < 4; jx++) *(uint2*)(hr + jx * 256 + lane * 4) = make_uint2(pack2(hn[jx].x, hn[jx].y), pack2(hn[jx].z, hn[jx].w));
      } else if (tt >= 1) {
        bf16_t* hr = H + (size_t)(lr0 + tt - 1) * ldh;
#pragma unroll
        for (int jx = 0; jx < 4; jx++) {
          *(uint2*)(hr + jx * 256 + lane * 4) = make_uint2(pack2(hc[jx].x, hc[jx].y), pack2(hc[jx].z, hc[jx].w));
          float4 xx;
          xx.x = 0.5f * (hp[jx].x + hn[jx].x) - hc[jx].x; xx.y = 0.5f * (hp[jx].y + hn[jx].y) - hc[jx].y;
          xx.z = 0.5f * (hp[jx].z + hn[jx].z) - hc[jx].z; xx.w = 0.5f * (hp[jx].w + hn[jx].w) - hc[jx].w;
          *(uint2*)(hr + 1024 + jx * 256 + lane * 4) = make_uint2(pack2(xx.x, xx.y), pack2(xx.z, xx.w));
        }
      }
#pragma unroll
      for (int jx = 0; jx < 4; jx++) { hp[jx] = hc[jx]; hc[jx] = hn[jx]; }
    }
  }
}

constexpr int LDT = 72;
DI void gemm_mainloop(const bf16_t* __restrict__ A, int lda, const bf16_t* __restrict__ Bt, int ldb, int K, char* smem, f32x16 (&acc)[2][2]) {
  const int tidx = opaque_tid();
  bf16_t* sA = (bf16_t*)smem;
  bf16_t* sB = sA + 2 * 128 * LDT;
  const int tid = tidx, lane = tid & 63, w = tid >> 6, wm = w >> 1, wn = w & 1;
  const int lrow = tid >> 3, lkc = (tid & 7) * 8;
#pragma unroll
  for (int mi = 0; mi < 2; mi++)
#pragma unroll
    for (int ni = 0; ni < 2; ni++)
#pragma unroll
      for (int r = 0; r < 16; r++) acc[mi][ni][r] = 0.f;
  const unsigned ao = (unsigned)(lrow * lda + lkc), bo = (unsigned)(lrow * ldb + lkc);
  uint4 ra[4], rb[4];
#pragma unroll
  for (int i = 0; i < 4; i++) { ra[i] = *(const uint4*)(A + (ao + (unsigned)(i * 32 * lda))); rb[i] = *(const uint4*)(Bt + (bo + (unsigned)(i * 32 * ldb))); }
#pragma unroll
  for (int i = 0; i < 4; i++) { *(uint4*)(sA + (lrow + 32 * i) * LDT + lkc) = ra[i]; *(uint4*)(sB + (lrow + 32 * i) * LDT + lkc) = rb[i]; }
  __syncthreads();
  const int nk = K >> 6;
  const int aoff = (wm * 64 + (lane & 31)) * LDT + (lane >> 5) * 8;
  const int boff = (wn * 64 + (lane & 31)) * LDT + (lane >> 5) * 8;
  for (int kt = 0; kt < nk; kt++) {
    const int cur = kt & 1;
    if (kt + 1 < nk) {
      const bf16_t* A1 = A + (kt + 1) * 64;
      const bf16_t* B1 = Bt + (kt + 1) * 64;
#pragma unroll
      for (int i = 0; i < 4; i++) { ra[i] = *(const uint4*)(A1 + (ao + (unsigned)(i * 32 * lda))); rb[i] = *(const uint4*)(B1 + (bo + (unsigned)(i * 32 * ldb))); }
    }
    const bf16_t* a_s = sA + cur * 128 * LDT + aoff;
    const bf16_t* b_s = sB + cur * 128 * LDT + boff;
#pragma unroll
    for (int kk = 0; kk < 4; kk++) {
      bf16x8 af[2], bq[2];
#pragma unroll
      for (int mi = 0; mi < 2; mi++) af[mi] = *(const bf16x8*)(a_s + mi * 32 * LDT + kk * 16);
#pragma unroll
      for (int ni = 0; ni < 2; ni++) bq[ni] = *(const bf16x8*)(b_s + ni * 32 * LDT + kk * 16);
#pragma unroll
      for (int mi = 0; mi < 2; mi++)
#pragma unroll
        for (int ni = 0; ni < 2; ni++) acc[mi][ni] = MFMA32(af[mi], bq[ni], acc[mi][ni]);
    }
    if (kt + 1 < nk) {
      bf16_t* a_w = sA + (cur ^ 1) * 128 * LDT;
      bf16_t* b_w = sB + (cur ^ 1) * 128 * LDT;
#pragma unroll
      for (int i = 0; i < 4; i++) { *(uint4*)(a_w + (lrow + 32 * i) * LDT + lkc) = ra[i]; *(uint4*)(b_w + (lrow + 32 * i) * LDT + lkc) = rb[i]; }
    }
    __syncthreads();
  }
}
constexpr int EST = 132;
DI void acc_to_lds(const f32x16 (&acc)[2][2], float* es) {
  const int tidx = opaque_tid();
  const int lane = tidx & 63, w = tidx >> 6, wm = w >> 1, wn = w & 1;
#pragma unroll
  for (int mi = 0; mi < 2; mi++)
#pragma unroll
    for (int ni = 0; ni < 2; ni++)
#pragma unroll
      for (int r = 0; r < 16; r++)
        es[(wm * 64 + mi * 32 + (r & 3) + 8 * (r >> 2) + 4 * (lane >> 5)) * EST + wn * 64 + ni * 32 + (lane & 31)] = acc[mi][ni][r];
}
#define EPI8_BEGIN                                                                   \
  {                                                                                  \
    float* es = (float*)smem;                                                        \
    acc_to_lds(acc, es);                                                             \
    __syncthreads();                                                                 \
    for (int pass = 0; pass < 8; pass++) {                                           \
      const int row = pass * 16 + (tidx >> 4), col = (tidx & 15) * 8;  \
      const float4 e_va = *(const float4*)(es + row * EST + col);                    \
      const float4 e_vb = *(const float4*)(es + row * EST + col + 4);                \
      float v[8] = {e_va.x, e_va.y, e_va.z, e_va.w, e_vb.x, e_vb.y, e_vb.z, e_vb.w};
#define EPI8_END                                                                     \
    }                                                                                \
    __syncthreads();                                                                 \
  }
DI uint4 pack8(const float (&v)[8]) { return make_uint4(pack2(v[0], v[1]), pack2(v[2], v[3]), pack2(v[4], v[5]), pack2(v[6], v[7])); }
DI void unpack8(const uint4 u, float (&v)[8]) {
  v[0] = lo_bf(u.x); v[1] = hi_bf(u.x); v[2] = lo_bf(u.y); v[3] = hi_bf(u.y); v[4] = lo_bf(u.z); v[5] = hi_bf(u.z); v[6] = lo_bf(u.w); v[7] = hi_bf(u.w);
}
DI void resid_update(float* xp, const float* gate, const float (&v)[8]) {
  float4 x0 = *(const float4*)xp, x1 = *(const float4*)(xp + 4);
  const float4 g0 = *(const float4*)gate, g1 = *(const float4*)(gate + 4);
  x0.x += g0.x * v[0]; x0.y += g0.y * v[1]; x0.z += g0.z * v[2]; x0.w += g0.w * v[3];
  x1.x += g1.x * v[4]; x1.y += g1.y * v[5]; x1.z += g1.z * v[6]; x1.w += g1.w * v[7];
  *(float4*)xp = x0; *(float4*)(xp + 4) = x1;
}

DI void phase_t1(const P& p, char* smem) {
  const int tidx = opaque_tid();
  const bf16_t* HX = (const bf16_t*)(p.ws + OFF_TR + TR_HX);
  const bf16_t* WL1 = (const bf16_t*)(p.ws + OFF_W) + W_L1;
  bf16_t* T1 = (bf16_t*)(p.ws + OFF_TR + TR_T1);
  for (int t = blockIdx.x; t < 136 * 5; t += gridDim.x) {
    const int nt = t % 5, lt = t / 5;
    f32x16 acc[2][2];
    gemm_mainloop(HX + (size_t)lt * 128 * 2048, 2048, WL1 + (size_t)nt * 128 * 2048, 2048, 2048, smem, acc);
    EPI8_BEGIN
      const int c = nt * 128 + col;
      if (c < 128) {
#pragma unroll
        for (int e = 0; e < 8; e++) v[e] = tanhf(v[e]);
      } else if (c >= 192 && c < 576) {
#pragma unroll
        for (int e = 0; e < 8; e++) v[e] = sigmoidf_(v[e]);
      }
      *(uint4*)(T1 + (size_t)(lt * 128 + row) * 640 + c) = pack8(v);
    EPI8_END
  }
}

DI void phase_feat(const P& p, int layer, int hf, char* smem) {
  const int tidx = opaque_tid();
  const int j = layer / 2;
  const bf16_t* W = (const bf16_t*)(p.ws + OFF_W);
  const bf16_t* HX = (const bf16_t*)(p.ws + OFF_TR + TR_HX);
  const bf16_t* T1 = (const bf16_t*)(p.ws + OFF_TR + TR_T1);
  bf16_t* VF = (bf16_t*)(p.ws + OFF_VF);
  for (int t = blockIdx.x; t < 136 * 24; t += gridDim.x) {
    const int mg = t / (8 * 24), rem = t % (8 * 24);
    const int nt = rem / 8, lt = mg * 8 + (rem % 8);
    const int s = nt / 8, n0 = (nt % 8) * 128;
    const int gt = half_gtile(hf, lt);
    f32x16 acc[2][2];
    bf16_t* outp = (bf16_t*)(p.ws + OFF_TR + (s == 0 ? TR_R : (s == 1 ? TR_K : TR_V)));
    if (s == 2 && j > 0) {
      gemm_mainloop(T1 + (size_t)lt * 128 * 640 + 576, 640, W + W_V2 + (size_t)n0 * 64, 64, 64, smem, acc);
      const float* v0 = p.rw_v0 + (size_t)(j - 1) * 1024;
      EPI8_BEGIN
        const int c = n0 + col;
#pragma unroll
        for (int e = 0; e < 8; e++) v[e] = sigmoidf_(v0[c + e] + v[e]);
        *(uint4*)(outp + (size_t)(lt * 128 + row) * 1024 + c) = pack8(v);
      EPI8_END
    }
    gemm_mainloop(HX + (size_t)lt * 128 * 2048, 2048, W + W_RKV + ((size_t)s * 1024 + n0) * 2048, 2048, 2048, smem, acc);
    if (s < 2) {
      EPI8_BEGIN
        *(uint4*)(outp + (size_t)(lt * 128 + row) * 1024 + n0 + col) = pack8(v);
      EPI8_END
    } else if (j == 0) {
      EPI8_BEGIN
        const uint4 u = pack8(v);
        *(uint4*)(outp + (size_t)(lt * 128 + row) * 1024 + n0 + col) = u;
        *(uint4*)(VF + (size_t)(gt * 128 + row) * 1024 + n0 + col) = u;
      EPI8_END
    } else {
      EPI8_BEGIN
        const size_t oi = (size_t)(lt * 128 + row) * 1024 + n0 + col;
        float sg[8], vf[8];
        unpack8(*(const uint4*)(outp + oi), sg);
        unpack8(*(const uint4*)(VF + (size_t)(gt * 128 + row) * 1024 + n0 + col), vf);
#pragma unroll
        for (int e = 0; e < 8; e++) v[e] = v[e] + (vf[e] - v[e]) * sg[e];
        *(uint4*)(outp + oi) = pack8(v);
      EPI8_END
    }
  }
  for (int t = blockIdx.x; t < 136 * 40; t += gridDim.x) {
    const int lt = t / 40, nt = t % 40;
    const int s = nt / 8, n0 = (nt % 8) * 128;
    f32x16 acc[2][2];
    if (s == 0) {
      gemm_mainloop(T1 + (size_t)lt * 128 * 640 + 128, 640, W + W_A2 + (size_t)n0 * 64, 64, 64, smem, acc);
      bf16_t* outp = (bf16_t*)(p.ws + OFF_TR + TR_A);
      const float* a0 = p.rw_a0 + (size_t)j * 1024;
      EPI8_BEGIN
#pragma unroll
        for (int e = 0; e < 8; e++) v[e] = sigmoidf_(a0[n0 + col + e] + v[e]);
        *(uint4*)(outp + (size_t)(lt * 128 + row) * 1024 + n0 + col) = pack8(v);
      EPI8_END
    } else if (s < 3) {
      const int d = s - 1;
      gemm_mainloop(T1 + (size_t)lt * 128 * 640 + d * 64, 640, W + W_W2 + (size_t)d * 65536 + (size_t)n0 * 64, 64, 64, smem, acc);
      bf16_t* outp = (bf16_t*)(p.ws + OFF_TR + (d ? TR_WL1 : TR_WL0));
      const float* w0 = p.rw_w0 + ((size_t)j * 2 + d) * 1024;
      EPI8_BEGIN
#pragma unroll
        for (int e = 0; e < 8; e++) {
          const float z = -(w0[n0 + col + e] + v[e]);
          const float sp = fmaxf(z, 0.f) + log1pf(__expf(-fabsf(z)));
          v[e] = -__expf(-sp - 0.5f);
        }
        *(uint4*)(outp + (size_t)(lt * 128 + row) * 1024 + n0 + col) = pack8(v);
      EPI8_END
    } else {
      const int d = s - 3;
      gemm_mainloop(T1 + (size_t)lt * 128 * 640 + 192 + d * 192, 640, W + W_G2 + (size_t)d * 196608 + (size_t)n0 * 192, 192, 192, smem, acc);
      bf16_t* outp = (bf16_t*)(p.ws + OFF_TR + (d ? TR_G1 : TR_G0));
      EPI8_BEGIN
        *(uint4*)(outp + (size_t)(lt * 128 + row) * 1024 + n0 + col) = pack8(v);
      EPI8_END
    }
  }
}

DI int scan_row(int bl, int dir, int pos) {
  if (pos < CL) { int t = dir ? (CL - 1 - pos) : pos; return 16384 + bl * CL + t; }
  int t = pos - CL; if (dir) t = SL - 1 - t;
  return bl * SL + t;
}

DI void phase_scan(const P& p, int layer, char* smem) {
  const int tidx = opaque_tid();
  const int j = layer / 2;
  const int tid = tidx;
  const bf16_t* R = (const bf16_t*)(p.ws + OFF_TR + TR_R);
  const bf16_t* Kx = (const bf16_t*)(p.ws + OFF_TR + TR_K);
  const bf16_t* V = (const bf16_t*)(p.ws + OFF_TR + TR_V);
  const bf16_t* Aa = (const bf16_t*)(p.ws + OFF_TR + TR_A);
  float* sbuf = (float*)smem;
  constexpr int BUFF = 5 * 16 * 64 + 256;
  float* obuf = sbuf + 2 * BUFF;
  const int ss = tid >> 4, c4 = tid & 15;
  const int rl = tid >> 4, cg = tid & 15;
  for (int item = blockIdx.x; item < 512; item += gridDim.x) {
    const int q = item & 3, dir = (item >> 2) & 1, head = (item >> 3) & 15, bl = item >> 7;
    const bf16_t* WL = (const bf16_t*)(p.ws + OFF_TR + (dir ? TR_WL1 : TR_WL0));
    bf16_t* O = (bf16_t*)(p.ws + OFF_TR + TR_HX) + (dir ? (size_t)HROWS * 1024 : 0);
    const int ch = head * 64 + c4 * 4;
    const float4 kkw = *(const float4*)(p.rw_kk + (size_t)j * 1024 + ch);
    const float4 kaw = *(const float4*)(p.rw_ka + (size_t)j * 1024 + ch);
    float S0 = 0.f, S1 = 0.f, S2 = 0.f, S3 = 0.f;
    uint2 gr_, gk_, ga_, gw_, gv_;
    gv_ = make_uint2(0, 0);
    auto issue = [&](int chunk) {
      const size_t ro = (size_t)scan_row(bl, dir, chunk * 16 + ss) * 1024;
      gr_ = *(const uint2*)(R + ro + ch); gk_ = *(const uint2*)(Kx + ro + ch);
      ga_ = *(const uint2*)(Aa + ro + ch); gw_ = *(const uint2*)(WL + ro + ch);
      if (c4 < 4) gv_ = *(const uint2*)(V + ro + head * 64 + q * 16 + c4 * 4);
    };
    auto stage = [&](int buf) {
      float* sb = sbuf + buf * BUFF;
      float r0 = lo_bf(gr_.x), r1 = hi_bf(gr_.x), r2 = lo_bf(gr_.y), r3 = hi_bf(gr_.y);
      float k0 = lo_bf(gk_.x), k1 = hi_bf(gk_.x), k2 = lo_bf(gk_.y), k3 = hi_bf(gk_.y);
      float a0 = lo_bf(ga_.x), a1 = hi_bf(ga_.x), a2 = lo_bf(ga_.y), a3 = hi_bf(ga_.y);
      float w0 = lo_bf(gw_.x), w1 = hi_bf(gw_.x), w2 = lo_bf(gw_.y), w3 = hi_bf(gw_.y);
      float u0 = k0 * kkw.x, u1 = k1 * kkw.y, u2 = k2 * kkw.z, u3 = k3 * kkw.w;
      float sq = rowsum16(u0 * u0 + u1 * u1 + u2 * u2 + u3 * u3);
      float inv = rsqrtf(fmaxf(sq, 1e-24f));
      u0 *= inv; u1 *= inv; u2 *= inv; u3 *= inv;
      const int o = ss * 64 + c4 * 4;
      *(float4*)(sb + 0 * 1024 + o) = make_float4(__expf(w0), __expf(w1), __expf(w2), __expf(w3));
      *(float4*)(sb + 1 * 1024 + o) = make_float4(k0 * (1.f + (a0 - 1.f) * kaw.x), k1 * (1.f + (a1 - 1.f) * kaw.y), k2 * (1.f + (a2 - 1.f) * kaw.z), k3 * (1.f + (a3 - 1.f) * kaw.w));
      *(float4*)(sb + 2 * 1024 + o) = make_float4(-u0, -u1, -u2, -u3);
      *(float4*)(sb + 3 * 1024 + o) = make_float4(u0 * a0, u1 * a1, u2 * a2, u3 * a3);
      *(float4*)(sb + 4 * 1024 + o) = make_float4(r0, r1, r2, r3);
      if (c4 < 4) *(float4*)(sb + 5 * 1024 + ss * 16 + c4 * 4) = make_float4(lo_bf(gv_.x), hi_bf(gv_.x), lo_bf(gv_.y), hi_bf(gv_.y));
    };
    __syncthreads();
    issue(0);
    stage(0);
    __syncthreads();
    constexpr int NCH = TK / 16;
    for (int chunk = 0; chunk < NCH; chunk++) {
      const int buf = chunk & 1;
      if (chunk + 1 < NCH) issue(chunk + 1);
      const float* sb = sbuf + buf * BUFF;
      float* ob = obuf + buf * 256;
#pragma unroll
      for (int s = 0; s < 16; s++) {
        const float4 w4 = *(const float4*)(sb + 0 * 1024 + s * 64 + cg * 4);
        const float4 k4 = *(const float4*)(sb + 1 * 1024 + s * 64 + cg * 4);
        const float4 n4 = *(const float4*)(sb + 2 * 1024 + s * 64 + cg * 4);
        const float4 b4 = *(const float4*)(sb + 3 * 1024 + s * 64 + cg * 4);
        const float4 r4 = *(const float4*)(sb + 4 * 1024 + s * 64 + cg * 4);
        const float vv = sb[5 * 1024 + s * 16 + rl];
        float sa = S0 * n4.x + S1 * n4.y + S2 * n4.z + S3 * n4.w;
        sa = rowsum16(sa);
        S0 = S0 * w4.x + (sa * b4.x + vv * k4.x);
        S1 = S1 * w4.y + (sa * b4.y + vv * k4.y);
        S2 = S2 * w4.z + (sa * b4.z + vv * k4.z);
        S3 = S3 * w4.w + (sa * b4.w + vv * k4.w);
        float o = S0 * r4.x + S1 * r4.y + S2 * r4.z + S3 * r4.w;
        o = rowsum16(o);
        if (cg == 0) ob[s * 16 + rl] = o;
      }
      if (chunk + 1 < NCH) stage(buf ^ 1);
      __syncthreads();
      {
        const int s = tid >> 4, rr = tid & 15;
        const size_t ro = (size_t)scan_row(bl, dir, chunk * 16 + s) * 1024;
        O[ro + head * 64 + q * 16 + rr] = f2bf(ob[s * 16 + rr]);
      }
    }
  }
}

DI void phase_combine(const P& p, int layer) {
  const int tidx = opaque_tid();
  const int j = layer / 2;
  const bf16_t* Of = (const bf16_t*)(p.ws + OFF_TR + TR_HX);
  const bf16_t* Ob = Of + (size_t)HROWS * 1024;
  const bf16_t* R = (const bf16_t*)(p.ws + OFF_TR + TR_R);
  const bf16_t* Kx = (const bf16_t*)(p.ws + OFF_TR + TR_K);
  const bf16_t* V = (const bf16_t*)(p.ws + OFF_TR + TR_V);
  const bf16_t* Aa = (const bf16_t*)(p.ws + OFF_TR + TR_A);
  bf16_t* G0 = (bf16_t*)(p.ws + OFF_TR + TR_G0);
  const bf16_t* G1 = (const bf16_t*)(p.ws + OFF_TR + TR_G1);
  const size_t total = (size_t)HROWS * 128;
  for (size_t i = (size_t)blockIdx.x * 256 + tidx; i < total; i += (size_t)gridDim.x * 256) {
    const int c0 = (int)(i & 127) * 8;
    const size_t off = (i >> 7) * 1024 + c0;
    const uint4 uof = *(const uint4*)(Of + off), uob = *(const uint4*)(Ob + off), ur = *(const uint4*)(R + off), uk = *(const uint4*)(Kx + off);
    const uint4 ua = *(const uint4*)(Aa + off), uv = *(const uint4*)(V + off), ug0 = *(const uint4*)(G0 + off), ug1 = *(const uint4*)(G1 + off);
    const unsigned aof[4] = {uof.x, uof.y, uof.z, uof.w}, aob[4] = {uob.x, uob.y, uob.z, uob.w}, ar[4] = {ur.x, ur.y, ur.z, ur.w}, ak[4] = {uk.x, uk.y, uk.z, uk.w};
    const unsigned aa[4] = {ua.x, ua.y, ua.z, ua.w}, av[4] = {uv.x, uv.y, uv.z, uv.w}, ag0[4] = {ug0.x, ug0.y, ug0.z, ug0.w}, ag1[4] = {ug1.x, ug1.y, ug1.z, ug1.w};
    const float* ka = p.rw_ka + (size_t)j * 1024 + c0;
    const float* rk = p.rw_rk + (size_t)j * 1024 + c0;
    const float* lg = p.rw_ln_g + (size_t)j * 1024 + c0;
    const float* lb = p.rw_ln_b + (size_t)j * 1024 + c0;
    float of[8], obv[8];
    float sf = 0.f, sf2 = 0.f, sb = 0.f, sb2 = 0.f, br = 0.f;
#pragma unroll
    for (int e = 0; e < 8; e++) {
      const int w = e >> 1;
      of[e] = (e & 1) ? hi_bf(aof[w]) : lo_bf(aof[w]);
      obv[e] = (e & 1) ? hi_bf(aob[w]) : lo_bf(aob[w]);
      const float r = (e & 1) ? hi_bf(ar[w]) : lo_bf(ar[w]);
      const float k = (e & 1) ? hi_bf(ak[w]) : lo_bf(ak[w]);
      const float a = (e & 1) ? hi_bf(aa[w]) : lo_bf(aa[w]);
      sf += of[e]; sf2 += of[e] * of[e]; sb += obv[e]; sb2 += obv[e] * obv[e];
      br += r * k * (1.f + (a - 1.f) * ka[e]) * rk[e];
    }
#pragma unroll
    for (int o = 1; o < 8; o <<= 1) { sf += __shfl_xor(sf, o); sf2 += __shfl_xor(sf2, o); sb += __shfl_xor(sb, o); sb2 += __shfl_xor(sb2, o); br += __shfl_xor(br, o); }
    const float muf = sf * (1.f / 64.f), mub = sb * (1.f / 64.f);
    const float rsf = rsqrtf(fmaxf(sf2 * (1.f / 64.f) - muf * muf, 0.f) + 64e-5f);
    const float rsb = rsqrtf(fmaxf(sb2 * (1.f / 64.f) - mub * mub, 0.f) + 64e-5f);
    float y[8];
#pragma unroll
    for (int e = 0; e < 8; e++) {
      const int w = e >> 1;
      const float v = (e & 1) ? hi_bf(av[w]) : lo_bf(av[w]);
      const float g0 = (e & 1) ? hi_bf(ag0[w]) : lo_bf(ag0[w]);
      const float g1 = (e & 1) ? hi_bf(ag1[w]) : lo_bf(ag1[w]);
      const float bonus = br * v;
      y[e] = ((of[e] - muf) * rsf * lg[e] + lb[e] + bonus) * g0 + ((obv[e] - mub) * rsb * lg[e] + lb[e] + bonus) * g1;
    }
    *(uint4*)(G0 + off) = make_uint4(pack2(y[0], y[1]), pack2(y[2], y[3]), pack2(y[4], y[5]), pack2(y[6], y[7]));
  }
}

DI void phase_rw_out(const P& p, int layer, int hf, char* smem) {
  const int tidx = opaque_tid();
  const bf16_t* Y = (const bf16_t*)(p.ws + OFF_TR + TR_G0);
  const bf16_t* WO = (const bf16_t*)(p.ws + OFF_W) + W_WO;
  const int nlt = (layer == 3) ? 128 : 136;
  for (int t = blockIdx.x; t < nlt * 8; t += gridDim.x) {
    const int lt = t / 8, n0 = (t % 8) * 128;
    const int gt = half_gtile(hf, lt);
    f32x16 acc[2][2];
    gemm_mainloop(Y + (size_t)lt * 128 * 1024, 1024, WO + (size_t)n0 * 1024, 1024, 1024, smem, acc);
    const float* gate = mods_ptr(p, layer, mod_row(gt * 128)) + 2048 + n0;
    float* xr = resid_row(p, gt * 128) + n0;
    EPI8_BEGIN
      resid_update(xr + (size_t)row * D + col, gate + col, v);
    EPI8_END
  }
}

DI void phase_mlp1(const P& p, int layer, char* smem) {
  const int tidx = opaque_tid();
  const bf16_t* H2 = (const bf16_t*)(p.ws + OFF_TR + TR_H2);
  const bf16_t* W1 = (const bf16_t*)(p.ws + OFF_W) + W_M1;
  bf16_t* HID = (bf16_t*)(p.ws + OFF_TR + TR_HID);
  const int nmt = (layer == 3) ? 256 : 272;
  const int ngrp = nmt / 16;
  for (int t = blockIdx.x; t < nmt * 32; t += gridDim.x) {
    const int mg = t / (16 * 32), rem = t % (16 * 32);
    const int nt = rem / 16, gt = mg * 16 + (rem % 16);
    (void)ngrp;
    f32x16 acc[2][2];
    gemm_mainloop(H2 + (size_t)gt * 128 * 1024, 1024, W1 + (size_t)nt * 128 * 1024, 1024, 1024, smem, acc);
    EPI8_BEGIN
#pragma unroll
      for (int e = 0; e < 8; e++) { const float rl = fmaxf(v[e], 0.f); v[e] = rl * rl; }
      *(uint4*)(HID + (size_t)(gt * 128 + row) * 4096 + nt * 128 + col) = pack8(v);
    EPI8_END
  }
}
DI void phase_mlp2(const P& p, int layer, char* smem) {
  const int tidx = opaque_tid();
  const bf16_t* HID = (const bf16_t*)(p.ws + OFF_TR + TR_HID);
  const bf16_t* W2 = (const bf16_t*)(p.ws + OFF_W) + W_M2;
  const int nmt = (layer == 3) ? 256 : 272;
  for (int t = blockIdx.x; t < nmt * 8; t += gridDim.x) {
    const int gt = t / 8, n0 = (t % 8) * 128;
    f32x16 acc[2][2];
    gemm_mainloop(HID + (size_t)gt * 128 * 4096, 4096, W2 + (size_t)n0 * 4096, 4096, 4096, smem, acc);
    const float* gate = mods_ptr(p, layer, mod_row(gt * 128)) + 5120 + n0;
    float* xr = resid_row(p, gt * 128) + n0;
    EPI8_BEGIN
      resid_update(xr + (size_t)row * D + col, gate + col, v);
    EPI8_END
  }
}

DI void phase_qkv(const P& p, char* smem) {
  const int tidx = opaque_tid();
  const bf16_t* H = (const bf16_t*)(p.ws + OFF_TR + TR_H);
  const bf16_t* WQ = (const bf16_t*)(p.ws + OFF_W) + W_QKV;
  bf16_t* Q = (bf16_t*)(p.ws + OFF_TR + TR_Q);
  bf16_t* Kb = (bf16_t*)(p.ws + OFF_TR + TR_KK);
  bf16_t* VT = (bf16_t*)(p.ws + OFF_TR + TR_VT);
  const float* cosT = (const float*)(p.ws + OFF_MISC);
  const float* sinT = cosT + 1024;
  for (int t = blockIdx.x; t < 272 * 24; t += gridDim.x) {
    const int mg = t / (16 * 24), rem = t % (16 * 24);
    const int nt = rem / 16, gt = mg * 16 + (rem % 16);
    f32x16 acc[2][2];
    gemm_mainloop(H + (size_t)gt * 128 * 1024, 1024, WQ + (size_t)nt * 128 * 1024, 1024, 1024, smem, acc);
    const bool lat = gt < 256;
    const int b = lat ? gt / 32 : (gt - 256) / 2;
    const int t0 = lat ? (gt % 32) * 128 : (gt - 256) % 2 * 128;
    const int tq0 = lat ? t0 : SL + t0;
    const int typ = nt / 8, h = nt % 8;
    if (typ < 2) {
      bf16_t* dst = typ == 0 ? Q : Kb;
      const float qs = typ == 0 ? 0.125f * 1.44269504088896f : 1.f;
      EPI8_BEGIN
        const int sidx = col >> 6, d0 = col & 63;
        if (lat) {
          const float4 pa = *(const float4*)(es + row * EST + (col ^ 16));
          const float4 pb = *(const float4*)(es + row * EST + (col ^ 16) + 4);
          const float pr[8] = {pa.x, pa.y, pa.z, pa.w, pb.x, pb.y, pb.z, pb.w};
          const int tt = t0 + row;
          const int pos = (d0 < 32) ? (tt >> 6) : (tt & 63);
          const float4 ca = *(const float4*)(cosT + pos * 16 + (d0 & 8)), cb = *(const float4*)(cosT + pos * 16 + (d0 & 8) + 4);
          const float4 sa = *(const float4*)(sinT + pos * 16 + (d0 & 8)), sb = *(const float4*)(sinT + pos * 16 + (d0 & 8) + 4);
          const float cs[8] = {ca.x, ca.y, ca.z, ca.w, cb.x, cb.y, cb.z, cb.w};
          const float sn[8] = {sa.x, sa.y, sa.z, sa.w, sb.x, sb.y, sb.z, sb.w};
          const float sgn = (d0 & 16) ? 1.f : -1.f;
#pragma unroll
          for (int e = 0; e < 8; e++) v[e] = v[e] * cs[e] + sgn * pr[e] * sn[e];
        }
#pragma unroll
        for (int e = 0; e < 8; e++) v[e] *= qs;
        *(uint4*)(dst + ((size_t)((b * 8 + h) * 2 + sidx) * TK + tq0 + row) * 64 + d0) = pack8(v);
      EPI8_END
    } else {
      float* es = (float*)smem;
      acc_to_lds(acc, es);
      __syncthreads();
      for (int pass = 0; pass < 8; pass++) {
        const int d = tidx & 127, tg = pass * 2 + (tidx >> 7);
        float v[8];
#pragma unroll
        for (int e = 0; e < 8; e++) v[e] = es[(tg * 8 + e) * EST + d];
        *(uint4*)(VT + ((size_t)(b * 8 + h) * 128 + d) * TK + tq0 + tg * 8) = pack8(v);
      }
      __syncthreads();
    }
  }
}

typedef _Float16 hv2 __attribute__((ext_vector_type(2)));
DI unsigned packh2(float a, float b) { hv2 r = {(_Float16)a, (_Float16)b}; return __builtin_bit_cast(unsigned, r); }
DI float lo_h(unsigned u) { hv2 r = __builtin_bit_cast(hv2, u); return (float)r[0]; }
DI float hi_h(unsigned u) { hv2 r = __builtin_bit_cast(hv2, u); return (float)r[1]; }

DI void phase_attn(const P& p, int layer, char* smem) {
  const int tidx = opaque_tid();
  const int j = layer / 2;
  const bool ctxq = layer != 3;
  const bf16_t* Q = (const bf16_t*)(p.ws + OFF_TR + TR_Q);
  const bf16_t* Kb = (const bf16_t*)(p.ws + OFF_TR + TR_KK);
  const bf16_t* VT = (const bf16_t*)(p.ws + OFF_TR + TR_VT);
  bf16_t* O = (bf16_t*)(p.ws + OFF_TR + TR_H);
  const float lam = ((const float*)(p.ws + OFF_MISC))[2048 + j];
  const float oml = 1.f - lambda_init(layer);
  const float* subg = p.da_subln_g + (size_t)j * 128;
  bf16_t* sK = (bf16_t*)smem;
  bf16_t* sV = sK + 2 * 64 * LDT;
  const int tid = tidx, lane = tid & 63, w = tid >> 6, g = lane >> 5, l31 = lane & 31;
  const int nitems = 2048 + (ctxq ? 128 : 0);
  for (int item = blockIdx.x; item < nitems; item += gridDim.x) {
    int b, h, q0, kbeg, ntiles;
    if (item < 2048) { b = item >> 8; h = (item >> 5) & 7; q0 = (item & 31) * 128; kbeg = 0; ntiles = TK / 64; }
    else { const int it = item - 2048; b = it >> 4; h = (it >> 1) & 7; q0 = SL + (it & 1) * 128; kbeg = SL; ntiles = CL / 64; }
    const bf16_t* Vp0 = VT + (size_t)(b * 8 + h) * 128 * TK;
    const int tq = q0 + w * 32 + l31;
    const size_t grow = tq < SL ? (size_t)b * SL + tq : (size_t)NLAT + (size_t)b * CL + (tq - SL);
    bf16_t* op = O + grow * 1024 + h * 128;
    for (int s = 0; s < 2; s++) {
      const bf16_t* Kp0 = Kb + (size_t)((b * 8 + h) * 2 + s) * TK * 64;
      const bf16_t* Qp = Q + ((size_t)((b * 8 + h) * 2 + s) * TK + tq) * 64 + g * 8;
      bf16x8 qf[4];
#pragma unroll
      for (int kk = 0; kk < 4; kk++) qf[kk] = *(const bf16x8*)(Qp + kk * 16);
      f32x16 o[4];
#pragma unroll
      for (int db = 0; db < 4; db++)
#pragma unroll
        for (int r = 0; r < 16; r++) o[db][r] = 0.f;
      float m = -1e30f, l = 0.f;
      uint4 rk0, rk1, rv0, rv1, rv2, rv3;
      const unsigned kvo = (unsigned)((tid >> 3) * 64 + (tid & 7) * 8);
      const unsigned vvo = (unsigned)((tid >> 3) * TK + (tid & 7) * 8);
      const unsigned sko = (unsigned)((tid >> 3) * LDT + (tid & 7) * 8);
#define ISSUE_KV(kt_)                                                             \
      {                                                                           \
        const bf16_t* kb_ = Kp0 + (size_t)(kbeg + (kt_) * 64) * 64;               \
        const bf16_t* vb_ = Vp0 + (kbeg + (kt_) * 64);                            \
        rk0 = *(const uint4*)(kb_ + kvo);                                         \
        rk1 = *(const uint4*)(kb_ + (kvo + 32u * 64u));                           \
        rv0 = *(const uint4*)(vb_ + vvo);                                         \
        rv1 = *(const uint4*)(vb_ + (vvo + 32u * (unsigned)TK));                  \
        rv2 = *(const uint4*)(vb_ + (vvo + 64u * (unsigned)TK));                  \
        rv3 = *(const uint4*)(vb_ + (vvo + 96u * (unsigned)TK));                  \
      }
#define STAGE_KV(buf_)                                                            \
      {                                                                           \
        bf16_t* ks_ = sK + (buf_) * 64 * LDT + sko;                               \
        bf16_t* vs_ = sV + (buf_) * 128 * LDT + sko;                              \
        *(uint4*)(ks_) = rk0;                                                     \
        *(uint4*)(ks_ + 32 * LDT) = rk1;                                          \
        *(uint4*)(vs_) = rv0;                                                     \
        *(uint4*)(vs_ + 32 * LDT) = rv1;                                          \
        *(uint4*)(vs_ + 64 * LDT) = rv2;                                          \
        *(uint4*)(vs_ + 96 * LDT) = rv3;                                          \
      }
      __syncthreads();
      ISSUE_KV(0);
      STAGE_KV(0);
      __syncthreads();
      for (int kt = 0; kt < ntiles; kt++) {
        const int buf = kt & 1;
        const bool more = kt + 1 < ntiles;
        if (more) ISSUE_KV(kt + 1);
        const bf16_t* kS = sK + buf * 64 * LDT;
        const bf16_t* vS = sV + buf * 128 * LDT;
#pragma unroll
        for (int kb = 0; kb < 2; kb++) {
          f32x16 st;
#pragma unroll
          for (int r = 0; r < 16; r++) st[r] = 0.f;
#pragma unroll
          for (int kk = 0; kk < 4; kk++) {
            const bf16x8 kf = *(const bf16x8*)(kS + (kb * 32 + l31) * LDT + kk * 16 + g * 8);
            st = MFMA32(kf, qf[kk], st);
          }
          float mx = st[0];
#pragma unroll
          for (int r = 1; r < 16; r++) mx = fmaxf(mx, st[r]);
          mx = fmaxf(mx, __shfl_xor(mx, 32));
          if (__any(mx > m + 8.f)) {
            const float mn = (mx > m + 8.f) ? mx : m;
            const float al = exp2f(m - mn);
            m = mn;
            l *= al;
#pragma unroll
            for (int db = 0; db < 4; db++)
#pragma unroll
              for (int r = 0; r < 16; r++) o[db][r] *= al;
          }
          float ls = 0.f;
          bf16x8 pk[2];
#pragma unroll
          for (int hh = 0; hh < 2; hh++) {
            float e[8];
#pragma unroll
            for (int i = 0; i < 8; i++) { e[i] = exp2f(st[hh * 8 + i] - m); ls += e[i]; }
            const uint4 u = make_uint4(pack2(e[0], e[1]), pack2(e[2], e[3]), pack2(e[4], e[5]), pack2(e[6], e[7]));
            pk[hh] = __builtin_bit_cast(bf16x8, u);
          }
          l += ls;
#pragma unroll
          for (int db = 0; db < 4; db++)
#pragma unroll
            for (int hh = 0; hh < 2; hh++) {
              const bf16_t* vp = vS + (db * 32 + l31) * LDT + kb * 32 + hh * 16 + 4 * g;
              const uint2 lo = *(const uint2*)vp;
              const uint2 hi = *(const uint2*)(vp + 8);
              const uint4 u = make_uint4(lo.x, lo.y, hi.x, hi.y);
              o[db] = MFMA32(__builtin_bit_cast(bf16x8, u), pk[hh], o[db]);
            }
        }
        if (more) STAGE_KV(buf ^ 1);
        __syncthreads();
      }
      const float lt = l + __shfl_xor(l, 32);
      if (s == 0) {
        const float inv = 1.f / lt;
#pragma unroll
        for (int db = 0; db < 4; db++)
#pragma unroll
          for (int rq = 0; rq < 4; rq++) {
            const int d = db * 32 + 8 * rq + 4 * g;
            *(uint2*)(op + d) = make_uint2(packh2(o[db][4 * rq] * inv, o[db][4 * rq + 1] * inv), packh2(o[db][4 * rq + 2] * inv, o[db][4 * rq + 3] * inv));
          }
      } else {
        const float inv = lam / lt;
        float ssq = 0.f;
#pragma unroll
        for (int db = 0; db < 4; db++)
#pragma unroll
          for (int rq = 0; rq < 4; rq++) {
            const int d = db * 32 + 8 * rq + 4 * g;
            const uint2 u0 = *(const uint2*)(op + d);
            const float a0 = lo_h(u0.x) - o[db][4 * rq] * inv, a1 = hi_h(u0.x) - o[db][4 * rq + 1] * inv;
            const float a2 = lo_h(u0.y) - o[db][4 * rq + 2] * inv, a3 = hi_h(u0.y) - o[db][4 * rq + 3] * inv;
            o[db][4 * rq] = a0; o[db][4 * rq + 1] = a1; o[db][4 * rq + 2] = a2; o[db][4 * rq + 3] = a3;
            ssq += a0 * a0 + a1 * a1 + a2 * a2 + a3 * a3;
          }
        ssq += __shfl_xor(ssq, 32);
        const float rs = rsqrtf(ssq * (1.f / 128.f) + 1e-5f) * oml;
#pragma unroll
        for (int db = 0; db < 4; db++)
#pragma unroll
          for (int rq = 0; rq < 4; rq++) {
            const int d = db * 32 + 8 * rq + 4 * g;
            const float4 sg = *(const float4*)(subg + d);
            *(uint2*)(op + d) = make_uint2(pack2(o[db][4 * rq] * rs * sg.x, o[db][4 * rq + 1] * rs * sg.y),
                                           pack2(o[db][4 * rq + 2] * rs * sg.z, o[db][4 * rq + 3] * rs * sg.w));
          }
      }
    }
  }
}

DI void phase_at_out(const P& p, int layer, char* smem) {
  const int tidx = opaque_tid();
  const bf16_t* O = (const bf16_t*)(p.ws + OFF_TR + TR_H);
  const bf16_t* WO = (const bf16_t*)(p.ws + OFF_W) + W_WO;
  const int nmt = (layer == 3) ? 256 : 272;
  for (int t = blockIdx.x; t < nmt * 8; t += gridDim.x) {
    const int gt = t / 8, n0 = (t % 8) * 128;
    f32x16 acc[2][2];
    gemm_mainloop(O + (size_t)gt * 128 * 1024, 1024, WO + (size_t)n0 * 1024, 1024, 1024, smem, acc);
    const float* gate = mods_ptr(p, layer, mod_row(gt * 128)) + 2048 + n0;
    float* xr = resid_row(p, gt * 128) + n0;
    EPI8_BEGIN
      resid_update(xr + (size_t)row * D + col, gate + col, v);
    EPI8_END
  }
}

DI void phase_final(const P& p) {
  const int tidx = opaque_tid();
  const int lane = tidx & 63, wv = tidx >> 6;
  for (int row = blockIdx.x * 4 + wv; row < NLAT; row += gridDim.x * 4) {
    float* xr = p.out + (size_t)row * D;
    float4 v[4];
    float ss = 0.f;
#pragma unroll
    for (int jx = 0; jx < 4; jx++) { v[jx] = *(const float4*)(xr + jx * 256 + lane * 4); ss += v[jx].x * v[jx].x + v[jx].y * v[jx].y + v[jx].z * v[jx].z + v[jx].w * v[jx].w; }
    ss = wave_sum(ss);
    const float rs = rsqrtf(ss * (1.f / 1024.f) + 1e-6f);
#pragma unroll
    for (int jx = 0; jx < 4; jx++) {
      const float4 g = *(const float4*)(p.final_g + jx * 256 + lane * 4);
      *(float4*)(xr + jx * 256 + lane * 4) = make_float4(v[jx].x * rs * g.x, v[jx].y * rs * g.y, v[jx].z * rs * g.z, v[jx].w * rs * g.w);
    }
  }
}

typedef __attribute__((address_space(1))) const float GCF;
typedef __attribute__((address_space(1))) float GF;
typedef __attribute__((address_space(1))) char GC;
DI unsigned long long lds_word(const unsigned long long* tbl, int i) {
  int z = i;
  asm volatile("" : "+v"(z));
  const unsigned long long v = tbl[z];
  const unsigned lo = __builtin_amdgcn_readfirstlane((unsigned)v), hi = __builtin_amdgcn_readfirstlane((unsigned)(v >> 32));
  return ((unsigned long long)hi << 32) | lo;
}
DI void load_params(P& q, const unsigned long long* tbl) {
  const float** fp = (const float**)&q;
#pragma unroll
  for (int i = 0; i < 36; i++) fp[i] = (const float*)(GCF*)lds_word(tbl, i);
  q.out = (float*)(GF*)lds_word(tbl, 36);
  q.ws = (char*)(GC*)lds_word(tbl, 37);
  q.only = 0;
  q.pad = 0;
}
__global__ void __launch_bounds__(256, 2) mega(P p) {
  __shared__ __attribute__((aligned(16))) char smem[73728];
  __shared__ unsigned long long s_tbl[40];
  {
#if defined(__HIP_DEVICE_COMPILE__)
    typedef __attribute__((address_space(4))) const unsigned long long KW;
    KW* kp = (KW*)__builtin_amdgcn_kernarg_segment_ptr();
    if (threadIdx.x < 39) s_tbl[threadIdx.x] = kp[threadIdx.x];
#endif
    __syncthreads();
  }
  const int only = (int)(unsigned)lds_word(s_tbl, 38);
  cg::grid_group grid = cg::this_grid();
  int step = 0;
#define STEP(body)                                   \
  {                                                  \
    if (only < 0 || only == step) {              \
      P q;                                           \
      load_params(q, s_tbl);                         \
      body;                                          \
    }                                                \
    step++;                                          \
    if (only < 0) grid.sync();                     \
  }
  STEP(phase_init(q, smem));
  for (int layer = 0; layer < 4; layer++) {
    STEP(phase_conv(q, layer, smem));
    if ((layer & 1) == 0) {
      for (int hf = 0; hf < 2; hf++) {
        STEP(phase_prep(q, layer, 0, hf, true, (bf16_t*)(q.ws + OFF_TR + TR_HX), 2048, false));
        STEP(phase_t1(q, smem));
        STEP(phase_feat(q, layer, hf, smem));
        STEP(phase_scan(q, layer, smem));
        STEP(phase_combine(q, layer));
        STEP(phase_rw_out(q, layer, hf, smem));
      }
    } else {
      STEP(phase_prep(q, layer, 0, -1, false, (bf16_t*)(q.ws + OFF_TR + TR_H), 1024, false));
      STEP(phase_qkv(q, smem));
      STEP(phase_attn(q, layer, smem));
      STEP(phase_at_out(q, layer, smem));
    }
    STEP(phase_prep(q, layer, 1, -1, false, (bf16_t*)(q.ws + OFF_TR + TR_H2), 1024, layer == 3));
    STEP(phase_mlp1(q, layer, smem));
    STEP(phase_mlp2(q, layer, smem));
  }
  STEP(phase_final(q));
}

#ifndef MULTI_LAUNCH
#define MULTI_LAUNCH 0
#endif
constexpr int NSTEPS = 1 + 2 * (1 + 12 + 3) + 2 * (1 + 4 + 3) + 1;

extern "C" void kernel_launch(void* const* d_in, const int* in_sizes, int n_in, void* d_out, int out_size, void* d_ws, size_t ws_size,
                              hipStream_t stream) {
  static int grid_blocks = 0;
  if (!grid_blocks) {
    int dev = 0, cus = 0, per_cu = 0;
    hipGetDevice(&dev);
    hipDeviceGetAttribute(&cus, hipDeviceAttributeMultiprocessorCount, dev);
    hipOccupancyMaxActiveBlocksPerMultiprocessor(&per_cu, mega, 256, 0);
    if (per_cu < 1) per_cu = 1;
    if (per_cu > 2) per_cu = 2;
    grid_blocks = cus * per_cu;
  }
  P p{};
  const float** fp = (const float**)&p;
  for (int i = 0; i < 36; i++) fp[i] = (const float*)d_in[i];
  p.out = (float*)d_out;
  p.ws = (char*)d_ws;
  p.pad = 0;
#if MULTI_LAUNCH
  for (int s = 0; s < NSTEPS; s++) {
    p.only = s;
    void* args[] = {&p};
    hipError_t e = hipLaunchCooperativeKernel((void*)mega, dim3(grid_blocks), dim3(256), args, 0, stream);
    if (e != hipSuccess) { fprintf(stderr, "launch failed: %s\n", hipGetErrorString(e)); break; }
  }
#else
  p.only = -1;
  void* args[] = {&p};
  hipError_t e = hipLaunchCooperativeKernel((void*)mega, dim3(grid_blocks), dim3(256), args, 0, stream);
  if (e != hipSuccess) fprintf(stderr, "cooperative launch failed: %s (grid %d)\n", hipGetErrorString(e), grid_blocks);
#endif
}
```

```cpp
#include <hip/hip_runtime.h>
#include <hip/hip_cooperative_groups.h>
#include <cstdio>
namespace cg = cooperative_groups;

#define DI __device__ __forceinline__
typedef unsigned short bf16_t;
using bf16x8 = __attribute__((ext_vector_type(8))) short;
using f32x16 = __attribute__((ext_vector_type(16))) float;
typedef __bf16 bfv2 __attribute__((ext_vector_type(2)));
typedef float fv2 __attribute__((ext_vector_type(2)));
#define MFMA32(a, b, c) __builtin_amdgcn_mfma_f32_32x32x16_bf16((a), (b), (c), 0, 0, 0)

constexpr int D = 1024, NB = 8, SL = 4096, CL = 256;
constexpr int NLAT = NB * SL, NCTX = NB * CL, NTOK = NLAT + NCTX;
constexpr int HROWS = NTOK / 2;
constexpr int TK = SL + CL;
constexpr size_t MiB = 1048576;
constexpr size_t OFF_W = 0, OFF_XC = 36 * MiB, OFF_MODS = 44 * MiB, OFF_MISC = 45 * MiB, OFF_VF = 46 * MiB, OFF_TR = 114 * MiB;
constexpr size_t W_RKV = 0;
constexpr size_t W_L1 = W_RKV + 3072ull * 2048;
constexpr size_t W_W2 = W_L1 + 640ull * 2048;
constexpr size_t W_A2 = W_W2 + 2ull * 65536;
constexpr size_t W_G2 = W_A2 + 65536;
constexpr size_t W_V2 = W_G2 + 2ull * 196608;
constexpr size_t W_WO = W_V2 + 65536;
constexpr size_t W_M1 = W_WO + 1048576;
constexpr size_t W_M2 = W_M1 + 4194304;
constexpr size_t W_QKV = 0;
constexpr size_t HALF_ARR = (size_t)HROWS * 1024 * 2;
constexpr size_t TR_HX = 0;
constexpr size_t TR_T1 = 2 * HALF_ARR;
constexpr size_t TR_R = TR_T1 + (size_t)HROWS * 640 * 2;
constexpr size_t TR_K = TR_R + HALF_ARR, TR_V = TR_K + HALF_ARR, TR_A = TR_V + HALF_ARR;
constexpr size_t TR_WL0 = TR_A + HALF_ARR, TR_WL1 = TR_WL0 + HALF_ARR, TR_G0 = TR_WL1 + HALF_ARR, TR_G1 = TR_G0 + HALF_ARR;
constexpr size_t FULL_ARR = (size_t)NTOK * 1024 * 2;
constexpr size_t TR_H = 0, TR_Q = FULL_ARR, TR_KK = 2 * FULL_ARR, TR_VT = 3 * FULL_ARR;
constexpr size_t TR_H2 = 0, TR_HID = FULL_ARR;

struct P {
  const float *x, *c, *ctx, *c_ctx, *ada_w, *ada_b, *norm_g, *final_g;
  const float *rw_mix, *rw_w_rkv, *rw_w0, *rw_w1, *rw_w2, *rw_a0, *rw_a1, *rw_a2, *rw_g1, *rw_g2, *rw_kk, *rw_ka, *rw_rk, *rw_ln_g, *rw_ln_b, *rw_w_o, *rw_v0, *rw_v1, *rw_v2;
  const float *da_w_qkv, *da_w_o, *da_lq1, *da_lk1, *da_lq2, *da_lk2, *da_subln_g, *mlp_w1, *mlp_w2;
  float* out;
  char* ws;
  int only;
  int pad;
};

DI float bf2f(bf16_t h) { return __uint_as_float(((unsigned)h) << 16); }
DI unsigned pack2(float a, float b) { fv2 v = {a, b}; bfv2 r = __builtin_convertvector(v, bfv2); return __builtin_bit_cast(unsigned, r); }
DI bf16_t f2bf(float a) { return (bf16_t)(pack2(a, 0.f) & 0xffffu); }
DI float lo_bf(unsigned u) { return __uint_as_float(u << 16); }
DI float hi_bf(unsigned u) { return __uint_as_float(u & 0xffff0000u); }
DI float sigmoidf_(float x) { return 1.f / (1.f + __expf(-x)); }
DI float wave_sum(float v) {
#pragma unroll
  for (int o = 32; o > 0; o >>= 1) v += __shfl_xor(v, o);
  return v;
}
template <int N> DI float ror_add(float x) { return x + __builtin_bit_cast(float, __builtin_amdgcn_mov_dpp(__builtin_bit_cast(int, x), 0x120 + N, 0xf, 0xf, true)); }
DI float rowsum16(float x) { x = ror_add<8>(x); x = ror_add<4>(x); x = ror_add<2>(x); x = ror_add<1>(x); return x; }

DI int opaque_tid() { int t = threadIdx.x; asm volatile("" : "+v"(t)); return t; }
DI float* resid_row(const P& p, int gr) { return gr < NLAT ? p.out + (size_t)gr * D : (float*)(p.ws + OFF_XC) + (size_t)(gr - NLAT) * D; }
DI int mod_row(int gr) { return gr < NLAT ? gr / SL : 8; }
DI const float* mods_ptr(const P& p, int layer, int mrow) { return (const float*)(p.ws + OFF_MODS) + ((size_t)layer * 9 + mrow) * 6144; }
DI int half_gtile(int hf, int lt) { return lt < 128 ? hf * 128 + lt : 256 + hf * 8 + (lt - 128); }
DI int first_tile(int base) { int g = gridDim.x; int s = (int)blockIdx.x - (base % g); if (s < 0) s += g; return s; }
DI float lambda_init(int layer) { return 0.8f - 0.6f * expf(-0.3f * (float)layer); }

DI void phase_init(const P& p, char* smem) {
  const int tidx = opaque_tid();
  const int tid = tidx;
  float* sc = (float*)smem;
  float* mods = (float*)(p.ws + OFF_MODS);
  for (int item = blockIdx.x; item < 96; item += gridDim.x) {
    const int layer = item / 24, cb = item % 24;
    __syncthreads();
    for (int i = tid; i < 9 * 1024; i += 256) {
      int r = i >> 10, k = i & 1023;
      float v = r < 8 ? p.c[r * 1024 + k] : p.c_ctx[k];
      sc[i] = v / (1.f + expf(-v));
    }
    __syncthreads();
    const int w = tid >> 6, q = tid & 63;
    float4 acc[9];
#pragma unroll
    for (int r = 0; r < 9; r++) acc[r] = make_float4(0.f, 0.f, 0.f, 0.f);
    const float* wp = p.ada_w + (size_t)layer * 1024 * 6144 + cb * 256 + q * 4;
    for (int k = w * 256; k < w * 256 + 256; k++) {
      float4 wv = *(const float4*)(wp + (size_t)k * 6144);
#pragma unroll
      for (int r = 0; r < 9; r++) {
        float s = sc[r * 1024 + k];
        acc[r].x += s * wv.x; acc[r].y += s * wv.y; acc[r].z += s * wv.z; acc[r].w += s * wv.w;
      }
    }
    __syncthreads();
    float4* red = (float4*)smem;
#pragma unroll
    for (int r = 0; r < 9; r++) red[(w * 9 + r) * 64 + q] = acc[r];
    __syncthreads();
    for (int i = tid; i < 9 * 64; i += 256) {
      int r = i / 64, qq = i % 64;
      float4 s0 = red[(0 * 9 + r) * 64 + qq], s1 = red[(1 * 9 + r) * 64 + qq], s2 = red[(2 * 9 + r) * 64 + qq], s3 = red[(3 * 9 + r) * 64 + qq];
      float4 bb = *(const float4*)(p.ada_b + layer * 6144 + cb * 256 + qq * 4);
      float4 o = make_float4(s0.x + s1.x + s2.x + s3.x + bb.x, s0.y + s1.y + s2.y + s3.y + bb.y, s0.z + s1.z + s2.z + s3.z + bb.z, s0.w + s1.w + s2.w + s3.w + bb.w);
      *(float4*)(mods + ((size_t)layer * 9 + r) * 6144 + cb * 256 + qq * 4) = o;
    }
  }
  if (blockIdx.x == gridDim.x - 1) {
    float* misc = (float*)(p.ws + OFF_MISC);
    for (int i = tid; i < 1024; i += 256) {
      int pos = i / 16, f = i % 16;
      float inv = powf(10000.f, -(float)f / 16.f);
      float ang = (float)pos * inv;
      misc[i] = cosf(ang);
      misc[1024 + i] = sinf(ang);
    }
    if (tid < 2) {
      float s1 = 0.f, s2 = 0.f;
      for (int k = 0; k < 64; k++) { s1 += p.da_lq1[tid * 64 + k] * p.da_lk1[tid * 64 + k]; s2 += p.da_lq2[tid * 64 + k] * p.da_lk2[tid * 64 + k]; }
      misc[2048 + tid] = expf(s1) - expf(s2) + lambda_init(2 * tid + 1);
    }
  }
  const size_t n4 = (size_t)NLAT * D / 4, c4 = (size_t)NCTX * D / 4;
  const float4* xs = (const float4*)p.x; float4* xo = (float4*)p.out;
  for (size_t i = (size_t)blockIdx.x * 256 + tid; i < n4; i += (size_t)gridDim.x * 256) xo[i] = xs[i];
  const float4* cs = (const float4*)p.ctx; float4* co = (float4*)(p.ws + OFF_XC);
  for (size_t i = (size_t)blockIdx.x * 256 + tid; i < c4; i += (size_t)gridDim.x * 256) co[i] = cs[i];
}

DI void conv_mat(const float* __restrict__ src, int K, int N, bf16_t* __restrict__ dst, int ldd, int koff, const float* __restrict__ scale,
                 int Kp, int Np, float* sm, int& base) {
  const int tidx = opaque_tid();
  const int tid = tidx;
  const int tk = Kp / 64, tn = Np / 64, nt = tk * tn;
  for (int t = first_tile(base); t < nt; t += gridDim.x) {
    const int k0 = (t / tn) * 64, n0 = (t % tn) * 64;
    __syncthreads();
#pragma unroll
    for (int i = 0; i < 4; i++) {
      int kr = (tid >> 4) + 16 * i, nc = (tid & 15) * 4;
      float4 v = make_float4(0.f, 0.f, 0.f, 0.f);
      if (src != nullptr && k0 + kr < K && n0 + nc < N) {
        v = *(const float4*)(src + (size_t)(k0 + kr) * N + n0 + nc);
        if (scale) { float s = scale[k0 + kr]; v.x *= s; v.y *= s; v.z *= s; v.w *= s; }
      }
      sm[kr * 65 + nc + 0] = v.x; sm[kr * 65 + nc + 1] = v.y; sm[kr * 65 + nc + 2] = v.z; sm[kr * 65 + nc + 3] = v.w;
    }
    __syncthreads();
    const int n = tid >> 2, kb = (tid & 3) * 16;
    unsigned o[8];
#pragma unroll
    for (int i = 0; i < 8; i++) o[i] = pack2(sm[(kb + 2 * i) * 65 + n], sm[(kb + 2 * i + 1) * 65 + n]);
    uint4* dp = (uint4*)(dst + (size_t)(n0 + n) * ldd + koff + k0 + kb);
    dp[0] = make_uint4(o[0], o[1], o[2], o[3]);
    dp[1] = make_uint4(o[4], o[5], o[6], o[7]);
  }
  base += nt;
}

DI void phase_conv(const P& p, int layer, char* smem) {
  float* sm = (float*)smem;
  bf16_t* W = (bf16_t*)(p.ws + OFF_W);
  int base = 0;
  const int j = layer / 2;
  if ((layer & 1) == 0) {
    const int mixsel[3] = {0, 2, 3};
    for (int s = 0; s < 3; s++) {
      const float* src = p.rw_w_rkv + ((size_t)j * 3 + s) * 1048576;
      conv_mat(src, 1024, 1024, W + W_RKV + (size_t)s * 1024 * 2048, 2048, 0, nullptr, 1024, 1024, sm, base);
      conv_mat(src, 1024, 1024, W + W_RKV + (size_t)s * 1024 * 2048, 2048, 1024, p.rw_mix + ((size_t)j * 6 + mixsel[s]) * 1024, 1024, 1024, sm, base);
    }
    for (int pass = 0; pass < 2; pass++) {
      const int ko = pass * 1024;
      const float* m1 = pass ? p.rw_mix + ((size_t)j * 6 + 1) * 1024 : nullptr;
      const float* m4 = pass ? p.rw_mix + ((size_t)j * 6 + 4) * 1024 : nullptr;
      const float* m5 = pass ? p.rw_mix + ((size_t)j * 6 + 5) * 1024 : nullptr;
      const float* m3 = pass ? p.rw_mix + ((size_t)j * 6 + 3) * 1024 : nullptr;
      bf16_t* L1 = W + W_L1;
      conv_mat(p.rw_w1 + ((size_t)j * 2 + 0) * 65536, 1024, 64, L1 + 0ull * 2048, 2048, ko, m1, 1024, 64, sm, base);
      conv_mat(p.rw_w1 + ((size_t)j * 2 + 1) * 65536, 1024, 64, L1 + 64ull * 2048, 2048, ko, m1, 1024, 64, sm, base);
      conv_mat(p.rw_a1 + (size_t)j * 65536, 1024, 64, L1 + 128ull * 2048, 2048, ko, m4, 1024, 64, sm, base);
      conv_mat(p.rw_g1 + ((size_t)j * 2 + 0) * 163840, 1024, 160, L1 + 192ull * 2048, 2048, ko, m5, 1024, 192, sm, base);
      conv_mat(p.rw_g1 + ((size_t)j * 2 + 1) * 163840, 1024, 160, L1 + 384ull * 2048, 2048, ko, m5, 1024, 192, sm, base);
      conv_mat(j > 0 ? p.rw_v1 + (size_t)(j - 1) * 32768 : nullptr, 1024, 32, L1 + 576ull * 2048, 2048, ko, m3, 1024, 64, sm, base);
    }
    conv_mat(p.rw_w2 + ((size_t)j * 2 + 0) * 65536, 64, 1024, W + W_W2, 64, 0, nullptr, 64, 1024, sm, base);
    conv_mat(p.rw_w2 + ((size_t)j * 2 + 1) * 65536, 64, 1024, W + W_W2 + 65536, 64, 0, nullptr, 64, 1024, sm, base);
    conv_mat(p.rw_a2 + (size_t)j * 65536, 64, 1024, W + W_A2, 64, 0, nullptr, 64, 1024, sm, base);
    conv_mat(p.rw_g2 + ((size_t)j * 2 + 0) * 163840, 160, 1024, W + W_G2, 192, 0, nullptr, 192, 1024, sm, base);
    conv_mat(p.rw_g2 + ((size_t)j * 2 + 1) * 163840, 160, 1024, W + W_G2 + 196608, 192, 0, nullptr, 192, 1024, sm, base);
    conv_mat(j > 0 ? p.rw_v2 + (size_t)(j - 1) * 32768 : nullptr, 32, 1024, W + W_V2, 64, 0, nullptr, 64, 1024, sm, base);
    conv_mat(p.rw_w_o + (size_t)j * 1048576, 1024, 1024, W + W_WO, 1024, 0, nullptr, 1024, 1024, sm, base);
  } else {
    conv_mat(p.da_w_qkv + (size_t)j * 3145728, 1024, 3072, W + W_QKV, 1024, 0, nullptr, 1024, 3072, sm, base);
    conv_mat(p.da_w_o + (size_t)j * 1048576, 1024, 1024, W + W_WO, 1024, 0, nullptr, 1024, 1024, sm, base);
  }
  conv_mat(p.mlp_w1 + (size_t)layer * 4194304, 1024, 4096, W + W_M1, 1024, 0, nullptr, 1024, 4096, sm, base);
  conv_mat(p.mlp_w2 + (size_t)layer * 4194304, 4096, 1024, W + W_M2, 4096, 0, nullptr, 4096, 1024, sm, base);
}

DI void phase_prep(const P& p, int layer, int sub, int hf, bool shift, bf16_t* H, int ldh, bool skip_ctx) {
  const int tidx = opaque_tid();
  const int lane = tidx & 63, wv = tidx >> 6;
  const int nrows = hf < 0 ? (skip_ctx ? NLAT : NTOK) : HROWS;
  const int nseg = nrows / 8;
  const float* ng = p.norm_g + ((size_t)layer * 2 + sub) * 1024;
  for (int seg = blockIdx.x * 4 + wv; seg < nseg; seg += gridDim.x * 4) {
    const int lr0 = seg * 8;
    const int gr0 = hf < 0 ? lr0 : (lr0 < 16384 ? hf * 16384 + lr0 : NLAT + hf * 1024 + (lr0 - 16384));
    const bool lat = gr0 < NLAT;
    const int T = lat ? SL : CL;
    const int t0 = lat ? (gr0 % SL) : ((gr0 - NLAT) % CL);
    const float* xbase = resid_row(p, gr0);
    const float* md = mods_ptr(p, layer, mod_row(gr0));
    float4 g4[4], sc4[4], sh4[4];
#pragma unroll
    for (int jx = 0; jx < 4; jx++) {
      int ch = jx * 256 + lane * 4;
      g4[jx] = *(const float4*)(ng + ch);
      sh4[jx] = *(const float4*)(md + sub * 3072 + ch);
      sc4[jx] = *(const float4*)(md + sub * 3072 + 1024 + ch);
      g4[jx].x *= (1.f + sc4[jx].x); g4[jx].y *= (1.f + sc4[jx].y); g4[jx].z *= (1.f + sc4[jx].z); g4[jx].w *= (1.f + sc4[jx].w);
    }
    float4 hp[4], hc[4], hn[4];
    const int tb = shift ? -1 : 0, te = shift ? 9 : 8;
    for (int tt = tb; tt < te; tt++) {
      const int t = t0 + tt;
      if (t >= 0 && t < T) {
        const float* xr = xbase + (ptrdiff_t)tt * D;
        float ss = 0.f;
#pragma unroll
        for (int jx = 0; jx < 4; jx++) {
          hn[jx] = *(const float4*)(xr + jx * 256 + lane * 4);
          ss += hn[jx].x * hn[jx].x + hn[jx].y * hn[jx].y + hn[jx].z * hn[jx].z + hn[jx].w * hn[jx].w;
        }
        ss = wave_sum(ss);
        const float rs = rsqrtf(ss * (1.f / 1024.f) + 1e-6f);
#pragma unroll
        for (int jx = 0; jx < 4; jx++) {
          hn[jx].x = hn[jx].x * rs * g4[jx].x + sh4[jx].x; hn[jx].y = hn[jx].y * rs * g4[jx].y + sh4[jx].y;
          hn[jx].z = hn[jx].z * rs * g4[jx].z + sh4[jx].z; hn[jx].w = hn[jx].w * rs * g4[jx].w + sh4[jx].w;
        }
      } else {
#pragma unroll
        for (int jx = 0; jx < 4; jx++) hn[jx] = make_float4(0.f, 0.f, 0.f, 0.f);
      }
      if (!shift) {
        bf16_t* hr = H + (size_t)(lr0 + tt) * ldh;
#pragma unroll
        for (int jx = 0; jx < 4; jx++) *(uint2*)(hr + jx * 256 + lane * 4) = make_uint2(pack2(hn[jx].x, hn[jx].y), pack2(hn[jx].z, hn[jx].w));
      } else if (tt >= 1) {
        bf16_t* hr = H + (size_t)(lr0 + tt - 1) * ldh;
#pragma unroll
        for (int jx = 0; jx < 4; jx++) {
          *(uint2*)(hr + jx * 256 + lane * 4) = make_uint2(pack2(hc[jx].x, hc[jx].y), pack2(hc[jx].z, hc[jx].w));
          float4 xx;
          xx.x = 0.5f * (hp[jx].x + hn[jx].x) - hc[jx].x; xx.y = 0.5f * (hp[jx].y + hn[jx].y) - hc[jx].y;
          xx.z = 0.5f * (hp[jx].z + hn[jx].z) - hc[jx].z; xx.w = 0.5f * (hp[jx].w + hn[jx].w) - hc[jx].w;
          *(uint2*)(hr + 1024 + jx * 256 + lane * 4) = make_uint2(pack2(xx.x, xx.y), pack2(xx.z, xx.w));
        }
      }
#pragma unroll
      for (int jx = 0; jx < 4; jx++) { hp[jx] = hc[jx]; hc[jx] = hn[jx]; }
    }
  }
}

constexpr int LDT = 72;
DI void gemm_mainloop(const bf16_t* __restrict__ A, int lda, const bf16_t* __restrict__ Bt, int ldb, int K, char* smem, f32x16 (&acc)[2][2]) {
  const int tidx = opaque_tid();
  bf16_t* sA = (bf16_t*)smem;
  bf16_t* sB = sA + 2 * 128 * LDT;
  const int tid = tidx, lane = tid & 63, w = tid >> 6, wm = w >> 1, wn = w & 1;
  const int lrow = tid >> 3, lkc = (tid & 7) * 8;
#pragma unroll
  for (int mi = 0; mi < 2; mi++)
#pragma unroll
    for (int ni = 0; ni < 2; ni++)
#pragma unroll
      for (int r = 0; r < 16; r++) acc[mi][ni][r] = 0.f;
  const unsigned ao = (unsigned)(lrow * lda + lkc), bo = (unsigned)(lrow * ldb + lkc);
  const unsigned a32 = (unsigned)(32 * lda), b32 = (unsigned)(32 * ldb);
  uint4 ra0, ra1, ra2, ra3, rb0, rb1, rb2, rb3;
#define G_LOAD(Ab, Bb)                                                                                   \
  {                                                                                                      \
    ra0 = *(const uint4*)((Ab) + ao); ra1 = *(const uint4*)((Ab) + (ao + a32));                          \
    ra2 = *(const uint4*)((Ab) + (ao + 2 * a32)); ra3 = *(const uint4*)((Ab) + (ao + 3 * a32));          \
    rb0 = *(const uint4*)((Bb) + bo); rb1 = *(const uint4*)((Bb) + (bo + b32));                          \
    rb2 = *(const uint4*)((Bb) + (bo + 2 * b32)); rb3 = *(const uint4*)((Bb) + (bo + 3 * b32));          \
  }
#define G_STORE(sa_, sb_)                                                                                \
  {                                                                                                      \
    bf16_t* a_w = (sa_) + lrow * LDT + lkc;                                                              \
    bf16_t* b_w = (sb_) + lrow * LDT + lkc;                                                              \
    *(uint4*)(a_w) = ra0; *(uint4*)(a_w + 32 * LDT) = ra1; *(uint4*)(a_w + 64 * LDT) = ra2; *(uint4*)(a_w + 96 * LDT) = ra3; \
    *(uint4*)(b_w) = rb0; *(uint4*)(b_w + 32 * LDT) = rb1; *(uint4*)(b_w + 64 * LDT) = rb2; *(uint4*)(b_w + 96 * LDT) = rb3; \
  }
  G_LOAD(A, Bt);
  G_STORE(sA, sB);
  __syncthreads();
  const int nk = K >> 6;
  const int aoff = (wm * 64 + (lane & 31)) * LDT + (lane >> 5) * 8;
  const int boff = (wn * 64 + (lane & 31)) * LDT + (lane >> 5) * 8;
  for (int kt = 0; kt < nk; kt++) {
    const int cur = kt & 1;
    if (kt + 1 < nk) {
      const bf16_t* A1 = A + (kt + 1) * 64;
      const bf16_t* B1 = Bt + (kt + 1) * 64;
      G_LOAD(A1, B1);
    }
    __builtin_amdgcn_sched_barrier(0);
    const bf16_t* a_s = sA + cur * 128 * LDT + aoff;
    const bf16_t* b_s = sB + cur * 128 * LDT + boff;
#pragma unroll
    for (int kk = 0; kk < 4; kk++) {
      bf16x8 af[2], bq[2];
#pragma unroll
      for (int mi = 0; mi < 2; mi++) af[mi] = *(const bf16x8*)(a_s + mi * 32 * LDT + kk * 16);
#pragma unroll
      for (int ni = 0; ni < 2; ni++) bq[ni] = *(const bf16x8*)(b_s + ni * 32 * LDT + kk * 16);
#pragma unroll
      for (int mi = 0; mi < 2; mi++)
#pragma unroll
        for (int ni = 0; ni < 2; ni++) acc[mi][ni] = MFMA32(af[mi], bq[ni], acc[mi][ni]);
    }
    __builtin_amdgcn_sched_barrier(0);
    if (kt + 1 < nk) G_STORE(sA + (cur ^ 1) * 128 * LDT, sB + (cur ^ 1) * 128 * LDT);
    __syncthreads();
  }
}
constexpr int EST = 132;
DI void acc_to_lds(const f32x16 (&acc)[2][2], float* es) {
  const int tidx = opaque_tid();
  const int lane = tidx & 63, w = tidx >> 6, wm = w >> 1, wn = w & 1;
#pragma unroll
  for (int mi = 0; mi < 2; mi++)
#pragma unroll
    for (int ni = 0; ni < 2; ni++)
#pragma unroll
      for (int r = 0; r < 16; r++)
        es[(wm * 64 + mi * 32 + (r & 3) + 8 * (r >> 2) + 4 * (lane >> 5)) * EST + wn * 64 + ni * 32 + (lane & 31)] = acc[mi][ni][r];
}
#define EPI8_BEGIN                                                                   \
  {                                                                                  \
    float* es = (float*)smem;                                                        \
    acc_to_lds(acc, es);                                                             \
    __syncthreads();                                                                 \
    for (int pass = 0; pass < 8; pass++) {                                           \
      const int row = pass * 16 + (tidx >> 4), col = (tidx & 15) * 8;  \
      const float4 e_va = *(const float4*)(es + row * EST + col);                    \
      const float4 e_vb = *(const float4*)(es + row * EST + col + 4);                \
      float v[8] = {e_va.x, e_va.y, e_va.z, e_va.w, e_vb.x, e_vb.y, e_vb.z, e_vb.w};
#define EPI8_END                                                                     \
    }                                                                                \
    __syncthreads();                                                                 \
  }
DI uint4 pack8(const float (&v)[8]) { return make_uint4(pack2(v[0], v[1]), pack2(v[2], v[3]), pack2(v[4], v[5]), pack2(v[6], v[7])); }
DI void unpack8(const uint4 u, float (&v)[8]) {
  v[0] = lo_bf(u.x); v[1] = hi_bf(u.x); v[2] = lo_bf(u.y); v[3] = hi_bf(u.y); v[4] = lo_bf(u.z); v[5] = hi_bf(u.z); v[6] = lo_bf(u.w); v[7] = hi_bf(u.w);
}
DI void resid_update(float* xp, const float* gate, const float (&v)[8]) {
  float4 x0 = *(const float4*)xp, x1 = *(const float4*)(xp + 4);
  const float4 g0 = *(const float4*)gate, g1 = *(const float4*)(gate + 4);
  x0.x += g0.x * v[0]; x0.y += g0.y * v[1]; x0.z += g0.z * v[2]; x0.w += g0.w * v[3];
  x1.x += g1.x * v[4]; x1.y += g1.y * v[5]; x1.z += g1.z * v[6]; x1.w += g1.w * v[7];
  *(float4*)xp = x0; *(float4*)(xp + 4) = x1;
}

DI void phase_t1(const P& p, char* smem) {
  const int tidx = opaque_tid();
  const bf16_t* HX = (const bf16_t*)(p.ws + OFF_TR + TR_HX);
  const bf16_t* WL1 = (const bf16_t*)(p.ws + OFF_W) + W_L1;
  bf16_t* T1 = (bf16_t*)(p.ws + OFF_TR + TR_T1);
  for (int t = blockIdx.x; t < 136 * 5; t += gridDim.x) {
    const int nt = t % 5, lt = t / 5;
    f32x16 acc[2][2];
    gemm_mainloop(HX + (size_t)lt * 128 * 2048, 2048, WL1 + (size_t)nt * 128 * 2048, 2048, 2048, smem, acc);
    EPI8_BEGIN
      const int c = nt * 128 + col;
      if (c < 128) {
#pragma unroll
        for (int e = 0; e < 8; e++) v[e] = tanhf(v[e]);
      } else if (c >= 192 && c < 576) {
#pragma unroll
        for (int e = 0; e < 8; e++) v[e] = sigmoidf_(v[e]);
      }
      *(uint4*)(T1 + (size_t)(lt * 128 + row) * 640 + c) = pack8(v);
    EPI8_END
  }
}

DI void phase_feat(const P& p, int layer, int hf, char* smem) {
  const int tidx = opaque_tid();
  const int j = layer / 2;
  const bf16_t* W = (const bf16_t*)(p.ws + OFF_W);
  const bf16_t* HX = (const bf16_t*)(p.ws + OFF_TR + TR_HX);
  const bf16_t* T1 = (const bf16_t*)(p.ws + OFF_TR + TR_T1);
  bf16_t* VF = (bf16_t*)(p.ws + OFF_VF);
  for (int t = blockIdx.x; t < 136 * 24; t += gridDim.x) {
    const int mg = t / (8 * 24), rem = t % (8 * 24);
    const int nt = rem / 8, lt = mg * 8 + (rem % 8);
    const int s = nt / 8, n0 = (nt % 8) * 128;
    const int gt = half_gtile(hf, lt);
    f32x16 acc[2][2];
    bf16_t* outp = (bf16_t*)(p.ws + OFF_TR + (s == 0 ? TR_R : (s == 1 ? TR_K : TR_V)));
    if (s == 2 && j > 0) {
      gemm_mainloop(T1 + (size_t)lt * 128 * 640 + 576, 640, W + W_V2 + (size_t)n0 * 64, 64, 64, smem, acc);
      const float* v0 = p.rw_v0 + (size_t)(j - 1) * 1024;
      EPI8_BEGIN
        const int c = n0 + col;
#pragma unroll
        for (int e = 0; e < 8; e++) v[e] = sigmoidf_(v0[c + e] + v[e]);
        *(uint4*)(outp + (size_t)(lt * 128 + row) * 1024 + c) = pack8(v);
      EPI8_END
    }
    gemm_mainloop(HX + (size_t)lt * 128 * 2048, 2048, W + W_RKV + ((size_t)s * 1024 + n0) * 2048, 2048, 2048, smem, acc);
    if (s < 2) {
      EPI8_BEGIN
        *(uint4*)(outp + (size_t)(lt * 128 + row) * 1024 + n0 + col) = pack8(v);
      EPI8_END
    } else if (j == 0) {
      EPI8_BEGIN
        const uint4 u = pack8(v);
        *(uint4*)(outp + (size_t)(lt * 128 + row) * 1024 + n0 + col) = u;
        *(uint4*)(VF + (size_t)(gt * 128 + row) * 1024 + n0 + col) = u;
      EPI8_END
    } else {
      EPI8_BEGIN
        const size_t oi = (size_t)(lt * 128 + row) * 1024 + n0 + col;
        float sg[8], vf[8];
        unpack8(*(const uint4*)(outp + oi), sg);
        unpack8(*(const uint4*)(VF + (size_t)(gt * 128 + row) * 1024 + n0 + col), vf);
#pragma unroll
        for (int e = 0; e < 8; e++) v[e] = v[e] + (vf[e] - v[e]) * sg[e];
        *(uint4*)(outp + oi) = pack8(v);
      EPI8_END
    }
  }
  for (int t = blockIdx.x; t < 136 * 40; t += gridDim.x) {
    const int lt = t / 40, nt = t % 40;
    const int s = nt / 8, n0 = (nt % 8) * 128;
    f32x16 acc[2][2];
    if (s == 0) {
      gemm_mainloop(T1 + (size_t)lt * 128 * 640 + 128, 640, W + W_A2 + (size_t)n0 * 64, 64, 64, smem, acc);
      bf16_t* outp = (bf16_t*)(p.ws + OFF_TR + TR_A);
      const float* a0 = p.rw_a0 + (size_t)j * 1024;
      EPI8_BEGIN
#pragma unroll
        for (int e = 0; e < 8; e++) v[e] = sigmoidf_(a0[n0 + col + e] + v[e]);
        *(uint4*)(outp + (size_t)(lt * 128 + row) * 1024 + n0 + col) = pack8(v);
      EPI8_END
    } else if (s < 3) {
      const int d = s - 1;
      gemm_mainloop(T1 + (size_t)lt * 128 * 640 + d * 64, 640, W + W_W2 + (size_t)d * 65536 + (size_t)n0 * 64, 64, 64, smem, acc);
      bf16_t* outp = (bf16_t*)(p.ws + OFF_TR + (d ? TR_WL1 : TR_WL0));
      const float* w0 = p.rw_w0 + ((size_t)j * 2 + d) * 1024;
      EPI8_BEGIN
#pragma unroll
        for (int e = 0; e < 8; e++) {
          const float z = -(w0[n0 + col + e] + v[e]);
          const float sp = fmaxf(z, 0.f) + log1pf(__expf(-fabsf(z)));
          v[e] = -__expf(-sp - 0.5f);
        }
        *(uint4*)(outp + (size_t)(lt * 128 + row) * 1024 + n0 + col) = pack8(v);
      EPI8_END
    } else {
      const int d = s - 3;
      gemm_mainloop(T1 + (size_t)lt * 128 * 640 + 192 + d * 192, 640, W + W_G2 + (size_t)d * 196608 + (size_t)n0 * 192, 192, 192, smem, acc);
      bf16_t* outp = (bf16_t*)(p.ws + OFF_TR + (d ? TR_G1 : TR_G0));
      EPI8_BEGIN
        *(uint4*)(outp + (size_t)(lt * 128 + row) * 1024 + n0 + col) = pack8(v);
      EPI8_END
    }
  }
}

DI int scan_row(int bl, int dir, int pos) {
  if (pos < CL) { int t = dir ? (CL - 1 - pos) : pos; return 16384 + bl * CL + t; }
  int t = pos - CL; if (dir) t = SL - 1 - t;
  return bl * SL + t;
}

DI void phase_scan(const P& p, int layer, char* smem) {
  const int tidx = opaque_tid();
  const int j = layer / 2;
  const int tid = tidx;
  const bf16_t* R = (const bf16_t*)(p.ws + OFF_TR + TR_R);
  const bf16_t* Kx = (const bf16_t*)(p.ws + OFF_TR + TR_K);
  const bf16_t* V = (const bf16_t*)(p.ws + OFF_TR + TR_V);
  const bf16_t* Aa = (const bf16_t*)(p.ws + OFF_TR + TR_A);
  float* sbuf = (float*)smem;
  constexpr int BUFF = 5 * 16 * 64 + 256;
  float* obuf = sbuf + 2 * BUFF;
  const int ss = tid >> 4, c4 = tid & 15;
  const int rl = tid >> 4, cg = tid & 15;
  for (int item = blockIdx.x; item < 512; item += gridDim.x) {
    const int q = item & 3, dir = (item >> 2) & 1, head = (item >> 3) & 15, bl = item >> 7;
    const bf16_t* WL = (const bf16_t*)(p.ws + OFF_TR + (dir ? TR_WL1 : TR_WL0));
    bf16_t* O = (bf16_t*)(p.ws + OFF_TR + TR_HX) + (dir ? (size_t)HROWS * 1024 : 0);
    const int ch = head * 64 + c4 * 4;
    const float4 kkw = *(const float4*)(p.rw_kk + (size_t)j * 1024 + ch);
    const float4 kaw = *(const float4*)(p.rw_ka + (size_t)j * 1024 + ch);
    float S0 = 0.f, S1 = 0.f, S2 = 0.f, S3 = 0.f;
    uint2 gr_, gk_, ga_, gw_, gv_;
    gv_ = make_uint2(0, 0);
    auto issue = [&](int chunk) {
      const size_t ro = (size_t)scan_row(bl, dir, chunk * 16 + ss) * 1024;
      gr_ = *(const uint2*)(R + ro + ch); gk_ = *(const uint2*)(Kx + ro + ch);
      ga_ = *(const uint2*)(Aa + ro + ch); gw_ = *(const uint2*)(WL + ro + ch);
      if (c4 < 4) gv_ = *(const uint2*)(V + ro + head * 64 + q * 16 + c4 * 4);
    };
    auto stage = [&](int buf) {
      float* sb = sbuf + buf * BUFF;
      float r0 = lo_bf(gr_.x), r1 = hi_bf(gr_.x), r2 = lo_bf(gr_.y), r3 = hi_bf(gr_.y);
      float k0 = lo_bf(gk_.x), k1 = hi_bf(gk_.x), k2 = lo_bf(gk_.y), k3 = hi_bf(gk_.y);
      float a0 = lo_bf(ga_.x), a1 = hi_bf(ga_.x), a2 = lo_bf(ga_.y), a3 = hi_bf(ga_.y);
      float w0 = lo_bf(gw_.x), w1 = hi_bf(gw_.x), w2 = lo_bf(gw_.y), w3 = hi_bf(gw_.y);
      float u0 = k0 * kkw.x, u1 = k1 * kkw.y, u2 = k2 * kkw.z, u3 = k3 * kkw.w;
      float sq = rowsum16(u0 * u0 + u1 * u1 + u2 * u2 + u3 * u3);
      float inv = rsqrtf(fmaxf(sq, 1e-24f));
      u0 *= inv; u1 *= inv; u2 *= inv; u3 *= inv;
      const int o = ss * 64 + c4 * 4;
      *(float4*)(sb + 0 * 1024 + o) = make_float4(__expf(w0), __expf(w1), __expf(w2), __expf(w3));
      *(float4*)(sb + 1 * 1024 + o) = make_float4(k0 * (1.f + (a0 - 1.f) * kaw.x), k1 * (1.f + (a1 - 1.f) * kaw.y), k2 * (1.f + (a2 - 1.f) * kaw.z), k3 * (1.f + (a3 - 1.f) * kaw.w));
      *(float4*)(sb + 2 * 1024 + o) = make_float4(-u0, -u1, -u2, -u3);
      *(float4*)(sb + 3 * 1024 + o) = make_float4(u0 * a0, u1 * a1, u2 * a2, u3 * a3);
      *(float4*)(sb + 4 * 1024 + o) = make_float4(r0, r1, r2, r3);
      if (c4 < 4) *(float4*)(sb + 5 * 1024 + ss * 16 + c4 * 4) = make_float4(lo_bf(gv_.x), hi_bf(gv_.x), lo_bf(gv_.y), hi_bf(gv_.y));
    };
    __syncthreads();
    issue(0);
    stage(0);
    __syncthreads();
    constexpr int NCH = TK / 16;
    for (int chunk = 0; chunk < NCH; chunk++) {
      const int buf = chunk & 1;
      if (chunk + 1 < NCH) issue(chunk + 1);
      __builtin_amdgcn_sched_barrier(0);
      const float* sb = sbuf + buf * BUFF;
      float* ob = obuf + buf * 256;
#pragma unroll
      for (int s = 0; s < 16; s++) {
        const float4 w4 = *(const float4*)(sb + 0 * 1024 + s * 64 + cg * 4);
        const float4 k4 = *(const float4*)(sb + 1 * 1024 + s * 64 + cg * 4);
        const float4 n4 = *(const float4*)(sb + 2 * 1024 + s * 64 + cg * 4);
        const float4 b4 = *(const float4*)(sb + 3 * 1024 + s * 64 + cg * 4);
        const float4 r4 = *(const float4*)(sb + 4 * 1024 + s * 64 + cg * 4);
        const float vv = sb[5 * 1024 + s * 16 + rl];
        float sa = S0 * n4.x + S1 * n4.y + S2 * n4.z + S3 * n4.w;
        sa = rowsum16(sa);
        S0 = S0 * w4.x + (sa * b4.x + vv * k4.x);
        S1 = S1 * w4.y + (sa * b4.y + vv * k4.y);
        S2 = S2 * w4.z + (sa * b4.z + vv * k4.z);
        S3 = S3 * w4.w + (sa * b4.w + vv * k4.w);
        float o = S0 * r4.x + S1 * r4.y + S2 * r4.z + S3 * r4.w;
        o = rowsum16(o);
        if (cg == 0) ob[s * 16 + rl] = o;
      }
      __builtin_amdgcn_sched_barrier(0);
      if (chunk + 1 < NCH) stage(buf ^ 1);
      __syncthreads();
      {
        const int s = tid >> 4, rr = tid & 15;
        const size_t ro = (size_t)scan_row(bl, dir, chunk * 16 + s) * 1024;
        O[ro + head * 64 + q * 16 + rr] = f2bf(ob[s * 16 + rr]);
      }
    }
  }
}

DI void phase_combine(const P& p, int layer) {
  const int tidx = opaque_tid();
  const int j = layer / 2;
  const bf16_t* Of = (const bf16_t*)(p.ws + OFF_TR + TR_HX);
  const bf16_t* Ob = Of + (size_t)HROWS * 1024;
  const bf16_t* R = (const bf16_t*)(p.ws + OFF_TR + TR_R);
  const bf16_t* Kx = (const bf16_t*)(p.ws + OFF_TR + TR_K);
  const bf16_t* V = (const bf16_t*)(p.ws + OFF_TR + TR_V);
  const bf16_t* Aa = (const bf16_t*)(p.ws + OFF_TR + TR_A);
  bf16_t* G0 = (bf16_t*)(p.ws + OFF_TR + TR_G0);
  const bf16_t* G1 = (const bf16_t*)(p.ws + OFF_TR + TR_G1);
  const size_t total = (size_t)HROWS * 128;
  for (size_t i = (size_t)blockIdx.x * 256 + tidx; i < total; i += (size_t)gridDim.x * 256) {
    const int c0 = (int)(i & 127) * 8;
    const size_t off = (i >> 7) * 1024 + c0;
    const uint4 uof = *(const uint4*)(Of + off), uob = *(const uint4*)(Ob + off), ur = *(const uint4*)(R + off), uk = *(const uint4*)(Kx + off);
    const uint4 ua = *(const uint4*)(Aa + off), uv = *(const uint4*)(V + off), ug0 = *(const uint4*)(G0 + off), ug1 = *(const uint4*)(G1 + off);
    const unsigned aof[4] = {uof.x, uof.y, uof.z, uof.w}, aob[4] = {uob.x, uob.y, uob.z, uob.w}, ar[4] = {ur.x, ur.y, ur.z, ur.w}, ak[4] = {uk.x, uk.y, uk.z, uk.w};
    const unsigned aa[4] = {ua.x, ua.y, ua.z, ua.w}, av[4] = {uv.x, uv.y, uv.z, uv.w}, ag0[4] = {ug0.x, ug0.y, ug0.z, ug0.w}, ag1[4] = {ug1.x, ug1.y, ug1.z, ug1.w};
    const float* ka = p.rw_ka + (size_t)j * 1024 + c0;
    const float* rk = p.rw_rk + (size_t)j * 1024 + c0;
    const float* lg = p.rw_ln_g + (size_t)j * 1024 + c0;
    const float* lb = p.rw_ln_b + (size_t)j * 1024 + c0;
    float of[8], obv[8];
    float sf = 0.f, sf2 = 0.f, sb = 0.f, sb2 = 0.f, br = 0.f;
#pragma unroll
    for (int e = 0; e < 8; e++) {
      const int w = e >> 1;
      of[e] = (e & 1) ? hi_bf(aof[w]) : lo_bf(aof[w]);
      obv[e] = (e & 1) ? hi_bf(aob[w]) : lo_bf(aob[w]);
      const float r = (e & 1) ? hi_bf(ar[w]) : lo_bf(ar[w]);
      const float k = (e & 1) ? hi_bf(ak[w]) : lo_bf(ak[w]);
      const float a = (e & 1) ? hi_bf(aa[w]) : lo_bf(aa[w]);
      sf += of[e]; sf2 += of[e] * of[e]; sb += obv[e]; sb2 += obv[e] * obv[e];
      br += r * k * (1.f + (a - 1.f) * ka[e]) * rk[e];
    }
#pragma unroll
    for (int o = 1; o < 8; o <<= 1) { sf += __shfl_xor(sf, o); sf2 += __shfl_xor(sf2, o); sb += __shfl_xor(sb, o); sb2 += __shfl_xor(sb2, o); br += __shfl_xor(br, o); }
    const float muf = sf * (1.f / 64.f), mub = sb * (1.f / 64.f);
    const float rsf = rsqrtf(fmaxf(sf2 * (1.f / 64.f) - muf * muf, 0.f) + 64e-5f);
    const float rsb = rsqrtf(fmaxf(sb2 * (1.f / 64.f) - mub * mub, 0.f) + 64e-5f);
    float y[8];
#pragma unroll
    for (int e = 0; e < 8; e++) {
      const int w = e >> 1;
      const float v = (e & 1) ? hi_bf(av[w]) : lo_bf(av[w]);
      const float g0 = (e & 1) ? hi_bf(ag0[w]) : lo_bf(ag0[w]);
      const float g1 = (e & 1) ? hi_bf(ag1[w]) : lo_bf(ag1[w]);
      const float bonus = br * v;
      y[e] = ((of[e] - muf) * rsf * lg[e] + lb[e] + bonus) * g0 + ((obv[e] - mub) * rsb * lg[e] + lb[e] + bonus) * g1;
    }
    *(uint4*)(G0 + off) = make_uint4(pack2(y[0], y[1]), pack2(y[2], y[3]), pack2(y[4], y[5]), pack2(y[6], y[7]));
  }
}

DI void phase_rw_out(const P& p, int layer, int hf, char* smem) {
  const int tidx = opaque_tid();
  const bf16_t* Y = (const bf16_t*)(p.ws + OFF_TR + TR_G0);
  const bf16_t* WO = (const bf16_t*)(p.ws + OFF_W) + W_WO;
  const int nlt = (layer == 3) ? 128 : 136;
  for (int t = blockIdx.x; t < nlt * 8; t += gridDim.x) {
    const int lt = t / 8, n0 = (t % 8) * 128;
    const int gt = half_gtile(hf, lt);
    f32x16 acc[2][2];
    gemm_mainloop(Y + (size_t)lt * 128 * 1024, 1024, WO + (size_t)n0 * 1024, 1024, 1024, smem, acc);
    const float* gate = mods_ptr(p, layer, mod_row(gt * 128)) + 2048 + n0;
    float* xr = resid_row(p, gt * 128) + n0;
    EPI8_BEGIN
      resid_update(xr + (size_t)row * D + col, gate + col, v);
    EPI8_END
  }
}

DI void phase_mlp1(const P& p, int layer, char* smem) {
  const int tidx = opaque_tid();
  const bf16_t* H2 = (const bf16_t*)(p.ws + OFF_TR + TR_H2);
  const bf16_t* W1 = (const bf16_t*)(p.ws + OFF_W) + W_M1;
  bf16_t* HID = (bf16_t*)(p.ws + OFF_TR + TR_HID);
  const int nmt = (layer == 3) ? 256 : 272;
  const int ngrp = nmt / 16;
  for (int t = blockIdx.x; t < nmt * 32; t += gridDim.x) {
    const int mg = t / (16 * 32), rem = t % (16 * 32);
    const int nt = rem / 16, gt = mg * 16 + (rem % 16);
    (void)ngrp;
    f32x16 acc[2][2];
    gemm_mainloop(H2 + (size_t)gt * 128 * 1024, 1024, W1 + (size_t)nt * 128 * 1024, 1024, 1024, smem, acc);
    EPI8_BEGIN
#pragma unroll
      for (int e = 0; e < 8; e++) { const float rl = fmaxf(v[e], 0.f); v[e] = rl * rl; }
      *(uint4*)(HID + (size_t)(gt * 128 + row) * 4096 + nt * 128 + col) = pack8(v);
    EPI8_END
  }
}
DI void phase_mlp2(const P& p, int layer, char* smem) {
  const int tidx = opaque_tid();
  const bf16_t* HID = (const bf16_t*)(p.ws + OFF_TR + TR_HID);
  const bf16_t* W2 = (const bf16_t*)(p.ws + OFF_W) + W_M2;
  const int nmt = (layer == 3) ? 256 : 272;
  for (int t = blockIdx.x; t < nmt * 8; t += gridDim.x) {
    const int gt = t / 8, n0 = (t % 8) * 128;
    f32x16 acc[2][2];
    gemm_mainloop(HID + (size_t)gt * 128 * 4096, 4096, W2 + (size_t)n0 * 4096, 4096, 4096, smem, acc);
    const float* gate = mods_ptr(p, layer, mod_row(gt * 128)) + 5120 + n0;
    float* xr = resid_row(p, gt * 128) + n0;
    EPI8_BEGIN
      resid_update(xr + (size_t)row * D + col, gate + col, v);
    EPI8_END
  }
}

DI void phase_qkv(const P& p, char* smem) {
  const int tidx = opaque_tid();
  const bf16_t* H = (const bf16_t*)(p.ws + OFF_TR + TR_H);
  const bf16_t* WQ = (const bf16_t*)(p.ws + OFF_W) + W_QKV;
  bf16_t* Q = (bf16_t*)(p.ws + OFF_TR + TR_Q);
  bf16_t* Kb = (bf16_t*)(p.ws + OFF_TR + TR_KK);
  bf16_t* VT = (bf16_t*)(p.ws + OFF_TR + TR_VT);
  const float* cosT = (const float*)(p.ws + OFF_MISC);
  const float* sinT = cosT + 1024;
  for (int t = blockIdx.x; t < 272 * 24; t += gridDim.x) {
    const int mg = t / (16 * 24), rem = t % (16 * 24);
    const int nt = rem / 16, gt = mg * 16 + (rem % 16);
    f32x16 acc[2][2];
    gemm_mainloop(H + (size_t)gt * 128 * 1024, 1024, WQ + (size_t)nt * 128 * 1024, 1024, 1024, smem, acc);
    const bool lat = gt < 256;
    const int b = lat ? gt / 32 : (gt - 256) / 2;
    const int t0 = lat ? (gt % 32) * 128 : (gt - 256) % 2 * 128;
    const int tq0 = lat ? t0 : SL + t0;
    const int typ = nt / 8, h = nt % 8;
    if (typ < 2) {
      bf16_t* dst = typ == 0 ? Q : Kb;
      const float qs = typ == 0 ? 0.125f * 1.44269504088896f : 1.f;
      EPI8_BEGIN
        const int sidx = col >> 6, d0 = col & 63;
        if (lat) {
          const float4 pa = *(const float4*)(es + row * EST + (col ^ 16));
          const float4 pb = *(const float4*)(es + row * EST + (col ^ 16) + 4);
          const float pr[8] = {pa.x, pa.y, pa.z, pa.w, pb.x, pb.y, pb.z, pb.w};
          const int tt = t0 + row;
          const int pos = (d0 < 32) ? (tt >> 6) : (tt & 63);
          const float4 ca = *(const float4*)(cosT + pos * 16 + (d0 & 8)), cb = *(const float4*)(cosT + pos * 16 + (d0 & 8) + 4);
          const float4 sa = *(const float4*)(sinT + pos * 16 + (d0 & 8)), sb = *(const float4*)(sinT + pos * 16 + (d0 & 8) + 4);
          const float cs[8] = {ca.x, ca.y, ca.z, ca.w, cb.x, cb.y, cb.z, cb.w};
          const float sn[8] = {sa.x, sa.y, sa.z, sa.w, sb.x, sb.y, sb.z, sb.w};
          const float sgn = (d0 & 16) ? 1.f : -1.f;
#pragma unroll
          for (int e = 0; e < 8; e++) v[e] = v[e] * cs[e] + sgn * pr[e] * sn[e];
        }
#pragma unroll
        for (int e = 0; e < 8; e++) v[e] *= qs;
        *(uint4*)(dst + ((size_t)((b * 8 + h) * 2 + sidx) * TK + tq0 + row) * 64 + d0) = pack8(v);
      EPI8_END
    } else {
      float* es = (float*)smem;
      acc_to_lds(acc, es);
      __syncthreads();
      for (int pass = 0; pass < 8; pass++) {
        const int d = tidx & 127, tg = pass * 2 + (tidx >> 7);
        float v[8];
#pragma unroll
        for (int e = 0; e < 8; e++) v[e] = es[(tg * 8 + e) * EST + d];
        *(uint4*)(VT + ((size_t)(b * 8 + h) * 128 + d) * TK + tq0 + tg * 8) = pack8(v);
      }
      __syncthreads();
    }
  }
}

typedef _Float16 hv2 __attribute__((ext_vector_type(2)));
DI unsigned packh2(float a, float b) { hv2 r = {(_Float16)a, (_Float16)b}; return __builtin_bit_cast(unsigned, r); }
DI float lo_h(unsigned u) { hv2 r = __builtin_bit_cast(hv2, u); return (float)r[0]; }
DI float hi_h(unsigned u) { hv2 r = __builtin_bit_cast(hv2, u); return (float)r[1]; }

DI void phase_attn(const P& p, int layer, char* smem) {
  const int tidx = opaque_tid();
  const int j = layer / 2;
  const bool ctxq = layer != 3;
  const bf16_t* Q = (const bf16_t*)(p.ws + OFF_TR + TR_Q);
  const bf16_t* Kb = (const bf16_t*)(p.ws + OFF_TR + TR_KK);
  const bf16_t* VT = (const bf16_t*)(p.ws + OFF_TR + TR_VT);
  bf16_t* O = (bf16_t*)(p.ws + OFF_TR + TR_H);
  const float lam = ((const float*)(p.ws + OFF_MISC))[2048 + j];
  const float oml = 1.f - lambda_init(layer);
  const float* subg = p.da_subln_g + (size_t)j * 128;
  bf16_t* sK = (bf16_t*)smem;
  bf16_t* sV = sK + 2 * 64 * LDT;
  const int tid = tidx, lane = tid & 63, w = tid >> 6, g = lane >> 5, l31 = lane & 31;
  const int nitems = 2048 + (ctxq ? 128 : 0);
  for (int item = blockIdx.x; item < nitems; item += gridDim.x) {
    int b, h, q0, kbeg, ntiles;
    if (item < 2048) { b = item >> 8; h = (item >> 5) & 7; q0 = (item & 31) * 128; kbeg = 0; ntiles = TK / 64; }
    else { const int it = item - 2048; b = it >> 4; h = (it >> 1) & 7; q0 = SL + (it & 1) * 128; kbeg = SL; ntiles = CL / 64; }
    const bf16_t* Vp0 = VT + (size_t)(b * 8 + h) * 128 * TK;
    const int tq = q0 + w * 32 + l31;
    const size_t grow = tq < SL ? (size_t)b * SL + tq : (size_t)NLAT + (size_t)b * CL + (tq - SL);
    bf16_t* op = O + grow * 1024 + h * 128;
    for (int s = 0; s < 2; s++) {
      const bf16_t* Kp0 = Kb + (size_t)((b * 8 + h) * 2 + s) * TK * 64;
      const bf16_t* Qp = Q + ((size_t)((b * 8 + h) * 2 + s) * TK + tq) * 64 + g * 8;
      bf16x8 qf[4];
#pragma unroll
      for (int kk = 0; kk < 4; kk++) qf[kk] = *(const bf16x8*)(Qp + kk * 16);
      f32x16 o[4];
#pragma unroll
      for (int db = 0; db < 4; db++)
#pragma unroll
        for (int r = 0; r < 16; r++) o[db][r] = 0.f;
      float m = -1e30f, l = 0.f;
      uint4 rk0, rk1, rv0, rv1, rv2, rv3;
      const unsigned kvo = (unsigned)((tid >> 3) * 64 + (tid & 7) * 8);
      const unsigned vvo = (unsigned)((tid >> 3) * TK + (tid & 7) * 8);
      const unsigned sko = (unsigned)((tid >> 3) * LDT + (tid & 7) * 8);
#define ISSUE_KV(kt_)                                                             \
      {                                                                           \
        const bf16_t* kb_ = Kp0 + (size_t)(kbeg + (kt_) * 64) * 64;               \
        const bf16_t* vb_ = Vp0 + (kbeg + (kt_) * 64);                            \
        rk0 = *(const uint4*)(kb_ + kvo);                                         \
        rk1 = *(const uint4*)(kb_ + (kvo + 32u * 64u));                           \
        rv0 = *(const uint4*)(vb_ + vvo);                                         \
        rv1 = *(const uint4*)(vb_ + (vvo + 32u * (unsigned)TK));                  \
        rv2 = *(const uint4*)(vb_ + (vvo + 64u * (unsigned)TK));                  \
        rv3 = *(const uint4*)(vb_ + (vvo + 96u * (unsigned)TK));                  \
      }
#define STAGE_KV(buf_)                                                            \
      {                                                                           \
        bf16_t* ks_ = sK + (buf_) * 64 * LDT + sko;                               \
        bf16_t* vs_ = sV + (buf_) * 128 * LDT + sko;                              \
        *(uint4*)(ks_) = rk0;                                                     \
        *(uint4*)(ks_ + 32 * LDT) = rk1;                                          \
        *(uint4*)(vs_) = rv0;                                                     \
        *(uint4*)(vs_ + 32 * LDT) = rv1;                                          \
        *(uint4*)(vs_ + 64 * LDT) = rv2;                                          \
        *(uint4*)(vs_ + 96 * LDT) = rv3;                                          \
      }
      __syncthreads();
      ISSUE_KV(0);
      STAGE_KV(0);
      __syncthreads();
      for (int kt = 0; kt < ntiles; kt++) {
        const int buf = kt & 1;
        const bool more = kt + 1 < ntiles;
        if (more) ISSUE_KV(kt + 1);
        __builtin_amdgcn_sched_barrier(0);
        const bf16_t* kS = sK + buf * 64 * LDT;
        const bf16_t* vS = sV + buf * 128 * LDT;
#pragma unroll
        for (int kb = 0; kb < 2; kb++) {
          f32x16 st;
#pragma unroll
          for (int r = 0; r < 16; r++) st[r] = 0.f;
#pragma unroll
          for (int kk = 0; kk < 4; kk++) {
            const bf16x8 kf = *(const bf16x8*)(kS + (kb * 32 + l31) * LDT + kk * 16 + g * 8);
            st = MFMA32(kf, qf[kk], st);
          }
          float mx = st[0];
#pragma unroll
          for (int r = 1; r < 16; r++) mx = fmaxf(mx, st[r]);
          mx = fmaxf(mx, __shfl_xor(mx, 32));
          if (__any(mx > m + 8.f)) {
            const float mn = (mx > m + 8.f) ? mx : m;
            const float al = exp2f(m - mn);
            m = mn;
            l *= al;
#pragma unroll
            for (int db = 0; db < 4; db++)
#pragma unroll
              for (int r = 0; r < 16; r++) o[db][r] *= al;
          }
          float ls = 0.f;
          bf16x8 pk[2];
#pragma unroll
          for (int hh = 0; hh < 2; hh++) {
            float e[8];
#pragma unroll
            for (int i = 0; i < 8; i++) { e[i] = exp2f(st[hh * 8 + i] - m); ls += e[i]; }
            const uint4 u = make_uint4(pack2(e[0], e[1]), pack2(e[2], e[3]), pack2(e[4], e[5]), pack2(e[6], e[7]));
            pk[hh] = __builtin_bit_cast(bf16x8, u);
          }
          l += ls;
#pragma unroll
          for (int db = 0; db < 4; db++)
#pragma unroll
            for (int hh = 0; hh < 2; hh++) {
              const bf16_t* vp = vS + (db * 32 + l31) * LDT + kb * 32 + hh * 16 + 4 * g;
              const uint2 lo = *(const uint2*)vp;
              const uint2 hi = *(const uint2*)(vp + 8);
              const uint4 u = make_uint4(lo.x, lo.y, hi.x, hi.y);
              o[db] = MFMA32(__builtin_bit_cast(bf16x8, u), pk[hh], o[db]);
            }
        }
        __builtin_amdgcn_sched_barrier(0);
        if (more) STAGE_KV(buf ^ 1);
        __syncthreads();
      }
      const float lt = l + __shfl_xor(l, 32);
      if (s == 0) {
        const float inv = 1.f / lt;
#pragma unroll
        for (int db = 0; db < 4; db++)
#pragma unroll
          for (int rq = 0; rq < 4; rq++) {
            const int d = db * 32 + 8 * rq + 4 * g;
            *(uint2*)(op + d) = make_uint2(packh2(o[db][4 * rq] * inv, o[db][4 * rq + 1] * inv), packh2(o[db][4 * rq + 2] * inv, o[db][4 * rq + 3] * inv));
          }
      } else {
        const float inv = lam / lt;
        float ssq = 0.f;
#pragma unroll
        for (int db = 0; db < 4; db++)
#pragma unroll
          for (int rq = 0; rq < 4; rq++) {
            const int d = db * 32 + 8 * rq + 4 * g;
            const uint2 u0 = *(const uint2*)(op + d);
            const float a0 = lo_h(u0.x) - o[db][4 * rq] * inv, a1 = hi_h(u0.x) - o[db][4 * rq + 1] * inv;
            const float a2 = lo_h(u0.y) - o[db][4 * rq + 2] * inv, a3 = hi_h(u0.y) - o[db][4 * rq + 3] * inv;
            o[db][4 * rq] = a0; o[db][4 * rq + 1] = a1; o[db][4 * rq + 2] = a2; o[db][4 * rq + 3] = a3;
            ssq += a0 * a0 + a1 * a1 + a2 * a2 + a3 * a3;
          }
        ssq += __shfl_xor(ssq, 32);
        const float rs = rsqrtf(ssq * (1.f / 128.f) + 1e-5f) * oml;
#pragma unroll
        for (int db = 0; db < 4; db++)
#pragma unroll
          for (int rq = 0; rq < 4; rq++) {
            const int d = db * 32 + 8 * rq + 4 * g;
            const float4 sg = *(const float4*)(subg + d);
            *(uint2*)(op + d) = make_uint2(pack2(o[db][4 * rq] * rs * sg.x, o[db][4 * rq + 1] * rs * sg.y),
                                           pack2(o[db][4 * rq + 2] * rs * sg.z, o[db][4 * rq + 3] * rs * sg.w));
          }
      }
    }
  }
}

DI void phase_at_out(const P& p, int layer, char* smem) {
  const int tidx = opaque_tid();
  const bf16_t* O = (const bf16_t*)(p.ws + OFF_TR + TR_H);
  const bf16_t* WO = (const bf16_t*)(p.ws + OFF_W) + W_WO;
  const int nmt = (layer == 3) ? 256 : 272;
  for (int t = blockIdx.x; t < nmt * 8; t += gridDim.x) {
    const int gt = t / 8, n0 = (t % 8) * 128;
    f32x16 acc[2][2];
    gemm_mainloop(O + (size_t)gt * 128 * 1024, 1024, WO + (size_t)n0 * 1024, 1024, 1024, smem, acc);
    const float* gate = mods_ptr(p, layer, mod_row(gt * 128)) + 2048 + n0;
    float* xr = resid_row(p, gt * 128) + n0;
    EPI8_BEGIN
      resid_update(xr + (size_t)row * D + col, gate + col, v);
    EPI8_END
  }
}

DI void phase_final(const P& p) {
  const int tidx = opaque_tid();
  const int lane = tidx & 63, wv = tidx >> 6;
  for (int row = blockIdx.x * 4 + wv; row < NLAT; row += gridDim.x * 4) {
    float* xr = p.out + (size_t)row * D;
    float4 v[4];
    float ss = 0.f;
#pragma unroll
    for (int jx = 0; jx < 4; jx++) { v[jx] = *(const float4*)(xr + jx * 256 + lane * 4); ss += v[jx].x * v[jx].x + v[jx].y * v[jx].y + v[jx].z * v[jx].z + v[jx].w * v[jx].w; }
    ss = wave_sum(ss);
    const float rs = rsqrtf(ss * (1.f / 1024.f) + 1e-6f);
#pragma unroll
    for (int jx = 0; jx < 4; jx++) {
      const float4 g = *(const float4*)(p.final_g + jx * 256 + lane * 4);
      *(float4*)(xr + jx * 256 + lane * 4) = make_float4(v[jx].x * rs * g.x, v[jx].y * rs * g.y, v[jx].z * rs * g.z, v[jx].w * rs * g.w);
    }
  }
}

typedef __attribute__((address_space(1))) const float GCF;
typedef __attribute__((address_space(1))) float GF;
typedef __attribute__((address_space(1))) char GC;
DI unsigned long long lds_word(const unsigned long long* tbl, int i) {
  int z = i;
  asm volatile("" : "+v"(z));
  const unsigned long long v = tbl[z];
  const unsigned lo = __builtin_amdgcn_readfirstlane((unsigned)v), hi = __builtin_amdgcn_readfirstlane((unsigned)(v >> 32));
  return ((unsigned long long)hi << 32) | lo;
}
DI void load_params(P& q, const unsigned long long* tbl) {
  const float** fp = (const float**)&q;
#pragma unroll
  for (int i = 0; i < 36; i++) fp[i] = (const float*)(GCF*)lds_word(tbl, i);
  q.out = (float*)(GF*)lds_word(tbl, 36);
  q.ws = (char*)(GC*)lds_word(tbl, 37);
  q.only = 0;
  q.pad = 0;
}
__global__ void __launch_bounds__(256, 2) mega(P p) {
  __shared__ __attribute__((aligned(16))) char smem[73728];
  __shared__ unsigned long long s_tbl[40];
  {
#if defined(__HIP_DEVICE_COMPILE__)
    typedef __attribute__((address_space(4))) const unsigned long long KW;
    KW* kp = (KW*)__builtin_amdgcn_kernarg_segment_ptr();
    if (threadIdx.x < 39) s_tbl[threadIdx.x] = kp[threadIdx.x];
#endif
    __syncthreads();
  }
  const int only = (int)(unsigned)lds_word(s_tbl, 38);
  cg::grid_group grid = cg::this_grid();
  int step = 0;
#define STEP(body)                                   \
  {                                                  \
    if (only < 0 || only == step) {              \
      P q;                                           \
      load_params(q, s_tbl);                         \
      body;                                          \
    }                                                \
    step++;                                          \
    if (only < 0) grid.sync();                     \
  }
#ifndef DUP
#define DUP 0
#endif
#define STEPD(id, body)                              \
  {                                                  \
    if (only < 0 || only == step) {                  \
      P q;                                           \
      load_params(q, s_tbl);                         \
      body;                                          \
      if (DUP == id) { __syncthreads(); body; }      \
    }                                                \
    step++;                                          \
    if (only < 0) grid.sync();                       \
  }
  STEP(phase_init(q, smem));
  for (int layer = 0; layer < 4; layer++) {
    STEPD(1, phase_conv(q, layer, smem));
    if ((layer & 1) == 0) {
      for (int hf = 0; hf < 2; hf++) {
        STEP(phase_prep(q, layer, 0, hf, true, (bf16_t*)(q.ws + OFF_TR + TR_HX), 2048, false));
        STEPD(3, phase_t1(q, smem));
        STEPD(4, phase_feat(q, layer, hf, smem));
        STEPD(5, phase_scan(q, layer, smem));
        STEP(phase_combine(q, layer));
        STEP(phase_rw_out(q, layer, hf, smem));
      }
    } else {
      STEP(phase_prep(q, layer, 0, -1, false, (bf16_t*)(q.ws + OFF_TR + TR_H), 1024, false));
      STEPD(7, phase_qkv(q, smem));
      STEPD(8, phase_attn(q, layer, smem));
      STEP(phase_at_out(q, layer, smem));
    }
    STEP(phase_prep(q, layer, 1, -1, false, (bf16_t*)(q.ws + OFF_TR + TR_H2), 1024, layer == 3));
    STEPD(9, phase_mlp1(q, layer, smem));
    STEP(phase_mlp2(q, layer, smem));
  }
  STEP(phase_final(q));
}

#ifndef MULTI_LAUNCH
#define MULTI_LAUNCH 0
#endif
constexpr int NSTEPS = 1 + 2 * (1 + 12 + 3) + 2 * (1 + 4 + 3) + 1;

extern "C" void kernel_launch(void* const* d_in, const int* in_sizes, int n_in, void* d_out, int out_size, void* d_ws, size_t ws_size,
                              hipStream_t stream) {
  static int grid_blocks = 0;
  if (!grid_blocks) {
    int dev = 0, cus = 0, per_cu = 0;
    hipGetDevice(&dev);
    hipDeviceGetAttribute(&cus, hipDeviceAttributeMultiprocessorCount, dev);
    hipOccupancyMaxActiveBlocksPerMultiprocessor(&per_cu, mega, 256, 0);
    if (per_cu < 1) per_cu = 1;
    if (per_cu > 2) per_cu = 2;
    grid_blocks = cus * per_cu;
  }
  P p{};
  const float** fp = (const float**)&p;
  for (int i = 0; i < 36; i++) fp[i] = (const float*)d_in[i];
  p.out = (float*)d_out;
  p.ws = (char*)d_ws;
  p.pad = 0;
#if MULTI_LAUNCH
  for (int s = 0; s < NSTEPS; s++) {
    p.only = s;
    void* args[] = {&p};
    hipError_t e = hipLaunchCooperativeKernel((void*)mega, dim3(grid_blocks), dim3(256), args, 0, stream);
    if (e != hipSuccess) { fprintf(stderr, "launch failed: %s\n", hipGetErrorString(e)); break; }
  }
#else
  p.only = -1;
  void* args[] = {&p};
  hipError_t e = hipLaunchCooperativeKernel((void*)mega, dim3(grid_blocks), dim3(256), args, 0, stream);
  if (e != hipSuccess) fprintf(stderr, "cooperative launch failed: %s (grid %d)\n", hipGetErrorString(e), grid_blocks);
#endif
}
```

```cpp
#include <hip/hip_runtime.h>
#include <hip/hip_cooperative_groups.h>
#include <cstdio>
namespace cg = cooperative_groups;

#define DI __device__ __forceinline__
typedef unsigned short bf16_t;
using bf16x8 = __attribute__((ext_vector_type(8))) short;
using f32x16 = __attribute__((ext_vector_type(16))) float;
typedef __bf16 bfv2 __attribute__((ext_vector_type(2)));
typedef float fv2 __attribute__((ext_vector_type(2)));
#define MFMA32(a, b, c) __builtin_amdgcn_mfma_f32_32x32x16_bf16((a), (b), (c), 0, 0, 0)

constexpr int D = 1024, NB = 8, SL = 4096, CL = 256;
constexpr int NLAT = NB * SL, NCTX = NB * CL, NTOK = NLAT + NCTX;
constexpr int HROWS = NTOK / 2;
constexpr int TK = SL + CL;
constexpr size_t MiB = 1048576;
constexpr size_t OFF_W = 0, OFF_XC = 36 * MiB, OFF_MODS = 44 * MiB, OFF_MISC = 45 * MiB, OFF_VF = 46 * MiB, OFF_TR = 114 * MiB;
constexpr size_t W_RKV = 0;
constexpr size_t W_L1 = W_RKV + 3072ull * 2048;
constexpr size_t W_W2 = W_L1 + 640ull * 2048;
constexpr size_t W_A2 = W_W2 + 2ull * 65536;
constexpr size_t W_G2 = W_A2 + 65536;
constexpr size_t W_V2 = W_G2 + 2ull * 196608;
constexpr size_t W_WO = W_V2 + 65536;
constexpr size_t W_M1 = W_WO + 1048576;
constexpr size_t W_M2 = W_M1 + 4194304;
constexpr size_t W_QKV = 0;
constexpr size_t HALF_ARR = (size_t)HROWS * 1024 * 2;
constexpr size_t TR_HX = 0;
constexpr size_t TR_T1 = 2 * HALF_ARR;
constexpr size_t TR_R = TR_T1 + (size_t)HROWS * 640 * 2;
constexpr size_t TR_K = TR_R + HALF_ARR, TR_V = TR_K + HALF_ARR, TR_A = TR_V + HALF_ARR;
constexpr size_t TR_WL0 = TR_A + HALF_ARR, TR_WL1 = TR_WL0 + HALF_ARR, TR_G0 = TR_WL1 + HALF_ARR, TR_G1 = TR_G0 + HALF_ARR;
constexpr size_t FULL_ARR = (size_t)NTOK * 1024 * 2;
constexpr size_t TR_H = 0, TR_Q = FULL_ARR, TR_KK = 2 * FULL_ARR, TR_VT = 3 * FULL_ARR;
constexpr size_t TR_H2 = 0, TR_HID = FULL_ARR;

struct P {
  const float *x, *c, *ctx, *c_ctx, *ada_w, *ada_b, *norm_g, *final_g;
  const float *rw_mix, *rw_w_rkv, *rw_w0, *rw_w1, *rw_w2, *rw_a0, *rw_a1, *rw_a2, *rw_g1, *rw_g2, *rw_kk, *rw_ka, *rw_rk, *rw_ln_g, *rw_ln_b, *rw_w_o, *rw_v0, *rw_v1, *rw_v2;
  const float *da_w_qkv, *da_w_o, *da_lq1, *da_lk1, *da_lq2, *da_lk2, *da_subln_g, *mlp_w1, *mlp_w2;
  float* out;
  char* ws;
  int only;
  int pad;
};

DI float bf2f(bf16_t h) { return __uint_as_float(((unsigned)h) << 16); }
DI unsigned pack2(float a, float b) { fv2 v = {a, b}; bfv2 r = __builtin_convertvector(v, bfv2); return __builtin_bit_cast(unsigned, r); }
DI bf16_t f2bf(float a) { return (bf16_t)(pack2(a, 0.f) & 0xffffu); }
DI float lo_bf(unsigned u) { return __uint_as_float(u << 16); }
DI float hi_bf(unsigned u) { return __uint_as_float(u & 0xffff0000u); }
DI float sigmoidf_(float x) { return 1.f / (1.f + __expf(-x)); }
DI float wave_sum(float v) {
#pragma unroll
  for (int o = 32; o > 0; o >>= 1) v += __shfl_xor(v, o);
  return v;
}
template <int N> DI float ror_add(float x) { return x + __builtin_bit_cast(float, __builtin_amdgcn_mov_dpp(__builtin_bit_cast(int, x), 0x120 + N, 0xf, 0xf, true)); }
DI float rowsum16(float x) { x = ror_add<8>(x); x = ror_add<4>(x); x = ror_add<2>(x); x = ror_add<1>(x); return x; }

DI int opaque_tid() { int t = threadIdx.x; asm volatile("" : "+v"(t)); return t; }
DI float* resid_row(const P& p, int gr) { return gr < NLAT ? p.out + (size_t)gr * D : (float*)(p.ws + OFF_XC) + (size_t)(gr - NLAT) * D; }
DI int mod_row(int gr) { return gr < NLAT ? gr / SL : 8; }
DI const float* mods_ptr(const P& p, int layer, int mrow) { return (const float*)(p.ws + OFF_MODS) + ((size_t)layer * 9 + mrow) * 6144; }
DI int half_gtile(int hf, int lt) { return lt < 128 ? hf * 128 + lt : 256 + hf * 8 + (lt - 128); }
DI int first_tile(int base) { int g = gridDim.x; int s = (int)blockIdx.x - (base % g); if (s < 0) s += g; return s; }
DI float lambda_init(int layer) { return 0.8f - 0.6f * expf(-0.3f * (float)layer); }

DI void phase_init(const P& p, char* smem) {
  const int tidx = opaque_tid();
  const int tid = tidx;
  float* sc = (float*)smem;
  float* mods = (float*)(p.ws + OFF_MODS);
  for (int item = blockIdx.x; item < 96; item += gridDim.x) {
    const int layer = item / 24, cb = item % 24;
    __syncthreads();
    for (int i = tid; i < 9 * 1024; i += 256) {
      int r = i >> 10, k = i & 1023;
      float v = r < 8 ? p.c[r * 1024 + k] : p.c_ctx[k];
      sc[i] = v / (1.f + expf(-v));
    }
    __syncthreads();
    const int w = tid >> 6, q = tid & 63;
    float4 acc[9];
#pragma unroll
    for (int r = 0; r < 9; r++) acc[r] = make_float4(0.f, 0.f, 0.f, 0.f);
    const float* wp = p.ada_w + (size_t)layer * 1024 * 6144 + cb * 256 + q * 4;
    for (int k = w * 256; k < w * 256 + 256; k++) {
      float4 wv = *(const float4*)(wp + (size_t)k * 6144);
#pragma unroll
      for (int r = 0; r < 9; r++) {
        float s = sc[r * 1024 + k];
        acc[r].x += s * wv.x; acc[r].y += s * wv.y; acc[r].z += s * wv.z; acc[r].w += s * wv.w;
      }
    }
    __syncthreads();
    float4* red = (float4*)smem;
#pragma unroll
    for (int r = 0; r < 9; r++) red[(w * 9 + r) * 64 + q] = acc[r];
    __syncthreads();
    for (int i = tid; i < 9 * 64; i += 256) {
      int r = i / 64, qq = i % 64;
      float4 s0 = red[(0 * 9 + r) * 64 + qq], s1 = red[(1 * 9 + r) * 64 + qq], s2 = red[(2 * 9 + r) * 64 + qq], s3 = red[(3 * 9 + r) * 64 + qq];
      float4 bb = *(const float4*)(p.ada_b + layer * 6144 + cb * 256 + qq * 4);
      float4 o = make_float4(s0.x + s1.x + s2.x + s3.x + bb.x, s0.y + s1.y + s2.y + s3.y + bb.y, s0.z + s1.z + s2.z + s3.z + bb.z, s0.w + s1.w + s2.w + s3.w + bb.w);
      *(float4*)(mods + ((size_t)layer * 9 + r) * 6144 + cb * 256 + qq * 4) = o;
    }
  }
  if (blockIdx.x == gridDim.x - 1) {
    float* misc = (float*)(p.ws + OFF_MISC);
    for (int i = tid; i < 1024; i += 256) {
      int pos = i / 16, f = i % 16;
      float inv = powf(10000.f, -(float)f / 16.f);
      float ang = (float)pos * inv;
      misc[i] = cosf(ang);
      misc[1024 + i] = sinf(ang);
    }
    if (tid < 2) {
      float s1 = 0.f, s2 = 0.f;
      for (int k = 0; k < 64; k++) { s1 += p.da_lq1[tid * 64 + k] * p.da_lk1[tid * 64 + k]; s2 += p.da_lq2[tid * 64 + k] * p.da_lk2[tid * 64 + k]; }
      misc[2048 + tid] = expf(s1) - expf(s2) + lambda_init(2 * tid + 1);
    }
  }
  const size_t n4 = (size_t)NLAT * D / 4, c4 = (size_t)NCTX * D / 4;
  const float4* xs = (const float4*)p.x; float4* xo = (float4*)p.out;
  for (size_t i = (size_t)blockIdx.x * 256 + tid; i < n4; i += (size_t)gridDim.x * 256) xo[i] = xs[i];
  const float4* cs = (const float4*)p.ctx; float4* co = (float4*)(p.ws + OFF_XC);
  for (size_t i = (size_t)blockIdx.x * 256 + tid; i < c4; i += (size_t)gridDim.x * 256) co[i] = cs[i];
}

DI void conv_mat(const float* __restrict__ src, int K, int N, bf16_t* __restrict__ dst, int ldd, int koff, const float* __restrict__ scale,
                 int Kp, int Np, float* sm, int& base) {
  const int tidx = opaque_tid();
  const int tid = tidx;
  const int tk = Kp / 64, tn = Np / 64, nt = tk * tn;
  for (int t = first_tile(base); t < nt; t += gridDim.x) {
    const int k0 = (t / tn) * 64, n0 = (t % tn) * 64;
    __syncthreads();
#pragma unroll
    for (int i = 0; i < 4; i++) {
      int kr = (tid >> 4) + 16 * i, nc = (tid & 15) * 4;
      float4 v = make_float4(0.f, 0.f, 0.f, 0.f);
      if (src != nullptr && k0 + kr < K && n0 + nc < N) {
        v = *(const float4*)(src + (size_t)(k0 + kr) * N + n0 + nc);
        if (scale) { float s = scale[k0 + kr]; v.x *= s; v.y *= s; v.z *= s; v.w *= s; }
      }
      sm[kr * 65 + nc + 0] = v.x; sm[kr * 65 + nc + 1] = v.y; sm[kr * 65 + nc + 2] = v.z; sm[kr * 65 + nc + 3] = v.w;
    }
    __syncthreads();
    const int n = tid >> 2, kb = (tid & 3) * 16;
    unsigned o[8];
#pragma unroll
    for (int i = 0; i < 8; i++) o[i] = pack2(sm[(kb + 2 * i) * 65 + n], sm[(kb + 2 * i + 1) * 65 + n]);
    uint4* dp = (uint4*)(dst + (size_t)(n0 + n) * ldd + koff + k0 + kb);
    dp[0] = make_uint4(o[0], o[1], o[2], o[3]);
    dp[1] = make_uint4(o[4], o[5], o[6], o[7]);
  }
  base += nt;
}

DI void phase_conv(const P& p, int layer, char* smem) {
  float* sm = (float*)smem;
  bf16_t* W = (bf16_t*)(p.ws + OFF_W);
  int base = 0;
  const int j = layer / 2;
  if ((layer & 1) == 0) {
    const int mixsel[3] = {0, 2, 3};
    for (int s = 0; s < 3; s++) {
      const float* src = p.rw_w_rkv + ((size_t)j * 3 + s) * 1048576;
      conv_mat(src, 1024, 1024, W + W_RKV + (size_t)s * 1024 * 2048, 2048, 0, nullptr, 1024, 1024, sm, base);
      conv_mat(src, 1024, 1024, W + W_RKV + (size_t)s * 1024 * 2048, 2048, 1024, p.rw_mix + ((size_t)j * 6 + mixsel[s]) * 1024, 1024, 1024, sm, base);
    }
    for (int pass = 0; pass < 2; pass++) {
      const int ko = pass * 1024;
      const float* m1 = pass ? p.rw_mix + ((size_t)j * 6 + 1) * 1024 : nullptr;
      const float* m4 = pass ? p.rw_mix + ((size_t)j * 6 + 4) * 1024 : nullptr;
      const float* m5 = pass ? p.rw_mix + ((size_t)j * 6 + 5) * 1024 : nullptr;
      const float* m3 = pass ? p.rw_mix + ((size_t)j * 6 + 3) * 1024 : nullptr;
      bf16_t* L1 = W + W_L1;
      conv_mat(p.rw_w1 + ((size_t)j * 2 + 0) * 65536, 1024, 64, L1 + 0ull * 2048, 2048, ko, m1, 1024, 64, sm, base);
      conv_mat(p.rw_w1 + ((size_t)j * 2 + 1) * 65536, 1024, 64, L1 + 64ull * 2048, 2048, ko, m1, 1024, 64, sm, base);
      conv_mat(p.rw_a1 + (size_t)j * 65536, 1024, 64, L1 + 128ull * 2048, 2048, ko, m4, 1024, 64, sm, base);
      conv_mat(p.rw_g1 + ((size_t)j * 2 + 0) * 163840, 1024, 160, L1 + 192ull * 2048, 2048, ko, m5, 1024, 192, sm, base);
      conv_mat(p.rw_g1 + ((size_t)j * 2 + 1) * 163840, 1024, 160, L1 + 384ull * 2048, 2048, ko, m5, 1024, 192, sm, base);
      conv_mat(j > 0 ? p.rw_v1 + (size_t)(j - 1) * 32768 : nullptr, 1024, 32, L1 + 576ull * 2048, 2048, ko, m3, 1024, 64, sm, base);
    }
    conv_mat(p.rw_w2 + ((size_t)j * 2 + 0) * 65536, 64, 1024, W + W_W2, 64, 0, nullptr, 64, 1024, sm, base);
    conv_mat(p.rw_w2 + ((size_t)j * 2 + 1) * 65536, 64, 1024, W + W_W2 + 65536, 64, 0, nullptr, 64, 1024, sm, base);
    conv_mat(p.rw_a2 + (size_t)j * 65536, 64, 1024, W + W_A2, 64, 0, nullptr, 64, 1024, sm, base);
    conv_mat(p.rw_g2 + ((size_t)j * 2 + 0) * 163840, 160, 1024, W + W_G2, 192, 0, nullptr, 192, 1024, sm, base);
    conv_mat(p.rw_g2 + ((size_t)j * 2 + 1) * 163840, 160, 1024, W + W_G2 + 196608, 192, 0, nullptr, 192, 1024, sm, base);
    conv_mat(j > 0 ? p.rw_v2 + (size_t)(j - 1) * 32768 : nullptr, 32, 1024, W + W_V2, 64, 0, nullptr, 64, 1024, sm, base);
    conv_mat(p.rw_w_o + (size_t)j * 1048576, 1024, 1024, W + W_WO, 1024, 0, nullptr, 1024, 1024, sm, base);
  } else {
    conv_mat(p.da_w_qkv + (size_t)j * 3145728, 1024, 3072, W + W_QKV, 1024, 0, nullptr, 1024, 3072, sm, base);
    conv_mat(p.da_w_o + (size_t)j * 1048576, 1024, 1024, W + W_WO, 1024, 0, nullptr, 1024, 1024, sm, base);
  }
  conv_mat(p.mlp_w1 + (size_t)layer * 4194304, 1024, 4096, W + W_M1, 1024, 0, nullptr, 1024, 4096, sm, base);
  conv_mat(p.mlp_w2 + (size_t)layer * 4194304, 4096, 1024, W + W_M2, 4096, 0, nullptr, 4096, 1024, sm, base);
}

DI void phase_prep(const P& p, int layer, int sub, int hf, bool shift, bf16_t* H, int ldh, bool skip_ctx) {
  const int tidx = opaque_tid();
  const int lane = tidx & 63, wv = tidx >> 6;
  const int nrows = hf < 0 ? (skip_ctx ? NLAT : NTOK) : HROWS;
  const int nseg = nrows / 8;
  const float* ng = p.norm_g + ((size_t)layer * 2 + sub) * 1024;
  for (int seg = blockIdx.x * 4 + wv; seg < nseg; seg += gridDim.x * 4) {
    const int lr0 = seg * 8;
    const int gr0 = hf < 0 ? lr0 : (lr0 < 16384 ? hf * 16384 + lr0 : NLAT + hf * 1024 + (lr0 - 16384));
    const bool lat = gr0 < NLAT;
    const int T = lat ? SL : CL;
    const int t0 = lat ? (gr0 % SL) : ((gr0 - NLAT) % CL);
    const float* xbase = resid_row(p, gr0);
    const float* md = mods_ptr(p, layer, mod_row(gr0));
    float4 g4[4], sc4[4], sh4[4];
#pragma unroll
    for (int jx = 0; jx < 4; jx++) {
      int ch = jx * 256 + lane * 4;
      g4[jx] = *(const float4*)(ng + ch);
      sh4[jx] = *(const float4*)(md + sub * 3072 + ch);
      sc4[jx] = *(const float4*)(md + sub * 3072 + 1024 + ch);
      g4[jx].x *= (1.f + sc4[jx].x); g4[jx].y *= (1.f + sc4[jx].y); g4[jx].z *= (1.f + sc4[jx].z); g4[jx].w *= (1.f + sc4[jx].w);
    }
    float4 hp[4], hc[4], hn[4];
    const int tb = shift ? -1 : 0, te = shift ? 9 : 8;
    for (int tt = tb; tt < te; tt++) {
      const int t = t0 + tt;
      if (t >= 0 && t < T) {
        const float* xr = xbase + (ptrdiff_t)tt * D;
        float ss = 0.f;
#pragma unroll
        for (int jx = 0; jx < 4; jx++) {
          hn[jx] = *(const float4*)(xr + jx * 256 + lane * 4);
          ss += hn[jx].x * hn[jx].x + hn[jx].y * hn[jx].y + hn[jx].z * hn[jx].z + hn[jx].w * hn[jx].w;
        }
        ss = wave_sum(ss);
        const float rs = rsqrtf(ss * (1.f / 1024.f) + 1e-6f);
#pragma unroll
        for (int jx = 0; jx < 4; jx++) {
          hn[jx].x = hn[jx].x * rs * g4[jx].x + sh4[jx].x; hn[jx].y = hn[jx].y * rs * g4[jx].y + sh4[jx].y;
          hn[jx].z = hn[jx].z * rs * g4[jx].z + sh4[jx].z; hn[jx].w = hn[jx].w * rs * g4[jx].w + sh4[jx].w;
        }
      } else {
#pragma unroll
        for (int jx = 0; jx < 4; jx++) hn[jx] = make_float4(0.f, 0.f, 0.f, 0.f);
      }
      if (!shift) {
        bf16_t* hr = H + (size_t)(lr0 + tt) * ldh;
#pragma unroll
        for (int jx = 0; jx < 4; jx++) *(uint2*)(hr + jx * 256 + lane * 4) = make_uint2(pack2(hn[jx].x, hn[jx].y), pack2(hn[jx].z, hn[jx].w));
      } else if (tt >= 1) {
        bf16_t* hr = H + (size_t)(lr0 + tt - 1) * ldh;
#pragma unroll
        for (int jx = 0; jx < 4; jx++) {
          *(uint2*)(hr + jx * 256 + lane * 4) = make_uint2(pack2(hc[jx].x, hc[jx].y), pack2(hc[jx].z, hc[jx].w));
          float4 xx;
          xx.x = 0.5f * (hp[jx].x + hn[jx].x) - hc[jx].x; xx.y = 0.5f * (hp[jx].y + hn[jx].y) - hc[jx].y;
          xx.z = 0.5f * (hp[jx].z + hn[jx].z) - hc[jx].z; xx.w = 0.5f * (hp[jx].w + hn[jx].w) - hc[jx].w;
          *(uint2*)(hr + 1024 + jx * 256 + lane * 4) = make_uint2(pack2(xx.x, xx.y), pack2(xx.z, xx.w));
        }
      }
#pragma unroll
      for (int jx = 0; jx < 4; jx++) { hp[jx] = hc[jx]; hc[jx] = hn[jx]; }
    }
  }
}

constexpr int LDT = 72;
DI void gemm_mainloop(const bf16_t* __restrict__ A, int lda, const bf16_t* __restrict__ Bt, int ldb, int K, char* smem, f32x16 (&acc)[2][2]) {
  const int tidx = opaque_tid();
  bf16_t* sA = (bf16_t*)smem;
  bf16_t* sB = sA + 2 * 128 * LDT;
  const int tid = tidx, lane = tid & 63, w = tid >> 6, wm = w >> 1, wn = w & 1;
  const int lrow = tid >> 3, lkc = (tid & 7) * 8;
#pragma unroll
  for (int mi = 0; mi < 2; mi++)
#pragma unroll
    for (int ni = 0; ni < 2; ni++)
#pragma unroll
      for (int r = 0; r < 16; r++) acc[mi][ni][r] = 0.f;
  const unsigned ao = (unsigned)(lrow * lda + lkc), bo = (unsigned)(lrow * ldb + lkc);
  const unsigned a32 = (unsigned)(32 * lda), b32 = (unsigned)(32 * ldb);
  uint4 ra0, ra1, ra2, ra3, rb0, rb1, rb2, rb3;
#define G_LOAD(Ab, Bb)                                                                                   \
  {                                                                                                      \
    ra0 = *(const uint4*)((Ab) + ao); ra1 = *(const uint4*)((Ab) + (ao + a32));                          \
    ra2 = *(const uint4*)((Ab) + (ao + 2 * a32)); ra3 = *(const uint4*)((Ab) + (ao + 3 * a32));          \
    rb0 = *(const uint4*)((Bb) + bo); rb1 = *(const uint4*)((Bb) + (bo + b32));                          \
    rb2 = *(const uint4*)((Bb) + (bo + 2 * b32)); rb3 = *(const uint4*)((Bb) + (bo + 3 * b32));          \
  }
#define G_STORE(sa_, sb_)                                                                                \
  {                                                                                                      \
    bf16_t* a_w = (sa_) + lrow * LDT + lkc;                                                              \
    bf16_t* b_w = (sb_) + lrow * LDT + lkc;                                                              \
    *(uint4*)(a_w) = ra0; *(uint4*)(a_w + 32 * LDT) = ra1; *(uint4*)(a_w + 64 * LDT) = ra2; *(uint4*)(a_w + 96 * LDT) = ra3; \
    *(uint4*)(b_w) = rb0; *(uint4*)(b_w + 32 * LDT) = rb1; *(uint4*)(b_w + 64 * LDT) = rb2; *(uint4*)(b_w + 96 * LDT) = rb3; \
  }
  G_LOAD(A, Bt);
  G_STORE(sA, sB);
  __syncthreads();
  const int nk = K >> 6;
  const int aoff = (wm * 64 + (lane & 31)) * LDT + (lane >> 5) * 8;
  const int boff = (wn * 64 + (lane & 31)) * LDT + (lane >> 5) * 8;
  for (int kt = 0; kt < nk; kt++) {
    const int cur = kt & 1;
    if (kt + 1 < nk) {
      const bf16_t* A1 = A + (kt + 1) * 64;
      const bf16_t* B1 = Bt + (kt + 1) * 64;
      G_LOAD(A1, B1);
    }
    __builtin_amdgcn_sched_barrier(0);
    const bf16_t* a_s = sA + cur * 128 * LDT + aoff;
    const bf16_t* b_s = sB + cur * 128 * LDT + boff;
#pragma unroll
    for (int kk = 0; kk < 4; kk++) {
      bf16x8 af[2], bq[2];
#pragma unroll
      for (int mi = 0; mi < 2; mi++) af[mi] = *(const bf16x8*)(a_s + mi * 32 * LDT + kk * 16);
#pragma unroll
      for (int ni = 0; ni < 2; ni++) bq[ni] = *(const bf16x8*)(b_s + ni * 32 * LDT + kk * 16);
#pragma unroll
      for (int mi = 0; mi < 2; mi++)
#pragma unroll
        for (int ni = 0; ni < 2; ni++) acc[mi][ni] = MFMA32(af[mi], bq[ni], acc[mi][ni]);
    }
    __builtin_amdgcn_sched_barrier(0);
    if (kt + 1 < nk) G_STORE(sA + (cur ^ 1) * 128 * LDT, sB + (cur ^ 1) * 128 * LDT);
    __syncthreads();
  }
}
constexpr int EST = 132;
DI void acc_to_lds(const f32x16 (&acc)[2][2], float* es) {
  const int tidx = opaque_tid();
  const int lane = tidx & 63, w = tidx >> 6, wm = w >> 1, wn = w & 1;
#pragma unroll
  for (int mi = 0; mi < 2; mi++)
#pragma unroll
    for (int ni = 0; ni < 2; ni++)
#pragma unroll
      for (int r = 0; r < 16; r++)
        es[(wm * 64 + mi * 32 + (r & 3) + 8 * (r >> 2) + 4 * (lane >> 5)) * EST + wn * 64 + ni * 32 + (lane & 31)] = acc[mi][ni][r];
}
#define EPI8_BEGIN                                                                   \
  {                                                                                  \
    float* es = (float*)smem;                                                        \
    acc_to_lds(acc, es);                                                             \
    __syncthreads();                                                                 \
    for (int pass = 0; pass < 8; pass++) {                                           \
      const int row = pass * 16 + (tidx >> 4), col = (tidx & 15) * 8;  \
      const float4 e_va = *(const float4*)(es + row * EST + col);                    \
      const float4 e_vb = *(const float4*)(es + row * EST + col + 4);                \
      float v[8] = {e_va.x, e_va.y, e_va.z, e_va.w, e_vb.x, e_vb.y, e_vb.z, e_vb.w};
#define EPI8_END                                                                     \
    }                                                                                \
    __syncthreads();                                                                 \
  }
DI uint4 pack8(const float (&v)[8]) { return make_uint4(pack2(v[0], v[1]), pack2(v[2], v[3]), pack2(v[4], v[5]), pack2(v[6], v[7])); }
DI void unpack8(const uint4 u, float (&v)[8]) {
  v[0] = lo_bf(u.x); v[1] = hi_bf(u.x); v[2] = lo_bf(u.y); v[3] = hi_bf(u.y); v[4] = lo_bf(u.z); v[5] = hi_bf(u.z); v[6] = lo_bf(u.w); v[7] = hi_bf(u.w);
}
DI void resid_update(float* xp, const float* gate, const float (&v)[8]) {
  float4 x0 = *(const float4*)xp, x1 = *(const float4*)(xp + 4);
  const float4 g0 = *(const float4*)gate, g1 = *(const float4*)(gate + 4);
  x0.x += g0.x * v[0]; x0.y += g0.y * v[1]; x0.z += g0.z * v[2]; x0.w += g0.w * v[3];
  x1.x += g1.x * v[4]; x1.y += g1.y * v[5]; x1.z += g1.z * v[6]; x1.w += g1.w * v[7];
  *(float4*)xp = x0; *(float4*)(xp + 4) = x1;
}

DI void phase_t1(const P& p, char* smem) {
  const int tidx = opaque_tid();
  const bf16_t* HX = (const bf16_t*)(p.ws + OFF_TR + TR_HX);
  const bf16_t* WL1 = (const bf16_t*)(p.ws + OFF_W) + W_L1;
  bf16_t* T1 = (bf16_t*)(p.ws + OFF_TR + TR_T1);
  for (int t = blockIdx.x; t < 136 * 5; t += gridDim.x) {
    const int nt = t % 5, lt = t / 5;
    f32x16 acc[2][2];
    gemm_mainloop(HX + (size_t)lt * 128 * 2048, 2048, WL1 + (size_t)nt * 128 * 2048, 2048, 2048, smem, acc);
    EPI8_BEGIN
      const int c = nt * 128 + col;
      if (c < 128) {
#pragma unroll
        for (int e = 0; e < 8; e++) v[e] = tanhf(v[e]);
      } else if (c >= 192 && c < 576) {
#pragma unroll
        for (int e = 0; e < 8; e++) v[e] = sigmoidf_(v[e]);
      }
      *(uint4*)(T1 + (size_t)(lt * 128 + row) * 640 + c) = pack8(v);
    EPI8_END
  }
}

DI void phase_feat(const P& p, int layer, int hf, char* smem) {
  const int tidx = opaque_tid();
  const int j = layer / 2;
  const bf16_t* W = (const bf16_t*)(p.ws + OFF_W);
  const bf16_t* HX = (const bf16_t*)(p.ws + OFF_TR + TR_HX);
  const bf16_t* T1 = (const bf16_t*)(p.ws + OFF_TR + TR_T1);
  bf16_t* VF = (bf16_t*)(p.ws + OFF_VF);
  for (int t = blockIdx.x; t < 136 * 24; t += gridDim.x) {
    const int mg = t / (8 * 24), rem = t % (8 * 24);
    const int nt = rem / 8, lt = mg * 8 + (rem % 8);
    const int s = nt / 8, n0 = (nt % 8) * 128;
    const int gt = half_gtile(hf, lt);
    f32x16 acc[2][2];
    bf16_t* outp = (bf16_t*)(p.ws + OFF_TR + (s == 0 ? TR_R : (s == 1 ? TR_K : TR_V)));
    if (s == 2 && j > 0) {
      gemm_mainloop(T1 + (size_t)lt * 128 * 640 + 576, 640, W + W_V2 + (size_t)n0 * 64, 64, 64, smem, acc);
      const float* v0 = p.rw_v0 + (size_t)(j - 1) * 1024;
      EPI8_BEGIN
        const int c = n0 + col;
#pragma unroll
        for (int e = 0; e < 8; e++) v[e] = sigmoidf_(v0[c + e] + v[e]);
        *(uint4*)(outp + (size_t)(lt * 128 + row) * 1024 + c) = pack8(v);
      EPI8_END
    }
    gemm_mainloop(HX + (size_t)lt * 128 * 2048, 2048, W + W_RKV + ((size_t)s * 1024 + n0) * 2048, 2048, 2048, smem, acc);
    if (s < 2) {
      EPI8_BEGIN
        *(uint4*)(outp + (size_t)(lt * 128 + row) * 1024 + n0 + col) = pack8(v);
      EPI8_END
    } else if (j == 0) {
      EPI8_BEGIN
        const uint4 u = pack8(v);
        *(uint4*)(outp + (size_t)(lt * 128 + row) * 1024 + n0 + col) = u;
        *(uint4*)(VF + (size_t)(gt * 128 + row) * 1024 + n0 + col) = u;
      EPI8_END
    } else {
      EPI8_BEGIN
        const size_t oi = (size_t)(lt * 128 + row) * 1024 + n0 + col;
        float sg[8], vf[8];
        unpack8(*(const uint4*)(outp + oi), sg);
        unpack8(*(const uint4*)(VF + (size_t)(gt * 128 + row) * 1024 + n0 + col), vf);
#pragma unroll
        for (int e = 0; e < 8; e++) v[e] = v[e] + (vf[e] - v[e]) * sg[e];
        *(uint4*)(outp + oi) = pack8(v);
      EPI8_END
    }
  }
  for (int t = blockIdx.x; t < 136 * 40; t += gridDim.x) {
    const int lt = t / 40, nt = t % 40;
    const int s = nt / 8, n0 = (nt % 8) * 128;
    f32x16 acc[2][2];
    if (s == 0) {
      gemm_mainloop(T1 + (size_t)lt * 128 * 640 + 128, 640, W + W_A2 + (size_t)n0 * 64, 64, 64, smem, acc);
      bf16_t* outp = (bf16_t*)(p.ws + OFF_TR + TR_A);
      const float* a0 = p.rw_a0 + (size_t)j * 1024;
      EPI8_BEGIN
#pragma unroll
        for (int e = 0; e < 8; e++) v[e] = sigmoidf_(a0[n0 + col + e] + v[e]);
        *(uint4*)(outp + (size_t)(lt * 128 + row) * 1024 + n0 + col) = pack8(v);
      EPI8_END
    } else if (s < 3) {
      const int d = s - 1;
      gemm_mainloop(T1 + (size_t)lt * 128 * 640 + d * 64, 640, W + W_W2 + (size_t)d * 65536 + (size_t)n0 * 64, 64, 64, smem, acc);
      bf16_t* outp = (bf16_t*)(p.ws + OFF_TR + (d ? TR_WL1 : TR_WL0));
      const float* w0 = p.rw_w0 + ((size_t)j * 2 + d) * 1024;
      EPI8_BEGIN
#pragma unroll
        for (int e = 0; e < 8; e++) {
          const float z = -(w0[n0 + col + e] + v[e]);
          const float sp = fmaxf(z, 0.f) + log1pf(__expf(-fabsf(z)));
          v[e] = -__expf(-sp - 0.5f);
        }
        *(uint4*)(outp + (size_t)(lt * 128 + row) * 1024 + n0 + col) = pack8(v);
      EPI8_END
    } else {
      const int d = s - 3;
      gemm_mainloop(T1 + (size_t)lt * 128 * 640 + 192 + d * 192, 640, W + W_G2 + (size_t)d * 196608 + (size_t)n0 * 192, 192, 192, smem, acc);
      bf16_t* outp = (bf16_t*)(p.ws + OFF_TR + (d ? TR_G1 : TR_G0));
      EPI8_BEGIN
        *(uint4*)(outp + (size_t)(lt * 128 + row) * 1024 + n0 + col) = pack8(v);
      EPI8_END
    }
  }
}

DI int scan_row(int bl, int dir, int pos) {
  if (pos < CL) { int t = dir ? (CL - 1 - pos) : pos; return 16384 + bl * CL + t; }
  int t = pos - CL; if (dir) t = SL - 1 - t;
  return bl * SL + t;
}

DI void phase_scan(const P& p, int layer, char* smem) {
  const int tidx = opaque_tid();
  const int j = layer / 2;
  const int tid = tidx;
  const bf16_t* R = (const bf16_t*)(p.ws + OFF_TR + TR_R);
  const bf16_t* Kx = (const bf16_t*)(p.ws + OFF_TR + TR_K);
  const bf16_t* V = (const bf16_t*)(p.ws + OFF_TR + TR_V);
  const bf16_t* Aa = (const bf16_t*)(p.ws + OFF_TR + TR_A);
  float* sbuf = (float*)smem;
  constexpr int BUFF = 5 * 16 * 64 + 256;
  float* obuf = sbuf + 2 * BUFF;
  const int ss = tid >> 4, c4 = tid & 15;
  const int rl = tid >> 4, cg = tid & 15;
  for (int item = blockIdx.x; item < 512; item += gridDim.x) {
    const int q = item & 3, dir = (item >> 2) & 1, head = (item >> 3) & 15, bl = item >> 7;
    const bf16_t* WL = (const bf16_t*)(p.ws + OFF_TR + (dir ? TR_WL1 : TR_WL0));
    bf16_t* O = (bf16_t*)(p.ws + OFF_TR + TR_HX) + (dir ? (size_t)HROWS * 1024 : 0);
    const int ch = head * 64 + c4 * 4;
    const float4 kkw = *(const float4*)(p.rw_kk + (size_t)j * 1024 + ch);
    const float4 kaw = *(const float4*)(p.rw_ka + (size_t)j * 1024 + ch);
    float S0 = 0.f, S1 = 0.f, S2 = 0.f, S3 = 0.f;
    uint2 gr_, gk_, ga_, gw_, gv_;
    gv_ = make_uint2(0, 0);
    auto issue = [&](int chunk) {
      const size_t ro = (size_t)scan_row(bl, dir, chunk * 16 + ss) * 1024;
      gr_ = *(const uint2*)(R + ro + ch); gk_ = *(const uint2*)(Kx + ro + ch);
      ga_ = *(const uint2*)(Aa + ro + ch); gw_ = *(const uint2*)(WL + ro + ch);
      if (c4 < 4) gv_ = *(const uint2*)(V + ro + head * 64 + q * 16 + c4 * 4);
    };
    auto stage = [&](int buf) {
      float* sb = sbuf + buf * BUFF;
      float r0 = lo_bf(gr_.x), r1 = hi_bf(gr_.x), r2 = lo_bf(gr_.y), r3 = hi_bf(gr_.y);
      float k0 = lo_bf(gk_.x), k1 = hi_bf(gk_.x), k2 = lo_bf(gk_.y), k3 = hi_bf(gk_.y);
      float a0 = lo_bf(ga_.x), a1 = hi_bf(ga_.x), a2 = lo_bf(ga_.y), a3 = hi_bf(ga_.y);
      float w0 = lo_bf(gw_.x), w1 = hi_bf(gw_.x), w2 = lo_bf(gw_.y), w3 = hi_bf(gw_.y);
      float u0 = k0 * kkw.x, u1 = k1 * kkw.y, u2 = k2 * kkw.z, u3 = k3 * kkw.w;
      float sq = rowsum16(u0 * u0 + u1 * u1 + u2 * u2 + u3 * u3);
      float inv = rsqrtf(fmaxf(sq, 1e-24f));
      u0 *= inv; u1 *= inv; u2 *= inv; u3 *= inv;
      const int o = ss * 64 + c4 * 4;
      *(float4*)(sb + 0 * 1024 + o) = make_float4(__expf(w0), __expf(w1), __expf(w2), __expf(w3));
      *(float4*)(sb + 1 * 1024 + o) = make_float4(k0 * (1.f + (a0 - 1.f) * kaw.x), k1 * (1.f + (a1 - 1.f) * kaw.y), k2 * (1.f + (a2 - 1.f) * kaw.z), k3 * (1.f + (a3 - 1.f) * kaw.w));
      *(float4*)(sb + 2 * 1024 + o) = make_float4(-u0, -u1, -u2, -u3);
      *(float4*)(sb + 3 * 1024 + o) = make_float4(u0 * a0, u1 * a1, u2 * a2, u3 * a3);
      *(float4*)(sb + 4 * 1024 + o) = make_float4(r0, r1, r2, r3);
      if (c4 < 4) *(float4*)(sb + 5 * 1024 + ss * 16 + c4 * 4) = make_float4(lo_bf(gv_.x), hi_bf(gv_.x), lo_bf(gv_.y), hi_bf(gv_.y));
    };
    __syncthreads();
    issue(0);
    stage(0);
    __syncthreads();
    constexpr int NCH = TK / 16;
    for (int chunk = 0; chunk < NCH; chunk++) {
      const int buf = chunk & 1;
      if (chunk + 1 < NCH) issue(chunk + 1);
      __builtin_amdgcn_sched_barrier(0);
      const float* sb = sbuf + buf * BUFF;
      float* ob = obuf + buf * 256;
#pragma unroll
      for (int s = 0; s < 16; s++) {
        const float4 w4 = *(const float4*)(sb + 0 * 1024 + s * 64 + cg * 4);
        const float4 k4 = *(const float4*)(sb + 1 * 1024 + s * 64 + cg * 4);
        const float4 n4 = *(const float4*)(sb + 2 * 1024 + s * 64 + cg * 4);
        const float4 b4 = *(const float4*)(sb + 3 * 1024 + s * 64 + cg * 4);
        const float4 r4 = *(const float4*)(sb + 4 * 1024 + s * 64 + cg * 4);
        const float vv = sb[5 * 1024 + s * 16 + rl];
        float sa = S0 * n4.x + S1 * n4.y + S2 * n4.z + S3 * n4.w;
        sa = rowsum16(sa);
        S0 = S0 * w4.x + (sa * b4.x + vv * k4.x);
        S1 = S1 * w4.y + (sa * b4.y + vv * k4.y);
        S2 = S2 * w4.z + (sa * b4.z + vv * k4.z);
        S3 = S3 * w4.w + (sa * b4.w + vv * k4.w);
        float o = S0 * r4.x + S1 * r4.y + S2 * r4.z + S3 * r4.w;
        o = rowsum16(o);
        if (cg == 0) ob[s * 16 + rl] = o;
      }
      __builtin_amdgcn_sched_barrier(0);
      if (chunk + 1 < NCH) stage(buf ^ 1);
      __syncthreads();
      {
        const int s = tid >> 4, rr = tid & 15;
        const size_t ro = (size_t)scan_row(bl, dir, chunk * 16 + s) * 1024;
        O[ro + head * 64 + q * 16 + rr] = f2bf(ob[s * 16 + rr]);
      }
    }
  }
}

DI void phase_combine(const P& p, int layer) {
  const int tidx = opaque_tid();
  const int j = layer / 2;
  const bf16_t* Of = (const bf16_t*)(p.ws + OFF_TR + TR_HX);
  const bf16_t* Ob = Of + (size_t)HROWS * 1024;
  const bf16_t* R = (const bf16_t*)(p.ws + OFF_TR + TR_R);
  const bf16_t* Kx = (const bf16_t*)(p.ws + OFF_TR + TR_K);
  const bf16_t* V = (const bf16_t*)(p.ws + OFF_TR + TR_V);
  const bf16_t* Aa = (const bf16_t*)(p.ws + OFF_TR + TR_A);
  bf16_t* G0 = (bf16_t*)(p.ws + OFF_TR + TR_G0);
  const bf16_t* G1 = (const bf16_t*)(p.ws + OFF_TR + TR_G1);
  const size_t total = (size_t)HROWS * 128;
  for (size_t i = (size_t)blockIdx.x * 256 + tidx; i < total; i += (size_t)gridDim.x * 256) {
    const int c0 = (int)(i & 127) * 8;
    const size_t off = (i >> 7) * 1024 + c0;
    const uint4 uof = *(const uint4*)(Of + off), uob = *(const uint4*)(Ob + off), ur = *(const uint4*)(R + off), uk = *(const uint4*)(Kx + off);
    const uint4 ua = *(const uint4*)(Aa + off), uv = *(const uint4*)(V + off), ug0 = *(const uint4*)(G0 + off), ug1 = *(const uint4*)(G1 + off);
    const unsigned aof[4] = {uof.x, uof.y, uof.z, uof.w}, aob[4] = {uob.x, uob.y, uob.z, uob.w}, ar[4] = {ur.x, ur.y, ur.z, ur.w}, ak[4] = {uk.x, uk.y, uk.z, uk.w};
    const unsigned aa[4] = {ua.x, ua.y, ua.z, ua.w}, av[4] = {uv.x, uv.y, uv.z, uv.w}, ag0[4] = {ug0.x, ug0.y, ug0.z, ug0.w}, ag1[4] = {ug1.x, ug1.y, ug1.z, ug1.w};
    const float* ka = p.rw_ka + (size_t)j * 1024 + c0;
    const float* rk = p.rw_rk + (size_t)j * 1024 + c0;
    const float* lg = p.rw_ln_g + (size_t)j * 1024 + c0;
    const float* lb = p.rw_ln_b + (size_t)j * 1024 + c0;
    float of[8], obv[8];
    float sf = 0.f, sf2 = 0.f, sb = 0.f, sb2 = 0.f, br = 0.f;
#pragma unroll
    for (int e = 0; e < 8; e++) {
      const int w = e >> 1;
      of[e] = (e & 1) ? hi_bf(aof[w]) : lo_bf(aof[w]);
      obv[e] = (e & 1) ? hi_bf(aob[w]) : lo_bf(aob[w]);
      const float r = (e & 1) ? hi_bf(ar[w]) : lo_bf(ar[w]);
      const float k = (e & 1) ? hi_bf(ak[w]) : lo_bf(ak[w]);
      const float a = (e & 1) ? hi_bf(aa[w]) : lo_bf(aa[w]);
      sf += of[e]; sf2 += of[e] * of[e]; sb += obv[e]; sb2 += obv[e] * obv[e];
      br += r * k * (1.f + (a - 1.f) * ka[e]) * rk[e];
    }
#pragma unroll
    for (int o = 1; o < 8; o <<= 1) { sf += __shfl_xor(sf, o); sf2 += __shfl_xor(sf2, o); sb += __shfl_xor(sb, o); sb2 += __shfl_xor(sb2, o); br += __shfl_xor(br, o); }
    const float muf = sf * (1.f / 64.f), mub = sb * (1.f / 64.f);
    const float rsf = rsqrtf(fmaxf(sf2 * (1.f / 64.f) - muf * muf, 0.f) + 64e-5f);
    const float rsb = rsqrtf(fmaxf(sb2 * (1.f / 64.f) - mub * mub, 0.f) + 64e-5f);
    float y[8];
#pragma unroll
    for (int e = 0; e < 8; e++) {
      const int w = e >> 1;
      const float v = (e & 1) ? hi_bf(av[w]) : lo_bf(av[w]);
      const float g0 = (e & 1) ? hi_bf(ag0[w]) : lo_bf(ag0[w]);
      const float g1 = (e & 1) ? hi_bf(ag1[w]) : lo_bf(ag1[w]);
      const float bonus = br * v;
      y[e] = ((of[e] - muf) * rsf * lg[e] + lb[e] + bonus) * g0 + ((obv[e] - mub) * rsb * lg[e] + lb[e] + bonus) * g1;
    }
    *(uint4*)(G0 + off) = make_uint4(pack2(y[0], y[1]), pack2(y[2], y[3]), pack2(y[4], y[5]), pack2(y[6], y[7]));
  }
}

DI void phase_rw_out(const P& p, int layer, int hf, char* smem) {
  const int tidx = opaque_tid();
  const bf16_t* Y = (const bf16_t*)(p.ws + OFF_TR + TR_G0);
  const bf16_t* WO = (const bf16_t*)(p.ws + OFF_W) + W_WO;
  const int nlt = (layer == 3) ? 128 : 136;
  for (int t = blockIdx.x; t < nlt * 8; t += gridDim.x) {
    const int lt = t / 8, n0 = (t % 8) * 128;
    const int gt = half_gtile(hf, lt);
    f32x16 acc[2][2];
    gemm_mainloop(Y + (size_t)lt * 128 * 1024, 1024, WO + (size_t)n0 * 1024, 1024, 1024, smem, acc);
    const float* gate = mods_ptr(p, layer, mod_row(gt * 128)) + 2048 + n0;
    float* xr = resid_row(p, gt * 128) + n0;
    EPI8_BEGIN
      resid_update(xr + (size_t)row * D + col, gate + col, v);
    EPI8_END
  }
}

DI void phase_mlp1(const P& p, int layer, char* smem) {
  const int tidx = opaque_tid();
  const bf16_t* H2 = (const bf16_t*)(p.ws + OFF_TR + TR_H2);
  const bf16_t* W1 = (const bf16_t*)(p.ws + OFF_W) + W_M1;
  bf16_t* HID = (bf16_t*)(p.ws + OFF_TR + TR_HID);
  const int nmt = (layer == 3) ? 256 : 272;
  const int ngrp = nmt / 16;
  for (int t = blockIdx.x; t < nmt * 32; t += gridDim.x) {
    const int mg = t / (16 * 32), rem = t % (16 * 32);
    const int nt = rem / 16, gt = mg * 16 + (rem % 16);
    (void)ngrp;
    f32x16 acc[2][2];
    gemm_mainloop(H2 + (size_t)gt * 128 * 1024, 1024, W1 + (size_t)nt * 128 * 1024, 1024, 1024, smem, acc);
    EPI8_BEGIN
#pragma unroll
      for (int e = 0; e < 8; e++) { const float rl = fmaxf(v[e], 0.f); v[e] = rl * rl; }
      *(uint4*)(HID + (size_t)(gt * 128 + row) * 4096 + nt * 128 + col) = pack8(v);
    EPI8_END
  }
}
DI void phase_mlp2(const P& p, int layer, char* smem) {
  const int tidx = opaque_tid();
  const bf16_t* HID = (const bf16_t*)(p.ws + OFF_TR + TR_HID);
  const bf16_t* W2 = (const bf16_t*)(p.ws + OFF_W) + W_M2;
  const int nmt = (layer == 3) ? 256 : 272;
  for (int t = blockIdx.x; t < nmt * 8; t += gridDim.x) {
    const int gt = t / 8, n0 = (t % 8) * 128;
    f32x16 acc[2][2];
    gemm_mainloop(HID + (size_t)gt * 128 * 4096, 4096, W2 + (size_t)n0 * 4096, 4096, 4096, smem, acc);
    const float* gate = mods_ptr(p, layer, mod_row(gt * 128)) + 5120 + n0;
    float* xr = resid_row(p, gt * 128) + n0;
    EPI8_BEGIN
      resid_update(xr + (size_t)row * D + col, gate + col, v);
    EPI8_END
  }
}

DI void phase_qkv(const P& p, char* smem) {
  const int tidx = opaque_tid();
  const bf16_t* H = (const bf16_t*)(p.ws + OFF_TR + TR_H);
  const bf16_t* WQ = (const bf16_t*)(p.ws + OFF_W) + W_QKV;
  bf16_t* Q = (bf16_t*)(p.ws + OFF_TR + TR_Q);
  bf16_t* Kb = (bf16_t*)(p.ws + OFF_TR + TR_KK);
  bf16_t* VT = (bf16_t*)(p.ws + OFF_TR + TR_VT);
  const float* cosT = (const float*)(p.ws + OFF_MISC);
  const float* sinT = cosT + 1024;
  for (int t = blockIdx.x; t < 272 * 24; t += gridDim.x) {
    const int mg = t / (16 * 24), rem = t % (16 * 24);
    const int nt = rem / 16, gt = mg * 16 + (rem % 16);
    f32x16 acc[2][2];
    gemm_mainloop(H + (size_t)gt * 128 * 1024, 1024, WQ + (size_t)nt * 128 * 1024, 1024, 1024, smem, acc);
    const bool lat = gt < 256;
    const int b = lat ? gt / 32 : (gt - 256) / 2;
    const int t0 = lat ? (gt % 32) * 128 : (gt - 256) % 2 * 128;
    const int tq0 = lat ? t0 : SL + t0;
    const int typ = nt / 8, h = nt % 8;
    if (typ < 2) {
      bf16_t* dst = typ == 0 ? Q : Kb;
      const float qs = typ == 0 ? 0.125f * 1.44269504088896f : 1.f;
      EPI8_BEGIN
        const int sidx = col >> 6, d0 = col & 63;
        if (lat) {
          const float4 pa = *(const float4*)(es + row * EST + (col ^ 16));
          const float4 pb = *(const float4*)(es + row * EST + (col ^ 16) + 4);
          const float pr[8] = {pa.x, pa.y, pa.z, pa.w, pb.x, pb.y, pb.z, pb.w};
          const int tt = t0 + row;
          const int pos = (d0 < 32) ? (tt >> 6) : (tt & 63);
          const float4 ca = *(const float4*)(cosT + pos * 16 + (d0 & 8)), cb = *(const float4*)(cosT + pos * 16 + (d0 & 8) + 4);
          const float4 sa = *(const float4*)(sinT + pos * 16 + (d0 & 8)), sb = *(const float4*)(sinT + pos * 16 + (d0 & 8) + 4);
          const float cs[8] = {ca.x, ca.y, ca.z, ca.w, cb.x, cb.y, cb.z, cb.w};
          const float sn[8] = {sa.x, sa.y, sa.z, sa.w, sb.x, sb.y, sb.z, sb.w};
          const float sgn = (d0 & 16) ? 1.f : -1.f;
#pragma unroll
          for (int e = 0; e < 8; e++) v[e] = v[e] * cs[e] + sgn * pr[e] * sn[e];
        }
#pragma unroll
        for (int e = 0; e < 8; e++) v[e] *= qs;
        *(uint4*)(dst + ((size_t)((b * 8 + h) * 2 + sidx) * TK + tq0 + row) * 64 + d0) = pack8(v);
      EPI8_END
    } else {
      float* es = (float*)smem;
      acc_to_lds(acc, es);
      __syncthreads();
      for (int pass = 0; pass < 8; pass++) {
        const int d = tidx & 127, tg = pass * 2 + (tidx >> 7);
        float v[8];
#pragma unroll
        for (int e = 0; e < 8; e++) v[e] = es[(tg * 8 + e) * EST + d];
        *(uint4*)(VT + ((size_t)(b * 8 + h) * 128 + d) * TK + tq0 + tg * 8) = pack8(v);
      }
      __syncthreads();
    }
  }
}

typedef _Float16 hv2 __attribute__((ext_vector_type(2)));
DI unsigned packh2(float a, float b) { hv2 r = {(_Float16)a, (_Float16)b}; return __builtin_bit_cast(unsigned, r); }
DI float lo_h(unsigned u) { hv2 r = __builtin_bit_cast(hv2, u); return (float)r[0]; }
DI float hi_h(unsigned u) { hv2 r = __builtin_bit_cast(hv2, u); return (float)r[1]; }

DI void phase_attn(const P& p, int layer, char* smem) {
  const int tidx = opaque_tid();
  const int j = layer / 2;
  const bool ctxq = layer != 3;
  const bf16_t* Q = (const bf16_t*)(p.ws + OFF_TR + TR_Q);
  const bf16_t* Kb = (const bf16_t*)(p.ws + OFF_TR + TR_KK);
  const bf16_t* VT = (const bf16_t*)(p.ws + OFF_TR + TR_VT);
  bf16_t* O = (bf16_t*)(p.ws + OFF_TR + TR_H);
  const float lam = ((const float*)(p.ws + OFF_MISC))[2048 + j];
  const float oml = 1.f - lambda_init(layer);
  const float* subg = p.da_subln_g + (size_t)j * 128;
  bf16_t* sK = (bf16_t*)smem;
  bf16_t* sV = sK + 2 * 64 * LDT;
  const int tid = tidx, lane = tid & 63, w = tid >> 6, g = lane >> 5, l31 = lane & 31;
  const int nitems = 2048 + (ctxq ? 128 : 0);
  for (int item = blockIdx.x; item < nitems; item += gridDim.x) {
    int b, h, q0, kbeg, ntiles;
    if (item < 2048) { b = item >> 8; h = (item >> 5) & 7; q0 = (item & 31) * 128; kbeg = 0; ntiles = TK / 64; }
    else { const int it = item - 2048; b = it >> 4; h = (it >> 1) & 7; q0 = SL + (it & 1) * 128; kbeg = SL; ntiles = CL / 64; }
    const bf16_t* Vp0 = VT + (size_t)(b * 8 + h) * 128 * TK;
    const int tq = q0 + w * 32 + l31;
    const size_t grow = tq < SL ? (size_t)b * SL + tq : (size_t)NLAT + (size_t)b * CL + (tq - SL);
    bf16_t* op = O + grow * 1024 + h * 128;
    for (int s = 0; s < 2; s++) {
      const bf16_t* Kp0 = Kb + (size_t)((b * 8 + h) * 2 + s) * TK * 64;
      const bf16_t* Qp = Q + ((size_t)((b * 8 + h) * 2 + s) * TK + tq) * 64 + g * 8;
      bf16x8 qf[4];
#pragma unroll
      for (int kk = 0; kk < 4; kk++) qf[kk] = *(const bf16x8*)(Qp + kk * 16);
      f32x16 o[4];
#pragma unroll
      for (int db = 0; db < 4; db++)
#pragma unroll
        for (int r = 0; r < 16; r++) o[db][r] = 0.f;
      float m = -1e30f, l = 0.f;
      uint4 rk0, rk1, rv0, rv1, rv2, rv3;
      const unsigned kvo = (unsigned)((tid >> 3) * 64 + (tid & 7) * 8);
      const unsigned vvo = (unsigned)((tid >> 3) * TK + (tid & 7) * 8);
      const unsigned sko = (unsigned)((tid >> 3) * LDT + (tid & 7) * 8);
#define ISSUE_KV(kt_)                                                             \
      {                                                                           \
        const bf16_t* kb_ = Kp0 + (size_t)(kbeg + (kt_) * 64) * 64;               \
        const bf16_t* vb_ = Vp0 + (kbeg + (kt_) * 64);                            \
        rk0 = *(const uint4*)(kb_ + kvo);                                         \
        rk1 = *(const uint4*)(kb_ + (kvo + 32u * 64u));                           \
        rv0 = *(const uint4*)(vb_ + vvo);                                         \
        rv1 = *(const uint4*)(vb_ + (vvo + 32u * (unsigned)TK));                  \
        rv2 = *(const uint4*)(vb_ + (vvo + 64u * (unsigned)TK));                  \
        rv3 = *(const uint4*)(vb_ + (vvo + 96u * (unsigned)TK));                  \
      }
#define STAGE_KV(buf_)                                                            \
      {                                                                           \
        bf16_t* ks_ = sK + (buf_) * 64 * LDT + sko;                               \
        bf16_t* vs_ = sV + (buf_) * 128 * LDT + sko;                              \
        *(uint4*)(ks_) = rk0;                                                     \
        *(uint4*)(ks_ + 32 * LDT) = rk1;                                          \
        *(uint4*)(vs_) = rv0;                                                     \
        *(uint4*)(vs_ + 32 * LDT) = rv1;                                          \
        *(uint4*)(vs_ + 64 * LDT) = rv2;                                          \
        *(uint4*)(vs_ + 96 * LDT) = rv3;                                          \
      }
      __syncthreads();
      ISSUE_KV(0);
      STAGE_KV(0);
      __syncthreads();
      for (int kt = 0; kt < ntiles; kt++) {
        const int buf = kt & 1;
        const bool more = kt + 1 < ntiles;
        if (more) ISSUE_KV(kt + 1);
        __builtin_amdgcn_sched_barrier(0);
        const bf16_t* kS = sK + buf * 64 * LDT;
        const bf16_t* vS = sV + buf * 128 * LDT;
#pragma unroll
        for (int kb = 0; kb < 2; kb++) {
          f32x16 st;
#pragma unroll
          for (int r = 0; r < 16; r++) st[r] = 0.f;
#pragma unroll
          for (int kk = 0; kk < 4; kk++) {
            const bf16x8 kf = *(const bf16x8*)(kS + (kb * 32 + l31) * LDT + kk * 16 + g * 8);
            st = MFMA32(kf, qf[kk], st);
          }
          float mx = st[0];
#pragma unroll
          for (int r = 1; r < 16; r++) mx = fmaxf(mx, st[r]);
          mx = fmaxf(mx, __shfl_xor(mx, 32));
          if (__any(mx > m + 8.f)) {
            const float mn = (mx > m + 8.f) ? mx : m;
            const float al = exp2f(m - mn);
            m = mn;
            l *= al;
#pragma unroll
            for (int db = 0; db < 4; db++)
#pragma unroll
              for (int r = 0; r < 16; r++) o[db][r] *= al;
          }
          float ls = 0.f;
          bf16x8 pk[2];
#pragma unroll
          for (int hh = 0; hh < 2; hh++) {
            float e[8];
#pragma unroll
            for (int i = 0; i < 8; i++) { e[i] = exp2f(st[hh * 8 + i] - m); ls += e[i]; }
            const uint4 u = make_uint4(pack2(e[0], e[1]), pack2(e[2], e[3]), pack2(e[4], e[5]), pack2(e[6], e[7]));
            pk[hh] = __builtin_bit_cast(bf16x8, u);
          }
          l += ls;
#pragma unroll
          for (int db = 0; db < 4; db++)
#pragma unroll
            for (int hh = 0; hh < 2; hh++) {
              const bf16_t* vp = vS + (db * 32 + l31) * LDT + kb * 32 + hh * 16 + 4 * g;
              const uint2 lo = *(const uint2*)vp;
              const uint2 hi = *(const uint2*)(vp + 8);
              const uint4 u = make_uint4(lo.x, lo.y, hi.x, hi.y);
              o[db] = MFMA32(__builtin_bit_cast(bf16x8, u), pk[hh], o[db]);
            }
        }
        __builtin_amdgcn_sched_barrier(0);
        if (more) STAGE_KV(buf ^ 1);
        __syncthreads();
      }
      const float lt = l + __shfl_xor(l, 32);
      if (s == 0) {
        const float inv = 1.f / lt;
#pragma unroll
        for (int db = 0; db < 4; db++)
#pragma unroll
          for (int rq = 0; rq < 4; rq++) {
            const int d = db * 32 + 8 * rq + 4 * g;
            *(uint2*)(op + d) = make_uint2(packh2(o[db][4 * rq] * inv, o[db][4 * rq + 1] * inv), packh2(o[db][4 * rq + 2] * inv, o[db][4 * rq + 3] * inv));
          }
      } else {
        const float inv = lam / lt;
        float ssq = 0.f;
#pragma unroll
        for (int db = 0; db < 4; db++)
#pragma unroll
          for (int rq = 0; rq < 4; rq++) {
            const int d = db * 32 + 8 * rq + 4 * g;
            const uint2 u0 = *(const uint2*)(op + d);
            const float a0 = lo_h(u0.x) - o[db][4 * rq] * inv, a1 = hi_h(u0.x) - o[db][4 * rq + 1] * inv;
            const float a2 = lo_h(u0.y) - o[db][4 * rq + 2] * inv, a3 = hi_h(u0.y) - o[db][4 * rq + 3] * inv;
            o[db][4 * rq] = a0; o[db][4 * rq + 1] = a1; o[db][4 * rq + 2] = a2; o[db][4 * rq + 3] = a3;
            ssq += a0 * a0 + a1 * a1 + a2 * a2 + a3 * a3;
          }
        ssq += __shfl_xor(ssq, 32);
        const float rs = rsqrtf(ssq * (1.f / 128.f) + 1e-5f) * oml;
#pragma unroll
        for (int db = 0; db < 4; db++)
#pragma unroll
          for (int rq = 0; rq < 4; rq++) {
            const int d = db * 32 + 8 * rq + 4 * g;
            const float4 sg = *(const float4*)(subg + d);
            *(uint2*)(op + d) = make_uint2(pack2(o[db][4 * rq] * rs * sg.x, o[db][4 * rq + 1] * rs * sg.y),
                                           pack2(o[db][4 * rq + 2] * rs * sg.z, o[db][4 * rq + 3] * rs * sg.w));
          }
      }
    }
  }
}

DI void phase_at_out(const P& p, int layer, char* smem) {
  const int tidx = opaque_tid();
  const bf16_t* O = (const bf16_t*)(p.ws + OFF_TR + TR_H);
  const bf16_t* WO = (const bf16_t*)(p.ws + OFF_W) + W_WO;
  const int nmt = (layer == 3) ? 256 : 272;
  for (int t = blockIdx.x; t < nmt * 8; t += gridDim.x) {
    const int gt = t / 8, n0 = (t % 8) * 128;
    f32x16 acc[2][2];
    gemm_mainloop(O + (size_t)gt * 128 * 1024, 1024, WO + (size_t)n0 * 1024, 1024, 1024, smem, acc);
    const float* gate = mods_ptr(p, layer, mod_row(gt * 128)) + 2048 + n0;
    float* xr = resid_row(p, gt * 128) + n0;
    EPI8_BEGIN
      resid_update(xr + (size_t)row * D + col, gate + col, v);
    EPI8_END
  }
}

DI void phase_final(const P& p) {
  const int tidx = opaque_tid();
  const int lane = tidx & 63, wv = tidx >> 6;
  for (int row = blockIdx.x * 4 + wv; row < NLAT; row += gridDim.x * 4) {
    float* xr = p.out + (size_t)row * D;
    float4 v[4];
    float ss = 0.f;
#pragma unroll
    for (int jx = 0; jx < 4; jx++) { v[jx] = *(const float4*)(xr + jx * 256 + lane * 4); ss += v[jx].x * v[jx].x + v[jx].y * v[jx].y + v[jx].z * v[jx].z + v[jx].w * v[jx].w; }
    ss = wave_sum(ss);
    const float rs = rsqrtf(ss * (1.f / 1024.f) + 1e-6f);
#pragma unroll
    for (int jx = 0; jx < 4; jx++) {
      const float4 g = *(const float4*)(p.final_g + jx * 256 + lane * 4);
      *(float4*)(xr + jx * 256 + lane * 4) = make_float4(v[jx].x * rs * g.x, v[jx].y * rs * g.y, v[jx].z * rs * g.z, v[jx].w * rs * g.w);
    }
  }
}

#define XB_TMO      128
#define XB_XCNT(j)  (256  + 64 * (j))
#define XB_XSUB(j)  (1280 + 64 * (j))
#define XB_XGEN(j)  (2304 + 64 * (j))
#define XB_TOP      3328
#define XB_TOPGEN   3392
#define XCD_BAR_WORDS 3456
#define XB_SPIN_CAP (1u << 22)
#define LAS __attribute__((address_space(3)))
DI unsigned xb_ld(unsigned* p) { return __hip_atomic_load(p, __ATOMIC_RELAXED, __HIP_MEMORY_SCOPE_AGENT); }
DI unsigned xb_add(unsigned* p, unsigned v) { return __hip_atomic_fetch_add(p, v, __ATOMIC_RELAXED, __HIP_MEMORY_SCOPE_AGENT); }
DI unsigned xb_xcc_id() { return (unsigned)__builtin_amdgcn_s_getreg((3 << 11) | 20) & 0xFu; }
#define XB_SPIN(cond, bar) do { unsigned _sp = 0; while (cond) { __builtin_amdgcn_s_sleep(1); \
    if ((++_sp & 255u) == 0u) { if (xb_ld(&(bar)[XB_TMO])) break; if (_sp > XB_SPIN_CAP) { atomicAdd(&(bar)[XB_TMO], 1u); break; } } } } while (0)
struct XcdBarrier { unsigned* bar; unsigned x; volatile LAS unsigned* st; };
DI XcdBarrier xcd_barrier_post(unsigned* bar, volatile LAS unsigned* st) {
  XcdBarrier b; b.bar = bar; b.x = xb_xcc_id(); b.st = st;
  if (threadIdx.x == 0) (void)xb_add(&bar[XB_XCNT(b.x)], 1u);
  return b;
}
DI void xcd_barrier_complete(unsigned* bar, unsigned x, unsigned& nloc, unsigned& nx) {
  const unsigned G = gridDim.x * gridDim.y * gridDim.z;
  unsigned sum, cnt, mine, sp = 0u;
  for (;;) {
    sum = 0u; cnt = 0u; mine = 0u;
#pragma unroll
    for (unsigned j = 0; j < 16; ++j) { const unsigned c = xb_ld(&bar[XB_XCNT(j)]); sum += c; cnt += (c > 0u) ? 1u : 0u; mine = (j == x) ? c : mine; }
    if (sum == G) break;
    __builtin_amdgcn_s_sleep(1);
    if ((++sp & 255u) == 0u) { if (xb_ld(&bar[XB_TMO])) break; if (sp > XB_SPIN_CAP) { atomicAdd(&bar[XB_TMO], 1u); break; } }
  }
  nloc = mine > 0u ? mine : 1u; nx = cnt > 0u ? cnt : 1u;
}
DI void xcd_barrier(const XcdBarrier& b) {
  asm volatile("s_waitcnt vmcnt(0)" ::: "memory");
  __syncthreads();
  if (threadIdx.x == 0) {
    unsigned* bar = b.bar;
    __builtin_amdgcn_s_waitcnt(0);
    unsigned nloc = b.st[0], nx = b.st[1];
    if (nloc == 0u) { xcd_barrier_complete(bar, b.x, nloc, nx); b.st[0] = nloc; b.st[1] = nx; }
    const unsigned old = xb_add(&bar[XB_XSUB(b.x)], 1u);
    const unsigned gen = old / nloc;
    if (old + 1u == (gen + 1u) * nloc) {
      __builtin_amdgcn_fence(__ATOMIC_RELEASE, "agent");
      asm volatile("s_waitcnt vmcnt(0)" ::: "memory");
      const unsigned og = xb_add(&bar[XB_TOP], 1u);
      const unsigned tg = og / nx;
      if (og + 1u == (tg + 1u) * nx) xb_add(&bar[XB_TOPGEN], 1u);
      else XB_SPIN(xb_ld(&bar[XB_TOPGEN]) == tg, bar);
      __builtin_amdgcn_fence(__ATOMIC_ACQUIRE, "agent");
      xb_add(&bar[XB_XGEN(b.x)], 1u);
      asm volatile("s_waitcnt vmcnt(0)" ::: "memory");
    } else {
      XB_SPIN(xb_ld(&bar[XB_XGEN(b.x)]) == gen, bar);
      __builtin_amdgcn_fence(__ATOMIC_ACQUIRE, "agent");
      asm volatile("s_waitcnt vmcnt(0)" ::: "memory");
    }
  }
  __syncthreads();
}
constexpr size_t OFF_BAR = OFF_MISC + 65536;

typedef __attribute__((address_space(1))) const float GCF;
typedef __attribute__((address_space(1))) float GF;
typedef __attribute__((address_space(1))) char GC;
DI unsigned long long lds_word(const unsigned long long* tbl, int i) {
  int z = i;
  asm volatile("" : "+v"(z));
  const unsigned long long v = tbl[z];
  const unsigned lo = __builtin_amdgcn_readfirstlane((unsigned)v), hi = __builtin_amdgcn_readfirstlane((unsigned)(v >> 32));
  return ((unsigned long long)hi << 32) | lo;
}
DI void load_params(P& q, const unsigned long long* tbl) {
  const float** fp = (const float**)&q;
#pragma unroll
  for (int i = 0; i < 36; i++) fp[i] = (const float*)(GCF*)lds_word(tbl, i);
  q.out = (float*)(GF*)lds_word(tbl, 36);
  q.ws = (char*)(GC*)lds_word(tbl, 37);
  q.only = 0;
  q.pad = 0;
}
__global__ void __launch_bounds__(256, 2) mega(P p) {
  __shared__ __attribute__((aligned(16))) char smem[73728];
  __shared__ unsigned long long s_tbl[40];
  {
#if defined(__HIP_DEVICE_COMPILE__)
    typedef __attribute__((address_space(4))) const unsigned long long KW;
    KW* kp = (KW*)__builtin_amdgcn_kernarg_segment_ptr();
    if (threadIdx.x < 39) s_tbl[threadIdx.x] = kp[threadIdx.x];
#endif
    __syncthreads();
  }
  const int only = (int)(unsigned)lds_word(s_tbl, 38);
  cg::grid_group grid = cg::this_grid();
  __shared__ uint4 xb_words;
  if (threadIdx.x == 0) xb_words = make_uint4(0u, 0u, 0u, 0u);
  __syncthreads();
  XcdBarrier xb;
  {
    P q;
    load_params(q, s_tbl);
    xb = xcd_barrier_post((unsigned*)(q.ws + OFF_BAR), (volatile LAS unsigned*)&xb_words);
  }
  int step = 0;
#define GSYNC() { if (step == 1) grid.sync(); else xcd_barrier(xb); }
#define STEP(body)                                   \
  {                                                  \
    if (only < 0 || only == step) {              \
      P q;                                           \
      load_params(q, s_tbl);                         \
      body;                                          \
    }                                                \
    step++;                                          \
    if (only < 0) GSYNC();                         \
  }
#ifndef DUP
#define DUP 0
#endif
#define STEPD(id, body)                              \
  {                                                  \
    if (only < 0 || only == step) {                  \
      P q;                                           \
      load_params(q, s_tbl);                         \
      body;                                          \
      if (DUP == id) { __syncthreads(); body; }      \
    }                                                \
    step++;                                          \
    if (only < 0) GSYNC();                           \
  }
  STEP(phase_init(q, smem));
  for (int layer = 0; layer < 4; layer++) {
    STEPD(1, phase_conv(q, layer, smem));
    if ((layer & 1) == 0) {
      for (int hf = 0; hf < 2; hf++) {
        STEP(phase_prep(q, layer, 0, hf, true, (bf16_t*)(q.ws + OFF_TR + TR_HX), 2048, false));
        STEPD(3, phase_t1(q, smem));
        STEPD(4, phase_feat(q, layer, hf, smem));
        STEPD(5, phase_scan(q, layer, smem));
        STEP(phase_combine(q, layer));
        STEP(phase_rw_out(q, layer, hf, smem));
      }
    } else {
      STEP(phase_prep(q, layer, 0, -1, false, (bf16_t*)(q.ws + OFF_TR + TR_H), 1024, false));
      STEPD(7, phase_qkv(q, smem));
      STEPD(8, phase_attn(q, layer, smem));
      STEP(phase_at_out(q, layer, smem));
    }
    STEP(phase_prep(q, layer, 1, -1, false, (bf16_t*)(q.ws + OFF_TR + TR_H2), 1024, layer == 3));
    STEPD(9, phase_mlp1(q, layer, smem));
    STEP(phase_mlp2(q, layer, smem));
  }
  STEP(phase_final(q));
}

#ifndef MULTI_LAUNCH
#define MULTI_LAUNCH 0
#endif
constexpr int NSTEPS = 1 + 2 * (1 + 12 + 3) + 2 * (1 + 4 + 3) + 1;

extern "C" void kernel_launch(void* const* d_in, const int* in_sizes, int n_in, void* d_out, int out_size, void* d_ws, size_t ws_size,
                              hipStream_t stream) {
  static int grid_blocks = 0;
  if (!grid_blocks) {
    int dev = 0, cus = 0, per_cu = 0;
    hipGetDevice(&dev);
    hipDeviceGetAttribute(&cus, hipDeviceAttributeMultiprocessorCount, dev);
    hipOccupancyMaxActiveBlocksPerMultiprocessor(&per_cu, mega, 256, 0);
    if (per_cu < 1) per_cu = 1;
    if (per_cu > 2) per_cu = 2;
    grid_blocks = cus * per_cu;
  }
  P p{};
  const float** fp = (const float**)&p;
  for (int i = 0; i < 36; i++) fp[i] = (const float*)d_in[i];
  p.out = (float*)d_out;
  p.ws = (char*)d_ws;
  p.pad = 0;
#if MULTI_LAUNCH
  for (int s = 0; s < NSTEPS; s++) {
    p.only = s;
    void* args[] = {&p};
    hipError_t e = hipLaunchCooperativeKernel((void*)mega, dim3(grid_blocks), dim3(256), args, 0, stream);
    if (e != hipSuccess) { fprintf(stderr, "launch failed: %s\n", hipGetErrorString(e)); break; }
  }
#else
  p.only = -1;
  hipMemsetAsync((char*)d_ws + OFF_BAR, 0, XCD_BAR_WORDS * 4, stream);
  void* args[] = {&p};
  hipError_t e = hipLaunchCooperativeKernel((void*)mega, dim3(grid_blocks), dim3(256), args, 0, stream);
  if (e != hipSuccess) fprintf(stderr, "cooperative launch failed: %s (grid %d)\n", hipGetErrorString(e), grid_blocks);
#endif
}
```

```cpp
#include <hip/hip_runtime.h>
#include <hip/hip_cooperative_groups.h>
#include <cstdio>
namespace cg = cooperative_groups;

#define DI __device__ __forceinline__
typedef unsigned short bf16_t;
using bf16x8 = __attribute__((ext_vector_type(8))) short;
using f32x16 = __attribute__((ext_vector_type(16))) float;
typedef __bf16 bfv2 __attribute__((ext_vector_type(2)));
typedef float fv2 __attribute__((ext_vector_type(2)));
#define MFMA32(a, b, c) __builtin_amdgcn_mfma_f32_32x32x16_bf16((a), (b), (c), 0, 0, 0)

constexpr int D = 1024, NB = 8, SL = 4096, CL = 256;
constexpr int NLAT = NB * SL, NCTX = NB * CL, NTOK = NLAT + NCTX;
constexpr int HROWS = NTOK / 2;
constexpr int TK = SL + CL;
constexpr size_t MiB = 1048576;
constexpr size_t OFF_W = 0, OFF_XC = 36 * MiB, OFF_MODS = 44 * MiB, OFF_MISC = 45 * MiB, OFF_VF = 46 * MiB, OFF_TR = 114 * MiB;
constexpr size_t W_RKV = 0;
constexpr size_t W_L1 = W_RKV + 3072ull * 2048;
constexpr size_t W_W2 = W_L1 + 640ull * 2048;
constexpr size_t W_A2 = W_W2 + 2ull * 65536;
constexpr size_t W_G2 = W_A2 + 65536;
constexpr size_t W_V2 = W_G2 + 2ull * 196608;
constexpr size_t W_WO = W_V2 + 65536;
constexpr size_t W_M1 = W_WO + 1048576;
constexpr size_t W_M2 = W_M1 + 4194304;
constexpr size_t W_QKV = 0;
constexpr size_t HALF_ARR = (size_t)HROWS * 1024 * 2;
constexpr size_t TR_HX = 0;
constexpr size_t TR_T1 = 2 * HALF_ARR;
constexpr size_t TR_R = TR_T1 + (size_t)HROWS * 640 * 2;
constexpr size_t TR_K = TR_R + HALF_ARR, TR_V = TR_K + HALF_ARR, TR_A = TR_V + HALF_ARR;
constexpr size_t TR_WL0 = TR_A + HALF_ARR, TR_WL1 = TR_WL0 + HALF_ARR, TR_G0 = TR_WL1 + HALF_ARR, TR_G1 = TR_G0 + HALF_ARR;
constexpr size_t FULL_ARR = (size_t)NTOK * 1024 * 2;
constexpr size_t TR_H = 0, TR_Q = FULL_ARR, TR_KK = 2 * FULL_ARR, TR_VT = 3 * FULL_ARR;
constexpr size_t TR_H2 = 0, TR_HID = FULL_ARR;

struct P {
  const float *x, *c, *ctx, *c_ctx, *ada_w, *ada_b, *norm_g, *final_g;
  const float *rw_mix, *rw_w_rkv, *rw_w0, *rw_w1, *rw_w2, *rw_a0, *rw_a1, *rw_a2, *rw_g1, *rw_g2, *rw_kk, *rw_ka, *rw_rk, *rw_ln_g, *rw_ln_b, *rw_w_o, *rw_v0, *rw_v1, *rw_v2;
  const float *da_w_qkv, *da_w_o, *da_lq1, *da_lk1, *da_lq2, *da_lk2, *da_subln_g, *mlp_w1, *mlp_w2;
  float* out;
  char* ws;
  int only;
  int pad;
};

DI float bf2f(bf16_t h) { return __uint_as_float(((unsigned)h) << 16); }
DI unsigned pack2(float a, float b) { fv2 v = {a, b}; bfv2 r = __builtin_convertvector(v, bfv2); return __builtin_bit_cast(unsigned, r); }
DI bf16_t f2bf(float a) { return (bf16_t)(pack2(a, 0.f) & 0xffffu); }
DI float lo_bf(unsigned u) { return __uint_as_float(u << 16); }
DI float hi_bf(unsigned u) { return __uint_as_float(u & 0xffff0000u); }
DI float sigmoidf_(float x) { return 1.f / (1.f + __expf(-x)); }
DI float wave_sum(float v) {
#pragma unroll
  for (int o = 32; o > 0; o >>= 1) v += __shfl_xor(v, o);
  return v;
}
template <int N> DI float ror_add(float x) { return x + __builtin_bit_cast(float, __builtin_amdgcn_mov_dpp(__builtin_bit_cast(int, x), 0x120 + N, 0xf, 0xf, true)); }
DI float rowsum16(float x) { x = ror_add<8>(x); x = ror_add<4>(x); x = ror_add<2>(x); x = ror_add<1>(x); return x; }

DI int opaque_tid() { int t = threadIdx.x; asm volatile("" : "+v"(t)); return t; }
DI float* resid_row(const P& p, int gr) { return gr < NLAT ? p.out + (size_t)gr * D : (float*)(p.ws + OFF_XC) + (size_t)(gr - NLAT) * D; }
DI int mod_row(int gr) { return gr < NLAT ? gr / SL : 8; }
DI const float* mods_ptr(const P& p, int layer, int mrow) { return (const float*)(p.ws + OFF_MODS) + ((size_t)layer * 9 + mrow) * 6144; }
DI int half_gtile(int hf, int lt) { return lt < 128 ? hf * 128 + lt : 256 + hf * 8 + (lt - 128); }
DI int first_tile(int base) { int g = gridDim.x; int s = (int)blockIdx.x - (base % g); if (s < 0) s += g; return s; }
DI float lambda_init(int layer) { return 0.8f - 0.6f * expf(-0.3f * (float)layer); }

DI void phase_init(const P& p, char* smem) {
  const int tidx = opaque_tid();
  const int tid = tidx;
  float* sc = (float*)smem;
  float* mods = (float*)(p.ws + OFF_MODS);
  for (int item = blockIdx.x; item < 96; item += gridDim.x) {
    const int layer = item / 24, cb = item % 24;
    __syncthreads();
    for (int i = tid; i < 9 * 1024; i += 256) {
      int r = i >> 10, k = i & 1023;
      float v = r < 8 ? p.c[r * 1024 + k] : p.c_ctx[k];
      sc[i] = v / (1.f + expf(-v));
    }
    __syncthreads();
    const int w = tid >> 6, q = tid & 63;
    float4 acc[9];
#pragma unroll
    for (int r = 0; r < 9; r++) acc[r] = make_float4(0.f, 0.f, 0.f, 0.f);
    const float* wp = p.ada_w + (size_t)layer * 1024 * 6144 + cb * 256 + q * 4;
    for (int k = w * 256; k < w * 256 + 256; k++) {
      float4 wv = *(const float4*)(wp + (size_t)k * 6144);
#pragma unroll
      for (int r = 0; r < 9; r++) {
        float s = sc[r * 1024 + k];
        acc[r].x += s * wv.x; acc[r].y += s * wv.y; acc[r].z += s * wv.z; acc[r].w += s * wv.w;
      }
    }
    __syncthreads();
    float4* red = (float4*)smem;
#pragma unroll
    for (int r = 0; r < 9; r++) red[(w * 9 + r) * 64 + q] = acc[r];
    __syncthreads();
    for (int i = tid; i < 9 * 64; i += 256) {
      int r = i / 64, qq = i % 64;
      float4 s0 = red[(0 * 9 + r) * 64 + qq], s1 = red[(1 * 9 + r) * 64 + qq], s2 = red[(2 * 9 + r) * 64 + qq], s3 = red[(3 * 9 + r) * 64 + qq];
      float4 bb = *(const float4*)(p.ada_b + layer * 6144 + cb * 256 + qq * 4);
      float4 o = make_float4(s0.x + s1.x + s2.x + s3.x + bb.x, s0.y + s1.y + s2.y + s3.y + bb.y, s0.z + s1.z + s2.z + s3.z + bb.z, s0.w + s1.w + s2.w + s3.w + bb.w);
      *(float4*)(mods + ((size_t)layer * 9 + r) * 6144 + cb * 256 + qq * 4) = o;
    }
  }
  if (blockIdx.x == gridDim.x - 1) {
    float* misc = (float*)(p.ws + OFF_MISC);
    for (int i = tid; i < 1024; i += 256) {
      int pos = i / 16, f = i % 16;
      float inv = powf(10000.f, -(float)f / 16.f);
      float ang = (float)pos * inv;
      misc[i] = cosf(ang);
      misc[1024 + i] = sinf(ang);
    }
    if (tid < 2) {
      float s1 = 0.f, s2 = 0.f;
      for (int k = 0; k < 64; k++) { s1 += p.da_lq1[tid * 64 + k] * p.da_lk1[tid * 64 + k]; s2 += p.da_lq2[tid * 64 + k] * p.da_lk2[tid * 64 + k]; }
      misc[2048 + tid] = expf(s1) - expf(s2) + lambda_init(2 * tid + 1);
    }
  }
  const size_t n4 = (size_t)NLAT * D / 4, c4 = (size_t)NCTX * D / 4;
  const float4* xs = (const float4*)p.x; float4* xo = (float4*)p.out;
  for (size_t i = (size_t)blockIdx.x * 256 + tid; i < n4; i += (size_t)gridDim.x * 256) xo[i] = xs[i];
  const float4* cs = (const float4*)p.ctx; float4* co = (float4*)(p.ws + OFF_XC);
  for (size_t i = (size_t)blockIdx.x * 256 + tid; i < c4; i += (size_t)gridDim.x * 256) co[i] = cs[i];
}

DI void conv_mat(const float* __restrict__ src, int K, int N, bf16_t* __restrict__ dst, int ldd, int koff, const float* __restrict__ scale,
                 int Kp, int Np, float* sm, int& base) {
  const int tidx = opaque_tid();
  const int tid = tidx;
  const int tk = Kp / 64, tn = Np / 64, nt = tk * tn;
  for (int t = first_tile(base); t < nt; t += gridDim.x) {
    const int k0 = (t / tn) * 64, n0 = (t % tn) * 64;
    __syncthreads();
#pragma unroll
    for (int i = 0; i < 4; i++) {
      int kr = (tid >> 4) + 16 * i, nc = (tid & 15) * 4;
      float4 v = make_float4(0.f, 0.f, 0.f, 0.f);
      if (src != nullptr && k0 + kr < K && n0 + nc < N) {
        v = *(const float4*)(src + (size_t)(k0 + kr) * N + n0 + nc);
        if (scale) { float s = scale[k0 + kr]; v.x *= s; v.y *= s; v.z *= s; v.w *= s; }
      }
      sm[kr * 65 + nc + 0] = v.x; sm[kr * 65 + nc + 1] = v.y; sm[kr * 65 + nc + 2] = v.z; sm[kr * 65 + nc + 3] = v.w;
    }
    __syncthreads();
    const int n = tid >> 2, kb = (tid & 3) * 16;
    unsigned o[8];
#pragma unroll
    for (int i = 0; i < 8; i++) o[i] = pack2(sm[(kb + 2 * i) * 65 + n], sm[(kb + 2 * i + 1) * 65 + n]);
    uint4* dp = (uint4*)(dst + (size_t)(n0 + n) * ldd + koff + k0 + kb);
    dp[0] = make_uint4(o[0], o[1], o[2], o[3]);
    dp[1] = make_uint4(o[4], o[5], o[6], o[7]);
  }
  base += nt;
}

DI void phase_conv(const P& p, int layer, char* smem) {
  float* sm = (float*)smem;
  bf16_t* W = (bf16_t*)(p.ws + OFF_W);
  int base = 0;
  const int j = layer / 2;
  if ((layer & 1) == 0) {
    const int mixsel[3] = {0, 2, 3};
    for (int s = 0; s < 3; s++) {
      const float* src = p.rw_w_rkv + ((size_t)j * 3 + s) * 1048576;
      conv_mat(src, 1024, 1024, W + W_RKV + (size_t)s * 1024 * 2048, 2048, 0, nullptr, 1024, 1024, sm, base);
      conv_mat(src, 1024, 1024, W + W_RKV + (size_t)s * 1024 * 2048, 2048, 1024, p.rw_mix + ((size_t)j * 6 + mixsel[s]) * 1024, 1024, 1024, sm, base);
    }
    for (int pass = 0; pass < 2; pass++) {
      const int ko = pass * 1024;
      const float* m1 = pass ? p.rw_mix + ((size_t)j * 6 + 1) * 1024 : nullptr;
      const float* m4 = pass ? p.rw_mix + ((size_t)j * 6 + 4) * 1024 : nullptr;
      const float* m5 = pass ? p.rw_mix + ((size_t)j * 6 + 5) * 1024 : nullptr;
      const float* m3 = pass ? p.rw_mix + ((size_t)j * 6 + 3) * 1024 : nullptr;
      bf16_t* L1 = W + W_L1;
      conv_mat(p.rw_w1 + ((size_t)j * 2 + 0) * 65536, 1024, 64, L1 + 0ull * 2048, 2048, ko, m1, 1024, 64, sm, base);
      conv_mat(p.rw_w1 + ((size_t)j * 2 + 1) * 65536, 1024, 64, L1 + 64ull * 2048, 2048, ko, m1, 1024, 64, sm, base);
      conv_mat(p.rw_a1 + (size_t)j * 65536, 1024, 64, L1 + 128ull * 2048, 2048, ko, m4, 1024, 64, sm, base);
      conv_mat(p.rw_g1 + ((size_t)j * 2 + 0) * 163840, 1024, 160, L1 + 192ull * 2048, 2048, ko, m5, 1024, 192, sm, base);
      conv_mat(p.rw_g1 + ((size_t)j * 2 + 1) * 163840, 1024, 160, L1 + 384ull * 2048, 2048, ko, m5, 1024, 192, sm, base);
      conv_mat(j > 0 ? p.rw_v1 + (size_t)(j - 1) * 32768 : nullptr, 1024, 32, L1 + 576ull * 2048, 2048, ko, m3, 1024, 64, sm, base);
    }
    conv_mat(p.rw_w2 + ((size_t)j * 2 + 0) * 65536, 64, 1024, W + W_W2, 64, 0, nullptr, 64, 1024, sm, base);
    conv_mat(p.rw_w2 + ((size_t)j * 2 + 1) * 65536, 64, 1024, W + W_W2 + 65536, 64, 0, nullptr, 64, 1024, sm, base);
    conv_mat(p.rw_a2 + (size_t)j * 65536, 64, 1024, W + W_A2, 64, 0, nullptr, 64, 1024, sm, base);
    conv_mat(p.rw_g2 + ((size_t)j * 2 + 0) * 163840, 160, 1024, W + W_G2, 192, 0, nullptr, 192, 1024, sm, base);
    conv_mat(p.rw_g2 + ((size_t)j * 2 + 1) * 163840, 160, 1024, W + W_G2 + 196608, 192, 0, nullptr, 192, 1024, sm, base);
    conv_mat(j > 0 ? p.rw_v2 + (size_t)(j - 1) * 32768 : nullptr, 32, 1024, W + W_V2, 64, 0, nullptr, 64, 1024, sm, base);
    conv_mat(p.rw_w_o + (size_t)j * 1048576, 1024, 1024, W + W_WO, 1024, 0, nullptr, 1024, 1024, sm, base);
  } else {
    conv_mat(p.da_w_qkv + (size_t)j * 3145728, 1024, 3072, W + W_QKV, 1024, 0, nullptr, 1024, 3072, sm, base);
    conv_mat(p.da_w_o + (size_t)j * 1048576, 1024, 1024, W + W_WO, 1024, 0, nullptr, 1024, 1024, sm, base);
  }
  conv_mat(p.mlp_w1 + (size_t)layer * 4194304, 1024, 4096, W + W_M1, 1024, 0, nullptr, 1024, 4096, sm, base);
  conv_mat(p.mlp_w2 + (size_t)layer * 4194304, 4096, 1024, W + W_M2, 4096, 0, nullptr, 4096, 1024, sm, base);
}

DI void phase_prep(const P& p, int layer, int sub, int hf, bool shift, bf16_t* H, int ldh, bool skip_ctx) {
  const int tidx = opaque_tid();
  const int lane = tidx & 63, wv = tidx >> 6;
  const int nrows = hf < 0 ? (skip_ctx ? NLAT : NTOK) : HROWS;
  const int nseg = nrows / 8;
  const float* ng = p.norm_g + ((size_t)layer * 2 + sub) * 1024;
  for (int seg = blockIdx.x * 4 + wv; seg < nseg; seg += gridDim.x * 4) {
    const int lr0 = seg * 8;
    const int gr0 = hf < 0 ? lr0 : (lr0 < 16384 ? hf * 16384 + lr0 : NLAT + hf * 1024 + (lr0 - 16384));
    const bool lat = gr0 < NLAT;
    const int T = lat ? SL : CL;
    const int t0 = lat ? (gr0 % SL) : ((gr0 - NLAT) % CL);
    const float* xbase = resid_row(p, gr0);
    const float* md = mods_ptr(p, layer, mod_row(gr0));
    float4 g4[4], sc4[4], sh4[4];
#pragma unroll
    for (int jx = 0; jx < 4; jx++) {
      int ch = jx * 256 + lane * 4;
      g4[jx] = *(const float4*)(ng + ch);
      sh4[jx] = *(const float4*)(md + sub * 3072 + ch);
      sc4[jx] = *(const float4*)(md + sub * 3072 + 1024 + ch);
      g4[jx].x *= (1.f + sc4[jx].x); g4[jx].y *= (1.f + sc4[jx].y); g4[jx].z *= (1.f + sc4[jx].z); g4[jx].w *= (1.f + sc4[jx].w);
    }
    float4 hp[4], hc[4], hn[4];
    const int tb = shift ? -1 : 0, te = shift ? 9 : 8;
    for (int tt = tb; tt < te; tt++) {
      const int t = t0 + tt;
      if (t >= 0 && t < T) {
        const float* xr = xbase + (ptrdiff_t)tt * D;
        float ss = 0.f;
#pragma unroll
        for (int jx = 0; jx < 4; jx++) {
          hn[jx] = *(const float4*)(xr + jx * 256 + lane * 4);
          ss += hn[jx].x * hn[jx].x + hn[jx].y * hn[jx].y + hn[jx].z * hn[jx].z + hn[jx].w * hn[jx].w;
        }
        ss = wave_sum(ss);
        const float rs = rsqrtf(ss * (1.f / 1024.f) + 1e-6f);
#pragma unroll
        for (int jx = 0; jx < 4; jx++) {
          hn[jx].x = hn[jx].x * rs * g4[jx].x + sh4[jx].x; hn[jx].y = hn[jx].y * rs * g4[jx].y + sh4[jx].y;
          hn[jx].z = hn[jx].z * rs * g4[jx].z + sh4[jx].z; hn[jx].w = hn[jx].w * rs * g4[jx].w + sh4[jx].w;
        }
      } else {
#pragma unroll
        for (int jx = 0; jx < 4; jx++) hn[jx] = make_float4(0.f, 0.f, 0.f, 0.f);
      }
      if (!shift) {
        bf16_t* hr = H + (size_t)(lr0 + tt) * ldh;
#pragma unroll
        for (int jx = 0; jx < 4; jx++) *(uint2*)(hr + jx * 256 + lane * 4) = make_uint2(pack2(hn[jx].x, hn[jx].y), pack2(hn[jx].z, hn[jx].w));
      } else if (tt >= 1) {
        bf16_t* hr = H + (size_t)(lr0 + tt - 1) * ldh;
#pragma unroll
        for (int jx = 0; jx < 4; jx++) {
          *(uint2*)(hr + jx * 256 + lane * 4) = make_uint2(pack2(hc[jx].x, hc[jx].y), pack2(hc[jx].z, hc[jx].w));
          float4 xx;
          xx.x = 0.5f * (hp[jx].x + hn[jx].x) - hc[jx].x; xx.y = 0.5f * (hp[jx].y + hn[jx].y) - hc[jx].y;
          xx.z = 0.5f * (hp[jx].z + hn[jx].z) - hc[jx].z; xx.w = 0.5f * (hp[jx].w + hn[jx].w) - hc[jx].w;
          *(uint2*)(hr + 1024 + jx * 256 + lane * 4) = make_uint2(pack2(xx.x, xx.y), pack2(xx.z, xx.w));
        }
      }
#pragma unroll
      for (int jx = 0; jx < 4; jx++) { hp[jx] = hc[jx]; hc[jx] = hn[jx]; }
    }
  }
}

constexpr int LDT = 72;
DI void gemm_mainloop(const bf16_t* __restrict__ A, int lda, const bf16_t* __restrict__ Bt, int ldb, int K, char* smem, f32x16 (&acc)[2][2]) {
  const int tidx = opaque_tid();
  bf16_t* sA = (bf16_t*)smem;
  bf16_t* sB = sA + 2 * 128 * LDT;
  const int tid = tidx, lane = tid & 63, w = tid >> 6, wm = w >> 1, wn = w & 1;
  const int lrow = tid >> 3, lkc = (tid & 7) * 8;
#pragma unroll
  for (int mi = 0; mi < 2; mi++)
#pragma unroll
    for (int ni = 0; ni < 2; ni++)
#pragma unroll
      for (int r = 0; r < 16; r++) acc[mi][ni][r] = 0.f;
  const unsigned ao = (unsigned)(lrow * lda + lkc), bo = (unsigned)(lrow * ldb + lkc);
  const unsigned a32 = (unsigned)(32 * lda), b32 = (unsigned)(32 * ldb);
  uint4 ra0, ra1, ra2, ra3, rb0, rb1, rb2, rb3;
#define G_LOAD(Ab, Bb)                                                                                   \
  {                                                                                                      \
    ra0 = *(const uint4*)((Ab) + ao); ra1 = *(const uint4*)((Ab) + (ao + a32));                          \
    ra2 = *(const uint4*)((Ab) + (ao + 2 * a32)); ra3 = *(const uint4*)((Ab) + (ao + 3 * a32));          \
    rb0 = *(const uint4*)((Bb) + bo); rb1 = *(const uint4*)((Bb) + (bo + b32));                          \
    rb2 = *(const uint4*)((Bb) + (bo + 2 * b32)); rb3 = *(const uint4*)((Bb) + (bo + 3 * b32));          \
  }
#define G_STORE(sa_, sb_)                                                                                \
  {                                                                                                      \
    bf16_t* a_w = (sa_) + lrow * LDT + lkc;                                                              \
    bf16_t* b_w = (sb_) + lrow * LDT + lkc;                                                              \
    *(uint4*)(a_w) = ra0; *(uint4*)(a_w + 32 * LDT) = ra1; *(uint4*)(a_w + 64 * LDT) = ra2; *(uint4*)(a_w + 96 * LDT) = ra3; \
    *(uint4*)(b_w) = rb0; *(uint4*)(b_w + 32 * LDT) = rb1; *(uint4*)(b_w + 64 * LDT) = rb2; *(uint4*)(b_w + 96 * LDT) = rb3; \
  }
  G_LOAD(A, Bt);
  G_STORE(sA, sB);
  __syncthreads();
  const int nk = K >> 6;
  const int aoff = (wm * 64 + (lane & 31)) * LDT + (lane >> 5) * 8;
  const int boff = (wn * 64 + (lane & 31)) * LDT + (lane >> 5) * 8;
  for (int kt = 0; kt < nk; kt++) {
    const int cur = kt & 1;
    if (kt + 1 < nk) {
      const bf16_t* A1 = A + (kt + 1) * 64;
      const bf16_t* B1 = Bt + (kt + 1) * 64;
      G_LOAD(A1, B1);
    }
    __builtin_amdgcn_sched_barrier(0);
    const bf16_t* a_s = sA + cur * 128 * LDT + aoff;
    const bf16_t* b_s = sB + cur * 128 * LDT + boff;
#pragma unroll
    for (int kk = 0; kk < 4; kk++) {
      bf16x8 af[2], bq[2];
#pragma unroll
      for (int mi = 0; mi < 2; mi++) af[mi] = *(const bf16x8*)(a_s + mi * 32 * LDT + kk * 16);
#pragma unroll
      for (int ni = 0; ni < 2; ni++) bq[ni] = *(const bf16x8*)(b_s + ni * 32 * LDT + kk * 16);
#pragma unroll
      for (int mi = 0; mi < 2; mi++)
#pragma unroll
        for (int ni = 0; ni < 2; ni++) acc[mi][ni] = MFMA32(af[mi], bq[ni], acc[mi][ni]);
    }
    __builtin_amdgcn_sched_barrier(0);
    if (kt + 1 < nk) G_STORE(sA + (cur ^ 1) * 128 * LDT, sB + (cur ^ 1) * 128 * LDT);
    __syncthreads();
  }
}
constexpr int EST = 132;
DI void acc_to_lds(const f32x16 (&acc)[2][2], float* es) {
  const int tidx = opaque_tid();
  const int lane = tidx & 63, w = tidx >> 6, wm = w >> 1, wn = w & 1;
#pragma unroll
  for (int mi = 0; mi < 2; mi++)
#pragma unroll
    for (int ni = 0; ni < 2; ni++)
#pragma unroll
      for (int r = 0; r < 16; r++)
        es[(wm * 64 + mi * 32 + (r & 3) + 8 * (r >> 2) + 4 * (lane >> 5)) * EST + wn * 64 + ni * 32 + (lane & 31)] = acc[mi][ni][r];
}
#define EPI8_BEGIN                                                                   \
  {                                                                                  \
    float* es = (float*)smem;                                                        \
    acc_to_lds(acc, es);                                                             \
    __syncthreads();                                                                 \
    for (int pass = 0; pass < 8; pass++) {                                           \
      const int row = pass * 16 + (tidx >> 4), col = (tidx & 15) * 8;  \
      const float4 e_va = *(const float4*)(es + row * EST + col);                    \
      const float4 e_vb = *(const float4*)(es + row * EST + col + 4);                \
      float v[8] = {e_va.x, e_va.y, e_va.z, e_va.w, e_vb.x, e_vb.y, e_vb.z, e_vb.w};
#define EPI8_END                                                                     \
    }                                                                                \
    __syncthreads();                                                                 \
  }
DI uint4 pack8(const float (&v)[8]) { return make_uint4(pack2(v[0], v[1]), pack2(v[2], v[3]), pack2(v[4], v[5]), pack2(v[6], v[7])); }
DI void unpack8(const uint4 u, float (&v)[8]) {
  v[0] = lo_bf(u.x); v[1] = hi_bf(u.x); v[2] = lo_bf(u.y); v[3] = hi_bf(u.y); v[4] = lo_bf(u.z); v[5] = hi_bf(u.z); v[6] = lo_bf(u.w); v[7] = hi_bf(u.w);
}
DI void resid_update(float* xp, const float* gate, const float (&v)[8]) {
  float4 x0 = *(const float4*)xp, x1 = *(const float4*)(xp + 4);
  const float4 g0 = *(const float4*)gate, g1 = *(const float4*)(gate + 4);
  x0.x += g0.x * v[0]; x0.y += g0.y * v[1]; x0.z += g0.z * v[2]; x0.w += g0.w * v[3];
  x1.x += g1.x * v[4]; x1.y += g1.y * v[5]; x1.z += g1.z * v[6]; x1.w += g1.w * v[7];
  *(float4*)xp = x0; *(float4*)(xp + 4) = x1;
}

DI void phase_t1(const P& p, char* smem) {
  const int tidx = opaque_tid();
  const bf16_t* HX = (const bf16_t*)(p.ws + OFF_TR + TR_HX);
  const bf16_t* WL1 = (const bf16_t*)(p.ws + OFF_W) + W_L1;
  bf16_t* T1 = (bf16_t*)(p.ws + OFF_TR + TR_T1);
  for (int t = blockIdx.x; t < 136 * 5; t += gridDim.x) {
    const int nt = t % 5, lt = t / 5;
    f32x16 acc[2][2];
    gemm_mainloop(HX + (size_t)lt * 128 * 2048, 2048, WL1 + (size_t)nt * 128 * 2048, 2048, 2048, smem, acc);
    EPI8_BEGIN
      const int c = nt * 128 + col;
      if (c < 128) {
#pragma unroll
        for (int e = 0; e < 8; e++) v[e] = tanhf(v[e]);
      } else if (c >= 192 && c < 576) {
#pragma unroll
        for (int e = 0; e < 8; e++) v[e] = sigmoidf_(v[e]);
      }
      *(uint4*)(T1 + (size_t)(lt * 128 + row) * 640 + c) = pack8(v);
    EPI8_END
  }
}

DI void phase_feat(const P& p, int layer, int hf, char* smem) {
  const int tidx = opaque_tid();
  const int j = layer / 2;
  const bf16_t* W = (const bf16_t*)(p.ws + OFF_W);
  const bf16_t* HX = (const bf16_t*)(p.ws + OFF_TR + TR_HX);
  const bf16_t* T1 = (const bf16_t*)(p.ws + OFF_TR + TR_T1);
  bf16_t* VF = (bf16_t*)(p.ws + OFF_VF);
  for (int t = blockIdx.x; t < 136 * 24; t += gridDim.x) {
    const int mg = t / (8 * 24), rem = t % (8 * 24);
    const int nt = rem / 8, lt = mg * 8 + (rem % 8);
    const int s = nt / 8, n0 = (nt % 8) * 128;
    const int gt = half_gtile(hf, lt);
    f32x16 acc[2][2];
    bf16_t* outp = (bf16_t*)(p.ws + OFF_TR + (s == 0 ? TR_R : (s == 1 ? TR_K : TR_V)));
    if (s == 2 && j > 0) {
      gemm_mainloop(T1 + (size_t)lt * 128 * 640 + 576, 640, W + W_V2 + (size_t)n0 * 64, 64, 64, smem, acc);
      const float* v0 = p.rw_v0 + (size_t)(j - 1) * 1024;
      EPI8_BEGIN
        const int c = n0 + col;
#pragma unroll
        for (int e = 0; e < 8; e++) v[e] = sigmoidf_(v0[c + e] + v[e]);
        *(uint4*)(outp + (size_t)(lt * 128 + row) * 1024 + c) = pack8(v);
      EPI8_END
    }
    gemm_mainloop(HX + (size_t)lt * 128 * 2048, 2048, W + W_RKV + ((size_t)s * 1024 + n0) * 2048, 2048, 2048, smem, acc);
    if (s < 2) {
      EPI8_BEGIN
        *(uint4*)(outp + (size_t)(lt * 128 + row) * 1024 + n0 + col) = pack8(v);
      EPI8_END
    } else if (j == 0) {
      EPI8_BEGIN
        const uint4 u = pack8(v);
        *(uint4*)(outp + (size_t)(lt * 128 + row) * 1024 + n0 + col) = u;
        *(uint4*)(VF + (size_t)(gt * 128 + row) * 1024 + n0 + col) = u;
      EPI8_END
    } else {
      EPI8_BEGIN
        const size_t oi = (size_t)(lt * 128 + row) * 1024 + n0 + col;
        float sg[8], vf[8];
        unpack8(*(const uint4*)(outp + oi), sg);
        unpack8(*(const uint4*)(VF + (size_t)(gt * 128 + row) * 1024 + n0 + col), vf);
#pragma unroll
        for (int e = 0; e < 8; e++) v[e] = v[e] + (vf[e] - v[e]) * sg[e];
        *(uint4*)(outp + oi) = pack8(v);
      EPI8_END
    }
  }
  for (int t = blockIdx.x; t < 136 * 40; t += gridDim.x) {
    const int lt = t / 40, nt = t % 40;
    const int s = nt / 8, n0 = (nt % 8) * 128;
    f32x16 acc[2][2];
    if (s == 0) {
      gemm_mainloop(T1 + (size_t)lt * 128 * 640 + 128, 640, W + W_A2 + (size_t)n0 * 64, 64, 64, smem, acc);
      bf16_t* outp = (bf16_t*)(p.ws + OFF_TR + TR_A);
      const float* a0 = p.rw_a0 + (size_t)j * 1024;
      EPI8_BEGIN
#pragma unroll
        for (int e = 0; e < 8; e++) v[e] = sigmoidf_(a0[n0 + col + e] + v[e]);
        *(uint4*)(outp + (size_t)(lt * 128 + row) * 1024 + n0 + col) = pack8(v);
      EPI8_END
    } else if (s < 3) {
      const int d = s - 1;
      gemm_mainloop(T1 + (size_t)lt * 128 * 640 + d * 64, 640, W + W_W2 + (size_t)d * 65536 + (size_t)n0 * 64, 64, 64, smem, acc);
      bf16_t* outp = (bf16_t*)(p.ws + OFF_TR + (d ? TR_WL1 : TR_WL0));
      const float* w0 = p.rw_w0 + ((size_t)j * 2 + d) * 1024;
      EPI8_BEGIN
#pragma unroll
        for (int e = 0; e < 8; e++) {
          const float z = -(w0[n0 + col + e] + v[e]);
          const float sp = fmaxf(z, 0.f) + log1pf(__expf(-fabsf(z)));
          v[e] = -__expf(-sp - 0.5f);
        }
        *(uint4*)(outp + (size_t)(lt * 128 + row) * 1024 + n0 + col) = pack8(v);
      EPI8_END
    } else {
      const int d = s - 3;
      gemm_mainloop(T1 + (size_t)lt * 128 * 640 + 192 + d * 192, 640, W + W_G2 + (size_t)d * 196608 + (size_t)n0 * 192, 192, 192, smem, acc);
      bf16_t* outp = (bf16_t*)(p.ws + OFF_TR + (d ? TR_G1 : TR_G0));
      EPI8_BEGIN
        *(uint4*)(outp + (size_t)(lt * 128 + row) * 1024 + n0 + col) = pack8(v);
      EPI8_END
    }
  }
}

DI int scan_row(int bl, int dir, int pos) {
  if (pos < CL) { int t = dir ? (CL - 1 - pos) : pos; return 16384 + bl * CL + t; }
  int t = pos - CL; if (dir) t = SL - 1 - t;
  return bl * SL + t;
}

DI void phase_scan(const P& p, int layer, char* smem) {
  const int tidx = opaque_tid();
  const int j = layer / 2;
  const int tid = tidx;
  const bf16_t* R = (const bf16_t*)(p.ws + OFF_TR + TR_R);
  const bf16_t* Kx = (const bf16_t*)(p.ws + OFF_TR + TR_K);
  const bf16_t* V = (const bf16_t*)(p.ws + OFF_TR + TR_V);
  const bf16_t* Aa = (const bf16_t*)(p.ws + OFF_TR + TR_A);
  float* sbuf = (float*)smem;
  constexpr int BUFF = 5 * 16 * 64 + 512;
  constexpr int POP = 144;
  float* pobuf = sbuf + 2 * BUFF;
  const int ss = tid >> 4, c4 = tid & 15;
  const int rl = tid >> 4, cg = tid & 15;
  for (int item = blockIdx.x; item < 256; item += gridDim.x) {
    const int q2 = item & 1, dir = (item >> 1) & 1, head = (item >> 2) & 15, bl = item >> 6;
    const bf16_t* WL = (const bf16_t*)(p.ws + OFF_TR + (dir ? TR_WL1 : TR_WL0));
    bf16_t* O = (bf16_t*)(p.ws + OFF_TR + TR_HX) + (dir ? (size_t)HROWS * 1024 : 0);
    const int ch = head * 64 + c4 * 4;
    const float4 kkw = *(const float4*)(p.rw_kk + (size_t)j * 1024 + ch);
    const float4 kaw = *(const float4*)(p.rw_ka + (size_t)j * 1024 + ch);
    fv2 SA01 = {0.f, 0.f}, SA23 = {0.f, 0.f}, SB01 = {0.f, 0.f}, SB23 = {0.f, 0.f};
    uint2 gr_, gk_, ga_, gw_, gv_;
    gv_ = make_uint2(0, 0);
#define SC_ISSUE(chunk_)                                                                   \
    {                                                                                      \
      const size_t ro = (size_t)scan_row(bl, dir, (chunk_) * 16 + ss) * 1024;              \
      gr_ = *(const uint2*)(R + ro + ch); gk_ = *(const uint2*)(Kx + ro + ch);             \
      ga_ = *(const uint2*)(Aa + ro + ch); gw_ = *(const uint2*)(WL + ro + ch);            \
      if (c4 < 8) gv_ = *(const uint2*)(V + ro + head * 64 + q2 * 32 + c4 * 4);            \
    }
#define SC_STAGE(buf_)                                                                     \
    {                                                                                      \
      float* sb_ = sbuf + (buf_) * BUFF;                                                   \
      float r0 = lo_bf(gr_.x), r1 = hi_bf(gr_.x), r2 = lo_bf(gr_.y), r3 = hi_bf(gr_.y);    \
      float k0 = lo_bf(gk_.x), k1 = hi_bf(gk_.x), k2 = lo_bf(gk_.y), k3 = hi_bf(gk_.y);    \
      float a0 = lo_bf(ga_.x), a1 = hi_bf(ga_.x), a2 = lo_bf(ga_.y), a3 = hi_bf(ga_.y);    \
      float w0 = lo_bf(gw_.x), w1 = hi_bf(gw_.x), w2 = lo_bf(gw_.y), w3 = hi_bf(gw_.y);    \
      float u0 = k0 * kkw.x, u1 = k1 * kkw.y, u2 = k2 * kkw.z, u3 = k3 * kkw.w;            \
      float sq = rowsum16(u0 * u0 + u1 * u1 + u2 * u2 + u3 * u3);                          \
      float inv = rsqrtf(fmaxf(sq, 1e-24f));                                               \
      u0 *= inv; u1 *= inv; u2 *= inv; u3 *= inv;                                          \
      const int o_ = ss * 64 + c4 * 4;                                                     \
      *(float4*)(sb_ + 0 * 1024 + o_) = make_float4(__expf(w0), __expf(w1), __expf(w2), __expf(w3)); \
      *(float4*)(sb_ + 1 * 1024 + o_) = make_float4(k0 * (1.f + (a0 - 1.f) * kaw.x), k1 * (1.f + (a1 - 1.f) * kaw.y), k2 * (1.f + (a2 - 1.f) * kaw.z), k3 * (1.f + (a3 - 1.f) * kaw.w)); \
      *(float4*)(sb_ + 2 * 1024 + o_) = make_float4(-u0, -u1, -u2, -u3);                   \
      *(float4*)(sb_ + 3 * 1024 + o_) = make_float4(u0 * a0, u1 * a1, u2 * a2, u3 * a3);   \
      *(float4*)(sb_ + 4 * 1024 + o_) = make_float4(r0, r1, r2, r3);                       \
      if (c4 < 8) *(float4*)(sb_ + 5 * 1024 + ss * 32 + c4 * 4) = make_float4(lo_bf(gv_.x), hi_bf(gv_.x), lo_bf(gv_.y), hi_bf(gv_.y)); \
    }
    __syncthreads();
    SC_ISSUE(0);
    SC_STAGE(0);
    __syncthreads();
    constexpr int NCH = TK / 16;
    float* po_wa = pobuf + rl * POP + cg;
    float* po_wb = pobuf + (rl + 16) * POP + cg;
    const float* po_r = pobuf + (rl + 16 * (cg >> 3)) * POP + (cg & 7) * 16;
    for (int chunk = 0; chunk < NCH; chunk++) {
      const int buf = chunk & 1;
      if (chunk + 1 < NCH) SC_ISSUE(chunk + 1);
      __builtin_amdgcn_sched_barrier(0);
      const float* sb = sbuf + buf * BUFF + cg * 4;
      const float* sv = sbuf + buf * BUFF + 5 * 1024 + rl;
      float4 w4 = *(const float4*)(sb + 0 * 1024), k4 = *(const float4*)(sb + 1 * 1024), n4 = *(const float4*)(sb + 2 * 1024);
      float4 b4 = *(const float4*)(sb + 3 * 1024), r4 = *(const float4*)(sb + 4 * 1024);
      float va = sv[0], vb = sv[16];
#pragma unroll
      for (int s = 0; s < 16; s++) {
        float4 w4n = w4, k4n = k4, n4n = n4, b4n = b4, r4n = r4;
        float van = va, vbn = vb;
        if (s + 1 < 16) {
          w4n = *(const float4*)(sb + 0 * 1024 + (s + 1) * 64); k4n = *(const float4*)(sb + 1 * 1024 + (s + 1) * 64);
          n4n = *(const float4*)(sb + 2 * 1024 + (s + 1) * 64); b4n = *(const float4*)(sb + 3 * 1024 + (s + 1) * 64);
          r4n = *(const float4*)(sb + 4 * 1024 + (s + 1) * 64); van = sv[(s + 1) * 32]; vbn = sv[(s + 1) * 32 + 16];
        }
        const fv2 w01 = {w4.x, w4.y}, w23 = {w4.z, w4.w}, k01 = {k4.x, k4.y}, k23 = {k4.z, k4.w}, n01 = {n4.x, n4.y}, n23 = {n4.z, n4.w};
        const fv2 b01 = {b4.x, b4.y}, b23 = {b4.z, b4.w}, r01 = {r4.x, r4.y}, r23 = {r4.z, r4.w};
        const fv2 va2 = {va, va}, vb2 = {vb, vb};
        const fv2 vka01 = va2 * k01, vka23 = va2 * k23, vkb01 = vb2 * k01, vkb23 = vb2 * k23;
        fv2 ppa = SA01 * n01, ppb = SB01 * n01;
        ppa = __builtin_elementwise_fma(SA23, n23, ppa);
        ppb = __builtin_elementwise_fma(SB23, n23, ppb);
        float saa = ppa.x + ppa.y, sab = ppb.x + ppb.y;
        saa = ror_add<8>(saa); sab = ror_add<8>(sab);
        saa = ror_add<4>(saa); sab = ror_add<4>(sab);
        saa = ror_add<2>(saa); sab = ror_add<2>(sab);
        saa = ror_add<1>(saa); sab = ror_add<1>(sab);
        const fv2 saa2 = {saa, saa}, sab2 = {sab, sab};
        const fv2 ta01 = __builtin_elementwise_fma(saa2, b01, vka01), ta23 = __builtin_elementwise_fma(saa2, b23, vka23);
        const fv2 tb01 = __builtin_elementwise_fma(sab2, b01, vkb01), tb23 = __builtin_elementwise_fma(sab2, b23, vkb23);
        SA01 = __builtin_elementwise_fma(SA01, w01, ta01);
        SA23 = __builtin_elementwise_fma(SA23, w23, ta23);
        SB01 = __builtin_elementwise_fma(SB01, w01, tb01);
        SB23 = __builtin_elementwise_fma(SB23, w23, tb23);
        fv2 qa = SA01 * r01, qb = SB01 * r01;
        qa = __builtin_elementwise_fma(SA23, r23, qa);
        qb = __builtin_elementwise_fma(SB23, r23, qb);
        po_wa[(s & 7) * 16] = qa.x + qa.y;
        po_wb[(s & 7) * 16] = qb.x + qb.y;
        w4 = w4n; k4 = k4n; n4 = n4n; b4 = b4n; r4 = r4n; va = van; vb = vbn;
        __builtin_amdgcn_sched_barrier(0);
        if ((s & 7) == 7) {
          const float4 p0 = *(const float4*)(po_r), p1 = *(const float4*)(po_r + 4), p2 = *(const float4*)(po_r + 8), p3 = *(const float4*)(po_r + 12);
          const float ov = ((p0.x + p0.y) + (p0.z + p0.w)) + ((p1.x + p1.y) + (p1.z + p1.w)) + ((p2.x + p2.y) + (p2.z + p2.w)) + ((p3.x + p3.y) + (p3.z + p3.w));
          const size_t ro = (size_t)scan_row(bl, dir, chunk * 16 + (s & 8) + (cg & 7)) * 1024;
          O[ro + head * 64 + q2 * 32 + rl + 16 * (cg >> 3)] = f2bf(ov);
          __builtin_amdgcn_sched_barrier(0);
        }
      }
      if (chunk + 1 < NCH) SC_STAGE(buf ^ 1);
      __syncthreads();
    }
  }
}

DI void phase_combine(const P& p, int layer) {
  const int tidx = opaque_tid();
  const int j = layer / 2;
  const bf16_t* Of = (const bf16_t*)(p.ws + OFF_TR + TR_HX);
  const bf16_t* Ob = Of + (size_t)HROWS * 1024;
  const bf16_t* R = (const bf16_t*)(p.ws + OFF_TR + TR_R);
  const bf16_t* Kx = (const bf16_t*)(p.ws + OFF_TR + TR_K);
  const bf16_t* V = (const bf16_t*)(p.ws + OFF_TR + TR_V);
  const bf16_t* Aa = (const bf16_t*)(p.ws + OFF_TR + TR_A);
  bf16_t* G0 = (bf16_t*)(p.ws + OFF_TR + TR_G0);
  const bf16_t* G1 = (const bf16_t*)(p.ws + OFF_TR + TR_G1);
  const size_t total = (size_t)HROWS * 128;
  for (size_t i = (size_t)blockIdx.x * 256 + tidx; i < total; i += (size_t)gridDim.x * 256) {
    const int c0 = (int)(i & 127) * 8;
    const size_t off = (i >> 7) * 1024 + c0;
    const uint4 uof = *(const uint4*)(Of + off), uob = *(const uint4*)(Ob + off), ur = *(const uint4*)(R + off), uk = *(const uint4*)(Kx + off);
    const uint4 ua = *(const uint4*)(Aa + off), uv = *(const uint4*)(V + off), ug0 = *(const uint4*)(G0 + off), ug1 = *(const uint4*)(G1 + off);
    const unsigned aof[4] = {uof.x, uof.y, uof.z, uof.w}, aob[4] = {uob.x, uob.y, uob.z, uob.w}, ar[4] = {ur.x, ur.y, ur.z, ur.w}, ak[4] = {uk.x, uk.y, uk.z, uk.w};
    const unsigned aa[4] = {ua.x, ua.y, ua.z, ua.w}, av[4] = {uv.x, uv.y, uv.z, uv.w}, ag0[4] = {ug0.x, ug0.y, ug0.z, ug0.w}, ag1[4] = {ug1.x, ug1.y, ug1.z, ug1.w};
    const float* ka = p.rw_ka + (size_t)j * 1024 + c0;
    const float* rk = p.rw_rk + (size_t)j * 1024 + c0;
    const float* lg = p.rw_ln_g + (size_t)j * 1024 + c0;
    const float* lb = p.rw_ln_b + (size_t)j * 1024 + c0;
    float of[8], obv[8];
    float sf = 0.f, sf2 = 0.f, sb = 0.f, sb2 = 0.f, br = 0.f;
#pragma unroll
    for (int e = 0; e < 8; e++) {
      const int w = e >> 1;
      of[e] = (e & 1) ? hi_bf(aof[w]) : lo_bf(aof[w]);
      obv[e] = (e & 1) ? hi_bf(aob[w]) : lo_bf(aob[w]);
      const float r = (e & 1) ? hi_bf(ar[w]) : lo_bf(ar[w]);
      const float k = (e & 1) ? hi_bf(ak[w]) : lo_bf(ak[w]);
      const float a = (e & 1) ? hi_bf(aa[w]) : lo_bf(aa[w]);
      sf += of[e]; sf2 += of[e] * of[e]; sb += obv[e]; sb2 += obv[e] * obv[e];
      br += r * k * (1.f + (a - 1.f) * ka[e]) * rk[e];
    }
#pragma unroll
    for (int o = 1; o < 8; o <<= 1) { sf += __shfl_xor(sf, o); sf2 += __shfl_xor(sf2, o); sb += __shfl_xor(sb, o); sb2 += __shfl_xor(sb2, o); br += __shfl_xor(br, o); }
    const float muf = sf * (1.f / 64.f), mub = sb * (1.f / 64.f);
    const float rsf = rsqrtf(fmaxf(sf2 * (1.f / 64.f) - muf * muf, 0.f) + 64e-5f);
    const float rsb = rsqrtf(fmaxf(sb2 * (1.f / 64.f) - mub * mub, 0.f) + 64e-5f);
    float y[8];
#pragma unroll
    for (int e = 0; e < 8; e++) {
      const int w = e >> 1;
      const float v = (e & 1) ? hi_bf(av[w]) : lo_bf(av[w]);
      const float g0 = (e & 1) ? hi_bf(ag0[w]) : lo_bf(ag0[w]);
      const float g1 = (e & 1) ? hi_bf(ag1[w]) : lo_bf(ag1[w]);
      const float bonus = br * v;
      y[e] = ((of[e] - muf) * rsf * lg[e] + lb[e] + bonus) * g0 + ((obv[e] - mub) * rsb * lg[e] + lb[e] + bonus) * g1;
    }
    *(uint4*)(G0 + off) = make_uint4(pack2(y[0], y[1]), pack2(y[2], y[3]), pack2(y[4], y[5]), pack2(y[6], y[7]));
  }
}

DI void phase_rw_out(const P& p, int layer, int hf, char* smem) {
  const int tidx = opaque_tid();
  const bf16_t* Y = (const bf16_t*)(p.ws + OFF_TR + TR_G0);
  const bf16_t* WO = (const bf16_t*)(p.ws + OFF_W) + W_WO;
  const int nlt = (layer == 3) ? 128 : 136;
  for (int t = blockIdx.x; t < nlt * 8; t += gridDim.x) {
    const int lt = t / 8, n0 = (t % 8) * 128;
    const int gt = half_gtile(hf, lt);
    f32x16 acc[2][2];
    gemm_mainloop(Y + (size_t)lt * 128 * 1024, 1024, WO + (size_t)n0 * 1024, 1024, 1024, smem, acc);
    const float* gate = mods_ptr(p, layer, mod_row(gt * 128)) + 2048 + n0;
    float* xr = resid_row(p, gt * 128) + n0;
    EPI8_BEGIN
      resid_update(xr + (size_t)row * D + col, gate + col, v);
    EPI8_END
  }
}

DI void phase_mlp1(const P& p, int layer, char* smem) {
  const int tidx = opaque_tid();
  const bf16_t* H2 = (const bf16_t*)(p.ws + OFF_TR + TR_H2);
  const bf16_t* W1 = (const bf16_t*)(p.ws + OFF_W) + W_M1;
  bf16_t* HID = (bf16_t*)(p.ws + OFF_TR + TR_HID);
  const int nmt = (layer == 3) ? 256 : 272;
  const int ngrp = nmt / 16;
  for (int t = blockIdx.x; t < nmt * 32; t += gridDim.x) {
    const int mg = t / (16 * 32), rem = t % (16 * 32);
    const int nt = rem / 16, gt = mg * 16 + (rem % 16);
    (void)ngrp;
    f32x16 acc[2][2];
    gemm_mainloop(H2 + (size_t)gt * 128 * 1024, 1024, W1 + (size_t)nt * 128 * 1024, 1024, 1024, smem, acc);
    EPI8_BEGIN
#pragma unroll
      for (int e = 0; e < 8; e++) { const float rl = fmaxf(v[e], 0.f); v[e] = rl * rl; }
      *(uint4*)(HID + (size_t)(gt * 128 + row) * 4096 + nt * 128 + col) = pack8(v);
    EPI8_END
  }
}
DI void phase_mlp2(const P& p, int layer, char* smem) {
  const int tidx = opaque_tid();
  const bf16_t* HID = (const bf16_t*)(p.ws + OFF_TR + TR_HID);
  const bf16_t* W2 = (const bf16_t*)(p.ws + OFF_W) + W_M2;
  const int nmt = (layer == 3) ? 256 : 272;
  for (int t = blockIdx.x; t < nmt * 8; t += gridDim.x) {
    const int gt = t / 8, n0 = (t % 8) * 128;
    f32x16 acc[2][2];
    gemm_mainloop(HID + (size_t)gt * 128 * 4096, 4096, W2 + (size_t)n0 * 4096, 4096, 4096, smem, acc);
    const float* gate = mods_ptr(p, layer, mod_row(gt * 128)) + 5120 + n0;
    float* xr = resid_row(p, gt * 128) + n0;
    EPI8_BEGIN
      resid_update(xr + (size_t)row * D + col, gate + col, v);
    EPI8_END
  }
}

DI void phase_qkv(const P& p, char* smem) {
  const int tidx = opaque_tid();
  const bf16_t* H = (const bf16_t*)(p.ws + OFF_TR + TR_H);
  const bf16_t* WQ = (const bf16_t*)(p.ws + OFF_W) + W_QKV;
  bf16_t* Q = (bf16_t*)(p.ws + OFF_TR + TR_Q);
  bf16_t* Kb = (bf16_t*)(p.ws + OFF_TR + TR_KK);
  bf16_t* VT = (bf16_t*)(p.ws + OFF_TR + TR_VT);
  const float* cosT = (const float*)(p.ws + OFF_MISC);
  const float* sinT = cosT + 1024;
  for (int t = blockIdx.x; t < 272 * 24; t += gridDim.x) {
    const int mg = t / (16 * 24), rem = t % (16 * 24);
    const int nt = rem / 16, gt = mg * 16 + (rem % 16);
    f32x16 acc[2][2];
    gemm_mainloop(H + (size_t)gt * 128 * 1024, 1024, WQ + (size_t)nt * 128 * 1024, 1024, 1024, smem, acc);
    const bool lat = gt < 256;
    const int b = lat ? gt / 32 : (gt - 256) / 2;
    const int t0 = lat ? (gt % 32) * 128 : (gt - 256) % 2 * 128;
    const int tq0 = lat ? t0 : SL + t0;
    const int typ = nt / 8, h = nt % 8;
    if (typ < 2) {
      bf16_t* dst = typ == 0 ? Q : Kb;
      const float qs = typ == 0 ? 0.125f * 1.44269504088896f : 1.f;
      EPI8_BEGIN
        const int sidx = col >> 6, d0 = col & 63;
        if (lat) {
          const float4 pa = *(const float4*)(es + row * EST + (col ^ 16));
          const float4 pb = *(const float4*)(es + row * EST + (col ^ 16) + 4);
          const float pr[8] = {pa.x, pa.y, pa.z, pa.w, pb.x, pb.y, pb.z, pb.w};
          const int tt = t0 + row;
          const int pos = (d0 < 32) ? (tt >> 6) : (tt & 63);
          const float4 ca = *(const float4*)(cosT + pos * 16 + (d0 & 8)), cb = *(const float4*)(cosT + pos * 16 + (d0 & 8) + 4);
          const float4 sa = *(const float4*)(sinT + pos * 16 + (d0 & 8)), sb = *(const float4*)(sinT + pos * 16 + (d0 & 8) + 4);
          const float cs[8] = {ca.x, ca.y, ca.z, ca.w, cb.x, cb.y, cb.z, cb.w};
          const float sn[8] = {sa.x, sa.y, sa.z, sa.w, sb.x, sb.y, sb.z, sb.w};
          const float sgn = (d0 & 16) ? 1.f : -1.f;
#pragma unroll
          for (int e = 0; e < 8; e++) v[e] = v[e] * cs[e] + sgn * pr[e] * sn[e];
        }
#pragma unroll
        for (int e = 0; e < 8; e++) v[e] *= qs;
        *(uint4*)(dst + ((size_t)((b * 8 + h) * 2 + sidx) * TK + tq0 + row) * 64 + d0) = pack8(v);
      EPI8_END
    } else {
      float* es = (float*)smem;
      acc_to_lds(acc, es);
      __syncthreads();
      for (int pass = 0; pass < 8; pass++) {
        const int d = tidx & 127, tg = pass * 2 + (tidx >> 7);
        float v[8];
#pragma unroll
        for (int e = 0; e < 8; e++) v[e] = es[(tg * 8 + e) * EST + d];
        *(uint4*)(VT + ((size_t)(b * 8 + h) * 128 + d) * TK + tq0 + tg * 8) = pack8(v);
      }
      __syncthreads();
    }
  }
}

typedef _Float16 hv2 __attribute__((ext_vector_type(2)));
DI unsigned packh2(float a, float b) { hv2 r = {(_Float16)a, (_Float16)b}; return __builtin_bit_cast(unsigned, r); }
DI float lo_h(unsigned u) { hv2 r = __builtin_bit_cast(hv2, u); return (float)r[0]; }
DI float hi_h(unsigned u) { hv2 r = __builtin_bit_cast(hv2, u); return (float)r[1]; }

DI void phase_attn(const P& p, int layer, char* smem) {
  const int tidx = opaque_tid();
  const int j = layer / 2;
  const bool ctxq = layer != 3;
  const bf16_t* Q = (const bf16_t*)(p.ws + OFF_TR + TR_Q);
  const bf16_t* Kb = (const bf16_t*)(p.ws + OFF_TR + TR_KK);
  const bf16_t* VT = (const bf16_t*)(p.ws + OFF_TR + TR_VT);
  bf16_t* O = (bf16_t*)(p.ws + OFF_TR + TR_H);
  const float lam = ((const float*)(p.ws + OFF_MISC))[2048 + j];
  const float oml = 1.f - lambda_init(layer);
  const float* subg = p.da_subln_g + (size_t)j * 128;
  bf16_t* sK = (bf16_t*)smem;
  bf16_t* sV = sK + 2 * 64 * LDT;
  const int tid = tidx, lane = tid & 63, w = tid >> 6, g = lane >> 5, l31 = lane & 31;
  const int nitems = 2048 + (ctxq ? 128 : 0);
  for (int item = blockIdx.x; item < nitems; item += gridDim.x) {
    int b, h, q0, kbeg, ntiles;
    if (item < 2048) { b = item >> 8; h = (item >> 5) & 7; q0 = (item & 31) * 128; kbeg = 0; ntiles = TK / 64; }
    else { const int it = item - 2048; b = it >> 4; h = (it >> 1) & 7; q0 = SL + (it & 1) * 128; kbeg = SL; ntiles = CL / 64; }
    const bf16_t* Vp0 = VT + (size_t)(b * 8 + h) * 128 * TK;
    const int tq = q0 + w * 32 + l31;
    const size_t grow = tq < SL ? (size_t)b * SL + tq : (size_t)NLAT + (size_t)b * CL + (tq - SL);
    bf16_t* op = O + grow * 1024 + h * 128;
    for (int s = 0; s < 2; s++) {
      const bf16_t* Kp0 = Kb + (size_t)((b * 8 + h) * 2 + s) * TK * 64;
      const bf16_t* Qp = Q + ((size_t)((b * 8 + h) * 2 + s) * TK + tq) * 64 + g * 8;
      bf16x8 qf[4];
#pragma unroll
      for (int kk = 0; kk < 4; kk++) qf[kk] = *(const bf16x8*)(Qp + kk * 16);
      f32x16 o[4];
#pragma unroll
      for (int db = 0; db < 4; db++)
#pragma unroll
        for (int r = 0; r < 16; r++) o[db][r] = 0.f;
      float m = -1e30f, l = 0.f;
      uint4 rk0, rk1, rv0, rv1, rv2, rv3;
      const unsigned kvo = (unsigned)((tid >> 3) * 64 + (tid & 7) * 8);
      const unsigned vvo = (unsigned)((tid >> 3) * TK + (tid & 7) * 8);
      const unsigned sko = (unsigned)((tid >> 3) * LDT + (tid & 7) * 8);
#define ISSUE_KV(kt_)                                                             \
      {                                                                           \
        const bf16_t* kb_ = Kp0 + (size_t)(kbeg + (kt_) * 64) * 64;               \
        const bf16_t* vb_ = Vp0 + (kbeg + (kt_) * 64);                            \
        rk0 = *(const uint4*)(kb_ + kvo);                                         \
        rk1 = *(const uint4*)(kb_ + (kvo + 32u * 64u));                           \
        rv0 = *(const uint4*)(vb_ + vvo);                                         \
        rv1 = *(const uint4*)(vb_ + (vvo + 32u * (unsigned)TK));                  \
        rv2 = *(const uint4*)(vb_ + (vvo + 64u * (unsigned)TK));                  \
        rv3 = *(const uint4*)(vb_ + (vvo + 96u * (unsigned)TK));                  \
      }
#define STAGE_KV(buf_)                                                            \
      {                                                                           \
        bf16_t* ks_ = sK + (buf_) * 64 * LDT + sko;                               \
        bf16_t* vs_ = sV + (buf_) * 128 * LDT + sko;                              \
        *(uint4*)(ks_) = rk0;                                                     \
        *(uint4*)(ks_ + 32 * LDT) = rk1;                                          \
        *(uint4*)(vs_) = rv0;                                                     \
        *(uint4*)(vs_ + 32 * LDT) = rv1;                                          \
        *(uint4*)(vs_ + 64 * LDT) = rv2;                                          \
        *(uint4*)(vs_ + 96 * LDT) = rv3;                                          \
      }
      __syncthreads();
      ISSUE_KV(0);
      STAGE_KV(0);
      __syncthreads();
      for (int kt = 0; kt < ntiles; kt++) {
        const int buf = kt & 1;
        const bool more = kt + 1 < ntiles;
        if (more) ISSUE_KV(kt + 1);
        __builtin_amdgcn_sched_barrier(0);
        const bf16_t* kS = sK + buf * 64 * LDT;
        const bf16_t* vS = sV + buf * 128 * LDT;
#pragma unroll
        for (int kb = 0; kb < 2; kb++) {
          f32x16 st;
#pragma unroll
          for (int r = 0; r < 16; r++) st[r] = 0.f;
#pragma unroll
          for (int kk = 0; kk < 4; kk++) {
            const bf16x8 kf = *(const bf16x8*)(kS + (kb * 32 + l31) * LDT + kk * 16 + g * 8);
            st = MFMA32(kf, qf[kk], st);
          }
          float mx = st[0];
#pragma unroll
          for (int r = 1; r < 16; r++) mx = fmaxf(mx, st[r]);
          mx = fmaxf(mx, __shfl_xor(mx, 32));
          if (__any(mx > m + 8.f)) {
            const float mn = (mx > m + 8.f) ? mx : m;
            const float al = exp2f(m - mn);
            m = mn;
            l *= al;
#pragma unroll
            for (int db = 0; db < 4; db++)
#pragma unroll
              for (int r = 0; r < 16; r++) o[db][r] *= al;
          }
          float ls = 0.f;
          bf16x8 pk[2];
#pragma unroll
          for (int hh = 0; hh < 2; hh++) {
            float e[8];
#pragma unroll
            for (int i = 0; i < 8; i++) { e[i] = exp2f(st[hh * 8 + i] - m); ls += e[i]; }
            const uint4 u = make_uint4(pack2(e[0], e[1]), pack2(e[2], e[3]), pack2(e[4], e[5]), pack2(e[6], e[7]));
            pk[hh] = __builtin_bit_cast(bf16x8, u);
          }
          l += ls;
#pragma unroll
          for (int db = 0; db < 4; db++)
#pragma unroll
            for (int hh = 0; hh < 2; hh++) {
              const bf16_t* vp = vS + (db * 32 + l31) * LDT + kb * 32 + hh * 16 + 4 * g;
              const uint2 lo = *(const uint2*)vp;
              const uint2 hi = *(const uint2*)(vp + 8);
              const uint4 u = make_uint4(lo.x, lo.y, hi.x, hi.y);
              o[db] = MFMA32(__builtin_bit_cast(bf16x8, u), pk[hh], o[db]);
            }
        }
        __builtin_amdgcn_sched_barrier(0);
        if (more) STAGE_KV(buf ^ 1);
        __syncthreads();
      }
      const float lt = l + __shfl_xor(l, 32);
      if (s == 0) {
        const float inv = 1.f / lt;
#pragma unroll
        for (int db = 0; db < 4; db++)
#pragma unroll
          for (int rq = 0; rq < 4; rq++) {
            const int d = db * 32 + 8 * rq + 4 * g;
            *(uint2*)(op + d) = make_uint2(packh2(o[db][4 * rq] * inv, o[db][4 * rq + 1] * inv), packh2(o[db][4 * rq + 2] * inv, o[db][4 * rq + 3] * inv));
          }
      } else {
        const float inv = lam / lt;
        float ssq = 0.f;
#pragma unroll
        for (int db = 0; db < 4; db++)
#pragma unroll
          for (int rq = 0; rq < 4; rq++) {
            const int d = db * 32 + 8 * rq + 4 * g;
            const uint2 u0 = *(const uint2*)(op + d);
            const float a0 = lo_h(u0.x) - o[db][4 * rq] * inv, a1 = hi_h(u0.x) - o[db][4 * rq + 1] * inv;
            const float a2 = lo_h(u0.y) - o[db][4 * rq + 2] * inv, a3 = hi_h(u0.y) - o[db][4 * rq + 3] * inv;
            o[db][4 * rq] = a0; o[db][4 * rq + 1] = a1; o[db][4 * rq + 2] = a2; o[db][4 * rq + 3] = a3;
            ssq += a0 * a0 + a1 * a1 + a2 * a2 + a3 * a3;
          }
        ssq += __shfl_xor(ssq, 32);
        const float rs = rsqrtf(ssq * (1.f / 128.f) + 1e-5f) * oml;
#pragma unroll
        for (int db = 0; db < 4; db++)
#pragma unroll
          for (int rq = 0; rq < 4; rq++) {
            const int d = db * 32 + 8 * rq + 4 * g;
            const float4 sg = *(const float4*)(subg + d);
            *(uint2*)(op + d) = make_uint2(pack2(o[db][4 * rq] * rs * sg.x, o[db][4 * rq + 1] * rs * sg.y),
                                           pack2(o[db][4 * rq + 2] * rs * sg.z, o[db][4 * rq + 3] * rs * sg.w));
          }
      }
    }
  }
}

DI void phase_at_out(const P& p, int layer, char* smem) {
  const int tidx = opaque_tid();
  const bf16_t* O = (const bf16_t*)(p.ws + OFF_TR + TR_H);
  const bf16_t* WO = (const bf16_t*)(p.ws + OFF_W) + W_WO;
  const int nmt = (layer == 3) ? 256 : 272;
  for (int t = blockIdx.x; t < nmt * 8; t += gridDim.x) {
    const int gt = t / 8, n0 = (t % 8) * 128;
    f32x16 acc[2][2];
    gemm_mainloop(O + (size_t)gt * 128 * 1024, 1024, WO + (size_t)n0 * 1024, 1024, 1024, smem, acc);
    const float* gate = mods_ptr(p, layer, mod_row(gt * 128)) + 2048 + n0;
    float* xr = resid_row(p, gt * 128) + n0;
    EPI8_BEGIN
      resid_update(xr + (size_t)row * D + col, gate + col, v);
    EPI8_END
  }
}

DI void phase_final(const P& p) {
  const int tidx = opaque_tid();
  const int lane = tidx & 63, wv = tidx >> 6;
  for (int row = blockIdx.x * 4 + wv; row < NLAT; row += gridDim.x * 4) {
    float* xr = p.out + (size_t)row * D;
    float4 v[4];
    float ss = 0.f;
#pragma unroll
    for (int jx = 0; jx < 4; jx++) { v[jx] = *(const float4*)(xr + jx * 256 + lane * 4); ss += v[jx].x * v[jx].x + v[jx].y * v[jx].y + v[jx].z * v[jx].z + v[jx].w * v[jx].w; }
    ss = wave_sum(ss);
    const float rs = rsqrtf(ss * (1.f / 1024.f) + 1e-6f);
#pragma unroll
    for (int jx = 0; jx < 4; jx++) {
      const float4 g = *(const float4*)(p.final_g + jx * 256 + lane * 4);
      *(float4*)(xr + jx * 256 + lane * 4) = make_float4(v[jx].x * rs * g.x, v[jx].y * rs * g.y, v[jx].z * rs * g.z, v[jx].w * rs * g.w);
    }
  }
}

#define XB_TMO      128
#define XB_XCNT(j)  (256  + 64 * (j))
#define XB_XSUB(j)  (1280 + 64 * (j))
#define XB_XGEN(j)  (2304 + 64 * (j))
#define XB_TOP      3328
#define XB_TOPGEN   3392
#define XCD_BAR_WORDS 3456
#define XB_SPIN_CAP (1u << 22)
#define LAS __attribute__((address_space(3)))
DI unsigned xb_ld(unsigned* p) { return __hip_atomic_load(p, __ATOMIC_RELAXED, __HIP_MEMORY_SCOPE_AGENT); }
DI unsigned xb_add(unsigned* p, unsigned v) { return __hip_atomic_fetch_add(p, v, __ATOMIC_RELAXED, __HIP_MEMORY_SCOPE_AGENT); }
DI unsigned xb_xcc_id() { return (unsigned)__builtin_amdgcn_s_getreg((3 << 11) | 20) & 0xFu; }
#define XB_SPIN(cond, bar) do { unsigned _sp = 0; while (cond) { __builtin_amdgcn_s_sleep(1); \
    if ((++_sp & 255u) == 0u) { if (xb_ld(&(bar)[XB_TMO])) break; if (_sp > XB_SPIN_CAP) { atomicAdd(&(bar)[XB_TMO], 1u); break; } } } } while (0)
struct XcdBarrier { unsigned* bar; unsigned x; volatile LAS unsigned* st; };
DI XcdBarrier xcd_barrier_post(unsigned* bar, volatile LAS unsigned* st) {
  XcdBarrier b; b.bar = bar; b.x = xb_xcc_id(); b.st = st;
  if (threadIdx.x == 0) (void)xb_add(&bar[XB_XCNT(b.x)], 1u);
  return b;
}
DI void xcd_barrier_complete(unsigned* bar, unsigned x, unsigned& nloc, unsigned& nx) {
  const unsigned G = gridDim.x * gridDim.y * gridDim.z;
  unsigned sum, cnt, mine, sp = 0u;
  for (;;) {
    sum = 0u; cnt = 0u; mine = 0u;
#pragma unroll
    for (unsigned j = 0; j < 16; ++j) { const unsigned c = xb_ld(&bar[XB_XCNT(j)]); sum += c; cnt += (c > 0u) ? 1u : 0u; mine = (j == x) ? c : mine; }
    if (sum == G) break;
    __builtin_amdgcn_s_sleep(1);
    if ((++sp & 255u) == 0u) { if (xb_ld(&bar[XB_TMO])) break; if (sp > XB_SPIN_CAP) { atomicAdd(&bar[XB_TMO], 1u); break; } }
  }
  nloc = mine > 0u ? mine : 1u; nx = cnt > 0u ? cnt : 1u;
}
DI void xcd_barrier(const XcdBarrier& b) {
  asm volatile("s_waitcnt vmcnt(0)" ::: "memory");
  __syncthreads();
  if (threadIdx.x == 0) {
    unsigned* bar = b.bar;
    __builtin_amdgcn_s_waitcnt(0);
    unsigned nloc = b.st[0], nx = b.st[1];
    if (nloc == 0u) { xcd_barrier_complete(bar, b.x, nloc, nx); b.st[0] = nloc; b.st[1] = nx; }
    const unsigned old = xb_add(&bar[XB_XSUB(b.x)], 1u);
    const unsigned gen = old / nloc;
    if (old + 1u == (gen + 1u) * nloc) {
      __builtin_amdgcn_fence(__ATOMIC_RELEASE, "agent");
      asm volatile("s_waitcnt vmcnt(0)" ::: "memory");
      const unsigned og = xb_add(&bar[XB_TOP], 1u);
      const unsigned tg = og / nx;
      if (og + 1u == (tg + 1u) * nx) xb_add(&bar[XB_TOPGEN], 1u);
      else XB_SPIN(xb_ld(&bar[XB_TOPGEN]) == tg, bar);
      __builtin_amdgcn_fence(__ATOMIC_ACQUIRE, "agent");
      xb_add(&bar[XB_XGEN(b.x)], 1u);
      asm volatile("s_waitcnt vmcnt(0)" ::: "memory");
    } else {
      XB_SPIN(xb_ld(&bar[XB_XGEN(b.x)]) == gen, bar);
      __builtin_amdgcn_fence(__ATOMIC_ACQUIRE, "agent");
      asm volatile("s_waitcnt vmcnt(0)" ::: "memory");
    }
  }
  __syncthreads();
}
constexpr size_t OFF_BAR = OFF_MISC + 65536;

typedef __attribute__((address_space(1))) const float GCF;
typedef __attribute__((address_space(1))) float GF;
typedef __attribute__((address_space(1))) char GC;
DI unsigned long long lds_word(const unsigned long long* tbl, int i) {
  int z = i;
  asm volatile("" : "+v"(z));
  const unsigned long long v = tbl[z];
  const unsigned lo = __builtin_amdgcn_readfirstlane((unsigned)v), hi = __builtin_amdgcn_readfirstlane((unsigned)(v >> 32));
  return ((unsigned long long)hi << 32) | lo;
}
DI void load_params(P& q, const unsigned long long* tbl) {
  const float** fp = (const float**)&q;
#pragma unroll
  for (int i = 0; i < 36; i++) fp[i] = (const float*)(GCF*)lds_word(tbl, i);
  q.out = (float*)(GF*)lds_word(tbl, 36);
  q.ws = (char*)(GC*)lds_word(tbl, 37);
  q.only = 0;
  q.pad = 0;
}
__global__ void __launch_bounds__(256, 2) mega(P p) {
  __shared__ __attribute__((aligned(16))) char smem[73728];
  __shared__ unsigned long long s_tbl[40];
  {
#if defined(__HIP_DEVICE_COMPILE__)
    typedef __attribute__((address_space(4))) const unsigned long long KW;
    KW* kp = (KW*)__builtin_amdgcn_kernarg_segment_ptr();
    if (threadIdx.x < 39) s_tbl[threadIdx.x] = kp[threadIdx.x];
#endif
    __syncthreads();
  }
  const int only = (int)(unsigned)lds_word(s_tbl, 38);
  cg::grid_group grid = cg::this_grid();
  __shared__ uint4 xb_words;
  if (threadIdx.x == 0) xb_words = make_uint4(0u, 0u, 0u, 0u);
  __syncthreads();
  XcdBarrier xb;
  {
    P q;
    load_params(q, s_tbl);
    xb = xcd_barrier_post((unsigned*)(q.ws + OFF_BAR), (volatile LAS unsigned*)&xb_words);
  }
  int step = 0;
#define GSYNC() { if (step == 1) grid.sync(); else xcd_barrier(xb); }
#define STEP(body)                                   \
  {                                                  \
    if (only < 0 || only == step) {              \
      P q;                                           \
      load_params(q, s_tbl);                         \
      body;                                          \
    }                                                \
    step++;                                          \
    if (only < 0) GSYNC();                         \
  }
#ifndef DUP
#define DUP 0
#endif
#define STEPD(id, body)                              \
  {                                                  \
    if (only < 0 || only == step) {                  \
      P q;                                           \
      load_params(q, s_tbl);                         \
      body;                                          \
      if (DUP == id) { __syncthreads(); body; }      \
    }                                                \
    step++;                                          \
    if (only < 0) GSYNC();                           \
  }
  STEP(phase_init(q, smem));
  for (int layer = 0; layer < 4; layer++) {
    STEPD(1, phase_conv(q, layer, smem));
    if ((layer & 1) == 0) {
      for (int hf = 0; hf < 2; hf++) {
        STEP(phase_prep(q, layer, 0, hf, true, (bf16_t*)(q.ws + OFF_TR + TR_HX), 2048, false));
        STEPD(3, phase_t1(q, smem));
        STEPD(4, phase_feat(q, layer, hf, smem));
        STEPD(5, phase_scan(q, layer, smem));
        STEP(phase_combine(q, layer));
        STEP(phase_rw_out(q, layer, hf, smem));
      }
    } else {
      STEP(phase_prep(q, layer, 0, -1, false, (bf16_t*)(q.ws + OFF_TR + TR_H), 1024, false));
      STEPD(7, phase_qkv(q, smem));
      STEPD(8, phase_attn(q, layer, smem));
      STEP(phase_at_out(q, layer, smem));
    }
    STEP(phase_prep(q, layer, 1, -1, false, (bf16_t*)(q.ws + OFF_TR + TR_H2), 1024, layer == 3));
    STEPD(9, phase_mlp1(q, layer, smem));
    STEP(phase_mlp2(q, layer, smem));
  }
  STEP(phase_final(q));
}

#ifndef MULTI_LAUNCH
#define MULTI_LAUNCH 0
#endif
constexpr int NSTEPS = 1 + 2 * (1 + 12 + 3) + 2 * (1 + 4 + 3) + 1;

extern "C" void kernel_launch(void* const* d_in, const int* in_sizes, int n_in, void* d_out, int out_size, void* d_ws, size_t ws_size,
                              hipStream_t stream) {
  static int grid_blocks = 0;
  if (!grid_blocks) {
    int dev = 0, cus = 0, per_cu = 0;
    hipGetDevice(&dev);
    hipDeviceGetAttribute(&cus, hipDeviceAttributeMultiprocessorCount, dev);
    hipOccupancyMaxActiveBlocksPerMultiprocessor(&per_cu, mega, 256, 0);
    if (per_cu < 1) per_cu = 1;
    if (per_cu > 2) per_cu = 2;
    grid_blocks = cus * per_cu;
  }
  P p{};
  const float** fp = (const float**)&p;
  for (int i = 0; i < 36; i++) fp[i] = (const float*)d_in[i];
  p.out = (float*)d_out;
  p.ws = (char*)d_ws;
  p.pad = 0;
#if MULTI_LAUNCH
  for (int s = 0; s < NSTEPS; s++) {
    p.only = s;
    void* args[] = {&p};
    hipError_t e = hipLaunchCooperativeKernel((void*)mega, dim3(grid_blocks), dim3(256), args, 0, stream);
    if (e != hipSuccess) { fprintf(stderr, "launch failed: %s\n", hipGetErrorString(e)); break; }
  }
#else
  p.only = -1;
  hipMemsetAsync((char*)d_ws + OFF_BAR, 0, XCD_BAR_WORDS * 4, stream);
  void* args[] = {&p};
  hipError_t e = hipLaunchCooperativeKernel((void*)mega, dim3(grid_blocks), dim3(256), args, 0, stream);
  if (e != hipSuccess) fprintf(stderr, "cooperative launch failed: %s (grid %d)\n", hipGetErrorString(e), grid_blocks);
#endif
}
```

```cpp
#include <hip/hip_runtime.h>
#include <hip/hip_cooperative_groups.h>
#include <cstdio>
namespace cg = cooperative_groups;

#define DI __device__ __forceinline__
typedef unsigned short bf16_t;
using bf16x8 = __attribute__((ext_vector_type(8))) short;
using f32x16 = __attribute__((ext_vector_type(16))) float;
typedef __bf16 bfv2 __attribute__((ext_vector_type(2)));
typedef float fv2 __attribute__((ext_vector_type(2)));
#define MFMA32(a, b, c) __builtin_amdgcn_mfma_f32_32x32x16_bf16((a), (b), (c), 0, 0, 0)

constexpr int D = 1024, NB = 8, SL = 4096, CL = 256;
constexpr int NLAT = NB * SL, NCTX = NB * CL, NTOK = NLAT + NCTX;
constexpr int HROWS = NTOK / 2;
constexpr int TK = SL + CL;
constexpr size_t MiB = 1048576;
constexpr size_t OFF_W = 0, OFF_XC = 36 * MiB, OFF_MODS = 44 * MiB, OFF_MISC = 45 * MiB, OFF_VF = 46 * MiB, OFF_TR = 114 * MiB;
constexpr size_t W_RKV = 0;
constexpr size_t W_L1 = W_RKV + 3072ull * 2048;
constexpr size_t W_W2 = W_L1 + 640ull * 2048;
constexpr size_t W_A2 = W_W2 + 2ull * 65536;
constexpr size_t W_G2 = W_A2 + 65536;
constexpr size_t W_V2 = W_G2 + 2ull * 196608;
constexpr size_t W_WO = W_V2 + 65536;
constexpr size_t W_M1 = W_WO + 1048576;
constexpr size_t W_M2 = W_M1 + 4194304;
constexpr size_t W_QKV = 0;
constexpr size_t HALF_ARR = (size_t)HROWS * 1024 * 2;
constexpr size_t TR_HX = 0;
constexpr size_t TR_T1 = 2 * HALF_ARR;
constexpr size_t TR_R = TR_T1 + (size_t)HROWS * 640 * 2;
constexpr size_t TR_K = TR_R + HALF_ARR, TR_V = TR_K + HALF_ARR, TR_A = TR_V + HALF_ARR;
constexpr size_t TR_WL0 = TR_A + HALF_ARR, TR_WL1 = TR_WL0 + HALF_ARR, TR_G0 = TR_WL1 + HALF_ARR, TR_G1 = TR_G0 + HALF_ARR;
constexpr size_t FULL_ARR = (size_t)NTOK * 1024 * 2;
constexpr size_t TR_H = 0, TR_Q = FULL_ARR, TR_KK = 2 * FULL_ARR, TR_VT = 3 * FULL_ARR;
constexpr size_t TR_H2 = 0, TR_HID = FULL_ARR;

struct P {
  const float *x, *c, *ctx, *c_ctx, *ada_w, *ada_b, *norm_g, *final_g;
  const float *rw_mix, *rw_w_rkv, *rw_w0, *rw_w1, *rw_w2, *rw_a0, *rw_a1, *rw_a2, *rw_g1, *rw_g2, *rw_kk, *rw_ka, *rw_rk, *rw_ln_g, *rw_ln_b, *rw_w_o, *rw_v0, *rw_v1, *rw_v2;
  const float *da_w_qkv, *da_w_o, *da_lq1, *da_lk1, *da_lq2, *da_lk2, *da_subln_g, *mlp_w1, *mlp_w2;
  float* out;
  char* ws;
  int only;
  int pad;
};

DI float bf2f(bf16_t h) { return __uint_as_float(((unsigned)h) << 16); }
DI unsigned pack2(float a, float b) { fv2 v = {a, b}; bfv2 r = __builtin_convertvector(v, bfv2); return __builtin_bit_cast(unsigned, r); }
DI bf16_t f2bf(float a) { return (bf16_t)(pack2(a, 0.f) & 0xffffu); }
DI float lo_bf(unsigned u) { return __uint_as_float(u << 16); }
DI float hi_bf(unsigned u) { return __uint_as_float(u & 0xffff0000u); }
DI float sigmoidf_(float x) { return 1.f / (1.f + __expf(-x)); }
DI float wave_sum(float v) {
#pragma unroll
  for (int o = 32; o > 0; o >>= 1) v += __shfl_xor(v, o);
  return v;
}
template <int N> DI float ror_add(float x) { return x + __builtin_bit_cast(float, __builtin_amdgcn_mov_dpp(__builtin_bit_cast(int, x), 0x120 + N, 0xf, 0xf, true)); }
DI float rowsum16(float x) { x = ror_add<8>(x); x = ror_add<4>(x); x = ror_add<2>(x); x = ror_add<1>(x); return x; }

DI int opaque_tid() { int t = threadIdx.x; asm volatile("" : "+v"(t)); return t; }
DI float* resid_row(const P& p, int gr) { return gr < NLAT ? p.out + (size_t)gr * D : (float*)(p.ws + OFF_XC) + (size_t)(gr - NLAT) * D; }
DI int mod_row(int gr) { return gr < NLAT ? gr / SL : 8; }
DI const float* mods_ptr(const P& p, int layer, int mrow) { return (const float*)(p.ws + OFF_MODS) + ((size_t)layer * 9 + mrow) * 6144; }
DI int half_gtile(int hf, int lt) { return lt < 128 ? hf * 128 + lt : 256 + hf * 8 + (lt - 128); }
DI int first_tile(int base) { int g = gridDim.x; int s = (int)blockIdx.x - (base % g); if (s < 0) s += g; return s; }
DI float lambda_init(int layer) { return 0.8f - 0.6f * expf(-0.3f * (float)layer); }

DI void phase_init(const P& p, char* smem) {
  const int tidx = opaque_tid();
  const int tid = tidx;
  float* sc = (float*)smem;
  float* mods = (float*)(p.ws + OFF_MODS);
  for (int item = blockIdx.x; item < 96; item += gridDim.x) {
    const int layer = item / 24, cb = item % 24;
    __syncthreads();
    for (int i = tid; i < 9 * 1024; i += 256) {
      int r = i >> 10, k = i & 1023;
      float v = r < 8 ? p.c[r * 1024 + k] : p.c_ctx[k];
      sc[i] = v / (1.f + expf(-v));
    }
    __syncthreads();
    const int w = tid >> 6, q = tid & 63;
    float4 acc[9];
#pragma unroll
    for (int r = 0; r < 9; r++) acc[r] = make_float4(0.f, 0.f, 0.f, 0.f);
    const float* wp = p.ada_w + (size_t)layer * 1024 * 6144 + cb * 256 + q * 4;
    for (int k = w * 256; k < w * 256 + 256; k++) {
      float4 wv = *(const float4*)(wp + (size_t)k * 6144);
#pragma unroll
      for (int r = 0; r < 9; r++) {
        float s = sc[r * 1024 + k];
        acc[r].x += s * wv.x; acc[r].y += s * wv.y; acc[r].z += s * wv.z; acc[r].w += s * wv.w;
      }
    }
    __syncthreads();
    float4* red = (float4*)smem;
#pragma unroll
    for (int r = 0; r < 9; r++) red[(w * 9 + r) * 64 + q] = acc[r];
    __syncthreads();
    for (int i = tid; i < 9 * 64; i += 256) {
      int r = i / 64, qq = i % 64;
      float4 s0 = red[(0 * 9 + r) * 64 + qq], s1 = red[(1 * 9 + r) * 64 + qq], s2 = red[(2 * 9 + r) * 64 + qq], s3 = red[(3 * 9 + r) * 64 + qq];
      float4 bb = *(const float4*)(p.ada_b + layer * 6144 + cb * 256 + qq * 4);
      float4 o = make_float4(s0.x + s1.x + s2.x + s3.x + bb.x, s0.y + s1.y + s2.y + s3.y + bb.y, s0.z + s1.z + s2.z + s3.z + bb.z, s0.w + s1.w + s2.w + s3.w + bb.w);
      *(float4*)(mods + ((size_t)layer * 9 + r) * 6144 + cb * 256 + qq * 4) = o;
    }
  }
  if (blockIdx.x == gridDim.x - 1) {
    float* misc = (float*)(p.ws + OFF_MISC);
    for (int i = tid; i < 1024; i += 256) {
      int pos = i / 16, f = i % 16;
      float inv = powf(10000.f, -(float)f / 16.f);
      float ang = (float)pos * inv;
      misc[i] = cosf(ang);
      misc[1024 + i] = sinf(ang);
    }
    misc[4096 + tid] = 0.f;
    if (tid < 2) {
      float s1 = 0.f, s2 = 0.f;
      for (int k = 0; k < 64; k++) { s1 += p.da_lq1[tid * 64 + k] * p.da_lk1[tid * 64 + k]; s2 += p.da_lq2[tid * 64 + k] * p.da_lk2[tid * 64 + k]; }
      misc[2048 + tid] = expf(s1) - expf(s2) + lambda_init(2 * tid + 1);
    }
  }
  const size_t n4 = (size_t)NLAT * D / 4, c4 = (size_t)NCTX * D / 4;
  const float4* xs = (const float4*)p.x; float4* xo = (float4*)p.out;
  for (size_t i = (size_t)blockIdx.x * 256 + tid; i < n4; i += (size_t)gridDim.x * 256) xo[i] = xs[i];
  const float4* cs = (const float4*)p.ctx; float4* co = (float4*)(p.ws + OFF_XC);
  for (size_t i = (size_t)blockIdx.x * 256 + tid; i < c4; i += (size_t)gridDim.x * 256) co[i] = cs[i];
}

DI void conv_mat(const float* __restrict__ src, int K, int N, bf16_t* __restrict__ dst, int ldd, int koff, const float* __restrict__ scale,
                 int Kp, int Np, float* sm, int& base) {
  const int tidx = opaque_tid();
  const int tid = tidx;
  const int tk = Kp / 64, tn = Np / 64, nt = tk * tn;
  for (int t = first_tile(base); t < nt; t += gridDim.x) {
    const int k0 = (t / tn) * 64, n0 = (t % tn) * 64;
    __syncthreads();
#pragma unroll
    for (int i = 0; i < 4; i++) {
      int kr = (tid >> 4) + 16 * i, nc = (tid & 15) * 4;
      float4 v = make_float4(0.f, 0.f, 0.f, 0.f);
      if (src != nullptr && k0 + kr < K && n0 + nc < N) {
        v = *(const float4*)(src + (size_t)(k0 + kr) * N + n0 + nc);
        if (scale) { float s = scale[k0 + kr]; v.x *= s; v.y *= s; v.z *= s; v.w *= s; }
      }
      sm[kr * 65 + nc + 0] = v.x; sm[kr * 65 + nc + 1] = v.y; sm[kr * 65 + nc + 2] = v.z; sm[kr * 65 + nc + 3] = v.w;
    }
    __syncthreads();
    const int n = tid >> 2, kb = (tid & 3) * 16;
    unsigned o[8];
#pragma unroll
    for (int i = 0; i < 8; i++) o[i] = pack2(sm[(kb + 2 * i) * 65 + n], sm[(kb + 2 * i + 1) * 65 + n]);
    uint4* dp = (uint4*)(dst + (size_t)(n0 + n) * ldd + koff + k0 + kb);
    dp[0] = make_uint4(o[0], o[1], o[2], o[3]);
    dp[1] = make_uint4(o[4], o[5], o[6], o[7]);
  }
  base += nt;
}

DI void phase_conv(const P& p, int layer, char* smem) {
  float* sm = (float*)smem;
  bf16_t* W = (bf16_t*)(p.ws + OFF_W);
  int base = 0;
  const int j = layer / 2;
  if ((layer & 1) == 0) {
    const int mixsel[3] = {0, 2, 3};
    for (int s = 0; s < 3; s++) {
      const float* src = p.rw_w_rkv + ((size_t)j * 3 + s) * 1048576;
      conv_mat(src, 1024, 1024, W + W_RKV + (size_t)s * 1024 * 2048, 2048, 0, nullptr, 1024, 1024, sm, base);
      conv_mat(src, 1024, 1024, W + W_RKV + (size_t)s * 1024 * 2048, 2048, 1024, p.rw_mix + ((size_t)j * 6 + mixsel[s]) * 1024, 1024, 1024, sm, base);
    }
    for (int pass = 0; pass < 2; pass++) {
      const int ko = pass * 1024;
      const float* m1 = pass ? p.rw_mix + ((size_t)j * 6 + 1) * 1024 : nullptr;
      const float* m4 = pass ? p.rw_mix + ((size_t)j * 6 + 4) * 1024 : nullptr;
      const float* m5 = pass ? p.rw_mix + ((size_t)j * 6 + 5) * 1024 : nullptr;
      const float* m3 = pass ? p.rw_mix + ((size_t)j * 6 + 3) * 1024 : nullptr;
      bf16_t* L1 = W + W_L1;
      conv_mat(p.rw_w1 + ((size_t)j * 2 + 0) * 65536, 1024, 64, L1 + 0ull * 2048, 2048, ko, m1, 1024, 64, sm, base);
      conv_mat(p.rw_w1 + ((size_t)j * 2 + 1) * 65536, 1024, 64, L1 + 64ull * 2048, 2048, ko, m1, 1024, 64, sm, base);
      conv_mat(p.rw_a1 + (size_t)j * 65536, 1024, 64, L1 + 128ull * 2048, 2048, ko, m4, 1024, 64, sm, base);
      conv_mat(p.rw_g1 + ((size_t)j * 2 + 0) * 163840, 1024, 160, L1 + 192ull * 2048, 2048, ko, m5, 1024, 192, sm, base);
      conv_mat(p.rw_g1 + ((size_t)j * 2 + 1) * 163840, 1024, 160, L1 + 384ull * 2048, 2048, ko, m5, 1024, 192, sm, base);
      conv_mat(j > 0 ? p.rw_v1 + (size_t)(j - 1) * 32768 : nullptr, 1024, 32, L1 + 576ull * 2048, 2048, ko, m3, 1024, 64, sm, base);
    }
    conv_mat(p.rw_w2 + ((size_t)j * 2 + 0) * 65536, 64, 1024, W + W_W2, 64, 0, nullptr, 64, 1024, sm, base);
    conv_mat(p.rw_w2 + ((size_t)j * 2 + 1) * 65536, 64, 1024, W + W_W2 + 65536, 64, 0, nullptr, 64, 1024, sm, base);
    conv_mat(p.rw_a2 + (size_t)j * 65536, 64, 1024, W + W_A2, 64, 0, nullptr, 64, 1024, sm, base);
    conv_mat(p.rw_g2 + ((size_t)j * 2 + 0) * 163840, 160, 1024, W + W_G2, 192, 0, nullptr, 192, 1024, sm, base);
    conv_mat(p.rw_g2 + ((size_t)j * 2 + 1) * 163840, 160, 1024, W + W_G2 + 196608, 192, 0, nullptr, 192, 1024, sm, base);
    conv_mat(j > 0 ? p.rw_v2 + (size_t)(j - 1) * 32768 : nullptr, 32, 1024, W + W_V2, 64, 0, nullptr, 64, 1024, sm, base);
    conv_mat(p.rw_w_o + (size_t)j * 1048576, 1024, 1024, W + W_WO, 1024, 0, nullptr, 1024, 1024, sm, base);
  } else {
    conv_mat(p.da_w_qkv + (size_t)j * 3145728, 1024, 3072, W + W_QKV, 1024, 0, nullptr, 1024, 3072, sm, base);
    conv_mat(p.da_w_o + (size_t)j * 1048576, 1024, 1024, W + W_WO, 1024, 0, nullptr, 1024, 1024, sm, base);
  }
  conv_mat(p.mlp_w1 + (size_t)layer * 4194304, 1024, 4096, W + W_M1, 1024, 0, nullptr, 1024, 4096, sm, base);
  conv_mat(p.mlp_w2 + (size_t)layer * 4194304, 4096, 1024, W + W_M2, 4096, 0, nullptr, 4096, 1024, sm, base);
}

DI void phase_prep(const P& p, int layer, int sub, int hf, bool shift, bf16_t* H, int ldh, bool skip_ctx) {
  const int tidx = opaque_tid();
  const int lane = tidx & 63, wv = tidx >> 6;
  const int nrows = hf < 0 ? (skip_ctx ? NLAT : NTOK) : HROWS;
  const int nseg = nrows / 8;
  const float* ng = p.norm_g + ((size_t)layer * 2 + sub) * 1024;
  for (int seg = blockIdx.x * 4 + wv; seg < nseg; seg += gridDim.x * 4) {
    const int lr0 = seg * 8;
    const int gr0 = hf < 0 ? lr0 : (lr0 < 16384 ? hf * 16384 + lr0 : NLAT + hf * 1024 + (lr0 - 16384));
    const bool lat = gr0 < NLAT;
    const int T = lat ? SL : CL;
    const int t0 = lat ? (gr0 % SL) : ((gr0 - NLAT) % CL);
    const float* xbase = resid_row(p, gr0);
    const float* md = mods_ptr(p, layer, mod_row(gr0));
    float4 g4[4], sc4[4], sh4[4];
#pragma unroll
    for (int jx = 0; jx < 4; jx++) {
      int ch = jx * 256 + lane * 4;
      g4[jx] = *(const float4*)(ng + ch);
      sh4[jx] = *(const float4*)(md + sub * 3072 + ch);
      sc4[jx] = *(const float4*)(md + sub * 3072 + 1024 + ch);
      g4[jx].x *= (1.f + sc4[jx].x); g4[jx].y *= (1.f + sc4[jx].y); g4[jx].z *= (1.f + sc4[jx].z); g4[jx].w *= (1.f + sc4[jx].w);
    }
    float4 hp[4], hc[4], hn[4];
    const int tb = shift ? -1 : 0, te = shift ? 9 : 8;
    for (int tt = tb; tt < te; tt++) {
      const int t = t0 + tt;
      if (t >= 0 && t < T) {
        const float* xr = xbase + (ptrdiff_t)tt * D;
        float ss = 0.f;
#pragma unroll
        for (int jx = 0; jx < 4; jx++) {
          hn[jx] = *(const float4*)(xr + jx * 256 + lane * 4);
          ss += hn[jx].x * hn[jx].x + hn[jx].y * hn[jx].y + hn[jx].z * hn[jx].z + hn[jx].w * hn[jx].w;
        }
        ss = wave_sum(ss);
        const float rs = rsqrtf(ss * (1.f / 1024.f) + 1e-6f);
#pragma unroll
        for (int jx = 0; jx < 4; jx++) {
          hn[jx].x = hn[jx].x * rs * g4[jx].x + sh4[jx].x; hn[jx].y = hn[jx].y * rs * g4[jx].y + sh4[jx].y;
          hn[jx].z = hn[jx].z * rs * g4[jx].z + sh4[jx].z; hn[jx].w = hn[jx].w * rs * g4[jx].w + sh4[jx].w;
        }
      } else {
#pragma unroll
        for (int jx = 0; jx < 4; jx++) hn[jx] = make_float4(0.f, 0.f, 0.f, 0.f);
      }
      if (!shift) {
        bf16_t* hr = H + (size_t)(lr0 + tt) * ldh;
#pragma unroll
        for (int jx = 0; jx < 4; jx++) *(uint2*)(hr + jx * 256 + lane * 4) = make_uint2(pack2(hn[jx].x, hn[jx].y), pack2(hn[jx].z, hn[jx].w));
      } else if (tt >= 1) {
        bf16_t* hr = H + (size_t)(lr0 + tt - 1) * ldh;
#pragma unroll
        for (int jx = 0; jx < 4; jx++) {
          *(uint2*)(hr + jx * 256 + lane * 4) = make_uint2(pack2(hc[jx].x, hc[jx].y), pack2(hc[jx].z, hc[jx].w));
          float4 xx;
          xx.x = 0.5f * (hp[jx].x + hn[jx].x) - hc[jx].x; xx.y = 0.5f * (hp[jx].y + hn[jx].y) - hc[jx].y;
          xx.z = 0.5f * (hp[jx].z + hn[jx].z) - hc[jx].z; xx.w = 0.5f * (hp[jx].w + hn[jx].w) - hc[jx].w;
          *(uint2*)(hr + 1024 + jx * 256 + lane * 4) = make_uint2(pack2(xx.x, xx.y), pack2(xx.z, xx.w));
        }
      }
#pragma unroll
      for (int jx = 0; jx < 4; jx++) { hp[jx] = hc[jx]; hc[jx] = hn[jx]; }
    }
  }
}

constexpr int LDT = 72;
DI void gemm_mainloop(const bf16_t* __restrict__ A, int lda, const bf16_t* __restrict__ Bt, int ldb, int K, char* smem, f32x16 (&acc)[2][2]) {
  const int tidx = opaque_tid();
  bf16_t* sA = (bf16_t*)smem;
  bf16_t* sB = sA + 2 * 128 * LDT;
  const int tid = tidx, lane = tid & 63, w = tid >> 6, wm = w >> 1, wn = w & 1;
  const int lrow = tid >> 3, lkc = (tid & 7) * 8;
#pragma unroll
  for (int mi = 0; mi < 2; mi++)
#pragma unroll
    for (int ni = 0; ni < 2; ni++)
#pragma unroll
      for (int r = 0; r < 16; r++) acc[mi][ni][r] = 0.f;
  const unsigned ao = (unsigned)(lrow * lda + lkc), bo = (unsigned)(lrow * ldb + lkc);
  const unsigned a32 = (unsigned)(32 * lda), b32 = (unsigned)(32 * ldb);
  uint4 ra0, ra1, ra2, ra3, rb0, rb1, rb2, rb3;
#define G_LOAD(Ab, Bb)                                                                                   \
  {                                                                                                      \
    ra0 = *(const uint4*)((Ab) + ao); ra1 = *(const uint4*)((Ab) + (ao + a32));                          \
    ra2 = *(const uint4*)((Ab) + (ao + 2 * a32)); ra3 = *(const uint4*)((Ab) + (ao + 3 * a32));          \
    rb0 = *(const uint4*)((Bb) + bo); rb1 = *(const uint4*)((Bb) + (bo + b32));                          \
    rb2 = *(const uint4*)((Bb) + (bo + 2 * b32)); rb3 = *(const uint4*)((Bb) + (bo + 3 * b32));          \
  }
#define G_STORE(sa_, sb_)                                                                                \
  {                                                                                                      \
    bf16_t* a_w = (sa_) + lrow * LDT + lkc;                                                              \
    bf16_t* b_w = (sb_) + lrow * LDT + lkc;                                                              \
    *(uint4*)(a_w) = ra0; *(uint4*)(a_w + 32 * LDT) = ra1; *(uint4*)(a_w + 64 * LDT) = ra2; *(uint4*)(a_w + 96 * LDT) = ra3; \
    *(uint4*)(b_w) = rb0; *(uint4*)(b_w + 32 * LDT) = rb1; *(uint4*)(b_w + 64 * LDT) = rb2; *(uint4*)(b_w + 96 * LDT) = rb3; \
  }
  G_LOAD(A, Bt);
  G_STORE(sA, sB);
  __syncthreads();
  const int nk = K >> 6;
  const int aoff = (wm * 64 + (lane & 31)) * LDT + (lane >> 5) * 8;
  const int boff = (wn * 64 + (lane & 31)) * LDT + (lane >> 5) * 8;
  for (int kt = 0; kt < nk; kt++) {
    const int cur = kt & 1;
    if (kt + 1 < nk) {
      const bf16_t* A1 = A + (kt + 1) * 64;
      const bf16_t* B1 = Bt + (kt + 1) * 64;
      G_LOAD(A1, B1);
    }
    __builtin_amdgcn_sched_barrier(0);
    const bf16_t* a_s = sA + cur * 128 * LDT + aoff;
    const bf16_t* b_s = sB + cur * 128 * LDT + boff;
#pragma unroll
    for (int kk = 0; kk < 4; kk++) {
      bf16x8 af[2], bq[2];
#pragma unroll
      for (int mi = 0; mi < 2; mi++) af[mi] = *(const bf16x8*)(a_s + mi * 32 * LDT + kk * 16);
#pragma unroll
      for (int ni = 0; ni < 2; ni++) bq[ni] = *(const bf16x8*)(b_s + ni * 32 * LDT + kk * 16);
#pragma unroll
      for (int mi = 0; mi < 2; mi++)
#pragma unroll
        for (int ni = 0; ni < 2; ni++) acc[mi][ni] = MFMA32(af[mi], bq[ni], acc[mi][ni]);
    }
    __builtin_amdgcn_sched_barrier(0);
    if (kt + 1 < nk) G_STORE(sA + (cur ^ 1) * 128 * LDT, sB + (cur ^ 1) * 128 * LDT);
    __syncthreads();
  }
}
constexpr int EST = 132;
DI void acc_to_lds(const f32x16 (&acc)[2][2], float* es) {
  const int tidx = opaque_tid();
  const int lane = tidx & 63, w = tidx >> 6, wm = w >> 1, wn = w & 1;
#pragma unroll
  for (int mi = 0; mi < 2; mi++)
#pragma unroll
    for (int ni = 0; ni < 2; ni++)
#pragma unroll
      for (int r = 0; r < 16; r++)
        es[(wm * 64 + mi * 32 + (r & 3) + 8 * (r >> 2) + 4 * (lane >> 5)) * EST + wn * 64 + ni * 32 + (lane & 31)] = acc[mi][ni][r];
}
#define EPI8_BEGIN                                                                   \
  {                                                                                  \
    float* es = (float*)smem;                                                        \
    acc_to_lds(acc, es);                                                             \
    __syncthreads();                                                                 \
    for (int pass = 0; pass < 8; pass++) {                                           \
      const int row = pass * 16 + (tidx >> 4), col = (tidx & 15) * 8;  \
      const float4 e_va = *(const float4*)(es + row * EST + col);                    \
      const float4 e_vb = *(const float4*)(es + row * EST + col + 4);                \
      float v[8] = {e_va.x, e_va.y, e_va.z, e_va.w, e_vb.x, e_vb.y, e_vb.z, e_vb.w};
#define EPI8_END                                                                     \
    }                                                                                \
    __syncthreads();                                                                 \
  }
DI uint4 pack8(const float (&v)[8]) { return make_uint4(pack2(v[0], v[1]), pack2(v[2], v[3]), pack2(v[4], v[5]), pack2(v[6], v[7])); }
DI void unpack8(const uint4 u, float (&v)[8]) {
  v[0] = lo_bf(u.x); v[1] = hi_bf(u.x); v[2] = lo_bf(u.y); v[3] = hi_bf(u.y); v[4] = lo_bf(u.z); v[5] = hi_bf(u.z); v[6] = lo_bf(u.w); v[7] = hi_bf(u.w);
}
DI void resid_update(float* xp, const float* gate, const float (&v)[8]) {
  float4 x0 = *(const float4*)xp, x1 = *(const float4*)(xp + 4);
  const float4 g0 = *(const float4*)gate, g1 = *(const float4*)(gate + 4);
  x0.x += g0.x * v[0]; x0.y += g0.y * v[1]; x0.z += g0.z * v[2]; x0.w += g0.w * v[3];
  x1.x += g1.x * v[4]; x1.y += g1.y * v[5]; x1.z += g1.z * v[6]; x1.w += g1.w * v[7];
  *(float4*)xp = x0; *(float4*)(xp + 4) = x1;
}

DI bool xcd_tile(int t, int Mt, int Nt, int& mt, int& nt) {
  const int G = gridDim.x, spx = G >> 3, tn = spx >> 3;
  const int r = t % G, round = t / G;
  const int xcd = r & 7, li = r >> 3;
  const int smn = Mt >> 3, snn = Nt / tn;
  const int st = round * 8 + xcd;
  if (st >= smn * snn) return false;
  const int smi = st % smn, sni = st / smn;
  mt = smi * 8 + (li & 7);
  nt = sni * tn + (li >> 3);
  return true;
}
DI int xcd_rounds(int Mt, int Nt) { const int tn = gridDim.x >> 6; return ((Mt >> 3) * (Nt / tn) + 7) >> 3; }

DI void phase_t1(const P& p, char* smem) {
  const int tidx = opaque_tid();
  const bf16_t* HX = (const bf16_t*)(p.ws + OFF_TR + TR_HX);
  const bf16_t* WL1 = (const bf16_t*)(p.ws + OFF_W) + W_L1;
  bf16_t* T1 = (bf16_t*)(p.ws + OFF_TR + TR_T1);
  for (int t = blockIdx.x; t < 136 * 5; t += gridDim.x) {
    const int nt = t % 5, lt = t / 5;
    f32x16 acc[2][2];
    gemm_mainloop(HX + (size_t)lt * 128 * 2048, 2048, WL1 + (size_t)nt * 128 * 2048, 2048, 2048, smem, acc);
    EPI8_BEGIN
      const int c = nt * 128 + col;
      if (c < 128) {
#pragma unroll
        for (int e = 0; e < 8; e++) v[e] = tanhf(v[e]);
      } else if (c >= 192 && c < 576) {
#pragma unroll
        for (int e = 0; e < 8; e++) v[e] = sigmoidf_(v[e]);
      }
      *(uint4*)(T1 + (size_t)(lt * 128 + row) * 640 + c) = pack8(v);
    EPI8_END
  }
}

DI void phase_feat(const P& p, int layer, int hf, char* smem) {
  const int tidx = opaque_tid();
  const int j = layer / 2;
  const bf16_t* W = (const bf16_t*)(p.ws + OFF_W);
  const bf16_t* HX = (const bf16_t*)(p.ws + OFF_TR + TR_HX);
  const bf16_t* T1 = (const bf16_t*)(p.ws + OFF_TR + TR_T1);
  bf16_t* VF = (bf16_t*)(p.ws + OFF_VF);
  for (int t = blockIdx.x; t < xcd_rounds(136, 24) * (int)gridDim.x; t += gridDim.x) {
    int lt, nt;
    if (!xcd_tile(t, 136, 24, lt, nt)) continue;
    const int s = nt / 8, n0 = (nt % 8) * 128;
    const int gt = half_gtile(hf, lt);
    f32x16 acc[2][2];
    bf16_t* outp = (bf16_t*)(p.ws + OFF_TR + (s == 0 ? TR_R : (s == 1 ? TR_K : TR_V)));
    if (s == 2 && j > 0) {
      gemm_mainloop(T1 + (size_t)lt * 128 * 640 + 576, 640, W + W_V2 + (size_t)n0 * 64, 64, 64, smem, acc);
      const float* v0 = p.rw_v0 + (size_t)(j - 1) * 1024;
      EPI8_BEGIN
        const int c = n0 + col;
#pragma unroll
        for (int e = 0; e < 8; e++) v[e] = sigmoidf_(v0[c + e] + v[e]);
        *(uint4*)(outp + (size_t)(lt * 128 + row) * 1024 + c) = pack8(v);
      EPI8_END
    }
    gemm_mainloop(HX + (size_t)lt * 128 * 2048, 2048, W + W_RKV + ((size_t)s * 1024 + n0) * 2048, 2048, 2048, smem, acc);
    if (s < 2) {
      EPI8_BEGIN
        *(uint4*)(outp + (size_t)(lt * 128 + row) * 1024 + n0 + col) = pack8(v);
      EPI8_END
    } else if (j == 0) {
      EPI8_BEGIN
        const uint4 u = pack8(v);
        *(uint4*)(outp + (size_t)(lt * 128 + row) * 1024 + n0 + col) = u;
        *(uint4*)(VF + (size_t)(gt * 128 + row) * 1024 + n0 + col) = u;
      EPI8_END
    } else {
      EPI8_BEGIN
        const size_t oi = (size_t)(lt * 128 + row) * 1024 + n0 + col;
        float sg[8], vf[8];
        unpack8(*(const uint4*)(outp + oi), sg);
        unpack8(*(const uint4*)(VF + (size_t)(gt * 128 + row) * 1024 + n0 + col), vf);
#pragma unroll
        for (int e = 0; e < 8; e++) v[e] = v[e] + (vf[e] - v[e]) * sg[e];
        *(uint4*)(outp + oi) = pack8(v);
      EPI8_END
    }
  }
  for (int t = blockIdx.x; t < xcd_rounds(136, 40) * (int)gridDim.x; t += gridDim.x) {
    int lt, nt;
    if (!xcd_tile(t, 136, 40, lt, nt)) continue;
    const int s = nt / 8, n0 = (nt % 8) * 128;
    f32x16 acc[2][2];
    if (s == 0) {
      gemm_mainloop(T1 + (size_t)lt * 128 * 640 + 128, 640, W + W_A2 + (size_t)n0 * 64, 64, 64, smem, acc);
      bf16_t* outp = (bf16_t*)(p.ws + OFF_TR + TR_A);
      const float* a0 = p.rw_a0 + (size_t)j * 1024;
      EPI8_BEGIN
#pragma unroll
        for (int e = 0; e < 8; e++) v[e] = sigmoidf_(a0[n0 + col + e] + v[e]);
        *(uint4*)(outp + (size_t)(lt * 128 + row) * 1024 + n0 + col) = pack8(v);
      EPI8_END
    } else if (s < 3) {
      const int d = s - 1;
      gemm_mainloop(T1 + (size_t)lt * 128 * 640 + d * 64, 640, W + W_W2 + (size_t)d * 65536 + (size_t)n0 * 64, 64, 64, smem, acc);
      bf16_t* outp = (bf16_t*)(p.ws + OFF_TR + (d ? TR_WL1 : TR_WL0));
      const float* w0 = p.rw_w0 + ((size_t)j * 2 + d) * 1024;
      EPI8_BEGIN
#pragma unroll
        for (int e = 0; e < 8; e++) {
          const float z = -(w0[n0 + col + e] + v[e]);
          const float sp = fmaxf(z, 0.f) + log1pf(__expf(-fabsf(z)));
          v[e] = -__expf(-sp - 0.5f);
        }
        *(uint4*)(outp + (size_t)(lt * 128 + row) * 1024 + n0 + col) = pack8(v);
      EPI8_END
    } else {
      const int d = s - 3;
      gemm_mainloop(T1 + (size_t)lt * 128 * 640 + 192 + d * 192, 640, W + W_G2 + (size_t)d * 196608 + (size_t)n0 * 192, 192, 192, smem, acc);
      bf16_t* outp = (bf16_t*)(p.ws + OFF_TR + (d ? TR_G1 : TR_G0));
      EPI8_BEGIN
        *(uint4*)(outp + (size_t)(lt * 128 + row) * 1024 + n0 + col) = pack8(v);
      EPI8_END
    }
  }
}

DI int scan_row(int bl, int dir, int pos) {
  if (pos < CL) { int t = dir ? (CL - 1 - pos) : pos; return 16384 + bl * CL + t; }
  int t = pos - CL; if (dir) t = SL - 1 - t;
  return bl * SL + t;
}

DI void phase_scan(const P& p, int layer, char* smem) {
  const int tidx = opaque_tid();
  const int j = layer / 2;
  const int tid = tidx;
  const bf16_t* R = (const bf16_t*)(p.ws + OFF_TR + TR_R);
  const bf16_t* Kx = (const bf16_t*)(p.ws + OFF_TR + TR_K);
  const bf16_t* V = (const bf16_t*)(p.ws + OFF_TR + TR_V);
  const bf16_t* Aa = (const bf16_t*)(p.ws + OFF_TR + TR_A);
  float* sbuf = (float*)smem;
  constexpr int BUFF = 5 * 16 * 64 + 512;
  constexpr int POP = 144;
  float* pobuf = sbuf + 2 * BUFF;
  const int ss = tid >> 4, c4 = tid & 15;
  const int rl = tid >> 4, cg = tid & 15;
  for (int item = blockIdx.x; item < 256; item += gridDim.x) {
    const int q2 = item & 1, dir = (item >> 1) & 1, head = (item >> 2) & 15, bl = item >> 6;
    const bf16_t* WL = (const bf16_t*)(p.ws + OFF_TR + (dir ? TR_WL1 : TR_WL0));
    bf16_t* O = (bf16_t*)(p.ws + OFF_TR + TR_HX) + (dir ? (size_t)HROWS * 1024 : 0);
    const int ch = head * 64 + c4 * 4;
    const float4 kkw = *(const float4*)(p.rw_kk + (size_t)j * 1024 + ch);
    const float4 kaw = *(const float4*)(p.rw_ka + (size_t)j * 1024 + ch);
    fv2 SA01 = {0.f, 0.f}, SA23 = {0.f, 0.f}, SB01 = {0.f, 0.f}, SB23 = {0.f, 0.f};
    uint2 gr_, gk_, ga_, gw_, gv_;
    gv_ = make_uint2(0, 0);
#define SC_ISSUE(chunk_)                                                                   \
    {                                                                                      \
      const size_t ro = (size_t)scan_row(bl, dir, (chunk_) * 16 + ss) * 1024;              \
      gr_ = *(const uint2*)(R + ro + ch); gk_ = *(const uint2*)(Kx + ro + ch);             \
      ga_ = *(const uint2*)(Aa + ro + ch); gw_ = *(const uint2*)(WL + ro + ch);            \
      if (c4 < 8) gv_ = *(const uint2*)(V + ro + head * 64 + q2 * 32 + c4 * 4);            \
    }
#define SC_STAGE(buf_)                                                                     \
    {                                                                                      \
      float* sb_ = sbuf + (buf_) * BUFF;                                                   \
      float r0 = lo_bf(gr_.x), r1 = hi_bf(gr_.x), r2 = lo_bf(gr_.y), r3 = hi_bf(gr_.y);    \
      float k0 = lo_bf(gk_.x), k1 = hi_bf(gk_.x), k2 = lo_bf(gk_.y), k3 = hi_bf(gk_.y);    \
      float a0 = lo_bf(ga_.x), a1 = hi_bf(ga_.x), a2 = lo_bf(ga_.y), a3 = hi_bf(ga_.y);    \
      float w0 = lo_bf(gw_.x), w1 = hi_bf(gw_.x), w2 = lo_bf(gw_.y), w3 = hi_bf(gw_.y);    \
      float u0 = k0 * kkw.x, u1 = k1 * kkw.y, u2 = k2 * kkw.z, u3 = k3 * kkw.w;            \
      float sq = rowsum16(u0 * u0 + u1 * u1 + u2 * u2 + u3 * u3);                          \
      float inv = rsqrtf(fmaxf(sq, 1e-24f));                                               \
      u0 *= inv; u1 *= inv; u2 *= inv; u3 *= inv;                                          \
      const int o_ = ss * 64 + c4 * 4;                                                     \
      *(float4*)(sb_ + 0 * 1024 + o_) = make_float4(__expf(w0), __expf(w1), __expf(w2), __expf(w3)); \
      *(float4*)(sb_ + 1 * 1024 + o_) = make_float4(k0 * (1.f + (a0 - 1.f) * kaw.x), k1 * (1.f + (a1 - 1.f) * kaw.y), k2 * (1.f + (a2 - 1.f) * kaw.z), k3 * (1.f + (a3 - 1.f) * kaw.w)); \
      *(float4*)(sb_ + 2 * 1024 + o_) = make_float4(-u0, -u1, -u2, -u3);                   \
      *(float4*)(sb_ + 3 * 1024 + o_) = make_float4(u0 * a0, u1 * a1, u2 * a2, u3 * a3);   \
      *(float4*)(sb_ + 4 * 1024 + o_) = make_float4(r0, r1, r2, r3);                       \
      if (c4 < 8) *(float4*)(sb_ + 5 * 1024 + ss * 32 + c4 * 4) = make_float4(lo_bf(gv_.x), hi_bf(gv_.x), lo_bf(gv_.y), hi_bf(gv_.y)); \
    }
    __syncthreads();
    SC_ISSUE(0);
    SC_STAGE(0);
    __syncthreads();
    constexpr int NCH = TK / 16;
    float* po_wa = pobuf + rl * POP + cg;
    float* po_wb = pobuf + (rl + 16) * POP + cg;
    const float* po_r = pobuf + (rl + 16 * (cg >> 3)) * POP + (cg & 7) * 16;
    for (int chunk = 0; chunk < NCH; chunk++) {
      const int buf = chunk & 1;
      if (chunk + 1 < NCH) SC_ISSUE(chunk + 1);
      __builtin_amdgcn_sched_barrier(0);
      const float* sb = sbuf + buf * BUFF + cg * 4;
      const float* sv = sbuf + buf * BUFF + 5 * 1024 + rl;
      float4 w4 = *(const float4*)(sb + 0 * 1024), k4 = *(const float4*)(sb + 1 * 1024), n4 = *(const float4*)(sb + 2 * 1024);
      float4 b4 = *(const float4*)(sb + 3 * 1024), r4 = *(const float4*)(sb + 4 * 1024);
      float va = sv[0], vb = sv[16];
#pragma unroll
      for (int s = 0; s < 16; s++) {
        float4 w4n = w4, k4n = k4, n4n = n4, b4n = b4, r4n = r4;
        float van = va, vbn = vb;
        if (s + 1 < 16) {
          w4n = *(const float4*)(sb + 0 * 1024 + (s + 1) * 64); k4n = *(const float4*)(sb + 1 * 1024 + (s + 1) * 64);
          n4n = *(const float4*)(sb + 2 * 1024 + (s + 1) * 64); b4n = *(const float4*)(sb + 3 * 1024 + (s + 1) * 64);
          r4n = *(const float4*)(sb + 4 * 1024 + (s + 1) * 64); van = sv[(s + 1) * 32]; vbn = sv[(s + 1) * 32 + 16];
        }
        const fv2 w01 = {w4.x, w4.y}, w23 = {w4.z, w4.w}, k01 = {k4.x, k4.y}, k23 = {k4.z, k4.w}, n01 = {n4.x, n4.y}, n23 = {n4.z, n4.w};
        const fv2 b01 = {b4.x, b4.y}, b23 = {b4.z, b4.w}, r01 = {r4.x, r4.y}, r23 = {r4.z, r4.w};
        const fv2 va2 = {va, va}, vb2 = {vb, vb};
        const fv2 vka01 = va2 * k01, vka23 = va2 * k23, vkb01 = vb2 * k01, vkb23 = vb2 * k23;
        fv2 ppa = SA01 * n01, ppb = SB01 * n01;
        ppa = __builtin_elementwise_fma(SA23, n23, ppa);
        ppb = __builtin_elementwise_fma(SB23, n23, ppb);
        float saa = ppa.x + ppa.y, sab = ppb.x + ppb.y;
        saa = ror_add<8>(saa); sab = ror_add<8>(sab);
        saa = ror_add<4>(saa); sab = ror_add<4>(sab);
        saa = ror_add<2>(saa); sab = ror_add<2>(sab);
        saa = ror_add<1>(saa); sab = ror_add<1>(sab);
        const fv2 saa2 = {saa, saa}, sab2 = {sab, sab};
        const fv2 ta01 = __builtin_elementwise_fma(saa2, b01, vka01), ta23 = __builtin_elementwise_fma(saa2, b23, vka23);
        const fv2 tb01 = __builtin_elementwise_fma(sab2, b01, vkb01), tb23 = __builtin_elementwise_fma(sab2, b23, vkb23);
        SA01 = __builtin_elementwise_fma(SA01, w01, ta01);
        SA23 = __builtin_elementwise_fma(SA23, w23, ta23);
        SB01 = __builtin_elementwise_fma(SB01, w01, tb01);
        SB23 = __builtin_elementwise_fma(SB23, w23, tb23);
        fv2 qa = SA01 * r01, qb = SB01 * r01;
        qa = __builtin_elementwise_fma(SA23, r23, qa);
        qb = __builtin_elementwise_fma(SB23, r23, qb);
        po_wa[(s & 7) * 16] = qa.x + qa.y;
        po_wb[(s & 7) * 16] = qb.x + qb.y;
        w4 = w4n; k4 = k4n; n4 = n4n; b4 = b4n; r4 = r4n; va = van; vb = vbn;
        __builtin_amdgcn_sched_barrier(0);
        if ((s & 7) == 7) {
          const float4 p0 = *(const float4*)(po_r), p1 = *(const float4*)(po_r + 4), p2 = *(const float4*)(po_r + 8), p3 = *(const float4*)(po_r + 12);
          const float ov = ((p0.x + p0.y) + (p0.z + p0.w)) + ((p1.x + p1.y) + (p1.z + p1.w)) + ((p2.x + p2.y) + (p2.z + p2.w)) + ((p3.x + p3.y) + (p3.z + p3.w));
          const size_t ro = (size_t)scan_row(bl, dir, chunk * 16 + (s & 8) + (cg & 7)) * 1024;
          O[ro + head * 64 + q2 * 32 + rl + 16 * (cg >> 3)] = f2bf(ov);
          __builtin_amdgcn_sched_barrier(0);
        }
      }
      if (chunk + 1 < NCH) SC_STAGE(buf ^ 1);
      __syncthreads();
    }
  }
}

DI void phase_combine(const P& p, int layer) {
  const int tidx = opaque_tid();
  const int j = layer / 2;
  const bf16_t* Of = (const bf16_t*)(p.ws + OFF_TR + TR_HX);
  const bf16_t* Ob = Of + (size_t)HROWS * 1024;
  const bf16_t* R = (const bf16_t*)(p.ws + OFF_TR + TR_R);
  const bf16_t* Kx = (const bf16_t*)(p.ws + OFF_TR + TR_K);
  const bf16_t* V = (const bf16_t*)(p.ws + OFF_TR + TR_V);
  const bf16_t* Aa = (const bf16_t*)(p.ws + OFF_TR + TR_A);
  bf16_t* G0 = (bf16_t*)(p.ws + OFF_TR + TR_G0);
  const bf16_t* G1 = (const bf16_t*)(p.ws + OFF_TR + TR_G1);
  const size_t total = (size_t)HROWS * 128;
  for (size_t i = (size_t)blockIdx.x * 256 + tidx; i < total; i += (size_t)gridDim.x * 256) {
    const int c0 = (int)(i & 127) * 8;
    const size_t off = (i >> 7) * 1024 + c0;
    const uint4 uof = *(const uint4*)(Of + off), uob = *(const uint4*)(Ob + off), ur = *(const uint4*)(R + off), uk = *(const uint4*)(Kx + off);
    const uint4 ua = *(const uint4*)(Aa + off), uv = *(const uint4*)(V + off), ug0 = *(const uint4*)(G0 + off), ug1 = *(const uint4*)(G1 + off);
    const unsigned aof[4] = {uof.x, uof.y, uof.z, uof.w}, aob[4] = {uob.x, uob.y, uob.z, uob.w}, ar[4] = {ur.x, ur.y, ur.z, ur.w}, ak[4] = {uk.x, uk.y, uk.z, uk.w};
    const unsigned aa[4] = {ua.x, ua.y, ua.z, ua.w}, av[4] = {uv.x, uv.y, uv.z, uv.w}, ag0[4] = {ug0.x, ug0.y, ug0.z, ug0.w}, ag1[4] = {ug1.x, ug1.y, ug1.z, ug1.w};
    const float* ka = p.rw_ka + (size_t)j * 1024 + c0;
    const float* rk = p.rw_rk + (size_t)j * 1024 + c0;
    const float* lg = p.rw_ln_g + (size_t)j * 1024 + c0;
    const float* lb = p.rw_ln_b + (size_t)j * 1024 + c0;
    float of[8], obv[8];
    float sf = 0.f, sf2 = 0.f, sb = 0.f, sb2 = 0.f, br = 0.f;
#pragma unroll
    for (int e = 0; e < 8; e++) {
      const int w = e >> 1;
      of[e] = (e & 1) ? hi_bf(aof[w]) : lo_bf(aof[w]);
      obv[e] = (e & 1) ? hi_bf(aob[w]) : lo_bf(aob[w]);
      const float r = (e & 1) ? hi_bf(ar[w]) : lo_bf(ar[w]);
      const float k = (e & 1) ? hi_bf(ak[w]) : lo_bf(ak[w]);
      const float a = (e & 1) ? hi_bf(aa[w]) : lo_bf(aa[w]);
      sf += of[e]; sf2 += of[e] * of[e]; sb += obv[e]; sb2 += obv[e] * obv[e];
      br += r * k * (1.f + (a - 1.f) * ka[e]) * rk[e];
    }
#pragma unroll
    for (int o = 1; o < 8; o <<= 1) { sf += __shfl_xor(sf, o); sf2 += __shfl_xor(sf2, o); sb += __shfl_xor(sb, o); sb2 += __shfl_xor(sb2, o); br += __shfl_xor(br, o); }
    const float muf = sf * (1.f / 64.f), mub = sb * (1.f / 64.f);
    const float rsf = rsqrtf(fmaxf(sf2 * (1.f / 64.f) - muf * muf, 0.f) + 64e-5f);
    const float rsb = rsqrtf(fmaxf(sb2 * (1.f / 64.f) - mub * mub, 0.f) + 64e-5f);
    float y[8];
#pragma unroll
    for (int e = 0; e < 8; e++) {
      const int w = e >> 1;
      const float v = (e & 1) ? hi_bf(av[w]) : lo_bf(av[w]);
      const float g0 = (e & 1) ? hi_bf(ag0[w]) : lo_bf(ag0[w]);
      const float g1 = (e & 1) ? hi_bf(ag1[w]) : lo_bf(ag1[w]);
      const float bonus = br * v;
      y[e] = ((of[e] - muf) * rsf * lg[e] + lb[e] + bonus) * g0 + ((obv[e] - mub) * rsb * lg[e] + lb[e] + bonus) * g1;
    }
    *(uint4*)(G0 + off) = make_uint4(pack2(y[0], y[1]), pack2(y[2], y[3]), pack2(y[4], y[5]), pack2(y[6], y[7]));
  }
}

DI void phase_rw_out(const P& p, int layer, int hf, char* smem) {
  const int tidx = opaque_tid();
  const bf16_t* Y = (const bf16_t*)(p.ws + OFF_TR + TR_G0);
  const bf16_t* WO = (const bf16_t*)(p.ws + OFF_W) + W_WO;
  const int nlt = (layer == 3) ? 128 : 136;
  for (int t = blockIdx.x; t < xcd_rounds(nlt, 8) * (int)gridDim.x; t += gridDim.x) {
    int lt, nt_;
    if (!xcd_tile(t, nlt, 8, lt, nt_)) continue;
    const int n0 = nt_ * 128;
    const int gt = half_gtile(hf, lt);
    f32x16 acc[2][2];
    gemm_mainloop(Y + (size_t)lt * 128 * 1024, 1024, WO + (size_t)n0 * 1024, 1024, 1024, smem, acc);
    const float* gate = mods_ptr(p, layer, mod_row(gt * 128)) + 2048 + n0;
    float* xr = resid_row(p, gt * 128) + n0;
    EPI8_BEGIN
      resid_update(xr + (size_t)row * D + col, gate + col, v);
    EPI8_END
  }
}

DI void phase_mlp1(const P& p, int layer, char* smem) {
  const int tidx = opaque_tid();
  const bf16_t* H2 = (const bf16_t*)(p.ws + OFF_TR + TR_H2);
  const bf16_t* W1 = (const bf16_t*)(p.ws + OFF_W) + W_M1;
  bf16_t* HID = (bf16_t*)(p.ws + OFF_TR + TR_HID);
  const int nmt = (layer == 3) ? 256 : 272;
  const int ngrp = nmt / 16;
  (void)ngrp;
  for (int t = blockIdx.x; t < xcd_rounds(nmt, 32) * (int)gridDim.x; t += gridDim.x) {
    int gt, nt;
    if (!xcd_tile(t, nmt, 32, gt, nt)) continue;
    f32x16 acc[2][2];
    gemm_mainloop(H2 + (size_t)gt * 128 * 1024, 1024, W1 + (size_t)nt * 128 * 1024, 1024, 1024, smem, acc);
    EPI8_BEGIN
#pragma unroll
      for (int e = 0; e < 8; e++) { const float rl = fmaxf(v[e], 0.f); v[e] = rl * rl; }
      *(uint4*)(HID + (size_t)(gt * 128 + row) * 4096 + nt * 128 + col) = pack8(v);
    EPI8_END
  }
}
DI void phase_mlp2(const P& p, int layer, char* smem) {
  const int tidx = opaque_tid();
  const bf16_t* HID = (const bf16_t*)(p.ws + OFF_TR + TR_HID);
  const bf16_t* W2 = (const bf16_t*)(p.ws + OFF_W) + W_M2;
  const int nmt = (layer == 3) ? 256 : 272;
  for (int t = blockIdx.x; t < xcd_rounds(nmt, 8) * (int)gridDim.x; t += gridDim.x) {
    int gt, nt_;
    if (!xcd_tile(t, nmt, 8, gt, nt_)) continue;
    const int n0 = nt_ * 128;
    f32x16 acc[2][2];
    gemm_mainloop(HID + (size_t)gt * 128 * 4096, 4096, W2 + (size_t)n0 * 4096, 4096, 4096, smem, acc);
    const float* gate = mods_ptr(p, layer, mod_row(gt * 128)) + 5120 + n0;
    float* xr = resid_row(p, gt * 128) + n0;
    EPI8_BEGIN
      resid_update(xr + (size_t)row * D + col, gate + col, v);
    EPI8_END
  }
}

DI void phase_qkv(const P& p, int layer, char* smem) {
  const int tidx = opaque_tid();
  const bf16_t* H = (const bf16_t*)(p.ws + OFF_TR + TR_H);
  const bf16_t* WQ = (const bf16_t*)(p.ws + OFF_W) + W_QKV;
  bf16_t* Q = (bf16_t*)(p.ws + OFF_TR + TR_Q);
  bf16_t* Kb = (bf16_t*)(p.ws + OFF_TR + TR_KK);
  bf16_t* VT = (bf16_t*)(p.ws + OFF_TR + TR_VT);
  const float* cosT = (const float*)(p.ws + OFF_MISC);
  const float* sinT = cosT + 1024;
  for (int t = blockIdx.x; t < xcd_rounds(272, 24) * (int)gridDim.x; t += gridDim.x) {
    int gt, nt;
    if (!xcd_tile(t, 272, 24, gt, nt)) continue;
    f32x16 acc[2][2];
    gemm_mainloop(H + (size_t)gt * 128 * 1024, 1024, WQ + (size_t)nt * 128 * 1024, 1024, 1024, smem, acc);
    const bool lat = gt < 256;
    const int b = lat ? gt / 32 : (gt - 256) / 2;
    const int t0 = lat ? (gt % 32) * 128 : (gt - 256) % 2 * 128;
    const int tq0 = lat ? t0 : SL + t0;
    const int typ = nt / 8, h = nt % 8;
    if (typ < 2) {
      bf16_t* dst = typ == 0 ? Q : Kb;
      const float qs = typ == 0 ? 0.125f * 1.44269504088896f : 1.f;
      float kmx = 0.f;
      EPI8_BEGIN
        const int sidx = col >> 6, d0 = col & 63;
        if (lat) {
          const float4 pa = *(const float4*)(es + row * EST + (col ^ 16));
          const float4 pb = *(const float4*)(es + row * EST + (col ^ 16) + 4);
          const float pr[8] = {pa.x, pa.y, pa.z, pa.w, pb.x, pb.y, pb.z, pb.w};
          const int tt = t0 + row;
          const int pos = (d0 < 32) ? (tt >> 6) : (tt & 63);
          const float4 ca = *(const float4*)(cosT + pos * 16 + (d0 & 8)), cb = *(const float4*)(cosT + pos * 16 + (d0 & 8) + 4);
          const float4 sa = *(const float4*)(sinT + pos * 16 + (d0 & 8)), sb = *(const float4*)(sinT + pos * 16 + (d0 & 8) + 4);
          const float cs[8] = {ca.x, ca.y, ca.z, ca.w, cb.x, cb.y, cb.z, cb.w};
          const float sn[8] = {sa.x, sa.y, sa.z, sa.w, sb.x, sb.y, sb.z, sb.w};
          const float sgn = (d0 & 16) ? 1.f : -1.f;
#pragma unroll
          for (int e = 0; e < 8; e++) v[e] = v[e] * cs[e] + sgn * pr[e] * sn[e];
        }
#pragma unroll
        for (int e = 0; e < 8; e++) v[e] *= qs;
        const uint4 pk_ = pack8(v);
        *(uint4*)(dst + ((size_t)((b * 8 + h) * 2 + sidx) * TK + tq0 + row) * 64 + d0) = pk_;
        if (typ == 1) {
          float rv_[8];
          unpack8(pk_, rv_);
          float ssq_ = 0.f;
#pragma unroll
          for (int e = 0; e < 8; e++) ssq_ += rv_[e] * rv_[e];
          ssq_ += __shfl_xor(ssq_, 1); ssq_ += __shfl_xor(ssq_, 2); ssq_ += __shfl_xor(ssq_, 4);
          kmx = fmaxf(kmx, ssq_);
        }
      EPI8_END
      if (typ == 1) {
        kmx = fmaxf(kmx, __shfl_xor(kmx, 16));
        kmx = fmaxf(kmx, __shfl_xor(kmx, 32));
        if ((tidx & 55) == 0)
          atomicMax((unsigned*)(p.ws + OFF_MISC) + 4096 + (layer >> 1) * 128 + (b * 8 + h) * 2 + ((tidx >> 3) & 1), __float_as_uint(kmx));
      }
    } else {
      float* es = (float*)smem;
      acc_to_lds(acc, es);
      __syncthreads();
      for (int pass = 0; pass < 8; pass++) {
        const int d = tidx & 127, tg = pass * 2 + (tidx >> 7);
        float v[8];
#pragma unroll
        for (int e = 0; e < 8; e++) v[e] = es[(tg * 8 + e) * EST + d];
        *(uint4*)(VT + ((size_t)(b * 8 + h) * 128 + d) * TK + tq0 + tg * 8) = pack8(v);
      }
      __syncthreads();
    }
  }
}

typedef _Float16 hv2 __attribute__((ext_vector_type(2)));
DI unsigned packh2(float a, float b) { hv2 r = {(_Float16)a, (_Float16)b}; return __builtin_bit_cast(unsigned, r); }
DI float lo_h(unsigned u) { hv2 r = __builtin_bit_cast(hv2, u); return (float)r[0]; }
DI float hi_h(unsigned u) { hv2 r = __builtin_bit_cast(hv2, u); return (float)r[1]; }

DI void phase_attn(const P& p, int layer, char* smem) {
  const int tidx = opaque_tid();
  const int j = layer / 2;
  const bool ctxq = layer != 3;
  const bf16_t* Q = (const bf16_t*)(p.ws + OFF_TR + TR_Q);
  const bf16_t* Kb = (const bf16_t*)(p.ws + OFF_TR + TR_KK);
  const bf16_t* VT = (const bf16_t*)(p.ws + OFF_TR + TR_VT);
  bf16_t* O = (bf16_t*)(p.ws + OFF_TR + TR_H);
  const float lam = ((const float*)(p.ws + OFF_MISC))[2048 + j];
  const float* kmax2 = (const float*)(p.ws + OFF_MISC) + 4096 + j * 128;
  const float oml = 1.f - lambda_init(layer);
  const float* subg = p.da_subln_g + (size_t)j * 128;
  constexpr int LDV = 68;
  bf16_t* sK = (bf16_t*)smem;
  bf16_t* sV = sK + 2 * 64 * LDT;
  const int tid = tidx, lane = tid & 63, w = tid >> 6, g = lane >> 5, l31 = lane & 31;
  const int nitems = 2048 + (ctxq ? 128 : 0);
  const int spx = gridDim.x >> 3, gpr = spx >> 5;
  const int lat_rounds = 64 / (8 * gpr);
  for (int it0 = blockIdx.x; it0 < lat_rounds * (int)gridDim.x + (ctxq ? 128 : 0); it0 += gridDim.x) {
    int item;
    if (it0 < lat_rounds * (int)gridDim.x) {
      const int r = it0 % (int)gridDim.x, round = it0 / (int)gridDim.x;
      const int xcd = r & 7, li = r >> 3;
      const int bh = (round * 8 + xcd) * gpr + (li >> 5);
      item = bh * 32 + (li & 31);
    } else {
      item = 2048 + (it0 - lat_rounds * (int)gridDim.x);
    }
    (void)nitems;
    int b, h, q0, kbeg, ntiles;
    if (item < 2048) { b = item >> 8; h = (item >> 5) & 7; q0 = (item & 31) * 128; kbeg = 0; ntiles = TK / 64; }
    else { const int it = item - 2048; b = it >> 4; h = (it >> 1) & 7; q0 = SL + (it & 1) * 128; kbeg = SL; ntiles = CL / 64; }
    const bf16_t* Vp0 = VT + (size_t)(b * 8 + h) * 128 * TK;
    const int tq = q0 + w * 32 + l31;
    const size_t grow = tq < SL ? (size_t)b * SL + tq : (size_t)NLAT + (size_t)b * CL + (tq - SL);
    bf16_t* op = O + grow * 1024 + h * 128;
    for (int s = 0; s < 2; s++) {
      const bf16_t* Kp0 = Kb + (size_t)((b * 8 + h) * 2 + s) * TK * 64;
      const bf16_t* Qp = Q + ((size_t)((b * 8 + h) * 2 + s) * TK + tq) * 64 + g * 8;
      bf16x8 qf[4];
      float qss = 0.f;
#pragma unroll
      for (int kk = 0; kk < 4; kk++) {
        const uint4 u = *(const uint4*)(Qp + kk * 16);
        qf[kk] = __builtin_bit_cast(bf16x8, u);
        float qv[8];
        unpack8(u, qv);
#pragma unroll
        for (int e = 0; e < 8; e++) qss += qv[e] * qv[e];
      }
      qss += __shfl_xor(qss, 32);
      const float nmq = -sqrtf(qss * kmax2[(b * 8 + h) * 2 + s]);
      f32x16 o[4];
#pragma unroll
      for (int db = 0; db < 4; db++)
#pragma unroll
        for (int r = 0; r < 16; r++) o[db][r] = 0.f;
      float l = 0.f;
      uint4 rk0, rk1, rv0, rv1, rv2, rv3;
      const unsigned kvo = (unsigned)((tid >> 3) * 64 + (tid & 7) * 8);
      const unsigned vvo = (unsigned)((tid >> 3) * TK + (tid & 7) * 8);
      const unsigned sko = (unsigned)((tid >> 3) * LDT + (tid & 7) * 8);
      const unsigned svo = (unsigned)((tid >> 3) * LDV + (tid & 7) * 8);
#define ISSUE_KV(kt_)                                                             \
      {                                                                           \
        const bf16_t* kb_ = Kp0 + (size_t)(kbeg + (kt_) * 64) * 64;               \
        const bf16_t* vb_ = Vp0 + (kbeg + (kt_) * 64);                            \
        rk0 = *(const uint4*)(kb_ + kvo);                                         \
        rk1 = *(const uint4*)(kb_ + (kvo + 32u * 64u));                           \
        rv0 = *(const uint4*)(vb_ + vvo);                                         \
        rv1 = *(const uint4*)(vb_ + (vvo + 32u * (unsigned)TK));                  \
        rv2 = *(const uint4*)(vb_ + (vvo + 64u * (unsigned)TK));                  \
        rv3 = *(const uint4*)(vb_ + (vvo + 96u * (unsigned)TK));                  \
      }
#define ST_V(ptr_, r_) { *(uint2*)(ptr_) = make_uint2(r_.x, r_.y); *(uint2*)((ptr_) + 4) = make_uint2(r_.z, r_.w); }
#define STAGE_KV(buf_)                                                            \
      {                                                                           \
        bf16_t* ks_ = sK + (buf_) * 64 * LDT + sko;                               \
        bf16_t* vs_ = sV + (buf_) * 128 * LDV + svo;                              \
        *(uint4*)(ks_) = rk0;                                                     \
        *(uint4*)(ks_ + 32 * LDT) = rk1;                                          \
        ST_V(vs_, rv0); ST_V(vs_ + 32 * LDV, rv1); ST_V(vs_ + 64 * LDV, rv2); ST_V(vs_ + 96 * LDV, rv3); \
      }
      __syncthreads();
      ISSUE_KV(0);
      STAGE_KV(0);
      __syncthreads();
      for (int kt = 0; kt < ntiles; kt++) {
        const int buf = kt & 1;
        const bool more = kt + 1 < ntiles;
        if (more) ISSUE_KV(kt + 1);
        __builtin_amdgcn_sched_barrier(0);
        const bf16_t* kS = sK + buf * 64 * LDT;
        const bf16_t* vS = sV + buf * 128 * LDV;
#pragma unroll
        for (int kb = 0; kb < 2; kb++) {
          bf16x8 kf[4];
#pragma unroll
          for (int kk = 0; kk < 4; kk++) kf[kk] = *(const bf16x8*)(kS + (kb * 32 + l31) * LDT + kk * 16 + g * 8);
          __builtin_amdgcn_sched_barrier(0);
          f32x16 st;
#pragma unroll
          for (int r = 0; r < 16; r++) st[r] = nmq;
#pragma unroll
          for (int kk = 0; kk < 4; kk++) st = MFMA32(kf[kk], qf[kk], st);
          float ls = 0.f;
          bf16x8 pk[2];
#pragma unroll
          for (int hh = 0; hh < 2; hh++) {
            float e[8];
#pragma unroll
            for (int i = 0; i < 8; i++) { e[i] = __builtin_amdgcn_exp2f(st[hh * 8 + i]); ls += e[i]; }
            const uint4 u = make_uint4(pack2(e[0], e[1]), pack2(e[2], e[3]), pack2(e[4], e[5]), pack2(e[6], e[7]));
            pk[hh] = __builtin_bit_cast(bf16x8, u);
          }
          l += ls;
#pragma unroll
          for (int hh = 0; hh < 2; hh++) {
            uint4 vf[4];
#pragma unroll
            for (int db = 0; db < 4; db++) {
              const bf16_t* vp = vS + (db * 32 + l31) * LDV + kb * 32 + hh * 16 + 4 * g;
              const uint2 lo = *(const uint2*)vp;
              const uint2 hi = *(const uint2*)(vp + 8);
              vf[db] = make_uint4(lo.x, lo.y, hi.x, hi.y);
            }
            __builtin_amdgcn_sched_barrier(0);
#pragma unroll
            for (int db = 0; db < 4; db++) o[db] = MFMA32(__builtin_bit_cast(bf16x8, vf[db]), pk[hh], o[db]);
          }
        }
        __builtin_amdgcn_sched_barrier(0);
        if (more) STAGE_KV(buf ^ 1);
        __syncthreads();
      }
      const float lt = l + __shfl_xor(l, 32);
      if (s == 0) {
        const float inv = 1.f / lt;
#pragma unroll
        for (int db = 0; db < 4; db++)
#pragma unroll
          for (int rq = 0; rq < 4; rq++) {
            const int d = db * 32 + 8 * rq + 4 * g;
            *(uint2*)(op + d) = make_uint2(packh2(o[db][4 * rq] * inv, o[db][4 * rq + 1] * inv), packh2(o[db][4 * rq + 2] * inv, o[db][4 * rq + 3] * inv));
          }
      } else {
        const float inv = lam / lt;
        float ssq = 0.f;
#pragma unroll
        for (int db = 0; db < 4; db++)
#pragma unroll
          for (int rq = 0; rq < 4; rq++) {
            const int d = db * 32 + 8 * rq + 4 * g;
            const uint2 u0 = *(const uint2*)(op + d);
            const float a0 = lo_h(u0.x) - o[db][4 * rq] * inv, a1 = hi_h(u0.x) - o[db][4 * rq + 1] * inv;
            const float a2 = lo_h(u0.y) - o[db][4 * rq + 2] * inv, a3 = hi_h(u0.y) - o[db][4 * rq + 3] * inv;
            o[db][4 * rq] = a0; o[db][4 * rq + 1] = a1; o[db][4 * rq + 2] = a2; o[db][4 * rq + 3] = a3;
            ssq += a0 * a0 + a1 * a1 + a2 * a2 + a3 * a3;
          }
        ssq += __shfl_xor(ssq, 32);
        const float rs = rsqrtf(ssq * (1.f / 128.f) + 1e-5f) * oml;
#pragma unroll
        for (int db = 0; db < 4; db++)
#pragma unroll
          for (int rq = 0; rq < 4; rq++) {
            const int d = db * 32 + 8 * rq + 4 * g;
            const float4 sg = *(const float4*)(subg + d);
            *(uint2*)(op + d) = make_uint2(pack2(o[db][4 * rq] * rs * sg.x, o[db][4 * rq + 1] * rs * sg.y),
                                           pack2(o[db][4 * rq + 2] * rs * sg.z, o[db][4 * rq + 3] * rs * sg.w));
          }
      }
    }
  }
}

DI void phase_at_out(const P& p, int layer, char* smem) {
  const int tidx = opaque_tid();
  const bf16_t* O = (const bf16_t*)(p.ws + OFF_TR + TR_H);
  const bf16_t* WO = (const bf16_t*)(p.ws + OFF_W) + W_WO;
  const int nmt = (layer == 3) ? 256 : 272;
  for (int t = blockIdx.x; t < xcd_rounds(nmt, 8) * (int)gridDim.x; t += gridDim.x) {
    int gt, nt_;
    if (!xcd_tile(t, nmt, 8, gt, nt_)) continue;
    const int n0 = nt_ * 128;
    f32x16 acc[2][2];
    gemm_mainloop(O + (size_t)gt * 128 * 1024, 1024, WO + (size_t)n0 * 1024, 1024, 1024, smem, acc);
    const float* gate = mods_ptr(p, layer, mod_row(gt * 128)) + 2048 + n0;
    float* xr = resid_row(p, gt * 128) + n0;
    EPI8_BEGIN
      resid_update(xr + (size_t)row * D + col, gate + col, v);
    EPI8_END
  }
}

DI void phase_final(const P& p) {
  const int tidx = opaque_tid();
  const int lane = tidx & 63, wv = tidx >> 6;
  for (int row = blockIdx.x * 4 + wv; row < NLAT; row += gridDim.x * 4) {
    float* xr = p.out + (size_t)row * D;
    float4 v[4];
    float ss = 0.f;
#pragma unroll
    for (int jx = 0; jx < 4; jx++) { v[jx] = *(const float4*)(xr + jx * 256 + lane * 4); ss += v[jx].x * v[jx].x + v[jx].y * v[jx].y + v[jx].z * v[jx].z + v[jx].w * v[jx].w; }
    ss = wave_sum(ss);
    const float rs = rsqrtf(ss * (1.f / 1024.f) + 1e-6f);
#pragma unroll
    for (int jx = 0; jx < 4; jx++) {
      const float4 g = *(const float4*)(p.final_g + jx * 256 + lane * 4);
      *(float4*)(xr + jx * 256 + lane * 4) = make_float4(v[jx].x * rs * g.x, v[jx].y * rs * g.y, v[jx].z * rs * g.z, v[jx].w * rs * g.w);
    }
  }
}

#define XB_TMO      128
#define XB_XCNT(j)  (256  + 64 * (j))
#define XB_XSUB(j)  (1280 + 64 * (j))
#define XB_XGEN(j)  (2304 + 64 * (j))
#define XB_TOP      3328
#define XB_TOPGEN   3392
#define XCD_BAR_WORDS 3456
#define XB_SPIN_CAP (1u << 22)
#define LAS __attribute__((address_space(3)))
DI unsigned xb_ld(unsigned* p) { return __hip_atomic_load(p, __ATOMIC_RELAXED, __HIP_MEMORY_SCOPE_AGENT); }
DI unsigned xb_add(unsigned* p, unsigned v) { return __hip_atomic_fetch_add(p, v, __ATOMIC_RELAXED, __HIP_MEMORY_SCOPE_AGENT); }
DI unsigned xb_xcc_id() { return (unsigned)__builtin_amdgcn_s_getreg((3 << 11) | 20) & 0xFu; }
#define XB_SPIN(cond, bar) do { unsigned _sp = 0; while (cond) { __builtin_amdgcn_s_sleep(1); \
    if ((++_sp & 255u) == 0u) { if (xb_ld(&(bar)[XB_TMO])) break; if (_sp > XB_SPIN_CAP) { atomicAdd(&(bar)[XB_TMO], 1u); break; } } } } while (0)
struct XcdBarrier { unsigned* bar; unsigned x; volatile LAS unsigned* st; };
DI XcdBarrier xcd_barrier_post(unsigned* bar, volatile LAS unsigned* st) {
  XcdBarrier b; b.bar = bar; b.x = xb_xcc_id(); b.st = st;
  if (threadIdx.x == 0) (void)xb_add(&bar[XB_XCNT(b.x)], 1u);
  return b;
}
DI void xcd_barrier_complete(unsigned* bar, unsigned x, unsigned& nloc, unsigned& nx) {
  const unsigned G = gridDim.x * gridDim.y * gridDim.z;
  unsigned sum, cnt, mine, sp = 0u;
  for (;;) {
    sum = 0u; cnt = 0u; mine = 0u;
#pragma unroll
    for (unsigned j = 0; j < 16; ++j) { const unsigned c = xb_ld(&bar[XB_XCNT(j)]); sum += c; cnt += (c > 0u) ? 1u : 0u; mine = (j == x) ? c : mine; }
    if (sum == G) break;
    __builtin_amdgcn_s_sleep(1);
    if ((++sp & 255u) == 0u) { if (xb_ld(&bar[XB_TMO])) break; if (sp > XB_SPIN_CAP) { atomicAdd(&bar[XB_TMO], 1u); break; } }
  }
  nloc = mine > 0u ? mine : 1u; nx = cnt > 0u ? cnt : 1u;
}
DI void xcd_barrier(const XcdBarrier& b) {
  asm volatile("s_waitcnt vmcnt(0)" ::: "memory");
  __syncthreads();
  if (threadIdx.x == 0) {
    unsigned* bar = b.bar;
    __builtin_amdgcn_s_waitcnt(0);
    unsigned nloc = b.st[0], nx = b.st[1];
    if (nloc == 0u) { xcd_barrier_complete(bar, b.x, nloc, nx); b.st[0] = nloc; b.st[1] = nx; }
    const unsigned old = xb_add(&bar[XB_XSUB(b.x)], 1u);
    const unsigned gen = old / nloc;
    if (old + 1u == (gen + 1u) * nloc) {
      __builtin_amdgcn_fence(__ATOMIC_RELEASE, "agent");
      asm volatile("s_waitcnt vmcnt(0)" ::: "memory");
      const unsigned og = xb_add(&bar[XB_TOP], 1u);
      const unsigned tg = og / nx;
      if (og + 1u == (tg + 1u) * nx) xb_add(&bar[XB_TOPGEN], 1u);
      else XB_SPIN(xb_ld(&bar[XB_TOPGEN]) == tg, bar);
      __builtin_amdgcn_fence(__ATOMIC_ACQUIRE, "agent");
      xb_add(&bar[XB_XGEN(b.x)], 1u);
      asm volatile("s_waitcnt vmcnt(0)" ::: "memory");
    } else {
      XB_SPIN(xb_ld(&bar[XB_XGEN(b.x)]) == gen, bar);
      __builtin_amdgcn_fence(__ATOMIC_ACQUIRE, "agent");
      asm volatile("s_waitcnt vmcnt(0)" ::: "memory");
    }
  }
  __syncthreads();
}
constexpr size_t OFF_BAR = OFF_MISC + 65536;

typedef __attribute__((address_space(1))) const float GCF;
typedef __attribute__((address_space(1))) float GF;
typedef __attribute__((address_space(1))) char GC;
DI unsigned long long lds_word(const unsigned long long* tbl, int i) {
  int z = i;
  asm volatile("" : "+v"(z));
  const unsigned long long v = tbl[z];
  const unsigned lo = __builtin_amdgcn_readfirstlane((unsigned)v), hi = __builtin_amdgcn_readfirstlane((unsigned)(v >> 32));
  return ((unsigned long long)hi << 32) | lo;
}
DI void load_params(P& q, const unsigned long long* tbl) {
  const float** fp = (const float**)&q;
#pragma unroll
  for (int i = 0; i < 36; i++) fp[i] = (const float*)(GCF*)lds_word(tbl, i);
  q.out = (float*)(GF*)lds_word(tbl, 36);
  q.ws = (char*)(GC*)lds_word(tbl, 37);
  q.only = 0;
  q.pad = 0;
}
__global__ void __launch_bounds__(256, 2) mega(P p) {
  __shared__ __attribute__((aligned(16))) char smem[73728];
  __shared__ unsigned long long s_tbl[40];
  {
#if defined(__HIP_DEVICE_COMPILE__)
    typedef __attribute__((address_space(4))) const unsigned long long KW;
    KW* kp = (KW*)__builtin_amdgcn_kernarg_segment_ptr();
    if (threadIdx.x < 39) s_tbl[threadIdx.x] = kp[threadIdx.x];
#endif
    __syncthreads();
  }
  const int only = (int)(unsigned)lds_word(s_tbl, 38);
  cg::grid_group grid = cg::this_grid();
  __shared__ uint4 xb_words;
  if (threadIdx.x == 0) xb_words = make_uint4(0u, 0u, 0u, 0u);
  __syncthreads();
  XcdBarrier xb;
  {
    P q;
    load_params(q, s_tbl);
    xb = xcd_barrier_post((unsigned*)(q.ws + OFF_BAR), (volatile LAS unsigned*)&xb_words);
  }
  int step = 0;
#define GSYNC() { if (step == 1) grid.sync(); else xcd_barrier(xb); }
#define STEP(body)                                   \
  {                                                  \
    if (only < 0 || only == step) {              \
      P q;                                           \
      load_params(q, s_tbl);                         \
      body;                                          \
    }                                                \
    step++;                                          \
    if (only < 0) GSYNC();                         \
  }
#ifndef DUP
#define DUP 0
#endif
#define STEPD(id, body)                              \
  {                                                  \
    if (only < 0 || only == step) {                  \
      P q;                                           \
      load_params(q, s_tbl);                         \
      body;                                          \
      if (DUP == id) { __syncthreads(); body; }      \
    }                                                \
    step++;                                          \
    if (only < 0) GSYNC();                           \
  }
  STEP(phase_init(q, smem));
  for (int layer = 0; layer < 4; layer++) {
    STEPD(1, phase_conv(q, layer, smem));
    if ((layer & 1) == 0) {
      for (int hf = 0; hf < 2; hf++) {
        STEP(phase_prep(q, layer, 0, hf, true, (bf16_t*)(q.ws + OFF_TR + TR_HX), 2048, false));
        STEPD(3, phase_t1(q, smem));
        STEPD(4, phase_feat(q, layer, hf, smem));
        STEPD(5, phase_scan(q, layer, smem));
        STEP(phase_combine(q, layer));
        STEP(phase_rw_out(q, layer, hf, smem));
      }
    } else {
      STEP(phase_prep(q, layer, 0, -1, false, (bf16_t*)(q.ws + OFF_TR + TR_H), 1024, false));
      STEPD(7, phase_qkv(q, layer, smem));
      STEPD(8, phase_attn(q, layer, smem));
      STEP(phase_at_out(q, layer, smem));
    }
    STEP(phase_prep(q, layer, 1, -1, false, (bf16_t*)(q.ws + OFF_TR + TR_H2), 1024, layer == 3));
    STEPD(9, phase_mlp1(q, layer, smem));
    STEP(phase_mlp2(q, layer, smem));
  }
  STEP(phase_final(q));
}

#ifndef MULTI_LAUNCH
#define MULTI_LAUNCH 0
#endif
constexpr int NSTEPS = 1 + 2 * (1 + 12 + 3) + 2 * (1 + 4 + 3) + 1;

extern "C" void kernel_launch(void* const* d_in, const int* in_sizes, int n_in, void* d_out, int out_size, void* d_ws, size_t ws_size,
                              hipStream_t stream) {
  static int grid_blocks = 0;
  if (!grid_blocks) {
    int dev = 0, cus = 0, per_cu = 0;
    hipGetDevice(&dev);
    hipDeviceGetAttribute(&cus, hipDeviceAttributeMultiprocessorCount, dev);
    hipOccupancyMaxActiveBlocksPerMultiprocessor(&per_cu, mega, 256, 0);
    if (per_cu < 1) per_cu = 1;
    if (per_cu > 2) per_cu = 2;
    grid_blocks = cus * per_cu;
  }
  P p{};
  const float** fp = (const float**)&p;
  for (int i = 0; i < 36; i++) fp[i] = (const float*)d_in[i];
  p.out = (float*)d_out;
  p.ws = (char*)d_ws;
  p.pad = 0;
#if MULTI_LAUNCH
  for (int s = 0; s < NSTEPS; s++) {
    p.only = s;
    void* args[] = {&p};
    hipError_t e = hipLaunchCooperativeKernel((void*)mega, dim3(grid_blocks), dim3(256), args, 0, stream);
    if (e != hipSuccess) { fprintf(stderr, "launch failed: %s\n", hipGetErrorString(e)); break; }
  }
#else
  p.only = -1;
  hipMemsetAsync((char*)d_ws + OFF_BAR, 0, XCD_BAR_WORDS * 4, stream);
  void* args[] = {&p};
  hipError_t e = hipLaunchCooperativeKernel((void*)mega, dim3(grid_blocks), dim3(256), args, 0, stream);
  if (e != hipSuccess) fprintf(stderr, "cooperative launch failed: %s (grid %d)\n", hipGetErrorString(e), grid_blocks);
#endif
}
```

```cpp
#include <hip/hip_runtime.h>
#include <hip/hip_cooperative_groups.h>
#include <cstdio>
namespace cg = cooperative_groups;

#define DI __device__ __forceinline__
typedef unsigned short bf16_t;
using bf16x8 = __attribute__((ext_vector_type(8))) short;
using f32x16 = __attribute__((ext_vector_type(16))) float;
typedef __bf16 bfv2 __attribute__((ext_vector_type(2)));
typedef float fv2 __attribute__((ext_vector_type(2)));
#define MFMA32(a, b, c) __builtin_amdgcn_mfma_f32_32x32x16_bf16((a), (b), (c), 0, 0, 0)

constexpr int D = 1024, NB = 8, SL = 4096, CL = 256;
constexpr int NLAT = NB * SL, NCTX = NB * CL, NTOK = NLAT + NCTX;
constexpr int HROWS = NTOK / 2;
constexpr int TK = SL + CL;
constexpr size_t MiB = 1048576;
constexpr size_t OFF_W2 = 476 * MiB;
constexpr size_t OFF_W = 0, OFF_XC = 36 * MiB, OFF_MODS = 44 * MiB, OFF_MISC = 45 * MiB, OFF_VF = 46 * MiB, OFF_TR = 114 * MiB;
constexpr size_t W_RKV = 0;
constexpr size_t W_L1 = W_RKV + 3072ull * 2048;
constexpr size_t W_W2 = W_L1 + 640ull * 2048;
constexpr size_t W_A2 = W_W2 + 2ull * 65536;
constexpr size_t W_G2 = W_A2 + 65536;
constexpr size_t W_V2 = W_G2 + 2ull * 196608;
constexpr size_t W_WO = W_V2 + 65536;
constexpr size_t W_M1 = W_WO + 1048576;
constexpr size_t W_M2 = W_M1 + 4194304;
constexpr size_t W_QKV = 0;
constexpr size_t HALF_ARR = (size_t)HROWS * 1024 * 2;
constexpr size_t TR_HX = 0;
constexpr size_t TR_T1 = 2 * HALF_ARR;
constexpr size_t TR_R = TR_T1 + (size_t)HROWS * 640 * 2;
constexpr size_t TR_K = TR_R + HALF_ARR, TR_V = TR_K + HALF_ARR, TR_A = TR_V + HALF_ARR;
constexpr size_t TR_WL0 = TR_A + HALF_ARR, TR_WL1 = TR_WL0 + HALF_ARR, TR_G0 = TR_WL1 + HALF_ARR, TR_G1 = TR_G0 + HALF_ARR;
constexpr size_t FULL_ARR = (size_t)NTOK * 1024 * 2;
constexpr size_t TR_H = 0, TR_Q = FULL_ARR, TR_KK = 2 * FULL_ARR, TR_VT = 3 * FULL_ARR;
constexpr size_t TR_H2 = 0, TR_HID = FULL_ARR;

struct P {
  const float *x, *c, *ctx, *c_ctx, *ada_w, *ada_b, *norm_g, *final_g;
  const float *rw_mix, *rw_w_rkv, *rw_w0, *rw_w1, *rw_w2, *rw_a0, *rw_a1, *rw_a2, *rw_g1, *rw_g2, *rw_kk, *rw_ka, *rw_rk, *rw_ln_g, *rw_ln_b, *rw_w_o, *rw_v0, *rw_v1, *rw_v2;
  const float *da_w_qkv, *da_w_o, *da_lq1, *da_lk1, *da_lq2, *da_lk2, *da_subln_g, *mlp_w1, *mlp_w2;
  float* out;
  char* ws;
  int only;
  int pad;
};

DI float bf2f(bf16_t h) { return __uint_as_float(((unsigned)h) << 16); }
DI unsigned pack2(float a, float b) { fv2 v = {a, b}; bfv2 r = __builtin_convertvector(v, bfv2); return __builtin_bit_cast(unsigned, r); }
DI bf16_t f2bf(float a) { return (bf16_t)(pack2(a, 0.f) & 0xffffu); }
DI float lo_bf(unsigned u) { return __uint_as_float(u << 16); }
DI float hi_bf(unsigned u) { return __uint_as_float(u & 0xffff0000u); }
DI float sigmoidf_(float x) { return 1.f / (1.f + __expf(-x)); }
DI float wave_sum(float v) {
#pragma unroll
  for (int o = 32; o > 0; o >>= 1) v += __shfl_xor(v, o);
  return v;
}
template <int N> DI float ror_add(float x) { return x + __builtin_bit_cast(float, __builtin_amdgcn_mov_dpp(__builtin_bit_cast(int, x), 0x120 + N, 0xf, 0xf, true)); }
DI float rowsum16(float x) { x = ror_add<8>(x); x = ror_add<4>(x); x = ror_add<2>(x); x = ror_add<1>(x); return x; }

DI int opaque_tid() { int t = threadIdx.x; asm volatile("" : "+v"(t)); return t; }
DI float* resid_row(const P& p, int gr) { return gr < NLAT ? p.out + (size_t)gr * D : (float*)(p.ws + OFF_XC) + (size_t)(gr - NLAT) * D; }
DI int mod_row(int gr) { return gr < NLAT ? gr / SL : 8; }
DI const float* mods_ptr(const P& p, int layer, int mrow) { return (const float*)(p.ws + OFF_MODS) + ((size_t)layer * 9 + mrow) * 6144; }
DI int half_gtile(int hf, int lt) { return lt < 128 ? hf * 128 + lt : 256 + hf * 8 + (lt - 128); }
DI int first_tile(int base) { int g = gridDim.x; int s = (int)blockIdx.x - (base % g); if (s < 0) s += g; return s; }
DI size_t w_off(int layer) { return (layer & 1) ? OFF_W2 : OFF_W; }
DI float lambda_init(int layer) { return 0.8f - 0.6f * expf(-0.3f * (float)layer); }

DI void phase_init(const P& p, char* smem) {
  const int tidx = opaque_tid();
  const int tid = tidx;
  float* sc = (float*)smem;
  float* mods = (float*)(p.ws + OFF_MODS);
  for (int item = blockIdx.x; item < 96; item += gridDim.x) {
    const int layer = item / 24, cb = item % 24;
    __syncthreads();
    for (int i = tid; i < 9 * 1024; i += 256) {
      int r = i >> 10, k = i & 1023;
      float v = r < 8 ? p.c[r * 1024 + k] : p.c_ctx[k];
      sc[i] = v / (1.f + expf(-v));
    }
    __syncthreads();
    const int w = tid >> 6, q = tid & 63;
    float4 acc[9];
#pragma unroll
    for (int r = 0; r < 9; r++) acc[r] = make_float4(0.f, 0.f, 0.f, 0.f);
    const float* wp = p.ada_w + (size_t)layer * 1024 * 6144 + cb * 256 + q * 4;
    for (int k = w * 256; k < w * 256 + 256; k++) {
      float4 wv = *(const float4*)(wp + (size_t)k * 6144);
#pragma unroll
      for (int r = 0; r < 9; r++) {
        float s = sc[r * 1024 + k];
        acc[r].x += s * wv.x; acc[r].y += s * wv.y; acc[r].z += s * wv.z; acc[r].w += s * wv.w;
      }
    }
    __syncthreads();
    float4* red = (float4*)smem;
#pragma unroll
    for (int r = 0; r < 9; r++) red[(w * 9 + r) * 64 + q] = acc[r];
    __syncthreads();
    for (int i = tid; i < 9 * 64; i += 256) {
      int r = i / 64, qq = i % 64;
      float4 s0 = red[(0 * 9 + r) * 64 + qq], s1 = red[(1 * 9 + r) * 64 + qq], s2 = red[(2 * 9 + r) * 64 + qq], s3 = red[(3 * 9 + r) * 64 + qq];
      float4 bb = *(const float4*)(p.ada_b + layer * 6144 + cb * 256 + qq * 4);
      float4 o = make_float4(s0.x + s1.x + s2.x + s3.x + bb.x, s0.y + s1.y + s2.y + s3.y + bb.y, s0.z + s1.z + s2.z + s3.z + bb.z, s0.w + s1.w + s2.w + s3.w + bb.w);
      *(float4*)(mods + ((size_t)layer * 9 + r) * 6144 + cb * 256 + qq * 4) = o;
    }
  }
  if (blockIdx.x == gridDim.x - 1) {
    float* misc = (float*)(p.ws + OFF_MISC);
    for (int i = tid; i < 1024; i += 256) {
      int pos = i / 16, f = i % 16;
      float inv = powf(10000.f, -(float)f / 16.f);
      float ang = (float)pos * inv;
      misc[i] = cosf(ang);
      misc[1024 + i] = sinf(ang);
    }
    misc[4096 + tid] = 0.f;
    if (tid < 2) {
      float s1 = 0.f, s2 = 0.f;
      for (int k = 0; k < 64; k++) { s1 += p.da_lq1[tid * 64 + k] * p.da_lk1[tid * 64 + k]; s2 += p.da_lq2[tid * 64 + k] * p.da_lk2[tid * 64 + k]; }
      misc[2048 + tid] = expf(s1) - expf(s2) + lambda_init(2 * tid + 1);
    }
  }
  const size_t n4 = (size_t)NLAT * D / 4, c4 = (size_t)NCTX * D / 4;
  const float4* xs = (const float4*)p.x; float4* xo = (float4*)p.out;
  for (size_t i = (size_t)blockIdx.x * 256 + tid; i < n4; i += (size_t)gridDim.x * 256) xo[i] = xs[i];
  const float4* cs = (const float4*)p.ctx; float4* co = (float4*)(p.ws + OFF_XC);
  for (size_t i = (size_t)blockIdx.x * 256 + tid; i < c4; i += (size_t)gridDim.x * 256) co[i] = cs[i];
}

DI void conv_mat(const float* __restrict__ src, int K, int N, bf16_t* __restrict__ dst, int ldd, int koff, const float* __restrict__ scale,
                 int Kp, int Np, float* sm, int& base, int vb, int vg) {
  const int tidx = opaque_tid();
  const int tid = tidx;
  const int tk = Kp / 64, tn = Np / 64, nt = tk * tn;
  int t0_ = vb - (base % vg);
  if (t0_ < 0) t0_ += vg;
  for (int t = t0_; t < nt; t += vg) {
    const int k0 = (t / tn) * 64, n0 = (t % tn) * 64;
    __syncthreads();
#pragma unroll
    for (int i = 0; i < 4; i++) {
      int kr = (tid >> 4) + 16 * i, nc = (tid & 15) * 4;
      float4 v = make_float4(0.f, 0.f, 0.f, 0.f);
      if (src != nullptr && k0 + kr < K && n0 + nc < N) {
        v = *(const float4*)(src + (size_t)(k0 + kr) * N + n0 + nc);
        if (scale) { float s = scale[k0 + kr]; v.x *= s; v.y *= s; v.z *= s; v.w *= s; }
      }
      sm[kr * 65 + nc + 0] = v.x; sm[kr * 65 + nc + 1] = v.y; sm[kr * 65 + nc + 2] = v.z; sm[kr * 65 + nc + 3] = v.w;
    }
    __syncthreads();
    const int n = tid >> 2, kb = (tid & 3) * 16;
    unsigned o[8];
#pragma unroll
    for (int i = 0; i < 8; i++) o[i] = pack2(sm[(kb + 2 * i) * 65 + n], sm[(kb + 2 * i + 1) * 65 + n]);
    uint4* dp = (uint4*)(dst + (size_t)(n0 + n) * ldd + koff + k0 + kb);
    dp[0] = make_uint4(o[0], o[1], o[2], o[3]);
    dp[1] = make_uint4(o[4], o[5], o[6], o[7]);
  }
  base += nt;
}

DI void phase_conv(const P& p, int layer, char* smem, int vb, int vg) {
  if (vb < 0) return;
  float* sm = (float*)smem;
  bf16_t* W = (bf16_t*)(p.ws + w_off(layer));
  int base = 0;
  const int j = layer / 2;
  if ((layer & 1) == 0) {
    for (int s = 0; s < 3; s++) {
      const float* src = p.rw_w_rkv + ((size_t)j * 3 + s) * 1048576;
      conv_mat(src, 1024, 1024, W + W_RKV + (size_t)s * 1024 * 2048, 2048, 0, nullptr, 1024, 1024, sm, base, vb, vg);
    }
    for (int pass = 0; pass < 2; pass++) {
      const int ko = pass * 1024;
      const float* m1 = pass ? p.rw_mix + ((size_t)j * 6 + 1) * 1024 : nullptr;
      const float* m4 = pass ? p.rw_mix + ((size_t)j * 6 + 4) * 1024 : nullptr;
      const float* m5 = pass ? p.rw_mix + ((size_t)j * 6 + 5) * 1024 : nullptr;
      const float* m3 = pass ? p.rw_mix + ((size_t)j * 6 + 3) * 1024 : nullptr;
      bf16_t* L1 = W + W_L1;
      conv_mat(p.rw_w1 + ((size_t)j * 2 + 0) * 65536, 1024, 64, L1 + 0ull * 2048, 2048, ko, m1, 1024, 64, sm, base, vb, vg);
      conv_mat(p.rw_w1 + ((size_t)j * 2 + 1) * 65536, 1024, 64, L1 + 64ull * 2048, 2048, ko, m1, 1024, 64, sm, base, vb, vg);
      conv_mat(p.rw_a1 + (size_t)j * 65536, 1024, 64, L1 + 128ull * 2048, 2048, ko, m4, 1024, 64, sm, base, vb, vg);
      conv_mat(p.rw_g1 + ((size_t)j * 2 + 0) * 163840, 1024, 160, L1 + 192ull * 2048, 2048, ko, m5, 1024, 192, sm, base, vb, vg);
      conv_mat(p.rw_g1 + ((size_t)j * 2 + 1) * 163840, 1024, 160, L1 + 384ull * 2048, 2048, ko, m5, 1024, 192, sm, base, vb, vg);
      conv_mat(j > 0 ? p.rw_v1 + (size_t)(j - 1) * 32768 : nullptr, 1024, 32, L1 + 576ull * 2048, 2048, ko, m3, 1024, 64, sm, base, vb, vg);
    }
    conv_mat(p.rw_w2 + ((size_t)j * 2 + 0) * 65536, 64, 1024, W + W_W2, 64, 0, nullptr, 64, 1024, sm, base, vb, vg);
    conv_mat(p.rw_w2 + ((size_t)j * 2 + 1) * 65536, 64, 1024, W + W_W2 + 65536, 64, 0, nullptr, 64, 1024, sm, base, vb, vg);
    conv_mat(p.rw_a2 + (size_t)j * 65536, 64, 1024, W + W_A2, 64, 0, nullptr, 64, 1024, sm, base, vb, vg);
    conv_mat(p.rw_g2 + ((size_t)j * 2 + 0) * 163840, 160, 1024, W + W_G2, 192, 0, nullptr, 192, 1024, sm, base, vb, vg);
    conv_mat(p.rw_g2 + ((size_t)j * 2 + 1) * 163840, 160, 1024, W + W_G2 + 196608, 192, 0, nullptr, 192, 1024, sm, base, vb, vg);
    conv_mat(j > 0 ? p.rw_v2 + (size_t)(j - 1) * 32768 : nullptr, 32, 1024, W + W_V2, 64, 0, nullptr, 64, 1024, sm, base, vb, vg);
    conv_mat(p.rw_w_o + (size_t)j * 1048576, 1024, 1024, W + W_WO, 1024, 0, nullptr, 1024, 1024, sm, base, vb, vg);
  } else {
    conv_mat(p.da_w_qkv + (size_t)j * 3145728, 1024, 3072, W + W_QKV, 1024, 0, nullptr, 1024, 3072, sm, base, vb, vg);
    conv_mat(p.da_w_o + (size_t)j * 1048576, 1024, 1024, W + W_WO, 1024, 0, nullptr, 1024, 1024, sm, base, vb, vg);
  }
  conv_mat(p.mlp_w1 + (size_t)layer * 4194304, 1024, 4096, W + W_M1, 1024, 0, nullptr, 1024, 4096, sm, base, vb, vg);
  conv_mat(p.mlp_w2 + (size_t)layer * 4194304, 4096, 1024, W + W_M2, 4096, 0, nullptr, 4096, 1024, sm, base, vb, vg);
}

DI void phase_prep(const P& p, int layer, int sub, int hf, bool shift, bf16_t* H, int ldh, bool skip_ctx) {
  const int tidx = opaque_tid();
  const int lane = tidx & 63, wv = tidx >> 6;
  const int nrows = hf < 0 ? (skip_ctx ? NLAT : NTOK) : HROWS;
  const int nseg = nrows / 8;
  const float* ng = p.norm_g + ((size_t)layer * 2 + sub) * 1024;
  for (int seg = blockIdx.x * 4 + wv; seg < nseg; seg += gridDim.x * 4) {
    const int lr0 = seg * 8;
    const int gr0 = hf < 0 ? lr0 : (lr0 < 16384 ? hf * 16384 + lr0 : NLAT + hf * 1024 + (lr0 - 16384));
    const bool lat = gr0 < NLAT;
    const int T = lat ? SL : CL;
    const int t0 = lat ? (gr0 % SL) : ((gr0 - NLAT) % CL);
    const float* xbase = resid_row(p, gr0);
    const float* md = mods_ptr(p, layer, mod_row(gr0));
    float4 g4[4], sc4[4], sh4[4];
#pragma unroll
    for (int jx = 0; jx < 4; jx++) {
      int ch = jx * 256 + lane * 4;
      g4[jx] = *(const float4*)(ng + ch);
      sh4[jx] = *(const float4*)(md + sub * 3072 + ch);
      sc4[jx] = *(const float4*)(md + sub * 3072 + 1024 + ch);
      g4[jx].x *= (1.f + sc4[jx].x); g4[jx].y *= (1.f + sc4[jx].y); g4[jx].z *= (1.f + sc4[jx].z); g4[jx].w *= (1.f + sc4[jx].w);
    }
    float4 hp[4], hc[4], hn[4];
    const int tb = shift ? -1 : 0, te = shift ? 9 : 8;
    for (int tt = tb; tt < te; tt++) {
      const int t = t0 + tt;
      if (t >= 0 && t < T) {
        const float* xr = xbase + (ptrdiff_t)tt * D;
        float ss = 0.f;
#pragma unroll
        for (int jx = 0; jx < 4; jx++) {
          hn[jx] = *(const float4*)(xr + jx * 256 + lane * 4);
          ss += hn[jx].x * hn[jx].x + hn[jx].y * hn[jx].y + hn[jx].z * hn[jx].z + hn[jx].w * hn[jx].w;
        }
        ss = wave_sum(ss);
        const float rs = rsqrtf(ss * (1.f / 1024.f) + 1e-6f);
#pragma unroll
        for (int jx = 0; jx < 4; jx++) {
          hn[jx].x = hn[jx].x * rs * g4[jx].x + sh4[jx].x; hn[jx].y = hn[jx].y * rs * g4[jx].y + sh4[jx].y;
          hn[jx].z = hn[jx].z * rs * g4[jx].z + sh4[jx].z; hn[jx].w = hn[jx].w * rs * g4[jx].w + sh4[jx].w;
        }
      } else {
#pragma unroll
        for (int jx = 0; jx < 4; jx++) hn[jx] = make_float4(0.f, 0.f, 0.f, 0.f);
      }
      if (!shift) {
        bf16_t* hr = H + (size_t)(lr0 + tt) * ldh;
#pragma unroll
        for (int jx = 0; jx < 4; jx++) *(uint2*)(hr + jx * 256 + lane * 4) = make_uint2(pack2(hn[jx].x, hn[jx].y), pack2(hn[jx].z, hn[jx].w));
      } else if (tt >= 1) {
        bf16_t* hr = H + (size_t)(lr0 + tt - 1) * ldh;
#pragma unroll
        for (int jx = 0; jx < 4; jx++) {
          *(uint2*)(hr + jx * 256 + lane * 4) = make_uint2(pack2(hc[jx].x, hc[jx].y), pack2(hc[jx].z, hc[jx].w));
          float4 xx;
          xx.x = 0.5f * (hp[jx].x + hn[jx].x) - hc[jx].x; xx.y = 0.5f * (hp[jx].y + hn[jx].y) - hc[jx].y;
          xx.z = 0.5f * (hp[jx].z + hn[jx].z) - hc[jx].z; xx.w = 0.5f * (hp[jx].w + hn[jx].w) - hc[jx].w;
          *(uint2*)(hr + 1024 + jx * 256 + lane * 4) = make_uint2(pack2(xx.x, xx.y), pack2(xx.z, xx.w));
        }
      }
#pragma unroll
      for (int jx = 0; jx < 4; jx++) { hp[jx] = hc[jx]; hc[jx] = hn[jx]; }
    }
  }
}

constexpr int LDT = 72;
DI void gemm_mainloop(const bf16_t* __restrict__ A, int lda, const bf16_t* __restrict__ Bt, int ldb, int K, char* smem, f32x16 (&acc)[2][2]) {
  const int tidx = opaque_tid();
  bf16_t* sA = (bf16_t*)smem;
  bf16_t* sB = sA + 2 * 128 * LDT;
  const int tid = tidx, lane = tid & 63, w = tid >> 6, wm = w >> 1, wn = w & 1;
  const int lrow = tid >> 3, lkc = (tid & 7) * 8;
#pragma unroll
  for (int mi = 0; mi < 2; mi++)
#pragma unroll
    for (int ni = 0; ni < 2; ni++)
#pragma unroll
      for (int r = 0; r < 16; r++) acc[mi][ni][r] = 0.f;
  const unsigned ao = (unsigned)(lrow * lda + lkc), bo = (unsigned)(lrow * ldb + lkc);
  const unsigned a32 = (unsigned)(32 * lda), b32 = (unsigned)(32 * ldb);
  uint4 ra0, ra1, ra2, ra3, rb0, rb1, rb2, rb3;
#define G_LOAD(Ab, Bb)                                                                                   \
  {                                                                                                      \
    ra0 = *(const uint4*)((Ab) + ao); ra1 = *(const uint4*)((Ab) + (ao + a32));                          \
    ra2 = *(const uint4*)((Ab) + (ao + 2 * a32)); ra3 = *(const uint4*)((Ab) + (ao + 3 * a32));          \
    rb0 = *(const uint4*)((Bb) + bo); rb1 = *(const uint4*)((Bb) + (bo + b32));                          \
    rb2 = *(const uint4*)((Bb) + (bo + 2 * b32)); rb3 = *(const uint4*)((Bb) + (bo + 3 * b32));          \
  }
#define G_STORE(sa_, sb_)                                                                                \
  {                                                                                                      \
    bf16_t* a_w = (sa_) + lrow * LDT + lkc;                                                              \
    bf16_t* b_w = (sb_) + lrow * LDT + lkc;                                                              \
    *(uint4*)(a_w) = ra0; *(uint4*)(a_w + 32 * LDT) = ra1; *(uint4*)(a_w + 64 * LDT) = ra2; *(uint4*)(a_w + 96 * LDT) = ra3; \
    *(uint4*)(b_w) = rb0; *(uint4*)(b_w + 32 * LDT) = rb1; *(uint4*)(b_w + 64 * LDT) = rb2; *(uint4*)(b_w + 96 * LDT) = rb3; \
  }
  G_LOAD(A, Bt);
  G_STORE(sA, sB);
  __syncthreads();
  const int nk = K >> 6;
  const int aoff = (wm * 64 + (lane & 31)) * LDT + (lane >> 5) * 8;
  const int boff = (wn * 64 + (lane & 31)) * LDT + (lane >> 5) * 8;
  for (int kt = 0; kt < nk; kt++) {
    const int cur = kt & 1;
    if (kt + 1 < nk) {
      const bf16_t* A1 = A + (kt + 1) * 64;
      const bf16_t* B1 = Bt + (kt + 1) * 64;
      G_LOAD(A1, B1);
    }
    __builtin_amdgcn_sched_barrier(0);
    const bf16_t* a_s = sA + cur * 128 * LDT + aoff;
    const bf16_t* b_s = sB + cur * 128 * LDT + boff;
#pragma unroll
    for (int kk = 0; kk < 4; kk++) {
      bf16x8 af[2], bq[2];
#pragma unroll
      for (int mi = 0; mi < 2; mi++) af[mi] = *(const bf16x8*)(a_s + mi * 32 * LDT + kk * 16);
#pragma unroll
      for (int ni = 0; ni < 2; ni++) bq[ni] = *(const bf16x8*)(b_s + ni * 32 * LDT + kk * 16);
#pragma unroll
      for (int mi = 0; mi < 2; mi++)
#pragma unroll
        for (int ni = 0; ni < 2; ni++) acc[mi][ni] = MFMA32(af[mi], bq[ni], acc[mi][ni]);
    }
    __builtin_amdgcn_sched_barrier(0);
    if (kt + 1 < nk) G_STORE(sA + (cur ^ 1) * 128 * LDT, sB + (cur ^ 1) * 128 * LDT);
    __syncthreads();
  }
}
DI uint4 mix8(const uint4 h, const uint4 x, const float4 m0, const float4 m1) {
  uint4 o;
  o.x = pack2(lo_bf(h.x) + lo_bf(x.x) * m0.x, hi_bf(h.x) + hi_bf(x.x) * m0.y);
  o.y = pack2(lo_bf(h.y) + lo_bf(x.y) * m0.z, hi_bf(h.y) + hi_bf(x.y) * m0.w);
  o.z = pack2(lo_bf(h.z) + lo_bf(x.z) * m1.x, hi_bf(h.z) + hi_bf(x.z) * m1.y);
  o.w = pack2(lo_bf(h.w) + lo_bf(x.w) * m1.z, hi_bf(h.w) + hi_bf(x.w) * m1.w);
  return o;
}
DI void gemm_mainloop_mix(const bf16_t* __restrict__ HX, const float* __restrict__ mix, const bf16_t* __restrict__ Bt, int ldb, char* smem, f32x16 (&acc)[2][2]) {
  const int tidx = opaque_tid();
  bf16_t* sA = (bf16_t*)smem;
  bf16_t* sB = sA + 2 * 128 * LDT;
  const int tid = tidx, lane = tid & 63, w = tid >> 6, wm = w >> 1, wn = w & 1;
  const int lrow = tid >> 3, lkc = (tid & 7) * 8;
#pragma unroll
  for (int mi = 0; mi < 2; mi++)
#pragma unroll
    for (int ni = 0; ni < 2; ni++)
#pragma unroll
      for (int r = 0; r < 16; r++) acc[mi][ni][r] = 0.f;
  const unsigned ao = (unsigned)(lrow * 2048 + lkc), bo = (unsigned)(lrow * ldb + lkc);
  const unsigned a32 = 32u * 2048u, b32 = (unsigned)(32 * ldb);
  uint4 h0, h1, h2, h3, x0, x1, x2, x3, rb0, rb1, rb2, rb3;
  float4 m0, m1;
#define GM_LOAD(kstep_)                                                                                  \
  {                                                                                                      \
    const bf16_t* Ab_ = HX + (kstep_) * 64;                                                              \
    const bf16_t* Bb_ = Bt + (kstep_) * 64;                                                              \
    h0 = *(const uint4*)(Ab_ + ao); h1 = *(const uint4*)(Ab_ + (ao + a32));                              \
    h2 = *(const uint4*)(Ab_ + (ao + 2 * a32)); h3 = *(const uint4*)(Ab_ + (ao + 3 * a32));              \
    x0 = *(const uint4*)(Ab_ + (ao + 1024u)); x1 = *(const uint4*)(Ab_ + (ao + a32 + 1024u));            \
    x2 = *(const uint4*)(Ab_ + (ao + 2 * a32 + 1024u)); x3 = *(const uint4*)(Ab_ + (ao + 3 * a32 + 1024u)); \
    rb0 = *(const uint4*)(Bb_ + bo); rb1 = *(const uint4*)(Bb_ + (bo + b32));                            \
    rb2 = *(const uint4*)(Bb_ + (bo + 2 * b32)); rb3 = *(const uint4*)(Bb_ + (bo + 3 * b32));            \
    m0 = *(const float4*)(mix + (kstep_) * 64 + lkc); m1 = *(const float4*)(mix + (kstep_) * 64 + lkc + 4); \
  }
#define GM_STORE(buf_)                                                                                   \
  {                                                                                                      \
    bf16_t* a_w = sA + (buf_) * 128 * LDT + lrow * LDT + lkc;                                            \
    bf16_t* b_w = sB + (buf_) * 128 * LDT + lrow * LDT + lkc;                                            \
    *(uint4*)(a_w) = mix8(h0, x0, m0, m1); *(uint4*)(a_w + 32 * LDT) = mix8(h1, x1, m0, m1);             \
    *(uint4*)(a_w + 64 * LDT) = mix8(h2, x2, m0, m1); *(uint4*)(a_w + 96 * LDT) = mix8(h3, x3, m0, m1);  \
    *(uint4*)(b_w) = rb0; *(uint4*)(b_w + 32 * LDT) = rb1; *(uint4*)(b_w + 64 * LDT) = rb2; *(uint4*)(b_w + 96 * LDT) = rb3; \
  }
  GM_LOAD(0);
  GM_STORE(0);
  __syncthreads();
  const int aoff = (wm * 64 + (lane & 31)) * LDT + (lane >> 5) * 8;
  const int boff = (wn * 64 + (lane & 31)) * LDT + (lane >> 5) * 8;
  for (int kt = 0; kt < 16; kt++) {
    const int cur = kt & 1;
    if (kt + 1 < 16) GM_LOAD(kt + 1);
    __builtin_amdgcn_sched_barrier(0);
    const bf16_t* a_s = sA + cur * 128 * LDT + aoff;
    const bf16_t* b_s = sB + cur * 128 * LDT + boff;
#pragma unroll
    for (int kk = 0; kk < 4; kk++) {
      bf16x8 af[2], bq[2];
#pragma unroll
      for (int mi = 0; mi < 2; mi++) af[mi] = *(const bf16x8*)(a_s + mi * 32 * LDT + kk * 16);
#pragma unroll
      for (int ni = 0; ni < 2; ni++) bq[ni] = *(const bf16x8*)(b_s + ni * 32 * LDT + kk * 16);
#pragma unroll
      for (int mi = 0; mi < 2; mi++)
#pragma unroll
        for (int ni = 0; ni < 2; ni++) acc[mi][ni] = MFMA32(af[mi], bq[ni], acc[mi][ni]);
    }
    __builtin_amdgcn_sched_barrier(0);
    if (kt + 1 < 16) GM_STORE(cur ^ 1);
    __syncthreads();
  }
}

constexpr int EST = 132;
DI void acc_to_lds(const f32x16 (&acc)[2][2], float* es) {
  const int tidx = opaque_tid();
  const int lane = tidx & 63, w = tidx >> 6, wm = w >> 1, wn = w & 1;
#pragma unroll
  for (int mi = 0; mi < 2; mi++)
#pragma unroll
    for (int ni = 0; ni < 2; ni++)
#pragma unroll
      for (int r = 0; r < 16; r++)
        es[(wm * 64 + mi * 32 + (r & 3) + 8 * (r >> 2) + 4 * (lane >> 5)) * EST + wn * 64 + ni * 32 + (lane & 31)] = acc[mi][ni][r];
}
#define EPI8_BEGIN                                                                   \
  {                                                                                  \
    float* es = (float*)smem;                                                        \
    acc_to_lds(acc, es);                                                             \
    __syncthreads();                                                                 \
    for (int pass = 0; pass < 8; pass++) {                                           \
      const int row = pass * 16 + (tidx >> 4), col = (tidx & 15) * 8;  \
      const float4 e_va = *(const float4*)(es + row * EST + col);                    \
      const float4 e_vb = *(const float4*)(es + row * EST + col + 4);                \
      float v[8] = {e_va.x, e_va.y, e_va.z, e_va.w, e_vb.x, e_vb.y, e_vb.z, e_vb.w};
#define EPI8_END                                                                     \
    }                                                                                \
    __syncthreads();                                                                 \
  }
DI uint4 pack8(const float (&v)[8]) { return make_uint4(pack2(v[0], v[1]), pack2(v[2], v[3]), pack2(v[4], v[5]), pack2(v[6], v[7])); }
DI void unpack8(const uint4 u, float (&v)[8]) {
  v[0] = lo_bf(u.x); v[1] = hi_bf(u.x); v[2] = lo_bf(u.y); v[3] = hi_bf(u.y); v[4] = lo_bf(u.z); v[5] = hi_bf(u.z); v[6] = lo_bf(u.w); v[7] = hi_bf(u.w);
}
DI void resid_update(float* xp, const float* gate, const float (&v)[8]) {
  float4 x0 = *(const float4*)xp, x1 = *(const float4*)(xp + 4);
  const float4 g0 = *(const float4*)gate, g1 = *(const float4*)(gate + 4);
  x0.x += g0.x * v[0]; x0.y += g0.y * v[1]; x0.z += g0.z * v[2]; x0.w += g0.w * v[3];
  x1.x += g1.x * v[4]; x1.y += g1.y * v[5]; x1.z += g1.z * v[6]; x1.w += g1.w * v[7];
  *(float4*)xp = x0; *(float4*)(xp + 4) = x1;
}

DI bool xcd_tile(int t, int Mt, int Nt, int& mt, int& nt) {
  const int G = gridDim.x, spx = G >> 3, tn = spx >> 3;
  const int r = t % G, round = t / G;
  const int xcd = r & 7, li = r >> 3;
  const int smn = Mt >> 3, snn = Nt / tn;
  const int st = round * 8 + xcd;
  if (st >= smn * snn) return false;
  const int smi = st % smn, sni = st / smn;
  mt = smi * 8 + (li & 7);
  nt = sni * tn + (li >> 3);
  return true;
}
DI int xcd_rounds(int Mt, int Nt) { const int tn = gridDim.x >> 6; return ((Mt >> 3) * (Nt / tn) + 7) >> 3; }

DI void phase_t1(const P& p, char* smem) {
  const int tidx = opaque_tid();
  const bf16_t* HX = (const bf16_t*)(p.ws + OFF_TR + TR_HX);
  const bf16_t* WL1 = (const bf16_t*)(p.ws + w_off(0)) + W_L1;
  bf16_t* T1 = (bf16_t*)(p.ws + OFF_TR + TR_T1);
  for (int t = blockIdx.x; t < 136 * 5; t += gridDim.x) {
    const int nt = t % 5, lt = t / 5;
    f32x16 acc[2][2];
    gemm_mainloop(HX + (size_t)lt * 128 * 2048, 2048, WL1 + (size_t)nt * 128 * 2048, 2048, 2048, smem, acc);
    EPI8_BEGIN
      const int c = nt * 128 + col;
      if (c < 128) {
#pragma unroll
        for (int e = 0; e < 8; e++) v[e] = tanhf(v[e]);
      } else if (c >= 192 && c < 576) {
#pragma unroll
        for (int e = 0; e < 8; e++) v[e] = sigmoidf_(v[e]);
      }
      *(uint4*)(T1 + (size_t)(lt * 128 + row) * 640 + c) = pack8(v);
    EPI8_END
  }
}

DI void phase_feat(const P& p, int layer, int hf, char* smem) {
  const int tidx = opaque_tid();
  const int j = layer / 2;
  const bf16_t* W = (const bf16_t*)(p.ws + w_off(layer));
  const bf16_t* HX = (const bf16_t*)(p.ws + OFF_TR + TR_HX);
  const bf16_t* T1 = (const bf16_t*)(p.ws + OFF_TR + TR_T1);
  bf16_t* VF = (bf16_t*)(p.ws + OFF_VF);
  for (int t = blockIdx.x; t < xcd_rounds(136, 24) * (int)gridDim.x; t += gridDim.x) {
    int lt, nt;
    if (!xcd_tile(t, 136, 24, lt, nt)) continue;
    const int s = nt / 8, n0 = (nt % 8) * 128;
    const int gt = half_gtile(hf, lt);
    f32x16 acc[2][2];
    bf16_t* outp = (bf16_t*)(p.ws + OFF_TR + (s == 0 ? TR_R : (s == 1 ? TR_K : TR_V)));
    if (s == 2 && j > 0) {
      gemm_mainloop(T1 + (size_t)lt * 128 * 640 + 576, 640, W + W_V2 + (size_t)n0 * 64, 64, 64, smem, acc);
      const float* v0 = p.rw_v0 + (size_t)(j - 1) * 1024;
      EPI8_BEGIN
        const int c = n0 + col;
#pragma unroll
        for (int e = 0; e < 8; e++) v[e] = sigmoidf_(v0[c + e] + v[e]);
        *(uint4*)(outp + (size_t)(lt * 128 + row) * 1024 + c) = pack8(v);
      EPI8_END
    }
    {
      const int mixsel = s == 0 ? 0 : (s == 1 ? 2 : 3);
      gemm_mainloop_mix(HX + (size_t)lt * 128 * 2048, p.rw_mix + ((size_t)j * 6 + mixsel) * 1024, W + W_RKV + ((size_t)s * 1024 + n0) * 2048, 2048, smem, acc);
    }
    if (s < 2) {
      EPI8_BEGIN
        *(uint4*)(outp + (size_t)(lt * 128 + row) * 1024 + n0 + col) = pack8(v);
      EPI8_END
    } else if (j == 0) {
      EPI8_BEGIN
        const uint4 u = pack8(v);
        *(uint4*)(outp + (size_t)(lt * 128 + row) * 1024 + n0 + col) = u;
        *(uint4*)(VF + (size_t)(gt * 128 + row) * 1024 + n0 + col) = u;
      EPI8_END
    } else {
      EPI8_BEGIN
        const size_t oi = (size_t)(lt * 128 + row) * 1024 + n0 + col;
        float sg[8], vf[8];
        unpack8(*(const uint4*)(outp + oi), sg);
        unpack8(*(const uint4*)(VF + (size_t)(gt * 128 + row) * 1024 + n0 + col), vf);
#pragma unroll
        for (int e = 0; e < 8; e++) v[e] = v[e] + (vf[e] - v[e]) * sg[e];
        *(uint4*)(outp + oi) = pack8(v);
      EPI8_END
    }
  }
  for (int t = blockIdx.x; t < xcd_rounds(136, 40) * (int)gridDim.x; t += gridDim.x) {
    int lt, nt;
    if (!xcd_tile(t, 136, 40, lt, nt)) continue;
    const int s = nt / 8, n0 = (nt % 8) * 128;
    f32x16 acc[2][2];
    if (s == 0) {
      gemm_mainloop(T1 + (size_t)lt * 128 * 640 + 128, 640, W + W_A2 + (size_t)n0 * 64, 64, 64, smem, acc);
      bf16_t* outp = (bf16_t*)(p.ws + OFF_TR + TR_A);
      const float* a0 = p.rw_a0 + (size_t)j * 1024;
      EPI8_BEGIN
#pragma unroll
        for (int e = 0; e < 8; e++) v[e] = sigmoidf_(a0[n0 + col + e] + v[e]);
        *(uint4*)(outp + (size_t)(lt * 128 + row) * 1024 + n0 + col) = pack8(v);
      EPI8_END
    } else if (s < 3) {
      const int d = s - 1;
      gemm_mainloop(T1 + (size_t)lt * 128 * 640 + d * 64, 640, W + W_W2 + (size_t)d * 65536 + (size_t)n0 * 64, 64, 64, smem, acc);
      bf16_t* outp = (bf16_t*)(p.ws + OFF_TR + (d ? TR_WL1 : TR_WL0));
      const float* w0 = p.rw_w0 + ((size_t)j * 2 + d) * 1024;
      EPI8_BEGIN
#pragma unroll
        for (int e = 0; e < 8; e++) {
          const float z = -(w0[n0 + col + e] + v[e]);
          const float sp = fmaxf(z, 0.f) + log1pf(__expf(-fabsf(z)));
          v[e] = -__expf(-sp - 0.5f);
        }
        *(uint4*)(outp + (size_t)(lt * 128 + row) * 1024 + n0 + col) = pack8(v);
      EPI8_END
    } else {
      const int d = s - 3;
      gemm_mainloop(T1 + (size_t)lt * 128 * 640 + 192 + d * 192, 640, W + W_G2 + (size_t)d * 196608 + (size_t)n0 * 192, 192, 192, smem, acc);
      bf16_t* outp = (bf16_t*)(p.ws + OFF_TR + (d ? TR_G1 : TR_G0));
      EPI8_BEGIN
        *(uint4*)(outp + (size_t)(lt * 128 + row) * 1024 + n0 + col) = pack8(v);
      EPI8_END
    }
  }
}

DI int scan_row(int bl, int dir, int pos) {
  if (pos < CL) { int t = dir ? (CL - 1 - pos) : pos; return 16384 + bl * CL + t; }
  int t = pos - CL; if (dir) t = SL - 1 - t;
  return bl * SL + t;
}

DI void phase_scan(const P& p, int layer, char* smem) {
  const int tidx = opaque_tid();
  const int j = layer / 2;
  const int tid = tidx;
  const bf16_t* R = (const bf16_t*)(p.ws + OFF_TR + TR_R);
  const bf16_t* Kx = (const bf16_t*)(p.ws + OFF_TR + TR_K);
  const bf16_t* V = (const bf16_t*)(p.ws + OFF_TR + TR_V);
  const bf16_t* Aa = (const bf16_t*)(p.ws + OFF_TR + TR_A);
  float* sbuf = (float*)smem;
  constexpr int BUFF = 5 * 16 * 64 + 512;
  constexpr int POP = 144;
  float* pobuf = sbuf + 2 * BUFF;
  const int ss = tid >> 4, c4 = tid & 15;
  const int rl = tid >> 4, cg = tid & 15;
  for (int item = blockIdx.x; item < 256; item += gridDim.x) {
    const int q2 = item & 1, dir = (item >> 1) & 1, head = (item >> 2) & 15, bl = item >> 6;
    const bf16_t* WL = (const bf16_t*)(p.ws + OFF_TR + (dir ? TR_WL1 : TR_WL0));
    bf16_t* O = (bf16_t*)(p.ws + OFF_TR + TR_HX) + (dir ? (size_t)HROWS * 1024 : 0);
    const int ch = head * 64 + c4 * 4;
    const float4 kkw = *(const float4*)(p.rw_kk + (size_t)j * 1024 + ch);
    const float4 kaw = *(const float4*)(p.rw_ka + (size_t)j * 1024 + ch);
    fv2 SA01 = {0.f, 0.f}, SA23 = {0.f, 0.f}, SB01 = {0.f, 0.f}, SB23 = {0.f, 0.f};
    uint2 gr_, gk_, ga_, gw_, gv_;
    gv_ = make_uint2(0, 0);
#define SC_ISSUE(chunk_)                                                                   \
    {                                                                                      \
      const size_t ro = (size_t)scan_row(bl, dir, (chunk_) * 16 + ss) * 1024;              \
      gr_ = *(const uint2*)(R + ro + ch); gk_ = *(const uint2*)(Kx + ro + ch);             \
      ga_ = *(const uint2*)(Aa + ro + ch); gw_ = *(const uint2*)(WL + ro + ch);            \
      if (c4 < 8) gv_ = *(const uint2*)(V + ro + head * 64 + q2 * 32 + c4 * 4);            \
    }
#define SC_STAGE(buf_)                                                                     \
    {                                                                                      \
      float* sb_ = sbuf + (buf_) * BUFF;                                                   \
      float r0 = lo_bf(gr_.x), r1 = hi_bf(gr_.x), r2 = lo_bf(gr_.y), r3 = hi_bf(gr_.y);    \
      float k0 = lo_bf(gk_.x), k1 = hi_bf(gk_.x), k2 = lo_bf(gk_.y), k3 = hi_bf(gk_.y);    \
      float a0 = lo_bf(ga_.x), a1 = hi_bf(ga_.x), a2 = lo_bf(ga_.y), a3 = hi_bf(ga_.y);    \
      float w0 = lo_bf(gw_.x), w1 = hi_bf(gw_.x), w2 = lo_bf(gw_.y), w3 = hi_bf(gw_.y);    \
      float u0 = k0 * kkw.x, u1 = k1 * kkw.y, u2 = k2 * kkw.z, u3 = k3 * kkw.w;            \
      float sq = rowsum16(u0 * u0 + u1 * u1 + u2 * u2 + u3 * u3);                          \
      float inv = rsqrtf(fmaxf(sq, 1e-24f));                                               \
      u0 *= inv; u1 *= inv; u2 *= inv; u3 *= inv;                                          \
      const int o_ = ss * 64 + c4 * 4;                                                     \
      *(float4*)(sb_ + 0 * 1024 + o_) = make_float4(__expf(w0), __expf(w1), __expf(w2), __expf(w3)); \
      *(float4*)(sb_ + 1 * 1024 + o_) = make_float4(k0 * (1.f + (a0 - 1.f) * kaw.x), k1 * (1.f + (a1 - 1.f) * kaw.y), k2 * (1.f + (a2 - 1.f) * kaw.z), k3 * (1.f + (a3 - 1.f) * kaw.w)); \
      *(float4*)(sb_ + 2 * 1024 + o_) = make_float4(-u0, -u1, -u2, -u3);                   \
      *(float4*)(sb_ + 3 * 1024 + o_) = make_float4(u0 * a0, u1 * a1, u2 * a2, u3 * a3);   \
      *(float4*)(sb_ + 4 * 1024 + o_) = make_float4(r0, r1, r2, r3);                       \
      if (c4 < 8) *(float4*)(sb_ + 5 * 1024 + ss * 32 + c4 * 4) = make_float4(lo_bf(gv_.x), hi_bf(gv_.x), lo_bf(gv_.y), hi_bf(gv_.y)); \
    }
    __syncthreads();
    SC_ISSUE(0);
    SC_STAGE(0);
    __syncthreads();
    constexpr int NCH = TK / 16;
    float* po_wa = pobuf + rl * POP + cg;
    float* po_wb = pobuf + (rl + 16) * POP + cg;
    const float* po_r = pobuf + (rl + 16 * (cg >> 3)) * POP + (cg & 7) * 16;
    for (int chunk = 0; chunk < NCH; chunk++) {
      const int buf = chunk & 1;
      if (chunk + 1 < NCH) SC_ISSUE(chunk + 1);
      __builtin_amdgcn_sched_barrier(0);
      const float* sb = sbuf + buf * BUFF + cg * 4;
      const float* sv = sbuf + buf * BUFF + 5 * 1024 + rl;
      float4 w4 = *(const float4*)(sb + 0 * 1024), k4 = *(const float4*)(sb + 1 * 1024), n4 = *(const float4*)(sb + 2 * 1024);
      float4 b4 = *(const float4*)(sb + 3 * 1024), r4 = *(const float4*)(sb + 4 * 1024);
      float va = sv[0], vb = sv[16];
#pragma unroll
      for (int s = 0; s < 16; s++) {
        float4 w4n = w4, k4n = k4, n4n = n4, b4n = b4, r4n = r4;
        float van = va, vbn = vb;
        if (s + 1 < 16) {
          w4n = *(const float4*)(sb + 0 * 1024 + (s + 1) * 64); k4n = *(const float4*)(sb + 1 * 1024 + (s + 1) * 64);
          n4n = *(const float4*)(sb + 2 * 1024 + (s + 1) * 64); b4n = *(const float4*)(sb + 3 * 1024 + (s + 1) * 64);
          r4n = *(const float4*)(sb + 4 * 1024 + (s + 1) * 64); van = sv[(s + 1) * 32]; vbn = sv[(s + 1) * 32 + 16];
        }
        const fv2 w01 = {w4.x, w4.y}, w23 = {w4.z, w4.w}, k01 = {k4.x, k4.y}, k23 = {k4.z, k4.w}, n01 = {n4.x, n4.y}, n23 = {n4.z, n4.w};
        const fv2 b01 = {b4.x, b4.y}, b23 = {b4.z, b4.w}, r01 = {r4.x, r4.y}, r23 = {r4.z, r4.w};
        const fv2 va2 = {va, va}, vb2 = {vb, vb};
        const fv2 vka01 = va2 * k01, vka23 = va2 * k23, vkb01 = vb2 * k01, vkb23 = vb2 * k23;
        fv2 ppa = SA01 * n01, ppb = SB01 * n01;
        ppa = __builtin_elementwise_fma(SA23, n23, ppa);
        ppb = __builtin_elementwise_fma(SB23, n23, ppb);
        float saa = ppa.x + ppa.y, sab = ppb.x + ppb.y;
        saa = ror_add<8>(saa); sab = ror_add<8>(sab);
        saa = ror_add<4>(saa); sab = ror_add<4>(sab);
        saa = ror_add<2>(saa); sab = ror_add<2>(sab);
        saa = ror_add<1>(saa); sab = ror_add<1>(sab);
        const fv2 saa2 = {saa, saa}, sab2 = {sab, sab};
        const fv2 ta01 = __builtin_elementwise_fma(saa2, b01, vka01), ta23 = __builtin_elementwise_fma(saa2, b23, vka23);
        const fv2 tb01 = __builtin_elementwise_fma(sab2, b01, vkb01), tb23 = __builtin_elementwise_fma(sab2, b23, vkb23);
        SA01 = __builtin_elementwise_fma(SA01, w01, ta01);
        SA23 = __builtin_elementwise_fma(SA23, w23, ta23);
        SB01 = __builtin_elementwise_fma(SB01, w01, tb01);
        SB23 = __builtin_elementwise_fma(SB23, w23, tb23);
        fv2 qa = SA01 * r01, qb = SB01 * r01;
        qa = __builtin_elementwise_fma(SA23, r23, qa);
        qb = __builtin_elementwise_fma(SB23, r23, qb);
        po_wa[(s & 7) * 16] = qa.x + qa.y;
        po_wb[(s & 7) * 16] = qb.x + qb.y;
        w4 = w4n; k4 = k4n; n4 = n4n; b4 = b4n; r4 = r4n; va = van; vb = vbn;
        __builtin_amdgcn_sched_barrier(0);
        if ((s & 7) == 7) {
          const float4 p0 = *(const float4*)(po_r), p1 = *(const float4*)(po_r + 4), p2 = *(const float4*)(po_r + 8), p3 = *(const float4*)(po_r + 12);
          const float ov = ((p0.x + p0.y) + (p0.z + p0.w)) + ((p1.x + p1.y) + (p1.z + p1.w)) + ((p2.x + p2.y) + (p2.z + p2.w)) + ((p3.x + p3.y) + (p3.z + p3.w));
          const size_t ro = (size_t)scan_row(bl, dir, chunk * 16 + (s & 8) + (cg & 7)) * 1024;
          O[ro + head * 64 + q2 * 32 + rl + 16 * (cg >> 3)] = f2bf(ov);
          __builtin_amdgcn_sched_barrier(0);
        }
      }
      if (chunk + 1 < NCH) SC_STAGE(buf ^ 1);
      __syncthreads();
    }
  }
}

DI void phase_combine(const P& p, int layer) {
  const int tidx = opaque_tid();
  const int j = layer / 2;
  const bf16_t* Of = (const bf16_t*)(p.ws + OFF_TR + TR_HX);
  const bf16_t* Ob = Of + (size_t)HROWS * 1024;
  const bf16_t* R = (const bf16_t*)(p.ws + OFF_TR + TR_R);
  const bf16_t* Kx = (const bf16_t*)(p.ws + OFF_TR + TR_K);
  const bf16_t* V = (const bf16_t*)(p.ws + OFF_TR + TR_V);
  const bf16_t* Aa = (const bf16_t*)(p.ws + OFF_TR + TR_A);
  bf16_t* G0 = (bf16_t*)(p.ws + OFF_TR + TR_G0);
  const bf16_t* G1 = (const bf16_t*)(p.ws + OFF_TR + TR_G1);
  const size_t total = (size_t)HROWS * 128;
  for (size_t i = (size_t)blockIdx.x * 256 + tidx; i < total; i += (size_t)gridDim.x * 256) {
    const int c0 = (int)(i & 127) * 8;
    const size_t off = (i >> 7) * 1024 + c0;
    const uint4 uof = *(const uint4*)(Of + off), uob = *(const uint4*)(Ob + off), ur = *(const uint4*)(R + off), uk = *(const uint4*)(Kx + off);
    const uint4 ua = *(const uint4*)(Aa + off), uv = *(const uint4*)(V + off), ug0 = *(const uint4*)(G0 + off), ug1 = *(const uint4*)(G1 + off);
    const unsigned aof[4] = {uof.x, uof.y, uof.z, uof.w}, aob[4] = {uob.x, uob.y, uob.z, uob.w}, ar[4] = {ur.x, ur.y, ur.z, ur.w}, ak[4] = {uk.x, uk.y, uk.z, uk.w};
    const unsigned aa[4] = {ua.x, ua.y, ua.z, ua.w}, av[4] = {uv.x, uv.y, uv.z, uv.w}, ag0[4] = {ug0.x, ug0.y, ug0.z, ug0.w}, ag1[4] = {ug1.x, ug1.y, ug1.z, ug1.w};
    const float* ka = p.rw_ka + (size_t)j * 1024 + c0;
    const float* rk = p.rw_rk + (size_t)j * 1024 + c0;
    const float* lg = p.rw_ln_g + (size_t)j * 1024 + c0;
    const float* lb = p.rw_ln_b + (size_t)j * 1024 + c0;
    float of[8], obv[8];
    float sf = 0.f, sf2 = 0.f, sb = 0.f, sb2 = 0.f, br = 0.f;
#pragma unroll
    for (int e = 0; e < 8; e++) {
      const int w = e >> 1;
      of[e] = (e & 1) ? hi_bf(aof[w]) : lo_bf(aof[w]);
      obv[e] = (e & 1) ? hi_bf(aob[w]) : lo_bf(aob[w]);
      const float r = (e & 1) ? hi_bf(ar[w]) : lo_bf(ar[w]);
      const float k = (e & 1) ? hi_bf(ak[w]) : lo_bf(ak[w]);
      const float a = (e & 1) ? hi_bf(aa[w]) : lo_bf(aa[w]);
      sf += of[e]; sf2 += of[e] * of[e]; sb += obv[e]; sb2 += obv[e] * obv[e];
      br += r * k * (1.f + (a - 1.f) * ka[e]) * rk[e];
    }
#pragma unroll
    for (int o = 1; o < 8; o <<= 1) { sf += __shfl_xor(sf, o); sf2 += __shfl_xor(sf2, o); sb += __shfl_xor(sb, o); sb2 += __shfl_xor(sb2, o); br += __shfl_xor(br, o); }
    const float muf = sf * (1.f / 64.f), mub = sb * (1.f / 64.f);
    const float rsf = rsqrtf(fmaxf(sf2 * (1.f / 64.f) - muf * muf, 0.f) + 64e-5f);
    const float rsb = rsqrtf(fmaxf(sb2 * (1.f / 64.f) - mub * mub, 0.f) + 64e-5f);
    float y[8];
#pragma unroll
    for (int e = 0; e < 8; e++) {
      const int w = e >> 1;
      const float v = (e & 1) ? hi_bf(av[w]) : lo_bf(av[w]);
      const float g0 = (e & 1) ? hi_bf(ag0[w]) : lo_bf(ag0[w]);
      const float g1 = (e & 1) ? hi_bf(ag1[w]) : lo_bf(ag1[w]);
      const float bonus = br * v;
      y[e] = ((of[e] - muf) * rsf * lg[e] + lb[e] + bonus) * g0 + ((obv[e] - mub) * rsb * lg[e] + lb[e] + bonus) * g1;
    }
    *(uint4*)(G0 + off) = make_uint4(pack2(y[0], y[1]), pack2(y[2], y[3]), pack2(y[4], y[5]), pack2(y[6], y[7]));
  }
}

DI void phase_rw_out(const P& p, int layer, int hf, char* smem) {
  const int tidx = opaque_tid();
  const bf16_t* Y = (const bf16_t*)(p.ws + OFF_TR + TR_G0);
  const bf16_t* WO = (const bf16_t*)(p.ws + w_off(layer)) + W_WO;
  const int nlt = (layer == 3) ? 128 : 136;
  for (int t = blockIdx.x; t < xcd_rounds(nlt, 8) * (int)gridDim.x; t += gridDim.x) {
    int lt, nt_;
    if (!xcd_tile(t, nlt, 8, lt, nt_)) continue;
    const int n0 = nt_ * 128;
    const int gt = half_gtile(hf, lt);
    f32x16 acc[2][2];
    gemm_mainloop(Y + (size_t)lt * 128 * 1024, 1024, WO + (size_t)n0 * 1024, 1024, 1024, smem, acc);
    const float* gate = mods_ptr(p, layer, mod_row(gt * 128)) + 2048 + n0;
    float* xr = resid_row(p, gt * 128) + n0;
    EPI8_BEGIN
      resid_update(xr + (size_t)row * D + col, gate + col, v);
    EPI8_END
  }
}

DI void phase_mlp1(const P& p, int layer, char* smem) {
  const int tidx = opaque_tid();
  const bf16_t* H2 = (const bf16_t*)(p.ws + OFF_TR + TR_H2);
  const bf16_t* W1 = (const bf16_t*)(p.ws + w_off(layer)) + W_M1;
  bf16_t* HID = (bf16_t*)(p.ws + OFF_TR + TR_HID);
  const int nmt = (layer == 3) ? 256 : 272;
  const int ngrp = nmt / 16;
  (void)ngrp;
  for (int t = blockIdx.x; t < xcd_rounds(nmt, 32) * (int)gridDim.x; t += gridDim.x) {
    int gt, nt;
    if (!xcd_tile(t, nmt, 32, gt, nt)) continue;
    f32x16 acc[2][2];
    gemm_mainloop(H2 + (size_t)gt * 128 * 1024, 1024, W1 + (size_t)nt * 128 * 1024, 1024, 1024, smem, acc);
    EPI8_BEGIN
#pragma unroll
      for (int e = 0; e < 8; e++) { const float rl = fmaxf(v[e], 0.f); v[e] = rl * rl; }
      *(uint4*)(HID + (size_t)(gt * 128 + row) * 4096 + nt * 128 + col) = pack8(v);
    EPI8_END
  }
}
DI void phase_mlp2(const P& p, int layer, char* smem) {
  const int tidx = opaque_tid();
  const bf16_t* HID = (const bf16_t*)(p.ws + OFF_TR + TR_HID);
  const bf16_t* W2 = (const bf16_t*)(p.ws + w_off(layer)) + W_M2;
  const int nmt = (layer == 3) ? 256 : 272;
  for (int t = blockIdx.x; t < xcd_rounds(nmt, 8) * (int)gridDim.x; t += gridDim.x) {
    int gt, nt_;
    if (!xcd_tile(t, nmt, 8, gt, nt_)) continue;
    const int n0 = nt_ * 128;
    f32x16 acc[2][2];
    gemm_mainloop(HID + (size_t)gt * 128 * 4096, 4096, W2 + (size_t)n0 * 4096, 4096, 4096, smem, acc);
    const float* gate = mods_ptr(p, layer, mod_row(gt * 128)) + 5120 + n0;
    float* xr = resid_row(p, gt * 128) + n0;
    EPI8_BEGIN
      resid_update(xr + (size_t)row * D + col, gate + col, v);
    EPI8_END
  }
}

DI void phase_qkv(const P& p, int layer, char* smem) {
  const int tidx = opaque_tid();
  const bf16_t* H = (const bf16_t*)(p.ws + OFF_TR + TR_H);
  const bf16_t* WQ = (const bf16_t*)(p.ws + w_off(layer)) + W_QKV;
  bf16_t* Q = (bf16_t*)(p.ws + OFF_TR + TR_Q);
  bf16_t* Kb = (bf16_t*)(p.ws + OFF_TR + TR_KK);
  bf16_t* VT = (bf16_t*)(p.ws + OFF_TR + TR_VT);
  const float* cosT = (const float*)(p.ws + OFF_MISC);
  const float* sinT = cosT + 1024;
  for (int t = blockIdx.x; t < xcd_rounds(272, 24) * (int)gridDim.x; t += gridDim.x) {
    int gt, nt;
    if (!xcd_tile(t, 272, 24, gt, nt)) continue;
    f32x16 acc[2][2];
    gemm_mainloop(H + (size_t)gt * 128 * 1024, 1024, WQ + (size_t)nt * 128 * 1024, 1024, 1024, smem, acc);
    const bool lat = gt < 256;
    const int b = lat ? gt / 32 : (gt - 256) / 2;
    const int t0 = lat ? (gt % 32) * 128 : (gt - 256) % 2 * 128;
    const int tq0 = lat ? t0 : SL + t0;
    const int typ = nt / 8, h = nt % 8;
    if (typ < 2) {
      bf16_t* dst = typ == 0 ? Q : Kb;
      const float qs = typ == 0 ? 0.125f * 1.44269504088896f : 1.f;
      float kmx = 0.f;
      EPI8_BEGIN
        const int sidx = col >> 6, d0 = col & 63;
        if (lat) {
          const float4 pa = *(const float4*)(es + row * EST + (col ^ 16));
          const float4 pb = *(const float4*)(es + row * EST + (col ^ 16) + 4);
          const float pr[8] = {pa.x, pa.y, pa.z, pa.w, pb.x, pb.y, pb.z, pb.w};
          const int tt = t0 + row;
          const int pos = (d0 < 32) ? (tt >> 6) : (tt & 63);
          const float4 ca = *(const float4*)(cosT + pos * 16 + (d0 & 8)), cb = *(const float4*)(cosT + pos * 16 + (d0 & 8) + 4);
          const float4 sa = *(const float4*)(sinT + pos * 16 + (d0 & 8)), sb = *(const float4*)(sinT + pos * 16 + (d0 & 8) + 4);
          const float cs[8] = {ca.x, ca.y, ca.z, ca.w, cb.x, cb.y, cb.z, cb.w};
          const float sn[8] = {sa.x, sa.y, sa.z, sa.w, sb.x, sb.y, sb.z, sb.w};
          const float sgn = (d0 & 16) ? 1.f : -1.f;
#pragma unroll
          for (int e = 0; e < 8; e++) v[e] = v[e] * cs[e] + sgn * pr[e] * sn[e];
        }
#pragma unroll
        for (int e = 0; e < 8; e++) v[e] *= qs;
        const uint4 pk_ = pack8(v);
        *(uint4*)(dst + ((size_t)((b * 8 + h) * 2 + sidx) * TK + tq0 + row) * 64 + d0) = pk_;
        if (typ == 1) {
          float rv_[8];
          unpack8(pk_, rv_);
          float ssq_ = 0.f;
#pragma unroll
          for (int e = 0; e < 8; e++) ssq_ += rv_[e] * rv_[e];
          ssq_ += __shfl_xor(ssq_, 1); ssq_ += __shfl_xor(ssq_, 2); ssq_ += __shfl_xor(ssq_, 4);
          kmx = fmaxf(kmx, ssq_);
        }
      EPI8_END
      if (typ == 1) {
        kmx = fmaxf(kmx, __shfl_xor(kmx, 16));
        kmx = fmaxf(kmx, __shfl_xor(kmx, 32));
        if ((tidx & 55) == 0)
          atomicMax((unsigned*)(p.ws + OFF_MISC) + 4096 + (layer >> 1) * 128 + (b * 8 + h) * 2 + ((tidx >> 3) & 1), __float_as_uint(kmx));
      }
    } else {
      float* es = (float*)smem;
      acc_to_lds(acc, es);
      __syncthreads();
      for (int pass = 0; pass < 8; pass++) {
        const int d = tidx & 127, tg = pass * 2 + (tidx >> 7);
        float v[8];
#pragma unroll
        for (int e = 0; e < 8; e++) v[e] = es[(tg * 8 + e) * EST + d];
        *(uint4*)(VT + ((size_t)(b * 8 + h) * 128 + d) * TK + tq0 + tg * 8) = pack8(v);
      }
      __syncthreads();
    }
  }
}

typedef _Float16 hv2 __attribute__((ext_vector_type(2)));
DI unsigned packh2(float a, float b) { hv2 r = {(_Float16)a, (_Float16)b}; return __builtin_bit_cast(unsigned, r); }
DI float lo_h(unsigned u) { hv2 r = __builtin_bit_cast(hv2, u); return (float)r[0]; }
DI float hi_h(unsigned u) { hv2 r = __builtin_bit_cast(hv2, u); return (float)r[1]; }

DI void phase_attn(const P& p, int layer, char* smem) {
  const int tidx = opaque_tid();
  const int j = layer / 2;
  const bool ctxq = layer != 3;
  const bf16_t* Q = (const bf16_t*)(p.ws + OFF_TR + TR_Q);
  const bf16_t* Kb = (const bf16_t*)(p.ws + OFF_TR + TR_KK);
  const bf16_t* VT = (const bf16_t*)(p.ws + OFF_TR + TR_VT);
  bf16_t* O = (bf16_t*)(p.ws + OFF_TR + TR_H);
  const float lam = ((const float*)(p.ws + OFF_MISC))[2048 + j];
  const float* kmax2 = (const float*)(p.ws + OFF_MISC) + 4096 + j * 128;
  const float oml = 1.f - lambda_init(layer);
  const float* subg = p.da_subln_g + (size_t)j * 128;
  constexpr int LDV = 68;
  bf16_t* sK = (bf16_t*)smem;
  bf16_t* sV = sK + 2 * 64 * LDT;
  const int tid = tidx, lane = tid & 63, w = tid >> 6, g = lane >> 5, l31 = lane & 31;
  const int nitems = 2048 + (ctxq ? 128 : 0);
  const int spx = gridDim.x >> 3, gpr = spx >> 5;
  const int lat_rounds = 64 / (8 * gpr);
  for (int it0 = blockIdx.x; it0 < lat_rounds * (int)gridDim.x + (ctxq ? 128 : 0); it0 += gridDim.x) {
    int item;
    if (it0 < lat_rounds * (int)gridDim.x) {
      const int r = it0 % (int)gridDim.x, round = it0 / (int)gridDim.x;
      const int xcd = r & 7, li = r >> 3;
      const int bh = (round * 8 + xcd) * gpr + (li >> 5);
      item = bh * 32 + (li & 31);
    } else {
      item = 2048 + (it0 - lat_rounds * (int)gridDim.x);
    }
    (void)nitems;
    int b, h, q0, kbeg, ntiles;
    if (item < 2048) { b = item >> 8; h = (item >> 5) & 7; q0 = (item & 31) * 128; kbeg = 0; ntiles = TK / 64; }
    else { const int it = item - 2048; b = it >> 4; h = (it >> 1) & 7; q0 = SL + (it & 1) * 128; kbeg = SL; ntiles = CL / 64; }
    const bf16_t* Vp0 = VT + (size_t)(b * 8 + h) * 128 * TK;
    const int tq = q0 + w * 32 + l31;
    const size_t grow = tq < SL ? (size_t)b * SL + tq : (size_t)NLAT + (size_t)b * CL + (tq - SL);
    bf16_t* op = O + grow * 1024 + h * 128;
    for (int s = 0; s < 2; s++) {
      const bf16_t* Kp0 = Kb + (size_t)((b * 8 + h) * 2 + s) * TK * 64;
      const bf16_t* Qp = Q + ((size_t)((b * 8 + h) * 2 + s) * TK + tq) * 64 + g * 8;
      bf16x8 qf[4];
      float qss = 0.f;
#pragma unroll
      for (int kk = 0; kk < 4; kk++) {
        const uint4 u = *(const uint4*)(Qp + kk * 16);
        qf[kk] = __builtin_bit_cast(bf16x8, u);
        float qv[8];
        unpack8(u, qv);
#pragma unroll
        for (int e = 0; e < 8; e++) qss += qv[e] * qv[e];
      }
      qss += __shfl_xor(qss, 32);
      const float nmq = -sqrtf(qss * kmax2[(b * 8 + h) * 2 + s]);
      f32x16 o[4];
#pragma unroll
      for (int db = 0; db < 4; db++)
#pragma unroll
        for (int r = 0; r < 16; r++) o[db][r] = 0.f;
      float l = 0.f;
      uint4 rk0, rk1, rv0, rv1, rv2, rv3;
      const unsigned kvo = (unsigned)((tid >> 3) * 64 + (tid & 7) * 8);
      const unsigned vvo = (unsigned)((tid >> 3) * TK + (tid & 7) * 8);
      const unsigned sko = (unsigned)((tid >> 3) * LDT + (tid & 7) * 8);
      const unsigned svo = (unsigned)((tid >> 3) * LDV + (tid & 7) * 8);
#define ISSUE_KV(kt_)                                                             \
      {                                                                           \
        const bf16_t* kb_ = Kp0 + (size_t)(kbeg + (kt_) * 64) * 64;               \
        const bf16_t* vb_ = Vp0 + (kbeg + (kt_) * 64);                            \
        unsigned kvo_ = kvo, vvo_ = vvo;                                          \
        asm volatile("" : "+v"(kvo_), "+v"(vvo_));     \
        rk0 = *(const uint4*)(kb_ + kvo_);                                        \
        rk1 = *(const uint4*)(kb_ + (kvo_ + 32u * 64u));                          \
        rv0 = *(const uint4*)(vb_ + vvo_);                                        \
        rv1 = *(const uint4*)(vb_ + (vvo_ + 32u * (unsigned)TK));                 \
        rv2 = *(const uint4*)(vb_ + (vvo_ + 64u * (unsigned)TK));                 \
        rv3 = *(const uint4*)(vb_ + (vvo_ + 96u * (unsigned)TK));                 \
      }
#define ST_V(ptr_, r_) { *(uint2*)(ptr_) = make_uint2(r_.x, r_.y); *(uint2*)((ptr_) + 4) = make_uint2(r_.z, r_.w); }
#define STAGE_KV(buf_)                                                            \
      {                                                                           \
        bf16_t* ks_ = sK + (buf_) * 64 * LDT + sko;                               \
        bf16_t* vs_ = sV + (buf_) * 128 * LDV + svo;                              \
        *(uint4*)(ks_) = rk0;                                                     \
        *(uint4*)(ks_ + 32 * LDT) = rk1;                                          \
        ST_V(vs_, rv0); ST_V(vs_ + 32 * LDV, rv1); ST_V(vs_ + 64 * LDV, rv2); ST_V(vs_ + 96 * LDV, rv3); \
      }
      __syncthreads();
      ISSUE_KV(0);
      STAGE_KV(0);
      __syncthreads();
      for (int kt = 0; kt < ntiles; kt++) {
        const int buf = kt & 1;
        const bool more = kt + 1 < ntiles;
        if (more) ISSUE_KV(kt + 1);
        __builtin_amdgcn_sched_barrier(0);
        const bf16_t* kS = sK + buf * 64 * LDT;
        const bf16_t* vS = sV + buf * 128 * LDV;
#pragma unroll
        for (int kb = 0; kb < 2; kb++) {
          bf16x8 kf[4];
#pragma unroll
          for (int kk = 0; kk < 4; kk++) kf[kk] = *(const bf16x8*)(kS + (kb * 32 + l31) * LDT + kk * 16 + g * 8);
          __builtin_amdgcn_sched_barrier(0);
          f32x16 st;
#pragma unroll
          for (int r = 0; r < 16; r++) st[r] = nmq;
#pragma unroll
          for (int kk = 0; kk < 4; kk++) st = MFMA32(kf[kk], qf[kk], st);
          float ls = 0.f;
          bf16x8 pk[2];
#pragma unroll
          for (int hh = 0; hh < 2; hh++) {
            float e[8];
#pragma unroll
            for (int i = 0; i < 8; i++) { e[i] = __builtin_amdgcn_exp2f(st[hh * 8 + i]); ls += e[i]; }
            const uint4 u = make_uint4(pack2(e[0], e[1]), pack2(e[2], e[3]), pack2(e[4], e[5]), pack2(e[6], e[7]));
            pk[hh] = __builtin_bit_cast(bf16x8, u);
          }
          l += ls;
#pragma unroll
          for (int hh = 0; hh < 2; hh++) {
            uint4 vf[4];
#pragma unroll
            for (int db = 0; db < 4; db++) {
              const bf16_t* vp = vS + (db * 32 + l31) * LDV + kb * 32 + hh * 16 + 4 * g;
              const uint2 lo = *(const uint2*)vp;
              const uint2 hi = *(const uint2*)(vp + 8);
              vf[db] = make_uint4(lo.x, lo.y, hi.x, hi.y);
            }
            __builtin_amdgcn_sched_barrier(0);
#pragma unroll
            for (int db = 0; db < 4; db++) o[db] = MFMA32(__builtin_bit_cast(bf16x8, vf[db]), pk[hh], o[db]);
          }
        }
        __builtin_amdgcn_sched_barrier(0);
        if (more) STAGE_KV(buf ^ 1);
        __syncthreads();
      }
      const float lt = l + __shfl_xor(l, 32);
      if (s == 0) {
        const float inv = 1.f / lt;
#pragma unroll
        for (int db = 0; db < 4; db++)
#pragma unroll
          for (int rq = 0; rq < 4; rq++) {
            const int d = db * 32 + 8 * rq + 4 * g;
            *(uint2*)(op + d) = make_uint2(packh2(o[db][4 * rq] * inv, o[db][4 * rq + 1] * inv), packh2(o[db][4 * rq + 2] * inv, o[db][4 * rq + 3] * inv));
          }
      } else {
        const float inv = lam / lt;
        float ssq = 0.f;
#pragma unroll
        for (int db = 0; db < 4; db++)
#pragma unroll
          for (int rq = 0; rq < 4; rq++) {
            const int d = db * 32 + 8 * rq + 4 * g;
            const uint2 u0 = *(const uint2*)(op + d);
            const float a0 = lo_h(u0.x) - o[db][4 * rq] * inv, a1 = hi_h(u0.x) - o[db][4 * rq + 1] * inv;
            const float a2 = lo_h(u0.y) - o[db][4 * rq + 2] * inv, a3 = hi_h(u0.y) - o[db][4 * rq + 3] * inv;
            o[db][4 * rq] = a0; o[db][4 * rq + 1] = a1; o[db][4 * rq + 2] = a2; o[db][4 * rq + 3] = a3;
            ssq += a0 * a0 + a1 * a1 + a2 * a2 + a3 * a3;
          }
        ssq += __shfl_xor(ssq, 32);
        const float rs = rsqrtf(ssq * (1.f / 128.f) + 1e-5f) * oml;
#pragma unroll
        for (int db = 0; db < 4; db++)
#pragma unroll
          for (int rq = 0; rq < 4; rq++) {
            const int d = db * 32 + 8 * rq + 4 * g;
            const float4 sg = *(const float4*)(subg + d);
            *(uint2*)(op + d) = make_uint2(pack2(o[db][4 * rq] * rs * sg.x, o[db][4 * rq + 1] * rs * sg.y),
                                           pack2(o[db][4 * rq + 2] * rs * sg.z, o[db][4 * rq + 3] * rs * sg.w));
          }
      }
    }
  }
}

DI void phase_at_out(const P& p, int layer, char* smem) {
  const int tidx = opaque_tid();
  const bf16_t* O = (const bf16_t*)(p.ws + OFF_TR + TR_H);
  const bf16_t* WO = (const bf16_t*)(p.ws + w_off(layer)) + W_WO;
  const int nmt = (layer == 3) ? 256 : 272;
  for (int t = blockIdx.x; t < xcd_rounds(nmt, 8) * (int)gridDim.x; t += gridDim.x) {
    int gt, nt_;
    if (!xcd_tile(t, nmt, 8, gt, nt_)) continue;
    const int n0 = nt_ * 128;
    f32x16 acc[2][2];
    gemm_mainloop(O + (size_t)gt * 128 * 1024, 1024, WO + (size_t)n0 * 1024, 1024, 1024, smem, acc);
    const float* gate = mods_ptr(p, layer, mod_row(gt * 128)) + 2048 + n0;
    float* xr = resid_row(p, gt * 128) + n0;
    EPI8_BEGIN
      resid_update(xr + (size_t)row * D + col, gate + col, v);
    EPI8_END
  }
}

DI void phase_final(const P& p) {
  const int tidx = opaque_tid();
  const int lane = tidx & 63, wv = tidx >> 6;
  for (int row = blockIdx.x * 4 + wv; row < NLAT; row += gridDim.x * 4) {
    float* xr = p.out + (size_t)row * D;
    float4 v[4];
    float ss = 0.f;
#pragma unroll
    for (int jx = 0; jx < 4; jx++) { v[jx] = *(const float4*)(xr + jx * 256 + lane * 4); ss += v[jx].x * v[jx].x + v[jx].y * v[jx].y + v[jx].z * v[jx].z + v[jx].w * v[jx].w; }
    ss = wave_sum(ss);
    const float rs = rsqrtf(ss * (1.f / 1024.f) + 1e-6f);
#pragma unroll
    for (int jx = 0; jx < 4; jx++) {
      const float4 g = *(const float4*)(p.final_g + jx * 256 + lane * 4);
      *(float4*)(xr + jx * 256 + lane * 4) = make_float4(v[jx].x * rs * g.x, v[jx].y * rs * g.y, v[jx].z * rs * g.z, v[jx].w * rs * g.w);
    }
  }
}

#define XB_TMO      128
#define XB_XCNT(j)  (256  + 64 * (j))
#define XB_XSUB(j)  (1280 + 64 * (j))
#define XB_XGEN(j)  (2304 + 64 * (j))
#define XB_TOP      3328
#define XB_TOPGEN   3392
#define XCD_BAR_WORDS 3456
#define XB_SPIN_CAP (1u << 22)
#define LAS __attribute__((address_space(3)))
DI unsigned xb_ld(unsigned* p) { return __hip_atomic_load(p, __ATOMIC_RELAXED, __HIP_MEMORY_SCOPE_AGENT); }
DI unsigned xb_add(unsigned* p, unsigned v) { return __hip_atomic_fetch_add(p, v, __ATOMIC_RELAXED, __HIP_MEMORY_SCOPE_AGENT); }
DI unsigned xb_xcc_id() { return (unsigned)__builtin_amdgcn_s_getreg((3 << 11) | 20) & 0xFu; }
#define XB_SPIN(cond, bar) do { unsigned _sp = 0; while (cond) { __builtin_amdgcn_s_sleep(1); \
    if ((++_sp & 255u) == 0u) { if (xb_ld(&(bar)[XB_TMO])) break; if (_sp > XB_SPIN_CAP) { atomicAdd(&(bar)[XB_TMO], 1u); break; } } } } while (0)
struct XcdBarrier { unsigned* bar; unsigned x; volatile LAS unsigned* st; };
DI XcdBarrier xcd_barrier_post(unsigned* bar, volatile LAS unsigned* st) {
  XcdBarrier b; b.bar = bar; b.x = xb_xcc_id(); b.st = st;
  if (threadIdx.x == 0) (void)xb_add(&bar[XB_XCNT(b.x)], 1u);
  return b;
}
DI void xcd_barrier_complete(unsigned* bar, unsigned x, unsigned& nloc, unsigned& nx) {
  const unsigned G = gridDim.x * gridDim.y * gridDim.z;
  unsigned sum, cnt, mine, sp = 0u;
  for (;;) {
    sum = 0u; cnt = 0u; mine = 0u;
#pragma unroll
    for (unsigned j = 0; j < 16; ++j) { const unsigned c = xb_ld(&bar[XB_XCNT(j)]); sum += c; cnt += (c > 0u) ? 1u : 0u; mine = (j == x) ? c : mine; }
    if (sum == G) break;
    __builtin_amdgcn_s_sleep(1);
    if ((++sp & 255u) == 0u) { if (xb_ld(&bar[XB_TMO])) break; if (sp > XB_SPIN_CAP) { atomicAdd(&bar[XB_TMO], 1u); break; } }
  }
  nloc = mine > 0u ? mine : 1u; nx = cnt > 0u ? cnt : 1u;
}
DI void xcd_barrier(const XcdBarrier& b) {
  asm volatile("s_waitcnt vmcnt(0)" ::: "memory");
  __syncthreads();
  if (threadIdx.x == 0) {
    unsigned* bar = b.bar;
    __builtin_amdgcn_s_waitcnt(0);
    unsigned nloc = b.st[0], nx = b.st[1];
    if (nloc == 0u) { xcd_barrier_complete(bar, b.x, nloc, nx); b.st[0] = nloc; b.st[1] = nx; }
    const unsigned old = xb_add(&bar[XB_XSUB(b.x)], 1u);
    const unsigned gen = old / nloc;
    if (old + 1u == (gen + 1u) * nloc) {
      __builtin_amdgcn_fence(__ATOMIC_RELEASE, "agent");
      asm volatile("s_waitcnt vmcnt(0)" ::: "memory");
      const unsigned og = xb_add(&bar[XB_TOP], 1u);
      const unsigned tg = og / nx;
      if (og + 1u == (tg + 1u) * nx) xb_add(&bar[XB_TOPGEN], 1u);
      else XB_SPIN(xb_ld(&bar[XB_TOPGEN]) == tg, bar);
      __builtin_amdgcn_fence(__ATOMIC_ACQUIRE, "agent");
      xb_add(&bar[XB_XGEN(b.x)], 1u);
      asm volatile("s_waitcnt vmcnt(0)" ::: "memory");
    } else {
      XB_SPIN(xb_ld(&bar[XB_XGEN(b.x)]) == gen, bar);
      __builtin_amdgcn_fence(__ATOMIC_ACQUIRE, "agent");
      asm volatile("s_waitcnt vmcnt(0)" ::: "memory");
    }
  }
  __syncthreads();
}
constexpr size_t OFF_BAR = OFF_MISC + 65536;

typedef __attribute__((address_space(1))) const float GCF;
typedef __attribute__((address_space(1))) float GF;
typedef __attribute__((address_space(1))) char GC;
DI unsigned long long lds_word(const unsigned long long* tbl, int i) {
  int z = i;
  asm volatile("" : "+v"(z));
  const unsigned long long v = tbl[z];
  const unsigned lo = __builtin_amdgcn_readfirstlane((unsigned)v), hi = __builtin_amdgcn_readfirstlane((unsigned)(v >> 32));
  return ((unsigned long long)hi << 32) | lo;
}
DI void load_params(P& q, const unsigned long long* tbl) {
  const float** fp = (const float**)&q;
#pragma unroll
  for (int i = 0; i < 36; i++) fp[i] = (const float*)(GCF*)lds_word(tbl, i);
  q.out = (float*)(GF*)lds_word(tbl, 36);
  q.ws = (char*)(GC*)lds_word(tbl, 37);
  q.only = 0;
  q.pad = 0;
}
__global__ void __launch_bounds__(256, 2) mega(P p) {
  __shared__ __attribute__((aligned(16))) char smem[73728];
  __shared__ unsigned long long s_tbl[40];
  {
#if defined(__HIP_DEVICE_COMPILE__)
    typedef __attribute__((address_space(4))) const unsigned long long KW;
    KW* kp = (KW*)__builtin_amdgcn_kernarg_segment_ptr();
    if (threadIdx.x < 39) s_tbl[threadIdx.x] = kp[threadIdx.x];
#endif
    __syncthreads();
  }
  const int only = (int)(unsigned)lds_word(s_tbl, 38);
  cg::grid_group grid = cg::this_grid();
  __shared__ uint4 xb_words;
  if (threadIdx.x == 0) xb_words = make_uint4(0u, 0u, 0u, 0u);
  __syncthreads();
  XcdBarrier xb;
  {
    P q;
    load_params(q, s_tbl);
    xb = xcd_barrier_post((unsigned*)(q.ws + OFF_BAR), (volatile LAS unsigned*)&xb_words);
  }
  int step = 0;
#define GSYNC() { if (step == 1) grid.sync(); else xcd_barrier(xb); }
#define STEP(body)                                   \
  {                                                  \
    if (only < 0 || only == step) {              \
      P q;                                           \
      load_params(q, s_tbl);                         \
      body;                                          \
    }                                                \
    step++;                                          \
    if (only < 0) GSYNC();                         \
  }
#ifndef DUP
#define DUP 0
#endif
#define STEPD(id, body)                              \
  {                                                  \
    if (only < 0 || only == step) {                  \
      P q;                                           \
      load_params(q, s_tbl);                         \
      body;                                          \
      if (DUP == id) { __syncthreads(); body; }      \
    }                                                \
    step++;                                          \
    if (only < 0) GSYNC();                           \
  }
  STEP(phase_init(q, smem); __syncthreads(); phase_conv(q, 0, smem, blockIdx.x, gridDim.x));
  for (int layer = 0; layer < 4; layer++) {
    if ((layer & 1) == 0) {
      for (int hf = 0; hf < 2; hf++) {
        STEP(phase_prep(q, layer, 0, hf, true, (bf16_t*)(q.ws + OFF_TR + TR_HX), 2048, false));
        STEPD(3, phase_t1(q, smem));
        STEPD(4, phase_feat(q, layer, hf, smem));
        STEPD(5, phase_scan(q, layer, smem);
              if (hf == 0) { __syncthreads(); phase_conv(q, layer + 1, smem, gridDim.x > 256 ? (int)blockIdx.x - 256 : (int)blockIdx.x, gridDim.x > 256 ? (int)gridDim.x - 256 : (int)gridDim.x); });
        STEP(phase_combine(q, layer));
        STEP(phase_rw_out(q, layer, hf, smem));
      }
    } else {
      STEP(phase_prep(q, layer, 0, -1, false, (bf16_t*)(q.ws + OFF_TR + TR_H), 1024, false);
           if (layer + 1 < 4) { __syncthreads(); phase_conv(q, layer + 1, smem, blockIdx.x, gridDim.x); });
      STEPD(7, phase_qkv(q, layer, smem));
      STEPD(8, phase_attn(q, layer, smem));
      STEP(phase_at_out(q, layer, smem));
    }
    STEP(phase_prep(q, layer, 1, -1, false, (bf16_t*)(q.ws + OFF_TR + TR_H2), 1024, layer == 3));
    STEPD(9, phase_mlp1(q, layer, smem));
    STEP(phase_mlp2(q, layer, smem));
  }
  STEP(phase_final(q));
}

#ifndef MULTI_LAUNCH
#define MULTI_LAUNCH 0
#endif
constexpr int NSTEPS = 1 + 2 * (12 + 3) + 2 * (4 + 3) + 1;

extern "C" void kernel_launch(void* const* d_in, const int* in_sizes, int n_in, void* d_out, int out_size, void* d_ws, size_t ws_size,
                              hipStream_t stream) {
  static int grid_blocks = 0;
  if (!grid_blocks) {
    int dev = 0, cus = 0, per_cu = 0;
    hipGetDevice(&dev);
    hipDeviceGetAttribute(&cus, hipDeviceAttributeMultiprocessorCount, dev);
    hipOccupancyMaxActiveBlocksPerMultiprocessor(&per_cu, mega, 256, 0);
    if (per_cu < 1) per_cu = 1;
    if (per_cu > 2) per_cu = 2;
    grid_blocks = cus * per_cu;
  }
  P p{};
  const float** fp = (const float**)&p;
  for (int i = 0; i < 36; i++) fp[i] = (const float*)d_in[i];
  p.out = (float*)d_out;
  p.ws = (char*)d_ws;
  p.pad = 0;
#if MULTI_LAUNCH
  for (int s = 0; s < NSTEPS; s++) {
    p.only = s;
    void* args[] = {&p};
    hipError_t e = hipLaunchCooperativeKernel((void*)mega, dim3(grid_blocks), dim3(256), args, 0, stream);
    if (e != hipSuccess) { fprintf(stderr, "launch failed: %s\n", hipGetErrorString(e)); break; }
  }
#else
  p.only = -1;
  hipMemsetAsync((char*)d_ws + OFF_BAR, 0, XCD_BAR_WORDS * 4, stream);
  void* args[] = {&p};
  hipError_t e = hipLaunchCooperativeKernel((void*)mega, dim3(grid_blocks), dim3(256), args, 0, stream);
  if (e != hipSuccess) fprintf(stderr, "cooperative launch failed: %s (grid %d)\n", hipGetErrorString(e), grid_blocks);
#endif
}
```

```cpp
#include <hip/hip_runtime.h>
#include <hip/hip_cooperative_groups.h>
#include <cstdio>
namespace cg = cooperative_groups;

#define DI __device__ __forceinline__
typedef unsigned short bf16_t;
using bf16x8 = __attribute__((ext_vector_type(8))) short;
using f32x16 = __attribute__((ext_vector_type(16))) float;
typedef __bf16 bfv2 __attribute__((ext_vector_type(2)));
typedef float fv2 __attribute__((ext_vector_type(2)));
#define MFMA32(a, b, c) __builtin_amdgcn_mfma_f32_32x32x16_bf16((a), (b), (c), 0, 0, 0)

constexpr int D = 1024, NB = 8, SL = 4096, CL = 256;
constexpr int NLAT = NB * SL, NCTX = NB * CL, NTOK = NLAT + NCTX;
constexpr int HROWS = NTOK / 2;
constexpr int TK = SL + CL;
constexpr size_t MiB = 1048576;
constexpr size_t OFF_W2 = 476 * MiB;
constexpr size_t OFF_W = 0, OFF_XC = 36 * MiB, OFF_MODS = 44 * MiB, OFF_MISC = 45 * MiB, OFF_VF = 46 * MiB, OFF_TR = 114 * MiB;
constexpr size_t W_RKV = 0;
constexpr size_t W_L1 = W_RKV + 3072ull * 2048;
constexpr size_t W_W2 = W_L1 + 640ull * 2048;
constexpr size_t W_A2 = W_W2 + 2ull * 65536;
constexpr size_t W_G2 = W_A2 + 65536;
constexpr size_t W_V2 = W_G2 + 2ull * 196608;
constexpr size_t W_WO = W_V2 + 65536;
constexpr size_t W_M1 = W_WO + 1048576;
constexpr size_t W_M2 = W_M1 + 4194304;
constexpr size_t W_QKV = 0;
constexpr size_t HALF_ARR = (size_t)HROWS * 1024 * 2;
constexpr size_t TR_HX = 0;
constexpr size_t TR_T1 = 2 * HALF_ARR;
constexpr size_t TR_R = TR_T1 + (size_t)HROWS * 640 * 2;
constexpr size_t TR_K = TR_R + HALF_ARR, TR_V = TR_K + HALF_ARR, TR_A = TR_V + HALF_ARR;
constexpr size_t TR_WL0 = TR_A + HALF_ARR, TR_WL1 = TR_WL0 + HALF_ARR, TR_G0 = TR_WL1 + HALF_ARR, TR_G1 = TR_G0 + HALF_ARR;
constexpr size_t FULL_ARR = (size_t)NTOK * 1024 * 2;
constexpr size_t TR_H = 0, TR_Q = FULL_ARR, TR_KK = 2 * FULL_ARR, TR_VT = 3 * FULL_ARR;
constexpr size_t TR_H2 = 0, TR_HID = FULL_ARR;

struct P {
  const float *x, *c, *ctx, *c_ctx, *ada_w, *ada_b, *norm_g, *final_g;
  const float *rw_mix, *rw_w_rkv, *rw_w0, *rw_w1, *rw_w2, *rw_a0, *rw_a1, *rw_a2, *rw_g1, *rw_g2, *rw_kk, *rw_ka, *rw_rk, *rw_ln_g, *rw_ln_b, *rw_w_o, *rw_v0, *rw_v1, *rw_v2;
  const float *da_w_qkv, *da_w_o, *da_lq1, *da_lk1, *da_lq2, *da_lk2, *da_subln_g, *mlp_w1, *mlp_w2;
  float* out;
  char* ws;
  int only;
  int pad;
};

DI float bf2f(bf16_t h) { return __uint_as_float(((unsigned)h) << 16); }
DI unsigned pack2(float a, float b) { fv2 v = {a, b}; bfv2 r = __builtin_convertvector(v, bfv2); return __builtin_bit_cast(unsigned, r); }
DI bf16_t f2bf(float a) { return (bf16_t)(pack2(a, 0.f) & 0xffffu); }
DI float lo_bf(unsigned u) { return __uint_as_float(u << 16); }
DI float hi_bf(unsigned u) { return __uint_as_float(u & 0xffff0000u); }
DI float sigmoidf_(float x) { return 1.f / (1.f + __expf(-x)); }
DI float wave_sum(float v) {
#pragma unroll
  for (int o = 32; o > 0; o >>= 1) v += __shfl_xor(v, o);
  return v;
}
template <int N> DI float ror_add(float x) { return x + __builtin_bit_cast(float, __builtin_amdgcn_mov_dpp(__builtin_bit_cast(int, x), 0x120 + N, 0xf, 0xf, true)); }
DI float rowsum16(float x) { x = ror_add<8>(x); x = ror_add<4>(x); x = ror_add<2>(x); x = ror_add<1>(x); return x; }

DI int opaque_tid() { int t = threadIdx.x; asm volatile("" : "+v"(t)); return t; }
DI float* resid_row(const P& p, int gr) { return gr < NLAT ? p.out + (size_t)gr * D : (float*)(p.ws + OFF_XC) + (size_t)(gr - NLAT) * D; }
DI int mod_row(int gr) { return gr < NLAT ? gr / SL : 8; }
DI const float* mods_ptr(const P& p, int layer, int mrow) { return (const float*)(p.ws + OFF_MODS) + ((size_t)layer * 9 + mrow) * 6144; }
DI int half_gtile(int hf, int lt) { return lt < 128 ? hf * 128 + lt : 256 + hf * 8 + (lt - 128); }
DI int first_tile(int base) { int g = gridDim.x; int s = (int)blockIdx.x - (base % g); if (s < 0) s += g; return s; }
DI size_t w_off(int layer) { return (layer & 1) ? OFF_W2 : OFF_W; }
DI float lambda_init(int layer) { return 0.8f - 0.6f * expf(-0.3f * (float)layer); }

DI void phase_init(const P& p, char* smem) {
  const int tidx = opaque_tid();
  const int tid = tidx;
  float* sc = (float*)smem;
  float* mods = (float*)(p.ws + OFF_MODS);
  for (int item = blockIdx.x; item < 96; item += gridDim.x) {
    const int layer = item / 24, cb = item % 24;
    __syncthreads();
    for (int i = tid; i < 9 * 1024; i += 256) {
      int r = i >> 10, k = i & 1023;
      float v = r < 8 ? p.c[r * 1024 + k] : p.c_ctx[k];
      sc[i] = v / (1.f + expf(-v));
    }
    __syncthreads();
    const int w = tid >> 6, q = tid & 63;
    float4 acc[9];
#pragma unroll
    for (int r = 0; r < 9; r++) acc[r] = make_float4(0.f, 0.f, 0.f, 0.f);
    const float* wp = p.ada_w + (size_t)layer * 1024 * 6144 + cb * 256 + q * 4;
    for (int k = w * 256; k < w * 256 + 256; k++) {
      float4 wv = *(const float4*)(wp + (size_t)k * 6144);
#pragma unroll
      for (int r = 0; r < 9; r++) {
        float s = sc[r * 1024 + k];
        acc[r].x += s * wv.x; acc[r].y += s * wv.y; acc[r].z += s * wv.z; acc[r].w += s * wv.w;
      }
    }
    __syncthreads();
    float4* red = (float4*)smem;
#pragma unroll
    for (int r = 0; r < 9; r++) red[(w * 9 + r) * 64 + q] = acc[r];
    __syncthreads();
    for (int i = tid; i < 9 * 64; i += 256) {
      int r = i / 64, qq = i % 64;
      float4 s0 = red[(0 * 9 + r) * 64 + qq], s1 = red[(1 * 9 + r) * 64 + qq], s2 = red[(2 * 9 + r) * 64 + qq], s3 = red[(3 * 9 + r) * 64 + qq];
      float4 bb = *(const float4*)(p.ada_b + layer * 6144 + cb * 256 + qq * 4);
      float4 o = make_float4(s0.x + s1.x + s2.x + s3.x + bb.x, s0.y + s1.y + s2.y + s3.y + bb.y, s0.z + s1.z + s2.z + s3.z + bb.z, s0.w + s1.w + s2.w + s3.w + bb.w);
      *(float4*)(mods + ((size_t)layer * 9 + r) * 6144 + cb * 256 + qq * 4) = o;
    }
  }
  if (blockIdx.x == gridDim.x - 1) {
    float* misc = (float*)(p.ws + OFF_MISC);
    for (int i = tid; i < 1024; i += 256) {
      int pos = i / 16, f = i % 16;
      float inv = powf(10000.f, -(float)f / 16.f);
      float ang = (float)pos * inv;
      misc[i] = cosf(ang);
      misc[1024 + i] = sinf(ang);
    }
    misc[4096 + tid] = 0.f;
    if (tid < 2) {
      float s1 = 0.f, s2 = 0.f;
      for (int k = 0; k < 64; k++) { s1 += p.da_lq1[tid * 64 + k] * p.da_lk1[tid * 64 + k]; s2 += p.da_lq2[tid * 64 + k] * p.da_lk2[tid * 64 + k]; }
      misc[2048 + tid] = expf(s1) - expf(s2) + lambda_init(2 * tid + 1);
    }
  }
  const size_t n4 = (size_t)NLAT * D / 4, c4 = (size_t)NCTX * D / 4;
  const float4* xs = (const float4*)p.x; float4* xo = (float4*)p.out;
  for (size_t i = (size_t)blockIdx.x * 256 + tid; i < n4; i += (size_t)gridDim.x * 256) xo[i] = xs[i];
  const float4* cs = (const float4*)p.ctx; float4* co = (float4*)(p.ws + OFF_XC);
  for (size_t i = (size_t)blockIdx.x * 256 + tid; i < c4; i += (size_t)gridDim.x * 256) co[i] = cs[i];
}

DI void conv_mat(const float* __restrict__ src, int K, int N, bf16_t* __restrict__ dst, int ldd, int koff, const float* __restrict__ scale,
                 int Kp, int Np, float* sm, int& base, int vb, int vg) {
  const int tidx = opaque_tid();
  const int tid = tidx;
  const int tk = Kp / 64, tn = Np / 64, nt = tk * tn;
  int t0_ = vb - (base % vg);
  if (t0_ < 0) t0_ += vg;
  for (int t = t0_; t < nt; t += vg) {
    const int k0 = (t / tn) * 64, n0 = (t % tn) * 64;
    __syncthreads();
#pragma unroll
    for (int i = 0; i < 4; i++) {
      int kr = (tid >> 4) + 16 * i, nc = (tid & 15) * 4;
      float4 v = make_float4(0.f, 0.f, 0.f, 0.f);
      if (src != nullptr && k0 + kr < K && n0 + nc < N) {
        v = *(const float4*)(src + (size_t)(k0 + kr) * N + n0 + nc);
        if (scale) { float s = scale[k0 + kr]; v.x *= s; v.y *= s; v.z *= s; v.w *= s; }
      }
      sm[kr * 65 + nc + 0] = v.x; sm[kr * 65 + nc + 1] = v.y; sm[kr * 65 + nc + 2] = v.z; sm[kr * 65 + nc + 3] = v.w;
    }
    __syncthreads();
    const int n = tid >> 2, kb = (tid & 3) * 16;
    unsigned o[8];
#pragma unroll
    for (int i = 0; i < 8; i++) o[i] = pack2(sm[(kb + 2 * i) * 65 + n], sm[(kb + 2 * i + 1) * 65 + n]);
    uint4* dp = (uint4*)(dst + (size_t)(n0 + n) * ldd + koff + k0 + kb);
    dp[0] = make_uint4(o[0], o[1], o[2], o[3]);
    dp[1] = make_uint4(o[4], o[5], o[6], o[7]);
  }
  base += nt;
}

DI void phase_conv(const P& p, int layer, char* smem, int vb, int vg) {
  if (vb < 0) return;
  float* sm = (float*)smem;
  bf16_t* W = (bf16_t*)(p.ws + w_off(layer));
  int base = 0;
  const int j = layer / 2;
  if ((layer & 1) == 0) {
    for (int s = 0; s < 3; s++) {
      const float* src = p.rw_w_rkv + ((size_t)j * 3 + s) * 1048576;
      conv_mat(src, 1024, 1024, W + W_RKV + (size_t)s * 1024 * 2048, 2048, 0, nullptr, 1024, 1024, sm, base, vb, vg);
    }
    for (int pass = 0; pass < 2; pass++) {
      const int ko = pass * 1024;
      const float* m1 = pass ? p.rw_mix + ((size_t)j * 6 + 1) * 1024 : nullptr;
      const float* m4 = pass ? p.rw_mix + ((size_t)j * 6 + 4) * 1024 : nullptr;
      const float* m5 = pass ? p.rw_mix + ((size_t)j * 6 + 5) * 1024 : nullptr;
      const float* m3 = pass ? p.rw_mix + ((size_t)j * 6 + 3) * 1024 : nullptr;
      bf16_t* L1 = W + W_L1;
      conv_mat(p.rw_w1 + ((size_t)j * 2 + 0) * 65536, 1024, 64, L1 + 0ull * 2048, 2048, ko, m1, 1024, 64, sm, base, vb, vg);
      conv_mat(p.rw_w1 + ((size_t)j * 2 + 1) * 65536, 1024, 64, L1 + 64ull * 2048, 2048, ko, m1, 1024, 64, sm, base, vb, vg);
      conv_mat(p.rw_a1 + (size_t)j * 65536, 1024, 64, L1 + 128ull * 2048, 2048, ko, m4, 1024, 64, sm, base, vb, vg);
      conv_mat(p.rw_g1 + ((size_t)j * 2 + 0) * 163840, 1024, 160, L1 + 256ull * 2048, 2048, ko, m5, 1024, 192, sm, base, vb, vg);
      conv_mat(p.rw_g1 + ((size_t)j * 2 + 1) * 163840, 1024, 160, L1 + 448ull * 2048, 2048, ko, m5, 1024, 192, sm, base, vb, vg);
      conv_mat(j > 0 ? p.rw_v1 + (size_t)(j - 1) * 32768 : nullptr, 1024, 32, L1 + 192ull * 2048, 2048, ko, m3, 1024, 64, sm, base, vb, vg);
    }
    conv_mat(p.rw_w2 + ((size_t)j * 2 + 0) * 65536, 64, 1024, W + W_W2, 64, 0, nullptr, 64, 1024, sm, base, vb, vg);
    conv_mat(p.rw_w2 + ((size_t)j * 2 + 1) * 65536, 64, 1024, W + W_W2 + 65536, 64, 0, nullptr, 64, 1024, sm, base, vb, vg);
    conv_mat(p.rw_a2 + (size_t)j * 65536, 64, 1024, W + W_A2, 64, 0, nullptr, 64, 1024, sm, base, vb, vg);
    conv_mat(p.rw_g2 + ((size_t)j * 2 + 0) * 163840, 160, 1024, W + W_G2, 192, 0, nullptr, 192, 1024, sm, base, vb, vg);
    conv_mat(p.rw_g2 + ((size_t)j * 2 + 1) * 163840, 160, 1024, W + W_G2 + 196608, 192, 0, nullptr, 192, 1024, sm, base, vb, vg);
    conv_mat(j > 0 ? p.rw_v2 + (size_t)(j - 1) * 32768 : nullptr, 32, 1024, W + W_V2, 64, 0, nullptr, 64, 1024, sm, base, vb, vg);
    conv_mat(p.rw_w_o + (size_t)j * 1048576, 1024, 1024, W + W_WO, 1024, 0, nullptr, 1024, 1024, sm, base, vb, vg);
  } else {
    conv_mat(p.da_w_qkv + (size_t)j * 3145728, 1024, 3072, W + W_QKV, 1024, 0, nullptr, 1024, 3072, sm, base, vb, vg);
    conv_mat(p.da_w_o + (size_t)j * 1048576, 1024, 1024, W + W_WO, 1024, 0, nullptr, 1024, 1024, sm, base, vb, vg);
  }
  conv_mat(p.mlp_w1 + (size_t)layer * 4194304, 1024, 4096, W + W_M1, 1024, 0, nullptr, 1024, 4096, sm, base, vb, vg);
  conv_mat(p.mlp_w2 + (size_t)layer * 4194304, 4096, 1024, W + W_M2, 4096, 0, nullptr, 4096, 1024, sm, base, vb, vg);
}

DI void phase_prep(const P& p, int layer, int sub, int hf, bool shift, bf16_t* H, int ldh, bool skip_ctx) {
  const int tidx = opaque_tid();
  const int lane = tidx & 63, wv = tidx >> 6;
  const int nrows = hf < 0 ? (skip_ctx ? NLAT : NTOK) : HROWS;
  const int nseg = nrows / 8;
  const float* ng = p.norm_g + ((size_t)layer * 2 + sub) * 1024;
  for (int seg = blockIdx.x * 4 + wv; seg < nseg; seg += gridDim.x * 4) {
    const int lr0 = seg * 8;
    const int gr0 = hf < 0 ? lr0 : (lr0 < 16384 ? hf * 16384 + lr0 : NLAT + hf * 1024 + (lr0 - 16384));
    const bool lat = gr0 < NLAT;
    const int T = lat ? SL : CL;
    const int t0 = lat ? (gr0 % SL) : ((gr0 - NLAT) % CL);
    const float* xbase = resid_row(p, gr0);
    const float* md = mods_ptr(p, layer, mod_row(gr0));
    float4 g4[4], sc4[4], sh4[4];
#pragma unroll
    for (int jx = 0; jx < 4; jx++) {
      int ch = jx * 256 + lane * 4;
      g4[jx] = *(const float4*)(ng + ch);
      sh4[jx] = *(const float4*)(md + sub * 3072 + ch);
      sc4[jx] = *(const float4*)(md + sub * 3072 + 1024 + ch);
      g4[jx].x *= (1.f + sc4[jx].x); g4[jx].y *= (1.f + sc4[jx].y); g4[jx].z *= (1.f + sc4[jx].z); g4[jx].w *= (1.f + sc4[jx].w);
    }
    float4 hp[4], hc[4], hn[4];
    const int tb = shift ? -1 : 0, te = shift ? 9 : 8;
    for (int tt = tb; tt < te; tt++) {
      const int t = t0 + tt;
      if (t >= 0 && t < T) {
        const float* xr = xbase + (ptrdiff_t)tt * D;
        float ss = 0.f;
#pragma unroll
        for (int jx = 0; jx < 4; jx++) {
          hn[jx] = *(const float4*)(xr + jx * 256 + lane * 4);
          ss += hn[jx].x * hn[jx].x + hn[jx].y * hn[jx].y + hn[jx].z * hn[jx].z + hn[jx].w * hn[jx].w;
        }
        ss = wave_sum(ss);
        const float rs = rsqrtf(ss * (1.f / 1024.f) + 1e-6f);
#pragma unroll
        for (int jx = 0; jx < 4; jx++) {
          hn[jx].x = hn[jx].x * rs * g4[jx].x + sh4[jx].x; hn[jx].y = hn[jx].y * rs * g4[jx].y + sh4[jx].y;
          hn[jx].z = hn[jx].z * rs * g4[jx].z + sh4[jx].z; hn[jx].w = hn[jx].w * rs * g4[jx].w + sh4[jx].w;
        }
      } else {
#pragma unroll
        for (int jx = 0; jx < 4; jx++) hn[jx] = make_float4(0.f, 0.f, 0.f, 0.f);
      }
      if (!shift) {
        bf16_t* hr = H + (size_t)(lr0 + tt) * ldh;
#pragma unroll
        for (int jx = 0; jx < 4; jx++) *(uint2*)(hr + jx * 256 + lane * 4) = make_uint2(pack2(hn[jx].x, hn[jx].y), pack2(hn[jx].z, hn[jx].w));
      } else if (tt >= 1) {
        bf16_t* hr = H + (size_t)(lr0 + tt - 1) * ldh;
#pragma unroll
        for (int jx = 0; jx < 4; jx++) {
          *(uint2*)(hr + jx * 256 + lane * 4) = make_uint2(pack2(hc[jx].x, hc[jx].y), pack2(hc[jx].z, hc[jx].w));
          float4 xx;
          xx.x = 0.5f * (hp[jx].x + hn[jx].x) - hc[jx].x; xx.y = 0.5f * (hp[jx].y + hn[jx].y) - hc[jx].y;
          xx.z = 0.5f * (hp[jx].z + hn[jx].z) - hc[jx].z; xx.w = 0.5f * (hp[jx].w + hn[jx].w) - hc[jx].w;
          *(uint2*)(hr + 1024 + jx * 256 + lane * 4) = make_uint2(pack2(xx.x, xx.y), pack2(xx.z, xx.w));
        }
      }
#pragma unroll
      for (int jx = 0; jx < 4; jx++) { hp[jx] = hc[jx]; hc[jx] = hn[jx]; }
    }
  }
}

constexpr int LDT = 72;
DI void gemm_mainloop(const bf16_t* __restrict__ A, int lda, const bf16_t* __restrict__ Bt, int ldb, int K, char* smem, f32x16 (&acc)[2][2]) {
  const int tidx = opaque_tid();
  bf16_t* sA = (bf16_t*)smem;
  bf16_t* sB = sA + 2 * 128 * LDT;
  const int tid = tidx, lane = tid & 63, w = tid >> 6, wm = w >> 1, wn = w & 1;
  const int lrow = tid >> 3, lkc = (tid & 7) * 8;
#pragma unroll
  for (int mi = 0; mi < 2; mi++)
#pragma unroll
    for (int ni = 0; ni < 2; ni++)
#pragma unroll
      for (int r = 0; r < 16; r++) acc[mi][ni][r] = 0.f;
  const unsigned ao = (unsigned)(lrow * lda + lkc), bo = (unsigned)(lrow * ldb + lkc);
  const unsigned a32 = (unsigned)(32 * lda), b32 = (unsigned)(32 * ldb);
  uint4 ra0, ra1, ra2, ra3, rb0, rb1, rb2, rb3;
#define G_LOAD(Ab, Bb)                                                                                   \
  {                                                                                                      \
    ra0 = *(const uint4*)((Ab) + ao); ra1 = *(const uint4*)((Ab) + (ao + a32));                          \
    ra2 = *(const uint4*)((Ab) + (ao + 2 * a32)); ra3 = *(const uint4*)((Ab) + (ao + 3 * a32));          \
    rb0 = *(const uint4*)((Bb) + bo); rb1 = *(const uint4*)((Bb) + (bo + b32));                          \
    rb2 = *(const uint4*)((Bb) + (bo + 2 * b32)); rb3 = *(const uint4*)((Bb) + (bo + 3 * b32));          \
  }
#define G_STORE(sa_, sb_)                                                                                \
  {                                                                                                      \
    bf16_t* a_w = (sa_) + lrow * LDT + lkc;                                                              \
    bf16_t* b_w = (sb_) + lrow * LDT + lkc;                                                              \
    *(uint4*)(a_w) = ra0; *(uint4*)(a_w + 32 * LDT) = ra1; *(uint4*)(a_w + 64 * LDT) = ra2; *(uint4*)(a_w + 96 * LDT) = ra3; \
    *(uint4*)(b_w) = rb0; *(uint4*)(b_w + 32 * LDT) = rb1; *(uint4*)(b_w + 64 * LDT) = rb2; *(uint4*)(b_w + 96 * LDT) = rb3; \
  }
  G_LOAD(A, Bt);
  G_STORE(sA, sB);
  __syncthreads();
  const int nk = K >> 6;
  const int aoff = (wm * 64 + (lane & 31)) * LDT + (lane >> 5) * 8;
  const int boff = (wn * 64 + (lane & 31)) * LDT + (lane >> 5) * 8;
  for (int kt = 0; kt < nk; kt++) {
    const int cur = kt & 1;
    if (kt + 1 < nk) {
      const bf16_t* A1 = A + (kt + 1) * 64;
      const bf16_t* B1 = Bt + (kt + 1) * 64;
      G_LOAD(A1, B1);
    }
    __builtin_amdgcn_sched_barrier(0);
    __builtin_amdgcn_s_setprio(1);
    const bf16_t* a_s = sA + cur * 128 * LDT + aoff;
    const bf16_t* b_s = sB + cur * 128 * LDT + boff;
#pragma unroll
    for (int kk = 0; kk < 4; kk++) {
      bf16x8 af[2], bq[2];
#pragma unroll
      for (int mi = 0; mi < 2; mi++) af[mi] = *(const bf16x8*)(a_s + mi * 32 * LDT + kk * 16);
#pragma unroll
      for (int ni = 0; ni < 2; ni++) bq[ni] = *(const bf16x8*)(b_s + ni * 32 * LDT + kk * 16);
#pragma unroll
      for (int mi = 0; mi < 2; mi++)
#pragma unroll
        for (int ni = 0; ni < 2; ni++) acc[mi][ni] = MFMA32(af[mi], bq[ni], acc[mi][ni]);
    }
    __builtin_amdgcn_s_setprio(0);
    __builtin_amdgcn_sched_barrier(0);
    if (kt + 1 < nk) G_STORE(sA + (cur ^ 1) * 128 * LDT, sB + (cur ^ 1) * 128 * LDT);
    __syncthreads();
  }
}
DI uint4 mix8(const uint4 h, const uint4 x, const float4 m0, const float4 m1) {
  uint4 o;
  o.x = pack2(lo_bf(h.x) + lo_bf(x.x) * m0.x, hi_bf(h.x) + hi_bf(x.x) * m0.y);
  o.y = pack2(lo_bf(h.y) + lo_bf(x.y) * m0.z, hi_bf(h.y) + hi_bf(x.y) * m0.w);
  o.z = pack2(lo_bf(h.z) + lo_bf(x.z) * m1.x, hi_bf(h.z) + hi_bf(x.z) * m1.y);
  o.w = pack2(lo_bf(h.w) + lo_bf(x.w) * m1.z, hi_bf(h.w) + hi_bf(x.w) * m1.w);
  return o;
}
DI void gemm_mainloop_mix(const bf16_t* __restrict__ HX, const float* __restrict__ mix, const bf16_t* __restrict__ Bt, int ldb, char* smem, f32x16 (&acc)[2][2]) {
  const int tidx = opaque_tid();
  bf16_t* sA = (bf16_t*)smem;
  bf16_t* sB = sA + 2 * 128 * LDT;
  const int tid = tidx, lane = tid & 63, w = tid >> 6, wm = w >> 1, wn = w & 1;
  const int lrow = tid >> 3, lkc = (tid & 7) * 8;
#pragma unroll
  for (int mi = 0; mi < 2; mi++)
#pragma unroll
    for (int ni = 0; ni < 2; ni++)
#pragma unroll
      for (int r = 0; r < 16; r++) acc[mi][ni][r] = 0.f;
  const unsigned ao = (unsigned)(lrow * 2048 + lkc), bo = (unsigned)(lrow * ldb + lkc);
  const unsigned a32 = 32u * 2048u, b32 = (unsigned)(32 * ldb);
  uint4 h0, h1, h2, h3, x0, x1, x2, x3, rb0, rb1, rb2, rb3;
  float4 m0, m1;
#define GM_LOAD(kstep_)                                                                                  \
  {                                                                                                      \
    const bf16_t* Ab_ = HX + (kstep_) * 64;                                                              \
    const bf16_t* Bb_ = Bt + (kstep_) * 64;                                                              \
    h0 = *(const uint4*)(Ab_ + ao); h1 = *(const uint4*)(Ab_ + (ao + a32));                              \
    h2 = *(const uint4*)(Ab_ + (ao + 2 * a32)); h3 = *(const uint4*)(Ab_ + (ao + 3 * a32));              \
    x0 = *(const uint4*)(Ab_ + (ao + 1024u)); x1 = *(const uint4*)(Ab_ + (ao + a32 + 1024u));            \
    x2 = *(const uint4*)(Ab_ + (ao + 2 * a32 + 1024u)); x3 = *(const uint4*)(Ab_ + (ao + 3 * a32 + 1024u)); \
    rb0 = *(const uint4*)(Bb_ + bo); rb1 = *(const uint4*)(Bb_ + (bo + b32));                            \
    rb2 = *(const uint4*)(Bb_ + (bo + 2 * b32)); rb3 = *(const uint4*)(Bb_ + (bo + 3 * b32));            \
    m0 = *(const float4*)(mix + (kstep_) * 64 + lkc); m1 = *(const float4*)(mix + (kstep_) * 64 + lkc + 4); \
  }
#define GM_STORE(buf_)                                                                                   \
  {                                                                                                      \
    bf16_t* a_w = sA + (buf_) * 128 * LDT + lrow * LDT + lkc;                                            \
    bf16_t* b_w = sB + (buf_) * 128 * LDT + lrow * LDT + lkc;                                            \
    *(uint4*)(a_w) = mix8(h0, x0, m0, m1); *(uint4*)(a_w + 32 * LDT) = mix8(h1, x1, m0, m1);             \
    *(uint4*)(a_w + 64 * LDT) = mix8(h2, x2, m0, m1); *(uint4*)(a_w + 96 * LDT) = mix8(h3, x3, m0, m1);  \
    *(uint4*)(b_w) = rb0; *(uint4*)(b_w + 32 * LDT) = rb1; *(uint4*)(b_w + 64 * LDT) = rb2; *(uint4*)(b_w + 96 * LDT) = rb3; \
  }
  GM_LOAD(0);
  GM_STORE(0);
  __syncthreads();
  const int aoff = (wm * 64 + (lane & 31)) * LDT + (lane >> 5) * 8;
  const int boff = (wn * 64 + (lane & 31)) * LDT + (lane >> 5) * 8;
  for (int kt = 0; kt < 16; kt++) {
    const int cur = kt & 1;
    if (kt + 1 < 16) GM_LOAD(kt + 1);
    __builtin_amdgcn_sched_barrier(0);
    __builtin_amdgcn_s_setprio(1);
    const bf16_t* a_s = sA + cur * 128 * LDT + aoff;
    const bf16_t* b_s = sB + cur * 128 * LDT + boff;
#pragma unroll
    for (int kk = 0; kk < 4; kk++) {
      bf16x8 af[2], bq[2];
#pragma unroll
      for (int mi = 0; mi < 2; mi++) af[mi] = *(const bf16x8*)(a_s + mi * 32 * LDT + kk * 16);
#pragma unroll
      for (int ni = 0; ni < 2; ni++) bq[ni] = *(const bf16x8*)(b_s + ni * 32 * LDT + kk * 16);
#pragma unroll
      for (int mi = 0; mi < 2; mi++)
#pragma unroll
        for (int ni = 0; ni < 2; ni++) acc[mi][ni] = MFMA32(af[mi], bq[ni], acc[mi][ni]);
    }
    __builtin_amdgcn_s_setprio(0);
    __builtin_amdgcn_sched_barrier(0);
    if (kt + 1 < 16) GM_STORE(cur ^ 1);
    __syncthreads();
  }
}

constexpr int EST = 132;
DI void acc_to_lds(const f32x16 (&acc)[2][2], float* es) {
  const int tidx = opaque_tid();
  const int lane = tidx & 63, w = tidx >> 6, wm = w >> 1, wn = w & 1;
#pragma unroll
  for (int mi = 0; mi < 2; mi++)
#pragma unroll
    for (int ni = 0; ni < 2; ni++)
#pragma unroll
      for (int r = 0; r < 16; r++)
        es[(wm * 64 + mi * 32 + (r & 3) + 8 * (r >> 2) + 4 * (lane >> 5)) * EST + wn * 64 + ni * 32 + (lane & 31)] = acc[mi][ni][r];
}
#define EPI8_BEGIN                                                                   \
  {                                                                                  \
    float* es = (float*)smem;                                                        \
    acc_to_lds(acc, es);                                                             \
    __syncthreads();                                                                 \
    for (int pass = 0; pass < 8; pass++) {                                           \
      const int row = pass * 16 + (tidx >> 4), col = (tidx & 15) * 8;  \
      const float4 e_va = *(const float4*)(es + row * EST + col);                    \
      const float4 e_vb = *(const float4*)(es + row * EST + col + 4);                \
      float v[8] = {e_va.x, e_va.y, e_va.z, e_va.w, e_vb.x, e_vb.y, e_vb.z, e_vb.w};
#define EPI8_END                                                                     \
    }                                                                                \
    __syncthreads();                                                                 \
  }
DI uint4 pack8(const float (&v)[8]) { return make_uint4(pack2(v[0], v[1]), pack2(v[2], v[3]), pack2(v[4], v[5]), pack2(v[6], v[7])); }
DI void unpack8(const uint4 u, float (&v)[8]) {
  v[0] = lo_bf(u.x); v[1] = hi_bf(u.x); v[2] = lo_bf(u.y); v[3] = hi_bf(u.y); v[4] = lo_bf(u.z); v[5] = hi_bf(u.z); v[6] = lo_bf(u.w); v[7] = hi_bf(u.w);
}
DI void resid_update(float* xp, const float* gate, const float (&v)[8]) {
  float4 x0 = *(const float4*)xp, x1 = *(const float4*)(xp + 4);
  const float4 g0 = *(const float4*)gate, g1 = *(const float4*)(gate + 4);
  x0.x += g0.x * v[0]; x0.y += g0.y * v[1]; x0.z += g0.z * v[2]; x0.w += g0.w * v[3];
  x1.x += g1.x * v[4]; x1.y += g1.y * v[5]; x1.z += g1.z * v[6]; x1.w += g1.w * v[7];
  *(float4*)xp = x0; *(float4*)(xp + 4) = x1;
}

DI bool xcd_tile(int t, int Mt, int Nt, int& mt, int& nt) {
  const int G = gridDim.x, spx = G >> 3, tn = spx >> 3;
  const int r = t % G, round = t / G;
  const int xcd = r & 7, li = r >> 3;
  const int smn = Mt >> 3, snn = Nt / tn;
  const int st = round * 8 + xcd;
  if (st >= smn * snn) return false;
  const int smi = st % smn, sni = st / smn;
  mt = smi * 8 + (li & 7);
  nt = sni * tn + (li >> 3);
  return true;
}
DI int xcd_rounds(int Mt, int Nt) { const int tn = gridDim.x >> 6; return ((Mt >> 3) * (Nt / tn) + 7) >> 3; }

DI void phase_t1(const P& p, int layer, char* smem) {
  const int j = layer / 2;
  const int tidx = opaque_tid();
  const bf16_t* HX = (const bf16_t*)(p.ws + OFF_TR + TR_HX);
  const bf16_t* WL1 = (const bf16_t*)(p.ws + w_off(0)) + W_L1;
  bf16_t* T1 = (bf16_t*)(p.ws + OFF_TR + TR_T1);
  for (int t = blockIdx.x; t < 136 * 5; t += gridDim.x) {
    const int nt = t % 5, lt = t / 5;
    f32x16 acc[2][2];
    if (nt == 1) gemm_mainloop(HX + (size_t)lt * 128 * 2048, 2048, WL1 + (size_t)nt * 128 * 2048, 2048, 2048, smem, acc);
    else gemm_mainloop_mix(HX + (size_t)lt * 128 * 2048, p.rw_mix + ((size_t)j * 6 + (nt == 0 ? 1 : 5)) * 1024, WL1 + (size_t)nt * 128 * 2048, 2048, smem, acc);
    EPI8_BEGIN
      const int c = nt * 128 + col;
      if (c < 128) {
#pragma unroll
        for (int e = 0; e < 8; e++) v[e] = tanhf(v[e]);
      } else if (c >= 256) {
#pragma unroll
        for (int e = 0; e < 8; e++) v[e] = sigmoidf_(v[e]);
      }
      *(uint4*)(T1 + (size_t)(lt * 128 + row) * 640 + c) = pack8(v);
    EPI8_END
  }
}

DI void phase_feat(const P& p, int layer, int hf, char* smem) {
  const int tidx = opaque_tid();
  const int j = layer / 2;
  const bf16_t* W = (const bf16_t*)(p.ws + w_off(layer));
  const bf16_t* HX = (const bf16_t*)(p.ws + OFF_TR + TR_HX);
  const bf16_t* T1 = (const bf16_t*)(p.ws + OFF_TR + TR_T1);
  bf16_t* VF = (bf16_t*)(p.ws + OFF_VF);
  for (int t = blockIdx.x; t < xcd_rounds(136, 24) * (int)gridDim.x; t += gridDim.x) {
    int lt, nt;
    if (!xcd_tile(t, 136, 24, lt, nt)) continue;
    const int s = nt / 8, n0 = (nt % 8) * 128;
    const int gt = half_gtile(hf, lt);
    f32x16 acc[2][2];
    bf16_t* outp = (bf16_t*)(p.ws + OFF_TR + (s == 0 ? TR_R : (s == 1 ? TR_K : TR_V)));
    if (s == 2 && j > 0) {
      gemm_mainloop(T1 + (size_t)lt * 128 * 640 + 192, 640, W + W_V2 + (size_t)n0 * 64, 64, 64, smem, acc);
      const float* v0 = p.rw_v0 + (size_t)(j - 1) * 1024;
      EPI8_BEGIN
        const int c = n0 + col;
#pragma unroll
        for (int e = 0; e < 8; e++) v[e] = sigmoidf_(v0[c + e] + v[e]);
        *(uint4*)(outp + (size_t)(lt * 128 + row) * 1024 + c) = pack8(v);
      EPI8_END
    }
    {
      const int mixsel = s == 0 ? 0 : (s == 1 ? 2 : 3);
      gemm_mainloop_mix(HX + (size_t)lt * 128 * 2048, p.rw_mix + ((size_t)j * 6 + mixsel) * 1024, W + W_RKV + ((size_t)s * 1024 + n0) * 2048, 2048, smem, acc);
    }
    if (s < 2) {
      EPI8_BEGIN
        *(uint4*)(outp + (size_t)(lt * 128 + row) * 1024 + n0 + col) = pack8(v);
      EPI8_END
    } else if (j == 0) {
      EPI8_BEGIN
        const uint4 u = pack8(v);
        *(uint4*)(outp + (size_t)(lt * 128 + row) * 1024 + n0 + col) = u;
        *(uint4*)(VF + (size_t)(gt * 128 + row) * 1024 + n0 + col) = u;
      EPI8_END
    } else {
      EPI8_BEGIN
        const size_t oi = (size_t)(lt * 128 + row) * 1024 + n0 + col;
        float sg[8], vf[8];
        unpack8(*(const uint4*)(outp + oi), sg);
        unpack8(*(const uint4*)(VF + (size_t)(gt * 128 + row) * 1024 + n0 + col), vf);
#pragma unroll
        for (int e = 0; e < 8; e++) v[e] = v[e] + (vf[e] - v[e]) * sg[e];
        *(uint4*)(outp + oi) = pack8(v);
      EPI8_END
    }
  }
  for (int t = blockIdx.x; t < xcd_rounds(136, 40) * (int)gridDim.x; t += gridDim.x) {
    int lt, nt;
    if (!xcd_tile(t, 136, 40, lt, nt)) continue;
    const int s = nt / 8, n0 = (nt % 8) * 128;
    f32x16 acc[2][2];
    if (s == 0) {
      gemm_mainloop(T1 + (size_t)lt * 128 * 640 + 128, 640, W + W_A2 + (size_t)n0 * 64, 64, 64, smem, acc);
      bf16_t* outp = (bf16_t*)(p.ws + OFF_TR + TR_A);
      const float* a0 = p.rw_a0 + (size_t)j * 1024;
      EPI8_BEGIN
#pragma unroll
        for (int e = 0; e < 8; e++) v[e] = sigmoidf_(a0[n0 + col + e] + v[e]);
        *(uint4*)(outp + (size_t)(lt * 128 + row) * 1024 + n0 + col) = pack8(v);
      EPI8_END
    } else if (s < 3) {
      const int d = s - 1;
      gemm_mainloop(T1 + (size_t)lt * 128 * 640 + d * 64, 640, W + W_W2 + (size_t)d * 65536 + (size_t)n0 * 64, 64, 64, smem, acc);
      bf16_t* outp = (bf16_t*)(p.ws + OFF_TR + (d ? TR_WL1 : TR_WL0));
      const float* w0 = p.rw_w0 + ((size_t)j * 2 + d) * 1024;
      EPI8_BEGIN
#pragma unroll
        for (int e = 0; e < 8; e++) {
          const float z = -(w0[n0 + col + e] + v[e]);
          const float sp = fmaxf(z, 0.f) + log1pf(__expf(-fabsf(z)));
          v[e] = -__expf(-sp - 0.5f);
        }
        *(uint4*)(outp + (size_t)(lt * 128 + row) * 1024 + n0 + col) = pack8(v);
      EPI8_END
    } else {
      const int d = s - 3;
      gemm_mainloop(T1 + (size_t)lt * 128 * 640 + 256 + d * 192, 640, W + W_G2 + (size_t)d * 196608 + (size_t)n0 * 192, 192, 192, smem, acc);
      bf16_t* outp = (bf16_t*)(p.ws + OFF_TR + (d ? TR_G1 : TR_G0));
      EPI8_BEGIN
        *(uint4*)(outp + (size_t)(lt * 128 + row) * 1024 + n0 + col) = pack8(v);
      EPI8_END
    }
  }
}

DI int scan_row(int bl, int dir, int pos) {
  if (pos < CL) { int t = dir ? (CL - 1 - pos) : pos; return 16384 + bl * CL + t; }
  int t = pos - CL; if (dir) t = SL - 1 - t;
  return bl * SL + t;
}

DI void phase_scan(const P& p, int layer, char* smem) {
  const int tidx = opaque_tid();
  const int j = layer / 2;
  const int tid = tidx;
  const bf16_t* R = (const bf16_t*)(p.ws + OFF_TR + TR_R);
  const bf16_t* Kx = (const bf16_t*)(p.ws + OFF_TR + TR_K);
  const bf16_t* V = (const bf16_t*)(p.ws + OFF_TR + TR_V);
  const bf16_t* Aa = (const bf16_t*)(p.ws + OFF_TR + TR_A);
  float* sbuf = (float*)smem;
  constexpr int BUFF = 5 * 16 * 64 + 512;
  constexpr int POP = 144;
  float* pobuf = sbuf + 2 * BUFF;
  const int ss = tid >> 4, c4 = tid & 15;
  const int rl = tid >> 4, cg = tid & 15;
  for (int item = blockIdx.x; item < 256; item += gridDim.x) {
    const int q2 = item & 1, dir = (item >> 1) & 1, head = (item >> 2) & 15, bl = item >> 6;
    const bf16_t* WL = (const bf16_t*)(p.ws + OFF_TR + (dir ? TR_WL1 : TR_WL0));
    bf16_t* O = (bf16_t*)(p.ws + OFF_TR + TR_HX) + (dir ? (size_t)HROWS * 1024 : 0);
    const int ch = head * 64 + c4 * 4;
    const float4 kkw = *(const float4*)(p.rw_kk + (size_t)j * 1024 + ch);
    const float4 kaw = *(const float4*)(p.rw_ka + (size_t)j * 1024 + ch);
    fv2 SA01 = {0.f, 0.f}, SA23 = {0.f, 0.f}, SB01 = {0.f, 0.f}, SB23 = {0.f, 0.f};
    uint2 gr_, gk_, ga_, gw_, gv_;
    gv_ = make_uint2(0, 0);
#define SC_ISSUE(chunk_)                                                                   \
    {                                                                                      \
      const size_t ro = (size_t)scan_row(bl, dir, (chunk_) * 16 + ss) * 1024;              \
      gr_ = *(const uint2*)(R + ro + ch); gk_ = *(const uint2*)(Kx + ro + ch);             \
      ga_ = *(const uint2*)(Aa + ro + ch); gw_ = *(const uint2*)(WL + ro + ch);            \
      if (c4 < 8) gv_ = *(const uint2*)(V + ro + head * 64 + q2 * 32 + c4 * 4);            \
    }
#define SC_STAGE(buf_)                                                                     \
    {                                                                                      \
      float* sb_ = sbuf + (buf_) * BUFF;                                                   \
      float r0 = lo_bf(gr_.x), r1 = hi_bf(gr_.x), r2 = lo_bf(gr_.y), r3 = hi_bf(gr_.y);    \
      float k0 = lo_bf(gk_.x), k1 = hi_bf(gk_.x), k2 = lo_bf(gk_.y), k3 = hi_bf(gk_.y);    \
      float a0 = lo_bf(ga_.x), a1 = hi_bf(ga_.x), a2 = lo_bf(ga_.y), a3 = hi_bf(ga_.y);    \
      float w0 = lo_bf(gw_.x), w1 = hi_bf(gw_.x), w2 = lo_bf(gw_.y), w3 = hi_bf(gw_.y);    \
      float u0 = k0 * kkw.x, u1 = k1 * kkw.y, u2 = k2 * kkw.z, u3 = k3 * kkw.w;            \
      float sq = rowsum16(u0 * u0 + u1 * u1 + u2 * u2 + u3 * u3);                          \
      float inv = rsqrtf(fmaxf(sq, 1e-24f));                                               \
      u0 *= inv; u1 *= inv; u2 *= inv; u3 *= inv;                                          \
      const int o_ = ss * 64 + c4 * 4;                                                     \
      *(float4*)(sb_ + 0 * 1024 + o_) = make_float4(__expf(w0), __expf(w1), __expf(w2), __expf(w3)); \
      *(float4*)(sb_ + 1 * 1024 + o_) = make_float4(k0 * (1.f + (a0 - 1.f) * kaw.x), k1 * (1.f + (a1 - 1.f) * kaw.y), k2 * (1.f + (a2 - 1.f) * kaw.z), k3 * (1.f + (a3 - 1.f) * kaw.w)); \
      *(float4*)(sb_ + 2 * 1024 + o_) = make_float4(-u0, -u1, -u2, -u3);                   \
      *(float4*)(sb_ + 3 * 1024 + o_) = make_float4(u0 * a0, u1 * a1, u2 * a2, u3 * a3);   \
      *(float4*)(sb_ + 4 * 1024 + o_) = make_float4(r0, r1, r2, r3);                       \
      if (c4 < 8) *(float4*)(sb_ + 5 * 1024 + ss * 32 + c4 * 4) = make_float4(lo_bf(gv_.x), hi_bf(gv_.x), lo_bf(gv_.y), hi_bf(gv_.y)); \
    }
    __syncthreads();
    SC_ISSUE(0);
    SC_STAGE(0);
    __syncthreads();
    constexpr int NCH = TK / 16;
    float* po_wa = pobuf + rl * POP + cg;
    float* po_wb = pobuf + (rl + 16) * POP + cg;
    const float* po_r = pobuf + (rl + 16 * (cg >> 3)) * POP + (cg & 7) * 16;
    for (int chunk = 0; chunk < NCH; chunk++) {
      const int buf = chunk & 1;
      if (chunk + 1 < NCH) SC_ISSUE(chunk + 1);
      __builtin_amdgcn_sched_barrier(0);
      const float* sb = sbuf + buf * BUFF + cg * 4;
      const float* sv = sbuf + buf * BUFF + 5 * 1024 + rl;
      float4 w4 = *(const float4*)(sb + 0 * 1024), k4 = *(const float4*)(sb + 1 * 1024), n4 = *(const float4*)(sb + 2 * 1024);
      float4 b4 = *(const float4*)(sb + 3 * 1024), r4 = *(const float4*)(sb + 4 * 1024);
      float va = sv[0], vb = sv[16];
#pragma unroll
      for (int s = 0; s < 16; s++) {
        float4 w4n = w4, k4n = k4, n4n = n4, b4n = b4, r4n = r4;
        float van = va, vbn = vb;
        if (s + 1 < 16) {
          w4n = *(const float4*)(sb + 0 * 1024 + (s + 1) * 64); k4n = *(const float4*)(sb + 1 * 1024 + (s + 1) * 64);
          n4n = *(const float4*)(sb + 2 * 1024 + (s + 1) * 64); b4n = *(const float4*)(sb + 3 * 1024 + (s + 1) * 64);
          r4n = *(const float4*)(sb + 4 * 1024 + (s + 1) * 64); van = sv[(s + 1) * 32]; vbn = sv[(s + 1) * 32 + 16];
        }
        const fv2 w01 = {w4.x, w4.y}, w23 = {w4.z, w4.w}, k01 = {k4.x, k4.y}, k23 = {k4.z, k4.w}, n01 = {n4.x, n4.y}, n23 = {n4.z, n4.w};
        const fv2 b01 = {b4.x, b4.y}, b23 = {b4.z, b4.w}, r01 = {r4.x, r4.y}, r23 = {r4.z, r4.w};
        const fv2 va2 = {va, va}, vb2 = {vb, vb};
        const fv2 vka01 = va2 * k01, vka23 = va2 * k23, vkb01 = vb2 * k01, vkb23 = vb2 * k23;
        fv2 ppa = SA01 * n01, ppb = SB01 * n01;
        ppa = __builtin_elementwise_fma(SA23, n23, ppa);
        ppb = __builtin_elementwise_fma(SB23, n23, ppb);
        float saa = ppa.x + ppa.y, sab = ppb.x + ppb.y;
        saa = ror_add<8>(saa); sab = ror_add<8>(sab);
        saa = ror_add<4>(saa); sab = ror_add<4>(sab);
        saa = ror_add<2>(saa); sab = ror_add<2>(sab);
        saa = ror_add<1>(saa); sab = ror_add<1>(sab);
        const fv2 saa2 = {saa, saa}, sab2 = {sab, sab};
        const fv2 ta01 = __builtin_elementwise_fma(saa2, b01, vka01), ta23 = __builtin_elementwise_fma(saa2, b23, vka23);
        const fv2 tb01 = __builtin_elementwise_fma(sab2, b01, vkb01), tb23 = __builtin_elementwise_fma(sab2, b23, vkb23);
        SA01 = __builtin_elementwise_fma(SA01, w01, ta01);
        SA23 = __builtin_elementwise_fma(SA23, w23, ta23);
        SB01 = __builtin_elementwise_fma(SB01, w01, tb01);
        SB23 = __builtin_elementwise_fma(SB23, w23, tb23);
        fv2 qa = SA01 * r01, qb = SB01 * r01;
        qa = __builtin_elementwise_fma(SA23, r23, qa);
        qb = __builtin_elementwise_fma(SB23, r23, qb);
        po_wa[(s & 7) * 16] = qa.x + qa.y;
        po_wb[(s & 7) * 16] = qb.x + qb.y;
        w4 = w4n; k4 = k4n; n4 = n4n; b4 = b4n; r4 = r4n; va = van; vb = vbn;
        __builtin_amdgcn_sched_barrier(0);
        if ((s & 7) == 7) {
          const float4 p0 = *(const float4*)(po_r), p1 = *(const float4*)(po_r + 4), p2 = *(const float4*)(po_r + 8), p3 = *(const float4*)(po_r + 12);
          const float ov = ((p0.x + p0.y) + (p0.z + p0.w)) + ((p1.x + p1.y) + (p1.z + p1.w)) + ((p2.x + p2.y) + (p2.z + p2.w)) + ((p3.x + p3.y) + (p3.z + p3.w));
          const size_t ro = (size_t)scan_row(bl, dir, chunk * 16 + (s & 8) + (cg & 7)) * 1024;
          O[ro + head * 64 + q2 * 32 + rl + 16 * (cg >> 3)] = f2bf(ov);
          __builtin_amdgcn_sched_barrier(0);
        }
      }
      if (chunk + 1 < NCH) SC_STAGE(buf ^ 1);
      __syncthreads();
    }
  }
}

DI void phase_combine(const P& p, int layer) {
  const int tidx = opaque_tid();
  const int j = layer / 2;
  const bf16_t* Of = (const bf16_t*)(p.ws + OFF_TR + TR_HX);
  const bf16_t* Ob = Of + (size_t)HROWS * 1024;
  const bf16_t* R = (const bf16_t*)(p.ws + OFF_TR + TR_R);
  const bf16_t* Kx = (const bf16_t*)(p.ws + OFF_TR + TR_K);
  const bf16_t* V = (const bf16_t*)(p.ws + OFF_TR + TR_V);
  const bf16_t* Aa = (const bf16_t*)(p.ws + OFF_TR + TR_A);
  bf16_t* G0 = (bf16_t*)(p.ws + OFF_TR + TR_G0);
  const bf16_t* G1 = (const bf16_t*)(p.ws + OFF_TR + TR_G1);
  const size_t total = (size_t)HROWS * 128;
  for (size_t i = (size_t)blockIdx.x * 256 + tidx; i < total; i += (size_t)gridDim.x * 256) {
    const int c0 = (int)(i & 127) * 8;
    const size_t off = (i >> 7) * 1024 + c0;
    const uint4 uof = *(const uint4*)(Of + off), uob = *(const uint4*)(Ob + off), ur = *(const uint4*)(R + off), uk = *(const uint4*)(Kx + off);
    const uint4 ua = *(const uint4*)(Aa + off), uv = *(const uint4*)(V + off), ug0 = *(const uint4*)(G0 + off), ug1 = *(const uint4*)(G1 + off);
    const unsigned aof[4] = {uof.x, uof.y, uof.z, uof.w}, aob[4] = {uob.x, uob.y, uob.z, uob.w}, ar[4] = {ur.x, ur.y, ur.z, ur.w}, ak[4] = {uk.x, uk.y, uk.z, uk.w};
    const unsigned aa[4] = {ua.x, ua.y, ua.z, ua.w}, av[4] = {uv.x, uv.y, uv.z, uv.w}, ag0[4] = {ug0.x, ug0.y, ug0.z, ug0.w}, ag1[4] = {ug1.x, ug1.y, ug1.z, ug1.w};
    const float* ka = p.rw_ka + (size_t)j * 1024 + c0;
    const float* rk = p.rw_rk + (size_t)j * 1024 + c0;
    const float* lg = p.rw_ln_g + (size_t)j * 1024 + c0;
    const float* lb = p.rw_ln_b + (size_t)j * 1024 + c0;
    float of[8], obv[8];
    float sf = 0.f, sf2 = 0.f, sb = 0.f, sb2 = 0.f, br = 0.f;
#pragma unroll
    for (int e = 0; e < 8; e++) {
      const int w = e >> 1;
      of[e] = (e & 1) ? hi_bf(aof[w]) : lo_bf(aof[w]);
      obv[e] = (e & 1) ? hi_bf(aob[w]) : lo_bf(aob[w]);
      const float r = (e & 1) ? hi_bf(ar[w]) : lo_bf(ar[w]);
      const float k = (e & 1) ? hi_bf(ak[w]) : lo_bf(ak[w]);
      const float a = (e & 1) ? hi_bf(aa[w]) : lo_bf(aa[w]);
      sf += of[e]; sf2 += of[e] * of[e]; sb += obv[e]; sb2 += obv[e] * obv[e];
      br += r * k * (1.f + (a - 1.f) * ka[e]) * rk[e];
    }
#pragma unroll
    for (int o = 1; o < 8; o <<= 1) { sf += __shfl_xor(sf, o); sf2 += __shfl_xor(sf2, o); sb += __shfl_xor(sb, o); sb2 += __shfl_xor(sb2, o); br += __shfl_xor(br, o); }
    const float muf = sf * (1.f / 64.f), mub = sb * (1.f / 64.f);
    const float rsf = rsqrtf(fmaxf(sf2 * (1.f / 64.f) - muf * muf, 0.f) + 64e-5f);
    const float rsb = rsqrtf(fmaxf(sb2 * (1.f / 64.f) - mub * mub, 0.f) + 64e-5f);
    float y[8];
#pragma unroll
    for (int e = 0; e < 8; e++) {
      const int w = e >> 1;
      const float v = (e & 1) ? hi_bf(av[w]) : lo_bf(av[w]);
      const float g0 = (e & 1) ? hi_bf(ag0[w]) : lo_bf(ag0[w]);
      const float g1 = (e & 1) ? hi_bf(ag1[w]) : lo_bf(ag1[w]);
      const float bonus = br * v;
      y[e] = ((of[e] - muf) * rsf * lg[e] + lb[e] + bonus) * g0 + ((obv[e] - mub) * rsb * lg[e] + lb[e] + bonus) * g1;
    }
    *(uint4*)(G0 + off) = make_uint4(pack2(y[0], y[1]), pack2(y[2], y[3]), pack2(y[4], y[5]), pack2(y[6], y[7]));
  }
}

DI void phase_rw_out(const P& p, int layer, int hf, char* smem) {
  const int tidx = opaque_tid();
  const bf16_t* Y = (const bf16_t*)(p.ws + OFF_TR + TR_G0);
  const bf16_t* WO = (const bf16_t*)(p.ws + w_off(layer)) + W_WO;
  const int nlt = (layer == 3) ? 128 : 136;
  for (int t = blockIdx.x; t < xcd_rounds(nlt, 8) * (int)gridDim.x; t += gridDim.x) {
    int lt, nt_;
    if (!xcd_tile(t, nlt, 8, lt, nt_)) continue;
    const int n0 = nt_ * 128;
    const int gt = half_gtile(hf, lt);
    f32x16 acc[2][2];
    gemm_mainloop(Y + (size_t)lt * 128 * 1024, 1024, WO + (size_t)n0 * 1024, 1024, 1024, smem, acc);
    const float* gate = mods_ptr(p, layer, mod_row(gt * 128)) + 2048 + n0;
    float* xr = resid_row(p, gt * 128) + n0;
    EPI8_BEGIN
      resid_update(xr + (size_t)row * D + col, gate + col, v);
    EPI8_END
  }
}

DI void phase_mlp1(const P& p, int layer, char* smem) {
  const int tidx = opaque_tid();
  const bf16_t* H2 = (const bf16_t*)(p.ws + OFF_TR + TR_H2);
  const bf16_t* W1 = (const bf16_t*)(p.ws + w_off(layer)) + W_M1;
  bf16_t* HID = (bf16_t*)(p.ws + OFF_TR + TR_HID);
  const int nmt = (layer == 3) ? 256 : 272;
  const int ngrp = nmt / 16;
  (void)ngrp;
  for (int t = blockIdx.x; t < xcd_rounds(nmt, 32) * (int)gridDim.x; t += gridDim.x) {
    int gt, nt;
    if (!xcd_tile(t, nmt, 32, gt, nt)) continue;
    f32x16 acc[2][2];
    gemm_mainloop(H2 + (size_t)gt * 128 * 1024, 1024, W1 + (size_t)nt * 128 * 1024, 1024, 1024, smem, acc);
    EPI8_BEGIN
#pragma unroll
      for (int e = 0; e < 8; e++) { const float rl = fmaxf(v[e], 0.f); v[e] = rl * rl; }
      *(uint4*)(HID + (size_t)(gt * 128 + row) * 4096 + nt * 128 + col) = pack8(v);
    EPI8_END
  }
}
DI void phase_mlp2(const P& p, int layer, char* smem) {
  const int tidx = opaque_tid();
  const bf16_t* HID = (const bf16_t*)(p.ws + OFF_TR + TR_HID);
  const bf16_t* W2 = (const bf16_t*)(p.ws + w_off(layer)) + W_M2;
  const int nmt = (layer == 3) ? 256 : 272;
  for (int t = blockIdx.x; t < xcd_rounds(nmt, 8) * (int)gridDim.x; t += gridDim.x) {
    int gt, nt_;
    if (!xcd_tile(t, nmt, 8, gt, nt_)) continue;
    const int n0 = nt_ * 128;
    f32x16 acc[2][2];
    gemm_mainloop(HID + (size_t)gt * 128 * 4096, 4096, W2 + (size_t)n0 * 4096, 4096, 4096, smem, acc);
    const float* gate = mods_ptr(p, layer, mod_row(gt * 128)) + 5120 + n0;
    float* xr = resid_row(p, gt * 128) + n0;
    EPI8_BEGIN
      resid_update(xr + (size_t)row * D + col, gate + col, v);
    EPI8_END
  }
}

DI void phase_qkv(const P& p, int layer, char* smem) {
  const int tidx = opaque_tid();
  const bf16_t* H = (const bf16_t*)(p.ws + OFF_TR + TR_H);
  const bf16_t* WQ = (const bf16_t*)(p.ws + w_off(layer)) + W_QKV;
  bf16_t* Q = (bf16_t*)(p.ws + OFF_TR + TR_Q);
  bf16_t* Kb = (bf16_t*)(p.ws + OFF_TR + TR_KK);
  bf16_t* VT = (bf16_t*)(p.ws + OFF_TR + TR_VT);
  const float* cosT = (const float*)(p.ws + OFF_MISC);
  const float* sinT = cosT + 1024;
  for (int t = blockIdx.x; t < xcd_rounds(272, 24) * (int)gridDim.x; t += gridDim.x) {
    int gt, nt;
    if (!xcd_tile(t, 272, 24, gt, nt)) continue;
    f32x16 acc[2][2];
    gemm_mainloop(H + (size_t)gt * 128 * 1024, 1024, WQ + (size_t)nt * 128 * 1024, 1024, 1024, smem, acc);
    const bool lat = gt < 256;
    const int b = lat ? gt / 32 : (gt - 256) / 2;
    const int t0 = lat ? (gt % 32) * 128 : (gt - 256) % 2 * 128;
    const int tq0 = lat ? t0 : SL + t0;
    const int typ = nt / 8, h = nt % 8;
    if (typ < 2) {
      bf16_t* dst = typ == 0 ? Q : Kb;
      const float qs = typ == 0 ? 0.125f * 1.44269504088896f : 1.f;
      float kmx = 0.f;
      EPI8_BEGIN
        const int sidx = col >> 6, d0 = col & 63;
        if (lat) {
          const float4 pa = *(const float4*)(es + row * EST + (col ^ 16));
          const float4 pb = *(const float4*)(es + row * EST + (col ^ 16) + 4);
          const float pr[8] = {pa.x, pa.y, pa.z, pa.w, pb.x, pb.y, pb.z, pb.w};
          const int tt = t0 + row;
          const int pos = (d0 < 32) ? (tt >> 6) : (tt & 63);
          const float4 ca = *(const float4*)(cosT + pos * 16 + (d0 & 8)), cb = *(const float4*)(cosT + pos * 16 + (d0 & 8) + 4);
          const float4 sa = *(const float4*)(sinT + pos * 16 + (d0 & 8)), sb = *(const float4*)(sinT + pos * 16 + (d0 & 8) + 4);
          const float cs[8] = {ca.x, ca.y, ca.z, ca.w, cb.x, cb.y, cb.z, cb.w};
          const float sn[8] = {sa.x, sa.y, sa.z, sa.w, sb.x, sb.y, sb.z, sb.w};
          const float sgn = (d0 & 16) ? 1.f : -1.f;
#pragma unroll
          for (int e = 0; e < 8; e++) v[e] = v[e] * cs[e] + sgn * pr[e] * sn[e];
        }
#pragma unroll
        for (int e = 0; e < 8; e++) v[e] *= qs;
        const uint4 pk_ = pack8(v);
        *(uint4*)(dst + ((size_t)((b * 8 + h) * 2 + sidx) * TK + tq0 + row) * 64 + d0) = pk_;
        if (typ == 1) {
          float rv_[8];
          unpack8(pk_, rv_);
          float ssq_ = 0.f;
#pragma unroll
          for (int e = 0; e < 8; e++) ssq_ += rv_[e] * rv_[e];
          ssq_ += __shfl_xor(ssq_, 1); ssq_ += __shfl_xor(ssq_, 2); ssq_ += __shfl_xor(ssq_, 4);
          kmx = fmaxf(kmx, ssq_);
        }
      EPI8_END
      if (typ == 1) {
        kmx = fmaxf(kmx, __shfl_xor(kmx, 16));
        kmx = fmaxf(kmx, __shfl_xor(kmx, 32));
        if ((tidx & 55) == 0)
          atomicMax((unsigned*)(p.ws + OFF_MISC) + 4096 + (layer >> 1) * 128 + (b * 8 + h) * 2 + ((tidx >> 3) & 1), __float_as_uint(kmx));
      }
    } else {
      float* es = (float*)smem;
      acc_to_lds(acc, es);
      __syncthreads();
      for (int pass = 0; pass < 8; pass++) {
        const int d = tidx & 127, tg = pass * 2 + (tidx >> 7);
        float v[8];
#pragma unroll
        for (int e = 0; e < 8; e++) v[e] = es[(tg * 8 + e) * EST + d];
        *(uint4*)(VT + ((size_t)(b * 8 + h) * 128 + d) * TK + tq0 + tg * 8) = pack8(v);
      }
      __syncthreads();
    }
  }
}

typedef _Float16 hv2 __attribute__((ext_vector_type(2)));
DI unsigned packh2(float a, float b) { hv2 r = {(_Float16)a, (_Float16)b}; return __builtin_bit_cast(unsigned, r); }
DI float lo_h(unsigned u) { hv2 r = __builtin_bit_cast(hv2, u); return (float)r[0]; }
DI float hi_h(unsigned u) { hv2 r = __builtin_bit_cast(hv2, u); return (float)r[1]; }

DI void phase_attn(const P& p, int layer, char* smem) {
  const int tidx = opaque_tid();
  const int j = layer / 2;
  const bool ctxq = layer != 3;
  const bf16_t* Q = (const bf16_t*)(p.ws + OFF_TR + TR_Q);
  const bf16_t* Kb = (const bf16_t*)(p.ws + OFF_TR + TR_KK);
  const bf16_t* VT = (const bf16_t*)(p.ws + OFF_TR + TR_VT);
  bf16_t* O = (bf16_t*)(p.ws + OFF_TR + TR_H);
  const float lam = ((const float*)(p.ws + OFF_MISC))[2048 + j];
  const float* kmax2 = (const float*)(p.ws + OFF_MISC) + 4096 + j * 128;
  const float oml = 1.f - lambda_init(layer);
  const float* subg = p.da_subln_g + (size_t)j * 128;
  constexpr int LDV = 68;
  bf16_t* sK = (bf16_t*)smem;
  bf16_t* sV = sK + 2 * 64 * LDT;
  const int tid = tidx, lane = tid & 63, w = tid >> 6, g = lane >> 5, l31 = lane & 31;
  const int nitems = 2048 + (ctxq ? 128 : 0);
  const int spx = gridDim.x >> 3, gpr = spx >> 5;
  const int lat_rounds = 64 / (8 * gpr);
  for (int it0 = blockIdx.x; it0 < lat_rounds * (int)gridDim.x + (ctxq ? 128 : 0); it0 += gridDim.x) {
    int item;
    if (it0 < lat_rounds * (int)gridDim.x) {
      const int r = it0 % (int)gridDim.x, round = it0 / (int)gridDim.x;
      const int xcd = r & 7, li = r >> 3;
      const int bh = (round * 8 + xcd) * gpr + (li >> 5);
      item = bh * 32 + (li & 31);
    } else {
      item = 2048 + (it0 - lat_rounds * (int)gridDim.x);
    }
    (void)nitems;
    int b, h, q0, kbeg, ntiles;
    if (item < 2048) { b = item >> 8; h = (item >> 5) & 7; q0 = (item & 31) * 128; kbeg = 0; ntiles = TK / 64; }
    else { const int it = item - 2048; b = it >> 4; h = (it >> 1) & 7; q0 = SL + (it & 1) * 128; kbeg = SL; ntiles = CL / 64; }
    const bf16_t* Vp0 = VT + (size_t)(b * 8 + h) * 128 * TK;
    const int tq = q0 + w * 32 + l31;
    const size_t grow = tq < SL ? (size_t)b * SL + tq : (size_t)NLAT + (size_t)b * CL + (tq - SL);
    bf16_t* op = O + grow * 1024 + h * 128;
    for (int s = 0; s < 2; s++) {
      const bf16_t* Kp0 = Kb + (size_t)((b * 8 + h) * 2 + s) * TK * 64;
      const bf16_t* Qp = Q + ((size_t)((b * 8 + h) * 2 + s) * TK + tq) * 64 + g * 8;
      bf16x8 qf[4];
      float qss = 0.f;
#pragma unroll
      for (int kk = 0; kk < 4; kk++) {
        const uint4 u = *(const uint4*)(Qp + kk * 16);
        qf[kk] = __builtin_bit_cast(bf16x8, u);
        float qv[8];
        unpack8(u, qv);
#pragma unroll
        for (int e = 0; e < 8; e++) qss += qv[e] * qv[e];
      }
      qss += __shfl_xor(qss, 32);
      const float nmq = -sqrtf(qss * kmax2[(b * 8 + h) * 2 + s]);
      f32x16 o[4];
#pragma unroll
      for (int db = 0; db < 4; db++)
#pragma unroll
        for (int r = 0; r < 16; r++) o[db][r] = 0.f;
      float l = 0.f;
      uint4 rk0, rk1, rv0, rv1, rv2, rv3;
      const unsigned kvo = (unsigned)((tid >> 3) * 64 + (tid & 7) * 8);
      const unsigned vvo = (unsigned)((tid >> 3) * TK + (tid & 7) * 8);
      const unsigned sko = (unsigned)((tid >> 3) * LDT + (tid & 7) * 8);
      const unsigned svo = (unsigned)((tid >> 3) * LDV + (tid & 7) * 8);
#define ISSUE_KV(kt_)                                                             \
      {                                                                           \
        const bf16_t* kb_ = Kp0 + (size_t)(kbeg + (kt_) * 64) * 64;               \
        const bf16_t* vb_ = Vp0 + (kbeg + (kt_) * 64);                            \
        unsigned kvo_ = kvo, vvo_ = vvo;                                          \
        asm volatile("" : "+v"(kvo_), "+v"(vvo_));     \
        rk0 = *(const uint4*)(kb_ + kvo_);                                        \
        rk1 = *(const uint4*)(kb_ + (kvo_ + 32u * 64u));                          \
        rv0 = *(const uint4*)(vb_ + vvo_);                                        \
        rv1 = *(const uint4*)(vb_ + (vvo_ + 32u * (unsigned)TK));                 \
        rv2 = *(const uint4*)(vb_ + (vvo_ + 64u * (unsigned)TK));                 \
        rv3 = *(const uint4*)(vb_ + (vvo_ + 96u * (unsigned)TK));                 \
      }
#define ST_V(ptr_, r_) { *(uint2*)(ptr_) = make_uint2(r_.x, r_.y); *(uint2*)((ptr_) + 4) = make_uint2(r_.z, r_.w); }
#define STAGE_KV(buf_)                                                            \
      {                                                                           \
        bf16_t* ks_ = sK + (buf_) * 64 * LDT + sko;                               \
        bf16_t* vs_ = sV + (buf_) * 128 * LDV + svo;                              \
        *(uint4*)(ks_) = rk0;                                                     \
        *(uint4*)(ks_ + 32 * LDT) = rk1;                                          \
        ST_V(vs_, rv0); ST_V(vs_ + 32 * LDV, rv1); ST_V(vs_ + 64 * LDV, rv2); ST_V(vs_ + 96 * LDV, rv3); \
      }
      __syncthreads();
      ISSUE_KV(0);
      STAGE_KV(0);
      __syncthreads();
      for (int kt = 0; kt < ntiles; kt++) {
        const int buf = kt & 1;
        const bool more = kt + 1 < ntiles;
        if (more) ISSUE_KV(kt + 1);
        __builtin_amdgcn_sched_barrier(0);
        const bf16_t* kS = sK + buf * 64 * LDT;
        const bf16_t* vS = sV + buf * 128 * LDV;
#pragma unroll
        for (int kb = 0; kb < 2; kb++) {
          bf16x8 kf[4];
#pragma unroll
          for (int kk = 0; kk < 4; kk++) kf[kk] = *(const bf16x8*)(kS + (kb * 32 + l31) * LDT + kk * 16 + g * 8);
          __builtin_amdgcn_sched_barrier(0);
          f32x16 st;
#pragma unroll
          for (int r = 0; r < 16; r++) st[r] = nmq;
#pragma unroll
          for (int kk = 0; kk < 4; kk++) st = MFMA32(kf[kk], qf[kk], st);
          float ls = 0.f;
          bf16x8 pk[2];
#pragma unroll
          for (int hh = 0; hh < 2; hh++) {
            float e[8];
#pragma unroll
            for (int i = 0; i < 8; i++) { e[i] = __builtin_amdgcn_exp2f(st[hh * 8 + i]); ls += e[i]; }
            const uint4 u = make_uint4(pack2(e[0], e[1]), pack2(e[2], e[3]), pack2(e[4], e[5]), pack2(e[6], e[7]));
            pk[hh] = __builtin_bit_cast(bf16x8, u);
          }
          l += ls;
#pragma unroll
          for (int hh = 0; hh < 2; hh++) {
            uint4 vf[4];
#pragma unroll
            for (int db = 0; db < 4; db++) {
              const bf16_t* vp = vS + (db * 32 + l31) * LDV + kb * 32 + hh * 16 + 4 * g;
              const uint2 lo = *(const uint2*)vp;
              const uint2 hi = *(const uint2*)(vp + 8);
              vf[db] = make_uint4(lo.x, lo.y, hi.x, hi.y);
            }
            __builtin_amdgcn_sched_barrier(0);
#pragma unroll
            for (int db = 0; db < 4; db++) o[db] = MFMA32(__builtin_bit_cast(bf16x8, vf[db]), pk[hh], o[db]);
          }
        }
        __builtin_amdgcn_sched_barrier(0);
        if (more) STAGE_KV(buf ^ 1);
        __syncthreads();
      }
      const float lt = l + __shfl_xor(l, 32);
      if (s == 0) {
        const float inv = 1.f / lt;
#pragma unroll
        for (int db = 0; db < 4; db++)
#pragma unroll
          for (int rq = 0; rq < 4; rq++) {
            const int d = db * 32 + 8 * rq + 4 * g;
            *(uint2*)(op + d) = make_uint2(packh2(o[db][4 * rq] * inv, o[db][4 * rq + 1] * inv), packh2(o[db][4 * rq + 2] * inv, o[db][4 * rq + 3] * inv));
          }
      } else {
        const float inv = lam / lt;
        float ssq = 0.f;
#pragma unroll
        for (int db = 0; db < 4; db++)
#pragma unroll
          for (int rq = 0; rq < 4; rq++) {
            const int d = db * 32 + 8 * rq + 4 * g;
            const uint2 u0 = *(const uint2*)(op + d);
            const float a0 = lo_h(u0.x) - o[db][4 * rq] * inv, a1 = hi_h(u0.x) - o[db][4 * rq + 1] * inv;
            const float a2 = lo_h(u0.y) - o[db][4 * rq + 2] * inv, a3 = hi_h(u0.y) - o[db][4 * rq + 3] * inv;
            o[db][4 * rq] = a0; o[db][4 * rq + 1] = a1; o[db][4 * rq + 2] = a2; o[db][4 * rq + 3] = a3;
            ssq += a0 * a0 + a1 * a1 + a2 * a2 + a3 * a3;
          }
        ssq += __shfl_xor(ssq, 32);
        const float rs = rsqrtf(ssq * (1.f / 128.f) + 1e-5f) * oml;
#pragma unroll
        for (int db = 0; db < 4; db++)
#pragma unroll
          for (int rq = 0; rq < 4; rq++) {
            const int d = db * 32 + 8 * rq + 4 * g;
            const float4 sg = *(const float4*)(subg + d);
            *(uint2*)(op + d) = make_uint2(pack2(o[db][4 * rq] * rs * sg.x, o[db][4 * rq + 1] * rs * sg.y),
                                           pack2(o[db][4 * rq + 2] * rs * sg.z, o[db][4 * rq + 3] * rs * sg.w));
          }
      }
    }
  }
}

DI void phase_at_out(const P& p, int layer, char* smem) {
  const int tidx = opaque_tid();
  const bf16_t* O = (const bf16_t*)(p.ws + OFF_TR + TR_H);
  const bf16_t* WO = (const bf16_t*)(p.ws + w_off(layer)) + W_WO;
  const int nmt = (layer == 3) ? 256 : 272;
  for (int t = blockIdx.x; t < xcd_rounds(nmt, 8) * (int)gridDim.x; t += gridDim.x) {
    int gt, nt_;
    if (!xcd_tile(t, nmt, 8, gt, nt_)) continue;
    const int n0 = nt_ * 128;
    f32x16 acc[2][2];
    gemm_mainloop(O + (size_t)gt * 128 * 1024, 1024, WO + (size_t)n0 * 1024, 1024, 1024, smem, acc);
    const float* gate = mods_ptr(p, layer, mod_row(gt * 128)) + 2048 + n0;
    float* xr = resid_row(p, gt * 128) + n0;
    EPI8_BEGIN
      resid_update(xr + (size_t)row * D + col, gate + col, v);
    EPI8_END
  }
}

DI void phase_final(const P& p) {
  const int tidx = opaque_tid();
  const int lane = tidx & 63, wv = tidx >> 6;
  for (int row = blockIdx.x * 4 + wv; row < NLAT; row += gridDim.x * 4) {
    float* xr = p.out + (size_t)row * D;
    float4 v[4];
    float ss = 0.f;
#pragma unroll
    for (int jx = 0; jx < 4; jx++) { v[jx] = *(const float4*)(xr + jx * 256 + lane * 4); ss += v[jx].x * v[jx].x + v[jx].y * v[jx].y + v[jx].z * v[jx].z + v[jx].w * v[jx].w; }
    ss = wave_sum(ss);
    const float rs = rsqrtf(ss * (1.f / 1024.f) + 1e-6f);
#pragma unroll
    for (int jx = 0; jx < 4; jx++) {
      const float4 g = *(const float4*)(p.final_g + jx * 256 + lane * 4);
      *(float4*)(xr + jx * 256 + lane * 4) = make_float4(v[jx].x * rs * g.x, v[jx].y * rs * g.y, v[jx].z * rs * g.z, v[jx].w * rs * g.w);
    }
  }
}

#define XB_TMO      128
#define XB_XCNT(j)  (256  + 64 * (j))
#define XB_XSUB(j)  (1280 + 64 * (j))
#define XB_XGEN(j)  (2304 + 64 * (j))
#define XB_TOP      3328
#define XB_TOPGEN   3392
#define XCD_BAR_WORDS 3456
#define XB_SPIN_CAP (1u << 22)
#define LAS __attribute__((address_space(3)))
DI unsigned xb_ld(unsigned* p) { return __hip_atomic_load(p, __ATOMIC_RELAXED, __HIP_MEMORY_SCOPE_AGENT); }
DI unsigned xb_add(unsigned* p, unsigned v) { return __hip_atomic_fetch_add(p, v, __ATOMIC_RELAXED, __HIP_MEMORY_SCOPE_AGENT); }
DI unsigned xb_xcc_id() { return (unsigned)__builtin_amdgcn_s_getreg((3 << 11) | 20) & 0xFu; }
#define XB_SPIN(cond, bar) do { unsigned _sp = 0; while (cond) { __builtin_amdgcn_s_sleep(1); \
    if ((++_sp & 255u) == 0u) { if (xb_ld(&(bar)[XB_TMO])) break; if (_sp > XB_SPIN_CAP) { atomicAdd(&(bar)[XB_TMO], 1u); break; } } } } while (0)
struct XcdBarrier { unsigned* bar; unsigned x; volatile LAS unsigned* st; };
DI XcdBarrier xcd_barrier_post(unsigned* bar, volatile LAS unsigned* st) {
  XcdBarrier b; b.bar = bar; b.x = xb_xcc_id(); b.st = st;
  if (threadIdx.x == 0) (void)xb_add(&bar[XB_XCNT(b.x)], 1u);
  return b;
}
DI void xcd_barrier_complete(unsigned* bar, unsigned x, unsigned& nloc, unsigned& nx) {
  const unsigned G = gridDim.x * gridDim.y * gridDim.z;
  unsigned sum, cnt, mine, sp = 0u;
  for (;;) {
    sum = 0u; cnt = 0u; mine = 0u;
#pragma unroll
    for (unsigned j = 0; j < 16; ++j) { const unsigned c = xb_ld(&bar[XB_XCNT(j)]); sum += c; cnt += (c > 0u) ? 1u : 0u; mine = (j == x) ? c : mine; }
    if (sum == G) break;
    __builtin_amdgcn_s_sleep(1);
    if ((++sp & 255u) == 0u) { if (xb_ld(&bar[XB_TMO])) break; if (sp > XB_SPIN_CAP) { atomicAdd(&bar[XB_TMO], 1u); break; } }
  }
  nloc = mine > 0u ? mine : 1u; nx = cnt > 0u ? cnt : 1u;
}
DI void xcd_barrier(const XcdBarrier& b) {
  asm volatile("s_waitcnt vmcnt(0)" ::: "memory");
  __syncthreads();
  if (threadIdx.x == 0) {
    unsigned* bar = b.bar;
    __builtin_amdgcn_s_waitcnt(0);
    unsigned nloc = b.st[0], nx = b.st[1];
    if (nloc == 0u) { xcd_barrier_complete(bar, b.x, nloc, nx); b.st[0] = nloc; b.st[1] = nx; }
    const unsigned old = xb_add(&bar[XB_XSUB(b.x)], 1u);
    const unsigned gen = old / nloc;
    if (old + 1u == (gen + 1u) * nloc) {
      __builtin_amdgcn_fence(__ATOMIC_RELEASE, "agent");
      asm volatile("s_waitcnt vmcnt(0)" ::: "memory");
      const unsigned og = xb_add(&bar[XB_TOP], 1u);
      const unsigned tg = og / nx;
      if (og + 1u == (tg + 1u) * nx) xb_add(&bar[XB_TOPGEN], 1u);
      else XB_SPIN(xb_ld(&bar[XB_TOPGEN]) == tg, bar);
      __builtin_amdgcn_fence(__ATOMIC_ACQUIRE, "agent");
      xb_add(&bar[XB_XGEN(b.x)], 1u);
      asm volatile("s_waitcnt vmcnt(0)" ::: "memory");
    } else {
      XB_SPIN(xb_ld(&bar[XB_XGEN(b.x)]) == gen, bar);
      __builtin_amdgcn_fence(__ATOMIC_ACQUIRE, "agent");
      asm volatile("s_waitcnt vmcnt(0)" ::: "memory");
    }
  }
  __syncthreads();
}
constexpr size_t OFF_BAR = OFF_MISC + 65536;

typedef __attribute__((address_space(1))) const float GCF;
typedef __attribute__((address_space(1))) float GF;
typedef __attribute__((address_space(1))) char GC;
DI unsigned long long lds_word(const unsigned long long* tbl, int i) {
  int z = i;
  asm volatile("" : "+v"(z));
  const unsigned long long v = tbl[z];
  const unsigned lo = __builtin_amdgcn_readfirstlane((unsigned)v), hi = __builtin_amdgcn_readfirstlane((unsigned)(v >> 32));
  return ((unsigned long long)hi << 32) | lo;
}
DI void load_params(P& q, const unsigned long long* tbl) {
  const float** fp = (const float**)&q;
#pragma unroll
  for (int i = 0; i < 36; i++) fp[i] = (const float*)(GCF*)lds_word(tbl, i);
  q.out = (float*)(GF*)lds_word(tbl, 36);
  q.ws = (char*)(GC*)lds_word(tbl, 37);
  q.only = 0;
  q.pad = 0;
}
__global__ void __launch_bounds__(256, 2) mega(P p) {
  __shared__ __attribute__((aligned(16))) char smem[73728];
  __shared__ unsigned long long s_tbl[40];
  {
#if defined(__HIP_DEVICE_COMPILE__)
    typedef __attribute__((address_space(4))) const unsigned long long KW;
    KW* kp = (KW*)__builtin_amdgcn_kernarg_segment_ptr();
    if (threadIdx.x < 39) s_tbl[threadIdx.x] = kp[threadIdx.x];
#endif
    __syncthreads();
  }
  const int only = (int)(unsigned)lds_word(s_tbl, 38);
  cg::grid_group grid = cg::this_grid();
  __shared__ uint4 xb_words;
  if (threadIdx.x == 0) xb_words = make_uint4(0u, 0u, 0u, 0u);
  __syncthreads();
  XcdBarrier xb;
  {
    P q;
    load_params(q, s_tbl);
    xb = xcd_barrier_post((unsigned*)(q.ws + OFF_BAR), (volatile LAS unsigned*)&xb_words);
  }
  int step = 0;
#define GSYNC() { if (step == 1) grid.sync(); else xcd_barrier(xb); }
#define STEP(body)                                   \
  {                                                  \
    if (only < 0 || only == step) {              \
      P q;                                           \
      load_params(q, s_tbl);                         \
      body;                                          \
    }                                                \
    step++;                                          \
    if (only < 0) GSYNC();                         \
  }
#ifndef DUP
#define DUP 0
#endif
#define STEPD(id, body)                              \
  {                                                  \
    if (only < 0 || only == step) {                  \
      P q;                                           \
      load_params(q, s_tbl);                         \
      body;                                          \
      if (DUP == id) { __syncthreads(); body; }      \
    }                                                \
    step++;                                          \
    if (only < 0) GSYNC();                           \
  }
  STEP(phase_init(q, smem); __syncthreads(); phase_conv(q, 0, smem, blockIdx.x, gridDim.x));
  for (int layer = 0; layer < 4; layer++) {
    if ((layer & 1) == 0) {
      for (int hf = 0; hf < 2; hf++) {
        STEP(phase_prep(q, layer, 0, hf, true, (bf16_t*)(q.ws + OFF_TR + TR_HX), 2048, false));
        STEPD(3, phase_t1(q, layer, smem));
        STEPD(4, phase_feat(q, layer, hf, smem));
        STEPD(5, phase_scan(q, layer, smem);
              if (hf == 0) { __syncthreads(); phase_conv(q, layer + 1, smem, gridDim.x > 256 ? (int)blockIdx.x - 256 : (int)blockIdx.x, gridDim.x > 256 ? (int)gridDim.x - 256 : (int)gridDim.x); });
        STEP(phase_combine(q, layer));
        STEP(phase_rw_out(q, layer, hf, smem));
      }
    } else {
      STEP(phase_prep(q, layer, 0, -1, false, (bf16_t*)(q.ws + OFF_TR + TR_H), 1024, false);
           if (layer + 1 < 4) { __syncthreads(); phase_conv(q, layer + 1, smem, blockIdx.x, gridDim.x); });
      STEPD(7, phase_qkv(q, layer, smem));
      STEPD(8, phase_attn(q, layer, smem));
      STEP(phase_at_out(q, layer, smem));
    }
    STEP(phase_prep(q, layer, 1, -1, false, (bf16_t*)(q.ws + OFF_TR + TR_H2), 1024, layer == 3));
    STEPD(9, phase_mlp1(q, layer, smem));
    STEP(phase_mlp2(q, layer, smem));
  }
  STEP(phase_final(q));
}

#ifndef MULTI_LAUNCH
#define MULTI_LAUNCH 0
#endif
constexpr int NSTEPS = 1 + 2 * (12 + 3) + 2 * (4 + 3) + 1;

extern "C" void kernel_launch(void* const* d_in, const int* in_sizes, int n_in, void* d_out, int out_size, void* d_ws, size_t ws_size,
                              hipStream_t stream) {
  static int grid_blocks = 0;
  if (!grid_blocks) {
    int dev = 0, cus = 0, per_cu = 0;
    hipGetDevice(&dev);
    hipDeviceGetAttribute(&cus, hipDeviceAttributeMultiprocessorCount, dev);
    hipOccupancyMaxActiveBlocksPerMultiprocessor(&per_cu, mega, 256, 0);
    if (per_cu < 1) per_cu = 1;
    if (per_cu > 2) per_cu = 2;
    grid_blocks = cus * per_cu;
  }
  P p{};
  const float** fp = (const float**)&p;
  for (int i = 0; i < 36; i++) fp[i] = (const float*)d_in[i];
  p.out = (float*)d_out;
  p.ws = (char*)d_ws;
  p.pad = 0;
#if MULTI_LAUNCH
  for (int s = 0; s < NSTEPS; s++) {
    p.only = s;
    void* args[] = {&p};
    hipError_t e = hipLaunchCooperativeKernel((void*)mega, dim3(grid_blocks), dim3(256), args, 0, stream);
    if (e != hipSuccess) { fprintf(stderr, "launch failed: %s\n", hipGetErrorString(e)); break; }
  }
#else
  p.only = -1;
  hipMemsetAsync((char*)d_ws + OFF_BAR, 0, XCD_BAR_WORDS * 4, stream);
  void* args[] = {&p};
  hipError_t e = hipLaunchCooperativeKernel((void*)mega, dim3(grid_blocks), dim3(256), args, 0, stream);
  if (e != hipSuccess) fprintf(stderr, "cooperative launch failed: %s (grid %d)\n", hipGetErrorString(e), grid_blocks);
#endif
}
```

```cpp
#include <hip/hip_runtime.h>
#include <hip/hip_cooperative_groups.h>
#include <cstdio>
namespace cg = cooperative_groups;

#define DI __device__ __forceinline__
typedef unsigned short bf16_t;
using bf16x8 = __attribute__((ext_vector_type(8))) short;
using f32x16 = __attribute__((ext_vector_type(16))) float;
typedef __bf16 bfv2 __attribute__((ext_vector_type(2)));
typedef float fv2 __attribute__((ext_vector_type(2)));
#define MFMA32(a, b, c) __builtin_amdgcn_mfma_f32_32x32x16_bf16((a), (b), (c), 0, 0, 0)

constexpr int D = 1024, NB = 8, SL = 4096, CL = 256;
constexpr int NLAT = NB * SL, NCTX = NB * CL, NTOK = NLAT + NCTX;
constexpr int HROWS = NTOK / 2;
constexpr int TK = SL + CL;
constexpr size_t MiB = 1048576;
constexpr size_t OFF_W2 = 476 * MiB;
constexpr size_t OFF_W = 0, OFF_XC = 36 * MiB, OFF_MODS = 44 * MiB, OFF_MISC = 45 * MiB, OFF_VF = 46 * MiB, OFF_TR = 114 * MiB;
constexpr size_t W_RKV = 0;
constexpr size_t W_L1 = W_RKV + 3072ull * 2048;
constexpr size_t W_W2 = W_L1 + 640ull * 2048;
constexpr size_t W_A2 = W_W2 + 2ull * 65536;
constexpr size_t W_G2 = W_A2 + 65536;
constexpr size_t W_V2 = W_G2 + 2ull * 196608;
constexpr size_t W_WO = W_V2 + 65536;
constexpr size_t W_M1 = W_WO + 1048576;
constexpr size_t W_M2 = W_M1 + 4194304;
constexpr size_t W_QKV = 0;
constexpr size_t HALF_ARR = (size_t)HROWS * 1024 * 2;
constexpr size_t TR_HX = 0;
constexpr size_t TR_T1 = 2 * HALF_ARR;
constexpr size_t TR_R = TR_T1 + (size_t)HROWS * 640 * 2;
constexpr size_t TR_K = TR_R + HALF_ARR, TR_V = TR_K + HALF_ARR, TR_A = TR_V + HALF_ARR;
constexpr size_t TR_WL0 = TR_A + HALF_ARR, TR_WL1 = TR_WL0 + HALF_ARR, TR_G0 = TR_WL1 + HALF_ARR, TR_G1 = TR_G0 + HALF_ARR;
constexpr size_t FULL_ARR = (size_t)NTOK * 1024 * 2;
constexpr size_t TR_H = 0, TR_Q = FULL_ARR, TR_KK = 2 * FULL_ARR, TR_VT = 3 * FULL_ARR;
constexpr size_t TR_H2 = 0, TR_HID = FULL_ARR;

struct P {
  const float *x, *c, *ctx, *c_ctx, *ada_w, *ada_b, *norm_g, *final_g;
  const float *rw_mix, *rw_w_rkv, *rw_w0, *rw_w1, *rw_w2, *rw_a0, *rw_a1, *rw_a2, *rw_g1, *rw_g2, *rw_kk, *rw_ka, *rw_rk, *rw_ln_g, *rw_ln_b, *rw_w_o, *rw_v0, *rw_v1, *rw_v2;
  const float *da_w_qkv, *da_w_o, *da_lq1, *da_lk1, *da_lq2, *da_lk2, *da_subln_g, *mlp_w1, *mlp_w2;
  float* out;
  char* ws;
  int only;
  int pad;
};

DI float bf2f(bf16_t h) { return __uint_as_float(((unsigned)h) << 16); }
DI unsigned pack2(float a, float b) { fv2 v = {a, b}; bfv2 r = __builtin_convertvector(v, bfv2); return __builtin_bit_cast(unsigned, r); }
DI bf16_t f2bf(float a) { return (bf16_t)(pack2(a, 0.f) & 0xffffu); }
DI float lo_bf(unsigned u) { return __uint_as_float(u << 16); }
DI float hi_bf(unsigned u) { return __uint_as_float(u & 0xffff0000u); }
DI float sigmoidf_(float x) { return 1.f / (1.f + __expf(-x)); }
DI float wave_sum(float v) {
#pragma unroll
  for (int o = 32; o > 0; o >>= 1) v += __shfl_xor(v, o);
  return v;
}
template <int N> DI float ror_add(float x) { return x + __builtin_bit_cast(float, __builtin_amdgcn_mov_dpp(__builtin_bit_cast(int, x), 0x120 + N, 0xf, 0xf, true)); }
DI float rowsum16(float x) { x = ror_add<8>(x); x = ror_add<4>(x); x = ror_add<2>(x); x = ror_add<1>(x); return x; }

DI int opaque_tid() { int t = threadIdx.x; asm volatile("" : "+v"(t)); return t; }
DI float* resid_row(const P& p, int gr) { return gr < NLAT ? p.out + (size_t)gr * D : (float*)(p.ws + OFF_XC) + (size_t)(gr - NLAT) * D; }
DI const float* input_row(const P& p, int gr) { return gr < NLAT ? p.x + (size_t)gr * D : p.ctx + (size_t)(gr - NLAT) * D; }
DI int mod_row(int gr) { return gr < NLAT ? gr / SL : 8; }
DI const float* mods_ptr(const P& p, int layer, int mrow) { return (const float*)(p.ws + OFF_MODS) + ((size_t)layer * 9 + mrow) * 6144; }
DI int half_gtile(int hf, int lt) { return lt < 128 ? hf * 128 + lt : 256 + hf * 8 + (lt - 128); }
DI int first_tile(int base) { int g = gridDim.x; int s = (int)blockIdx.x - (base % g); if (s < 0) s += g; return s; }
DI size_t w_off(int layer) { return (layer & 1) ? OFF_W2 : OFF_W; }
DI float lambda_init(int layer) { return 0.8f - 0.6f * expf(-0.3f * (float)layer); }

DI void phase_init(const P& p, char* smem) {
  const int tidx = opaque_tid();
  const int tid = tidx;
  float* sc = (float*)smem;
  float* mods = (float*)(p.ws + OFF_MODS);
  for (int item = blockIdx.x; item < 96; item += gridDim.x) {
    const int layer = item / 24, cb = item % 24;
    __syncthreads();
    for (int i = tid; i < 9 * 1024; i += 256) {
      int r = i >> 10, k = i & 1023;
      float v = r < 8 ? p.c[r * 1024 + k] : p.c_ctx[k];
      sc[i] = v / (1.f + expf(-v));
    }
    __syncthreads();
    const int w = tid >> 6, q = tid & 63;
    float4 acc[9];
#pragma unroll
    for (int r = 0; r < 9; r++) acc[r] = make_float4(0.f, 0.f, 0.f, 0.f);
    const float* wp = p.ada_w + (size_t)layer * 1024 * 6144 + cb * 256 + q * 4;
    for (int k = w * 256; k < w * 256 + 256; k++) {
      float4 wv = *(const float4*)(wp + (size_t)k * 6144);
#pragma unroll
      for (int r = 0; r < 9; r++) {
        float s = sc[r * 1024 + k];
        acc[r].x += s * wv.x; acc[r].y += s * wv.y; acc[r].z += s * wv.z; acc[r].w += s * wv.w;
      }
    }
    __syncthreads();
    float4* red = (float4*)smem;
#pragma unroll
    for (int r = 0; r < 9; r++) red[(w * 9 + r) * 64 + q] = acc[r];
    __syncthreads();
    for (int i = tid; i < 9 * 64; i += 256) {
      int r = i / 64, qq = i % 64;
      float4 s0 = red[(0 * 9 + r) * 64 + qq], s1 = red[(1 * 9 + r) * 64 + qq], s2 = red[(2 * 9 + r) * 64 + qq], s3 = red[(3 * 9 + r) * 64 + qq];
      float4 bb = *(const float4*)(p.ada_b + layer * 6144 + cb * 256 + qq * 4);
      float4 o = make_float4(s0.x + s1.x + s2.x + s3.x + bb.x, s0.y + s1.y + s2.y + s3.y + bb.y, s0.z + s1.z + s2.z + s3.z + bb.z, s0.w + s1.w + s2.w + s3.w + bb.w);
      *(float4*)(mods + ((size_t)layer * 9 + r) * 6144 + cb * 256 + qq * 4) = o;
    }
  }
  if (blockIdx.x == gridDim.x - 1) {
    float* misc = (float*)(p.ws + OFF_MISC);
    for (int i = tid; i < 1024; i += 256) {
      int pos = i / 16, f = i % 16;
      float inv = powf(10000.f, -(float)f / 16.f);
      float ang = (float)pos * inv;
      misc[i] = cosf(ang);
      misc[1024 + i] = sinf(ang);
    }
    misc[4096 + tid] = 0.f;
    if (tid < 2) {
      float s1 = 0.f, s2 = 0.f;
      for (int k = 0; k < 64; k++) { s1 += p.da_lq1[tid * 64 + k] * p.da_lk1[tid * 64 + k]; s2 += p.da_lq2[tid * 64 + k] * p.da_lk2[tid * 64 + k]; }
      misc[2048 + tid] = expf(s1) - expf(s2) + lambda_init(2 * tid + 1);
    }
  }
}

DI void conv_mat(const float* __restrict__ src, int K, int N, bf16_t* __restrict__ dst, int ldd, int koff, const float* __restrict__ scale,
                 int Kp, int Np, float* sm, int& base, int vb, int vg) {
  const int tidx = opaque_tid();
  const int tid = tidx;
  const int tk = Kp / 64, tn = Np / 64, nt = tk * tn;
  int t0_ = vb - (base % vg);
  if (t0_ < 0) t0_ += vg;
  for (int t = t0_; t < nt; t += vg) {
    const int k0 = (t / tn) * 64, n0 = (t % tn) * 64;
    __syncthreads();
#pragma unroll
    for (int i = 0; i < 4; i++) {
      int kr = (tid >> 4) + 16 * i, nc = (tid & 15) * 4;
      float4 v = make_float4(0.f, 0.f, 0.f, 0.f);
      if (src != nullptr && k0 + kr < K && n0 + nc < N) {
        v = *(const float4*)(src + (size_t)(k0 + kr) * N + n0 + nc);
        if (scale) { float s = scale[k0 + kr]; v.x *= s; v.y *= s; v.z *= s; v.w *= s; }
      }
      sm[kr * 65 + nc + 0] = v.x; sm[kr * 65 + nc + 1] = v.y; sm[kr * 65 + nc + 2] = v.z; sm[kr * 65 + nc + 3] = v.w;
    }
    __syncthreads();
    const int n = tid >> 2, kb = (tid & 3) * 16;
    unsigned o[8];
#pragma unroll
    for (int i = 0; i < 8; i++) o[i] = pack2(sm[(kb + 2 * i) * 65 + n], sm[(kb + 2 * i + 1) * 65 + n]);
    uint4* dp = (uint4*)(dst + (size_t)(n0 + n) * ldd + koff + k0 + kb);
    dp[0] = make_uint4(o[0], o[1], o[2], o[3]);
    dp[1] = make_uint4(o[4], o[5], o[6], o[7]);
  }
  base += nt;
}

DI void phase_conv(const P& p, int layer, char* smem, int vb, int vg) {
  if (vb < 0) return;
  float* sm = (float*)smem;
  bf16_t* W = (bf16_t*)(p.ws + w_off(layer));
  int base = 0;
  const int j = layer / 2;
  if ((layer & 1) == 0) {
    for (int s = 0; s < 3; s++) {
      const float* src = p.rw_w_rkv + ((size_t)j * 3 + s) * 1048576;
      conv_mat(src, 1024, 1024, W + W_RKV + (size_t)s * 1024 * 2048, 2048, 0, nullptr, 1024, 1024, sm, base, vb, vg);
    }
    for (int pass = 0; pass < 2; pass++) {
      const int ko = pass * 1024;
      const float* m1 = pass ? p.rw_mix + ((size_t)j * 6 + 1) * 1024 : nullptr;
      const float* m4 = pass ? p.rw_mix + ((size_t)j * 6 + 4) * 1024 : nullptr;
      const float* m5 = pass ? p.rw_mix + ((size_t)j * 6 + 5) * 1024 : nullptr;
      const float* m3 = pass ? p.rw_mix + ((size_t)j * 6 + 3) * 1024 : nullptr;
      bf16_t* L1 = W + W_L1;
      conv_mat(p.rw_w1 + ((size_t)j * 2 + 0) * 65536, 1024, 64, L1 + 0ull * 2048, 2048, ko, m1, 1024, 64, sm, base, vb, vg);
      conv_mat(p.rw_w1 + ((size_t)j * 2 + 1) * 65536, 1024, 64, L1 + 64ull * 2048, 2048, ko, m1, 1024, 64, sm, base, vb, vg);
      conv_mat(p.rw_a1 + (size_t)j * 65536, 1024, 64, L1 + 128ull * 2048, 2048, ko, m4, 1024, 64, sm, base, vb, vg);
      conv_mat(p.rw_g1 + ((size_t)j * 2 + 0) * 163840, 1024, 160, L1 + 256ull * 2048, 2048, ko, m5, 1024, 192, sm, base, vb, vg);
      conv_mat(p.rw_g1 + ((size_t)j * 2 + 1) * 163840, 1024, 160, L1 + 448ull * 2048, 2048, ko, m5, 1024, 192, sm, base, vb, vg);
      conv_mat(j > 0 ? p.rw_v1 + (size_t)(j - 1) * 32768 : nullptr, 1024, 32, L1 + 192ull * 2048, 2048, ko, m3, 1024, 64, sm, base, vb, vg);
    }
    conv_mat(p.rw_w2 + ((size_t)j * 2 + 0) * 65536, 64, 1024, W + W_W2, 64, 0, nullptr, 64, 1024, sm, base, vb, vg);
    conv_mat(p.rw_w2 + ((size_t)j * 2 + 1) * 65536, 64, 1024, W + W_W2 + 65536, 64, 0, nullptr, 64, 1024, sm, base, vb, vg);
    conv_mat(p.rw_a2 + (size_t)j * 65536, 64, 1024, W + W_A2, 64, 0, nullptr, 64, 1024, sm, base, vb, vg);
    conv_mat(p.rw_g2 + ((size_t)j * 2 + 0) * 163840, 160, 1024, W + W_G2, 192, 0, nullptr, 192, 1024, sm, base, vb, vg);
    conv_mat(p.rw_g2 + ((size_t)j * 2 + 1) * 163840, 160, 1024, W + W_G2 + 196608, 192, 0, nullptr, 192, 1024, sm, base, vb, vg);
    conv_mat(j > 0 ? p.rw_v2 + (size_t)(j - 1) * 32768 : nullptr, 32, 1024, W + W_V2, 64, 0, nullptr, 64, 1024, sm, base, vb, vg);
    conv_mat(p.rw_w_o + (size_t)j * 1048576, 1024, 1024, W + W_WO, 1024, 0, nullptr, 1024, 1024, sm, base, vb, vg);
  } else {
    conv_mat(p.da_w_qkv + (size_t)j * 3145728, 1024, 3072, W + W_QKV, 1024, 0, nullptr, 1024, 3072, sm, base, vb, vg);
    conv_mat(p.da_w_o + (size_t)j * 1048576, 1024, 1024, W + W_WO, 1024, 0, nullptr, 1024, 1024, sm, base, vb, vg);
  }
  conv_mat(p.mlp_w1 + (size_t)layer * 4194304, 1024, 4096, W + W_M1, 1024, 0, nullptr, 1024, 4096, sm, base, vb, vg);
  conv_mat(p.mlp_w2 + (size_t)layer * 4194304, 4096, 1024, W + W_M2, 4096, 0, nullptr, 4096, 1024, sm, base, vb, vg);
}

DI void phase_prep(const P& p, int layer, int sub, int hf, bool shift, bf16_t* H, int ldh, bool skip_ctx) {
  const int tidx = opaque_tid();
  const int lane = tidx & 63, wv = tidx >> 6;
  const int nrows = hf < 0 ? (skip_ctx ? NLAT : NTOK) : HROWS;
  const int nseg = nrows / 8;
  const float* ng = p.norm_g + ((size_t)layer * 2 + sub) * 1024;
  for (int seg = blockIdx.x * 4 + wv; seg < nseg; seg += gridDim.x * 4) {
    const int lr0 = seg * 8;
    const int gr0 = hf < 0 ? lr0 : (lr0 < 16384 ? hf * 16384 + lr0 : NLAT + hf * 1024 + (lr0 - 16384));
    const bool lat = gr0 < NLAT;
    const int T = lat ? SL : CL;
    const int t0 = lat ? (gr0 % SL) : ((gr0 - NLAT) % CL);
    const float* xbase = (layer == 0 && sub == 0) ? input_row(p, gr0) : resid_row(p, gr0);
    const float* md = mods_ptr(p, layer, mod_row(gr0));
    float4 g4[4], sc4[4], sh4[4];
#pragma unroll
    for (int jx = 0; jx < 4; jx++) {
      int ch = jx * 256 + lane * 4;
      g4[jx] = *(const float4*)(ng + ch);
      sh4[jx] = *(const float4*)(md + sub * 3072 + ch);
      sc4[jx] = *(const float4*)(md + sub * 3072 + 1024 + ch);
      g4[jx].x *= (1.f + sc4[jx].x); g4[jx].y *= (1.f + sc4[jx].y); g4[jx].z *= (1.f + sc4[jx].z); g4[jx].w *= (1.f + sc4[jx].w);
    }
    float4 hp[4], hc[4], hn[4];
    const int tb = shift ? -1 : 0, te = shift ? 9 : 8;
    for (int tt = tb; tt < te; tt++) {
      const int t = t0 + tt;
      if (t >= 0 && t < T) {
        const float* xr = xbase + (ptrdiff_t)tt * D;
        float ss = 0.f;
#pragma unroll
        for (int jx = 0; jx < 4; jx++) {
          hn[jx] = *(const float4*)(xr + jx * 256 + lane * 4);
          ss += hn[jx].x * hn[jx].x + hn[jx].y * hn[jx].y + hn[jx].z * hn[jx].z + hn[jx].w * hn[jx].w;
        }
        ss = wave_sum(ss);
        const float rs = rsqrtf(ss * (1.f / 1024.f) + 1e-6f);
#pragma unroll
        for (int jx = 0; jx < 4; jx++) {
          hn[jx].x = hn[jx].x * rs * g4[jx].x + sh4[jx].x; hn[jx].y = hn[jx].y * rs * g4[jx].y + sh4[jx].y;
          hn[jx].z = hn[jx].z * rs * g4[jx].z + sh4[jx].z; hn[jx].w = hn[jx].w * rs * g4[jx].w + sh4[jx].w;
        }
      } else {
#pragma unroll
        for (int jx = 0; jx < 4; jx++) hn[jx] = make_float4(0.f, 0.f, 0.f, 0.f);
      }
      if (!shift) {
        bf16_t* hr = H + (size_t)(lr0 + tt) * ldh;
#pragma unroll
        for (int jx = 0; jx < 4; jx++) *(uint2*)(hr + jx * 256 + lane * 4) = make_uint2(pack2(hn[jx].x, hn[jx].y), pack2(hn[jx].z, hn[jx].w));
      } else if (tt >= 1) {
        bf16_t* hr = H + (size_t)(lr0 + tt - 1) * ldh;
#pragma unroll
        for (int jx = 0; jx < 4; jx++) {
          *(uint2*)(hr + jx * 256 + lane * 4) = make_uint2(pack2(hc[jx].x, hc[jx].y), pack2(hc[jx].z, hc[jx].w));
          float4 xx;
          xx.x = 0.5f * (hp[jx].x + hn[jx].x) - hc[jx].x; xx.y = 0.5f * (hp[jx].y + hn[jx].y) - hc[jx].y;
          xx.z = 0.5f * (hp[jx].z + hn[jx].z) - hc[jx].z; xx.w = 0.5f * (hp[jx].w + hn[jx].w) - hc[jx].w;
          *(uint2*)(hr + 1024 + jx * 256 + lane * 4) = make_uint2(pack2(xx.x, xx.y), pack2(xx.z, xx.w));
        }
      }
#pragma unroll
      for (int jx = 0; jx < 4; jx++) { hp[jx] = hc[jx]; hc[jx] = hn[jx]; }
    }
  }
}

constexpr int LDT = 72;
DI void gemm_mainloop(const bf16_t* __restrict__ A, int lda, const bf16_t* __restrict__ Bt, int ldb, int K, char* smem, f32x16 (&acc)[2][2]) {
  const int tidx = opaque_tid();
  bf16_t* sA = (bf16_t*)smem;
  bf16_t* sB = sA + 2 * 128 * LDT;
  const int tid = tidx, lane = tid & 63, w = tid >> 6, wm = w >> 1, wn = w & 1;
  const int lrow = tid >> 3, lkc = (tid & 7) * 8;
#pragma unroll
  for (int mi = 0; mi < 2; mi++)
#pragma unroll
    for (int ni = 0; ni < 2; ni++)
#pragma unroll
      for (int r = 0; r < 16; r++) acc[mi][ni][r] = 0.f;
  const unsigned ao = (unsigned)(lrow * lda + lkc), bo = (unsigned)(lrow * ldb + lkc);
  const unsigned a32 = (unsigned)(32 * lda), b32 = (unsigned)(32 * ldb);
  uint4 ra0, ra1, ra2, ra3, rb0, rb1, rb2, rb3;
#define G_LOAD(Ab, Bb)                                                                                   \
  {                                                                                                      \
    ra0 = *(const uint4*)((Ab) + ao); ra1 = *(const uint4*)((Ab) + (ao + a32));                          \
    ra2 = *(const uint4*)((Ab) + (ao + 2 * a32)); ra3 = *(const uint4*)((Ab) + (ao + 3 * a32));          \
    rb0 = *(const uint4*)((Bb) + bo); rb1 = *(const uint4*)((Bb) + (bo + b32));                          \
    rb2 = *(const uint4*)((Bb) + (bo + 2 * b32)); rb3 = *(const uint4*)((Bb) + (bo + 3 * b32));          \
  }
#define G_STORE(sa_, sb_)                                                                                \
  {                                                                                                      \
    bf16_t* a_w = (sa_) + lrow * LDT + lkc;                                                              \
    bf16_t* b_w = (sb_) + lrow * LDT + lkc;                                                              \
    *(uint4*)(a_w) = ra0; *(uint4*)(a_w + 32 * LDT) = ra1; *(uint4*)(a_w + 64 * LDT) = ra2; *(uint4*)(a_w + 96 * LDT) = ra3; \
    *(uint4*)(b_w) = rb0; *(uint4*)(b_w + 32 * LDT) = rb1; *(uint4*)(b_w + 64 * LDT) = rb2; *(uint4*)(b_w + 96 * LDT) = rb3; \
  }
  G_LOAD(A, Bt);
  G_STORE(sA, sB);
  __syncthreads();
  const int nk = K >> 6;
  const int aoff = (wm * 64 + (lane & 31)) * LDT + (lane >> 5) * 8;
  const int boff = (wn * 64 + (lane & 31)) * LDT + (lane >> 5) * 8;
  for (int kt = 0; kt < nk; kt++) {
    const int cur = kt & 1;
    if (kt + 1 < nk) {
      const bf16_t* A1 = A + (kt + 1) * 64;
      const bf16_t* B1 = Bt + (kt + 1) * 64;
      G_LOAD(A1, B1);
    }
    __builtin_amdgcn_sched_barrier(0);
    __builtin_amdgcn_s_setprio(1);
    const bf16_t* a_s = sA + cur * 128 * LDT + aoff;
    const bf16_t* b_s = sB + cur * 128 * LDT + boff;
#pragma unroll
    for (int kk = 0; kk < 4; kk++) {
      bf16x8 af[2], bq[2];
#pragma unroll
      for (int mi = 0; mi < 2; mi++) af[mi] = *(const bf16x8*)(a_s + mi * 32 * LDT + kk * 16);
#pragma unroll
      for (int ni = 0; ni < 2; ni++) bq[ni] = *(const bf16x8*)(b_s + ni * 32 * LDT + kk * 16);
#pragma unroll
      for (int mi = 0; mi < 2; mi++)
#pragma unroll
        for (int ni = 0; ni < 2; ni++) acc[mi][ni] = MFMA32(af[mi], bq[ni], acc[mi][ni]);
    }
    __builtin_amdgcn_s_setprio(0);
    __builtin_amdgcn_sched_barrier(0);
    if (kt + 1 < nk) G_STORE(sA + (cur ^ 1) * 128 * LDT, sB + (cur ^ 1) * 128 * LDT);
    __syncthreads();
  }
}
DI uint4 mix8(const uint4 h, const uint4 x, const float4 m0, const float4 m1) {
  uint4 o;
  o.x = pack2(lo_bf(h.x) + lo_bf(x.x) * m0.x, hi_bf(h.x) + hi_bf(x.x) * m0.y);
  o.y = pack2(lo_bf(h.y) + lo_bf(x.y) * m0.z, hi_bf(h.y) + hi_bf(x.y) * m0.w);
  o.z = pack2(lo_bf(h.z) + lo_bf(x.z) * m1.x, hi_bf(h.z) + hi_bf(x.z) * m1.y);
  o.w = pack2(lo_bf(h.w) + lo_bf(x.w) * m1.z, hi_bf(h.w) + hi_bf(x.w) * m1.w);
  return o;
}
DI void gemm_mainloop_mix(const bf16_t* __restrict__ HX, const float* __restrict__ mix, const bf16_t* __restrict__ Bt, int ldb, char* smem, f32x16 (&acc)[2][2]) {
  const int tidx = opaque_tid();
  bf16_t* sA = (bf16_t*)smem;
  bf16_t* sB = sA + 2 * 128 * LDT;
  const int tid = tidx, lane = tid & 63, w = tid >> 6, wm = w >> 1, wn = w & 1;
  const int lrow = tid >> 3, lkc = (tid & 7) * 8;
#pragma unroll
  for (int mi = 0; mi < 2; mi++)
#pragma unroll
    for (int ni = 0; ni < 2; ni++)
#pragma unroll
      for (int r = 0; r < 16; r++) acc[mi][ni][r] = 0.f;
  const unsigned ao = (unsigned)(lrow * 2048 + lkc), bo = (unsigned)(lrow * ldb + lkc);
  const unsigned a32 = 32u * 2048u, b32 = (unsigned)(32 * ldb);
  uint4 h0, h1, h2, h3, x0, x1, x2, x3, rb0, rb1, rb2, rb3;
  float4 m0, m1;
#define GM_LOAD(kstep_)                                                                                  \
  {                                                                                                      \
    const bf16_t* Ab_ = HX + (kstep_) * 64;                                                              \
    const bf16_t* Bb_ = Bt + (kstep_) * 64;                                                              \
    h0 = *(const uint4*)(Ab_ + ao); h1 = *(const uint4*)(Ab_ + (ao + a32));                              \
    h2 = *(const uint4*)(Ab_ + (ao + 2 * a32)); h3 = *(const uint4*)(Ab_ + (ao + 3 * a32));              \
    x0 = *(const uint4*)(Ab_ + (ao + 1024u)); x1 = *(const uint4*)(Ab_ + (ao + a32 + 1024u));            \
    x2 = *(const uint4*)(Ab_ + (ao + 2 * a32 + 1024u)); x3 = *(const uint4*)(Ab_ + (ao + 3 * a32 + 1024u)); \
    rb0 = *(const uint4*)(Bb_ + bo); rb1 = *(const uint4*)(Bb_ + (bo + b32));                            \
    rb2 = *(const uint4*)(Bb_ + (bo + 2 * b32)); rb3 = *(const uint4*)(Bb_ + (bo + 3 * b32));            \
    m0 = *(const float4*)(mix + (kstep_) * 64 + lkc); m1 = *(const float4*)(mix + (kstep_) * 64 + lkc + 4); \
  }
#define GM_STORE(buf_)                                                                                   \
  {                                                                                                      \
    bf16_t* a_w = sA + (buf_) * 128 * LDT + lrow * LDT + lkc;                                            \
    bf16_t* b_w = sB + (buf_) * 128 * LDT + lrow * LDT + lkc;                                            \
    *(uint4*)(a_w) = mix8(h0, x0, m0, m1); *(uint4*)(a_w + 32 * LDT) = mix8(h1, x1, m0, m1);             \
    *(uint4*)(a_w + 64 * LDT) = mix8(h2, x2, m0, m1); *(uint4*)(a_w + 96 * LDT) = mix8(h3, x3, m0, m1);  \
    *(uint4*)(b_w) = rb0; *(uint4*)(b_w + 32 * LDT) = rb1; *(uint4*)(b_w + 64 * LDT) = rb2; *(uint4*)(b_w + 96 * LDT) = rb3; \
  }
  GM_LOAD(0);
  GM_STORE(0);
  __syncthreads();
  const int aoff = (wm * 64 + (lane & 31)) * LDT + (lane >> 5) * 8;
  const int boff = (wn * 64 + (lane & 31)) * LDT + (lane >> 5) * 8;
  for (int kt = 0; kt < 16; kt++) {
    const int cur = kt & 1;
    if (kt + 1 < 16) GM_LOAD(kt + 1);
    __builtin_amdgcn_sched_barrier(0);
    __builtin_amdgcn_s_setprio(1);
    const bf16_t* a_s = sA + cur * 128 * LDT + aoff;
    const bf16_t* b_s = sB + cur * 128 * LDT + boff;
#pragma unroll
    for (int kk = 0; kk < 4; kk++) {
      bf16x8 af[2], bq[2];
#pragma unroll
      for (int mi = 0; mi < 2; mi++) af[mi] = *(const bf16x8*)(a_s + mi * 32 * LDT + kk * 16);
#pragma unroll
      for (int ni = 0; ni < 2; ni++) bq[ni] = *(const bf16x8*)(b_s + ni * 32 * LDT + kk * 16);
#pragma unroll
      for (int mi = 0; mi < 2; mi++)
#pragma unroll
        for (int ni = 0; ni < 2; ni++) acc[mi][ni] = MFMA32(af[mi], bq[ni], acc[mi][ni]);
    }
    __builtin_amdgcn_s_setprio(0);
    __builtin_amdgcn_sched_barrier(0);
    if (kt + 1 < 16) GM_STORE(cur ^ 1);
    __syncthreads();
  }
}

constexpr int EST = 132;
DI void acc_to_lds(const f32x16 (&acc)[2][2], float* es) {
  const int tidx = opaque_tid();
  const int lane = tidx & 63, w = tidx >> 6, wm = w >> 1, wn = w & 1;
#pragma unroll
  for (int mi = 0; mi < 2; mi++)
#pragma unroll
    for (int ni = 0; ni < 2; ni++)
#pragma unroll
      for (int r = 0; r < 16; r++)
        es[(wm * 64 + mi * 32 + (r & 3) + 8 * (r >> 2) + 4 * (lane >> 5)) * EST + wn * 64 + ni * 32 + (lane & 31)] = acc[mi][ni][r];
}
#define EPI8_BEGIN                                                                   \
  {                                                                                  \
    float* es = (float*)smem;                                                        \
    acc_to_lds(acc, es);                                                             \
    __syncthreads();                                                                 \
    for (int pass = 0; pass < 8; pass++) {                                           \
      const int row = pass * 16 + (tidx >> 4), col = (tidx & 15) * 8;  \
      const float4 e_va = *(const float4*)(es + row * EST + col);                    \
      const float4 e_vb = *(const float4*)(es + row * EST + col + 4);                \
      float v[8] = {e_va.x, e_va.y, e_va.z, e_va.w, e_vb.x, e_vb.y, e_vb.z, e_vb.w};
#define EPI8_END                                                                     \
    }                                                                                \
    __syncthreads();                                                                 \
  }
DI uint4 pack8(const float (&v)[8]) { return make_uint4(pack2(v[0], v[1]), pack2(v[2], v[3]), pack2(v[4], v[5]), pack2(v[6], v[7])); }
DI void unpack8(const uint4 u, float (&v)[8]) {
  v[0] = lo_bf(u.x); v[1] = hi_bf(u.x); v[2] = lo_bf(u.y); v[3] = hi_bf(u.y); v[4] = lo_bf(u.z); v[5] = hi_bf(u.z); v[6] = lo_bf(u.w); v[7] = hi_bf(u.w);
}
DI void resid_update(float* xp, const float* xsrc, const float* gate, const float (&v)[8]) {
  float4 x0 = *(const float4*)xsrc, x1 = *(const float4*)(xsrc + 4);
  const float4 g0 = *(const float4*)gate, g1 = *(const float4*)(gate + 4);
  x0.x += g0.x * v[0]; x0.y += g0.y * v[1]; x0.z += g0.z * v[2]; x0.w += g0.w * v[3];
  x1.x += g1.x * v[4]; x1.y += g1.y * v[5]; x1.z += g1.z * v[6]; x1.w += g1.w * v[7];
  *(float4*)xp = x0; *(float4*)(xp + 4) = x1;
}

DI bool xcd_tile(int t, int Mt, int Nt, int& mt, int& nt) {
  const int G = gridDim.x, spx = G >> 3, tn = spx >> 3;
  const int r = t % G, round = t / G;
  const int xcd = r & 7, li = r >> 3;
  const int smn = Mt >> 3, snn = Nt / tn;
  const int st = round * 8 + xcd;
  if (st >= smn * snn) return false;
  const int smi = st % smn, sni = st / smn;
  mt = smi * 8 + (li & 7);
  nt = sni * tn + (li >> 3);
  return true;
}
DI int xcd_rounds(int Mt, int Nt) { const int tn = gridDim.x >> 6; return ((Mt >> 3) * (Nt / tn) + 7) >> 3; }

DI void phase_t1(const P& p, int layer, char* smem) {
  const int j = layer / 2;
  const int tidx = opaque_tid();
  const bf16_t* HX = (const bf16_t*)(p.ws + OFF_TR + TR_HX);
  const bf16_t* WL1 = (const bf16_t*)(p.ws + w_off(0)) + W_L1;
  bf16_t* T1 = (bf16_t*)(p.ws + OFF_TR + TR_T1);
  for (int t = blockIdx.x; t < 136 * 5; t += gridDim.x) {
    const int nt = t % 5, lt = t / 5;
    f32x16 acc[2][2];
    if (nt == 1) gemm_mainloop(HX + (size_t)lt * 128 * 2048, 2048, WL1 + (size_t)nt * 128 * 2048, 2048, 2048, smem, acc);
    else gemm_mainloop_mix(HX + (size_t)lt * 128 * 2048, p.rw_mix + ((size_t)j * 6 + (nt == 0 ? 1 : 5)) * 1024, WL1 + (size_t)nt * 128 * 2048, 2048, smem, acc);
    EPI8_BEGIN
      const int c = nt * 128 + col;
      if (c < 128) {
#pragma unroll
        for (int e = 0; e < 8; e++) v[e] = tanhf(v[e]);
      } else if (c >= 256) {
#pragma unroll
        for (int e = 0; e < 8; e++) v[e] = sigmoidf_(v[e]);
      }
      *(uint4*)(T1 + (size_t)(lt * 128 + row) * 640 + c) = pack8(v);
    EPI8_END
  }
}

DI void phase_feat(const P& p, int layer, int hf, char* smem) {
  const int tidx = opaque_tid();
  const int j = layer / 2;
  const bf16_t* W = (const bf16_t*)(p.ws + w_off(layer));
  const bf16_t* HX = (const bf16_t*)(p.ws + OFF_TR + TR_HX);
  const bf16_t* T1 = (const bf16_t*)(p.ws + OFF_TR + TR_T1);
  bf16_t* VF = (bf16_t*)(p.ws + OFF_VF);
  for (int t = blockIdx.x; t < xcd_rounds(136, 24) * (int)gridDim.x; t += gridDim.x) {
    int lt, nt;
    if (!xcd_tile(t, 136, 24, lt, nt)) continue;
    const int s = nt / 8, n0 = (nt % 8) * 128;
    const int gt = half_gtile(hf, lt);
    f32x16 acc[2][2];
    bf16_t* outp = (bf16_t*)(p.ws + OFF_TR + (s == 0 ? TR_R : (s == 1 ? TR_K : TR_V)));
    if (s == 2 && j > 0) {
      gemm_mainloop(T1 + (size_t)lt * 128 * 640 + 192, 640, W + W_V2 + (size_t)n0 * 64, 64, 64, smem, acc);
      const float* v0 = p.rw_v0 + (size_t)(j - 1) * 1024;
      EPI8_BEGIN
        const int c = n0 + col;
#pragma unroll
        for (int e = 0; e < 8; e++) v[e] = sigmoidf_(v0[c + e] + v[e]);
        *(uint4*)(outp + (size_t)(lt * 128 + row) * 1024 + c) = pack8(v);
      EPI8_END
    }
    {
      const int mixsel = s == 0 ? 0 : (s == 1 ? 2 : 3);
      gemm_mainloop_mix(HX + (size_t)lt * 128 * 2048, p.rw_mix + ((size_t)j * 6 + mixsel) * 1024, W + W_RKV + ((size_t)s * 1024 + n0) * 2048, 2048, smem, acc);
    }
    if (s < 2) {
      EPI8_BEGIN
        *(uint4*)(outp + (size_t)(lt * 128 + row) * 1024 + n0 + col) = pack8(v);
      EPI8_END
    } else if (j == 0) {
      EPI8_BEGIN
        const uint4 u = pack8(v);
        *(uint4*)(outp + (size_t)(lt * 128 + row) * 1024 + n0 + col) = u;
        *(uint4*)(VF + (size_t)(gt * 128 + row) * 1024 + n0 + col) = u;
      EPI8_END
    } else {
      EPI8_BEGIN
        const size_t oi = (size_t)(lt * 128 + row) * 1024 + n0 + col;
        float sg[8], vf[8];
        unpack8(*(const uint4*)(outp + oi), sg);
        unpack8(*(const uint4*)(VF + (size_t)(gt * 128 + row) * 1024 + n0 + col), vf);
#pragma unroll
        for (int e = 0; e < 8; e++) v[e] = v[e] + (vf[e] - v[e]) * sg[e];
        *(uint4*)(outp + oi) = pack8(v);
      EPI8_END
    }
  }
  for (int t = blockIdx.x; t < xcd_rounds(136, 40) * (int)gridDim.x; t += gridDim.x) {
    int lt, nt;
    if (!xcd_tile(t, 136, 40, lt, nt)) continue;
    const int s = nt / 8, n0 = (nt % 8) * 128;
    f32x16 acc[2][2];
    if (s == 0) {
      gemm_mainloop(T1 + (size_t)lt * 128 * 640 + 128, 640, W + W_A2 + (size_t)n0 * 64, 64, 64, smem, acc);
      bf16_t* outp = (bf16_t*)(p.ws + OFF_TR + TR_A);
      const float* a0 = p.rw_a0 + (size_t)j * 1024;
      EPI8_BEGIN
#pragma unroll
        for (int e = 0; e < 8; e++) v[e] = sigmoidf_(a0[n0 + col + e] + v[e]);
        *(uint4*)(outp + (size_t)(lt * 128 + row) * 1024 + n0 + col) = pack8(v);
      EPI8_END
    } else if (s < 3) {
      const int d = s - 1;
      gemm_mainloop(T1 + (size_t)lt * 128 * 640 + d * 64, 640, W + W_W2 + (size_t)d * 65536 + (size_t)n0 * 64, 64, 64, smem, acc);
      bf16_t* outp = (bf16_t*)(p.ws + OFF_TR + (d ? TR_WL1 : TR_WL0));
      const float* w0 = p.rw_w0 + ((size_t)j * 2 + d) * 1024;
      EPI8_BEGIN
#pragma unroll
        for (int e = 0; e < 8; e++) {
          const float z = -(w0[n0 + col + e] + v[e]);
          const float sp = fmaxf(z, 0.f) + log1pf(__expf(-fabsf(z)));
          v[e] = -__expf(-sp - 0.5f);
        }
        *(uint4*)(outp + (size_t)(lt * 128 + row) * 1024 + n0 + col) = pack8(v);
      EPI8_END
    } else {
      const int d = s - 3;
      gemm_mainloop(T1 + (size_t)lt * 128 * 640 + 256 + d * 192, 640, W + W_G2 + (size_t)d * 196608 + (size_t)n0 * 192, 192, 192, smem, acc);
      bf16_t* outp = (bf16_t*)(p.ws + OFF_TR + (d ? TR_G1 : TR_G0));
      EPI8_BEGIN
        *(uint4*)(outp + (size_t)(lt * 128 + row) * 1024 + n0 + col) = pack8(v);
      EPI8_END
    }
  }
}

DI int scan_row(int bl, int dir, int pos) {
  if (pos < CL) { int t = dir ? (CL - 1 - pos) : pos; return 16384 + bl * CL + t; }
  int t = pos - CL; if (dir) t = SL - 1 - t;
  return bl * SL + t;
}

DI void phase_scan(const P& p, int layer, char* smem) {
  const int tidx = opaque_tid();
  const int j = layer / 2;
  const int tid = tidx;
  const bf16_t* R = (const bf16_t*)(p.ws + OFF_TR + TR_R);
  const bf16_t* Kx = (const bf16_t*)(p.ws + OFF_TR + TR_K);
  const bf16_t* V = (const bf16_t*)(p.ws + OFF_TR + TR_V);
  const bf16_t* Aa = (const bf16_t*)(p.ws + OFF_TR + TR_A);
  float* sbuf = (float*)smem;
  constexpr int BUFF = 5 * 16 * 64 + 512;
  constexpr int POP = 144;
  float* pobuf = sbuf + 2 * BUFF;
  const int ss = tid >> 4, c4 = tid & 15;
  const int rl = tid >> 4, cg = tid & 15;
  for (int item = blockIdx.x; item < 256; item += gridDim.x) {
    const int q2 = item & 1, dir = (item >> 1) & 1, head = (item >> 2) & 15, bl = item >> 6;
    const bf16_t* WL = (const bf16_t*)(p.ws + OFF_TR + (dir ? TR_WL1 : TR_WL0));
    bf16_t* O = (bf16_t*)(p.ws + OFF_TR + TR_HX) + (dir ? (size_t)HROWS * 1024 : 0);
    const int ch = head * 64 + c4 * 4;
    const float4 kkw = *(const float4*)(p.rw_kk + (size_t)j * 1024 + ch);
    const float4 kaw = *(const float4*)(p.rw_ka + (size_t)j * 1024 + ch);
    fv2 SA01 = {0.f, 0.f}, SA23 = {0.f, 0.f}, SB01 = {0.f, 0.f}, SB23 = {0.f, 0.f};
    uint2 gr_, gk_, ga_, gw_, gv_;
    gv_ = make_uint2(0, 0);
#define SC_ISSUE(chunk_)                                                                   \
    {                                                                                      \
      const size_t ro = (size_t)scan_row(bl, dir, (chunk_) * 16 + ss) * 1024;              \
      gr_ = *(const uint2*)(R + ro + ch); gk_ = *(const uint2*)(Kx + ro + ch);             \
      ga_ = *(const uint2*)(Aa + ro + ch); gw_ = *(const uint2*)(WL + ro + ch);            \
      if (c4 < 8) gv_ = *(const uint2*)(V + ro + head * 64 + q2 * 32 + c4 * 4);            \
    }
#define SC_STAGE(buf_)                                                                     \
    {                                                                                      \
      float* sb_ = sbuf + (buf_) * BUFF;                                                   \
      float r0 = lo_bf(gr_.x), r1 = hi_bf(gr_.x), r2 = lo_bf(gr_.y), r3 = hi_bf(gr_.y);    \
      float k0 = lo_bf(gk_.x), k1 = hi_bf(gk_.x), k2 = lo_bf(gk_.y), k3 = hi_bf(gk_.y);    \
      float a0 = lo_bf(ga_.x), a1 = hi_bf(ga_.x), a2 = lo_bf(ga_.y), a3 = hi_bf(ga_.y);    \
      float w0 = lo_bf(gw_.x), w1 = hi_bf(gw_.x), w2 = lo_bf(gw_.y), w3 = hi_bf(gw_.y);    \
      float u0 = k0 * kkw.x, u1 = k1 * kkw.y, u2 = k2 * kkw.z, u3 = k3 * kkw.w;            \
      float sq = rowsum16(u0 * u0 + u1 * u1 + u2 * u2 + u3 * u3);                          \
      float inv = rsqrtf(fmaxf(sq, 1e-24f));                                               \
      u0 *= inv; u1 *= inv; u2 *= inv; u3 *= inv;                                          \
      const int o_ = ss * 64 + c4 * 4;                                                     \
      *(float4*)(sb_ + 0 * 1024 + o_) = make_float4(__expf(w0), __expf(w1), __expf(w2), __expf(w3)); \
      *(float4*)(sb_ + 1 * 1024 + o_) = make_float4(k0 * (1.f + (a0 - 1.f) * kaw.x), k1 * (1.f + (a1 - 1.f) * kaw.y), k2 * (1.f + (a2 - 1.f) * kaw.z), k3 * (1.f + (a3 - 1.f) * kaw.w)); \
      *(float4*)(sb_ + 2 * 1024 + o_) = make_float4(-u0, -u1, -u2, -u3);                   \
      *(float4*)(sb_ + 3 * 1024 + o_) = make_float4(u0 * a0, u1 * a1, u2 * a2, u3 * a3);   \
      *(float4*)(sb_ + 4 * 1024 + o_) = make_float4(r0, r1, r2, r3);                       \
      if (c4 < 8) *(float4*)(sb_ + 5 * 1024 + ss * 32 + c4 * 4) = make_float4(lo_bf(gv_.x), hi_bf(gv_.x), lo_bf(gv_.y), hi_bf(gv_.y)); \
    }
    __syncthreads();
    SC_ISSUE(0);
    SC_STAGE(0);
    __syncthreads();
    constexpr int NCH = TK / 16;
    float* po_wa = pobuf + rl * POP + cg;
    float* po_wb = pobuf + (rl + 16) * POP + cg;
    const float* po_r = pobuf + (rl + 16 * (cg >> 3)) * POP + (cg & 7) * 16;
    for (int chunk = 0; chunk < NCH; chunk++) {
      const int buf = chunk & 1;
      if (chunk + 1 < NCH) SC_ISSUE(chunk + 1);
      __builtin_amdgcn_sched_barrier(0);
      const float* sb = sbuf + buf * BUFF + cg * 4;
      const float* sv = sbuf + buf * BUFF + 5 * 1024 + rl;
      float4 w4 = *(const float4*)(sb + 0 * 1024), k4 = *(const float4*)(sb + 1 * 1024), n4 = *(const float4*)(sb + 2 * 1024);
      float4 b4 = *(const float4*)(sb + 3 * 1024), r4 = *(const float4*)(sb + 4 * 1024);
      float va = sv[0], vb = sv[16];
#pragma unroll
      for (int s = 0; s < 16; s++) {
        float4 w4n = w4, k4n = k4, n4n = n4, b4n = b4, r4n = r4;
        float van = va, vbn = vb;
        if (s + 1 < 16) {
          w4n = *(const float4*)(sb + 0 * 1024 + (s + 1) * 64); k4n = *(const float4*)(sb + 1 * 1024 + (s + 1) * 64);
          n4n = *(const float4*)(sb + 2 * 1024 + (s + 1) * 64); b4n = *(const float4*)(sb + 3 * 1024 + (s + 1) * 64);
          r4n = *(const float4*)(sb + 4 * 1024 + (s + 1) * 64); van = sv[(s + 1) * 32]; vbn = sv[(s + 1) * 32 + 16];
        }
        const fv2 w01 = {w4.x, w4.y}, w23 = {w4.z, w4.w}, k01 = {k4.x, k4.y}, k23 = {k4.z, k4.w}, n01 = {n4.x, n4.y}, n23 = {n4.z, n4.w};
        const fv2 b01 = {b4.x, b4.y}, b23 = {b4.z, b4.w}, r01 = {r4.x, r4.y}, r23 = {r4.z, r4.w};
        const fv2 va2 = {va, va}, vb2 = {vb, vb};
        const fv2 vka01 = va2 * k01, vka23 = va2 * k23, vkb01 = vb2 * k01, vkb23 = vb2 * k23;
        fv2 ppa = SA01 * n01, ppb = SB01 * n01;
        ppa = __builtin_elementwise_fma(SA23, n23, ppa);
        ppb = __builtin_elementwise_fma(SB23, n23, ppb);
        float saa = ppa.x + ppa.y, sab = ppb.x + ppb.y;
        saa = ror_add<8>(saa); sab = ror_add<8>(sab);
        saa = ror_add<4>(saa); sab = ror_add<4>(sab);
        saa = ror_add<2>(saa); sab = ror_add<2>(sab);
        saa = ror_add<1>(saa); sab = ror_add<1>(sab);
        const fv2 saa2 = {saa, saa}, sab2 = {sab, sab};
        const fv2 ta01 = __builtin_elementwise_fma(saa2, b01, vka01), ta23 = __builtin_elementwise_fma(saa2, b23, vka23);
        const fv2 tb01 = __builtin_elementwise_fma(sab2, b01, vkb01), tb23 = __builtin_elementwise_fma(sab2, b23, vkb23);
        SA01 = __builtin_elementwise_fma(SA01, w01, ta01);
        SA23 = __builtin_elementwise_fma(SA23, w23, ta23);
        SB01 = __builtin_elementwise_fma(SB01, w01, tb01);
        SB23 = __builtin_elementwise_fma(SB23, w23, tb23);
        fv2 qa = SA01 * r01, qb = SB01 * r01;
        qa = __builtin_elementwise_fma(SA23, r23, qa);
        qb = __builtin_elementwise_fma(SB23, r23, qb);
        po_wa[(s & 7) * 16] = qa.x + qa.y;
        po_wb[(s & 7) * 16] = qb.x + qb.y;
        w4 = w4n; k4 = k4n; n4 = n4n; b4 = b4n; r4 = r4n; va = van; vb = vbn;
        __builtin_amdgcn_sched_barrier(0);
        if ((s & 7) == 7) {
          const float4 p0 = *(const float4*)(po_r), p1 = *(const float4*)(po_r + 4), p2 = *(const float4*)(po_r + 8), p3 = *(const float4*)(po_r + 12);
          const float ov = ((p0.x + p0.y) + (p0.z + p0.w)) + ((p1.x + p1.y) + (p1.z + p1.w)) + ((p2.x + p2.y) + (p2.z + p2.w)) + ((p3.x + p3.y) + (p3.z + p3.w));
          const size_t ro = (size_t)scan_row(bl, dir, chunk * 16 + (s & 8) + (cg & 7)) * 1024;
          O[ro + head * 64 + q2 * 32 + rl + 16 * (cg >> 3)] = f2bf(ov);
          __builtin_amdgcn_sched_barrier(0);
        }
      }
      if (chunk + 1 < NCH) SC_STAGE(buf ^ 1);
      __syncthreads();
    }
  }
}

DI void phase_combine(const P& p, int layer) {
  const int tidx = opaque_tid();
  const int j = layer / 2;
  const bf16_t* Of = (const bf16_t*)(p.ws + OFF_TR + TR_HX);
  const bf16_t* Ob = Of + (size_t)HROWS * 1024;
  const bf16_t* R = (const bf16_t*)(p.ws + OFF_TR + TR_R);
  const bf16_t* Kx = (const bf16_t*)(p.ws + OFF_TR + TR_K);
  const bf16_t* V = (const bf16_t*)(p.ws + OFF_TR + TR_V);
  const bf16_t* Aa = (const bf16_t*)(p.ws + OFF_TR + TR_A);
  bf16_t* G0 = (bf16_t*)(p.ws + OFF_TR + TR_G0);
  const bf16_t* G1 = (const bf16_t*)(p.ws + OFF_TR + TR_G1);
  const size_t total = (size_t)HROWS * 128;
  for (size_t i = (size_t)blockIdx.x * 256 + tidx; i < total; i += (size_t)gridDim.x * 256) {
    const int c0 = (int)(i & 127) * 8;
    const size_t off = (i >> 7) * 1024 + c0;
    const uint4 uof = *(const uint4*)(Of + off), uob = *(const uint4*)(Ob + off), ur = *(const uint4*)(R + off), uk = *(const uint4*)(Kx + off);
    const uint4 ua = *(const uint4*)(Aa + off), uv = *(const uint4*)(V + off), ug0 = *(const uint4*)(G0 + off), ug1 = *(const uint4*)(G1 + off);
    const unsigned aof[4] = {uof.x, uof.y, uof.z, uof.w}, aob[4] = {uob.x, uob.y, uob.z, uob.w}, ar[4] = {ur.x, ur.y, ur.z, ur.w}, ak[4] = {uk.x, uk.y, uk.z, uk.w};
    const unsigned aa[4] = {ua.x, ua.y, ua.z, ua.w}, av[4] = {uv.x, uv.y, uv.z, uv.w}, ag0[4] = {ug0.x, ug0.y, ug0.z, ug0.w}, ag1[4] = {ug1.x, ug1.y, ug1.z, ug1.w};
    const float* ka = p.rw_ka + (size_t)j * 1024 + c0;
    const float* rk = p.rw_rk + (size_t)j * 1024 + c0;
    const float* lg = p.rw_ln_g + (size_t)j * 1024 + c0;
    const float* lb = p.rw_ln_b + (size_t)j * 1024 + c0;
    float of[8], obv[8];
    float sf = 0.f, sf2 = 0.f, sb = 0.f, sb2 = 0.f, br = 0.f;
#pragma unroll
    for (int e = 0; e < 8; e++) {
      const int w = e >> 1;
      of[e] = (e & 1) ? hi_bf(aof[w]) : lo_bf(aof[w]);
      obv[e] = (e & 1) ? hi_bf(aob[w]) : lo_bf(aob[w]);
      const float r = (e & 1) ? hi_bf(ar[w]) : lo_bf(ar[w]);
      const float k = (e & 1) ? hi_bf(ak[w]) : lo_bf(ak[w]);
      const float a = (e & 1) ? hi_bf(aa[w]) : lo_bf(aa[w]);
      sf += of[e]; sf2 += of[e] * of[e]; sb += obv[e]; sb2 += obv[e] * obv[e];
      br += r * k * (1.f + (a - 1.f) * ka[e]) * rk[e];
    }
#pragma unroll
    for (int o = 1; o < 8; o <<= 1) { sf += __shfl_xor(sf, o); sf2 += __shfl_xor(sf2, o); sb += __shfl_xor(sb, o); sb2 += __shfl_xor(sb2, o); br += __shfl_xor(br, o); }
    const float muf = sf * (1.f / 64.f), mub = sb * (1.f / 64.f);
    const float rsf = rsqrtf(fmaxf(sf2 * (1.f / 64.f) - muf * muf, 0.f) + 64e-5f);
    const float rsb = rsqrtf(fmaxf(sb2 * (1.f / 64.f) - mub * mub, 0.f) + 64e-5f);
    float y[8];
#pragma unroll
    for (int e = 0; e < 8; e++) {
      const int w = e >> 1;
      const float v = (e & 1) ? hi_bf(av[w]) : lo_bf(av[w]);
      const float g0 = (e & 1) ? hi_bf(ag0[w]) : lo_bf(ag0[w]);
      const float g1 = (e & 1) ? hi_bf(ag1[w]) : lo_bf(ag1[w]);
      const float bonus = br * v;
      y[e] = ((of[e] - muf) * rsf * lg[e] + lb[e] + bonus) * g0 + ((obv[e] - mub) * rsb * lg[e] + lb[e] + bonus) * g1;
    }
    *(uint4*)(G0 + off) = make_uint4(pack2(y[0], y[1]), pack2(y[2], y[3]), pack2(y[4], y[5]), pack2(y[6], y[7]));
  }
}

DI void phase_rw_out(const P& p, int layer, int hf, char* smem) {
  const int tidx = opaque_tid();
  const bf16_t* Y = (const bf16_t*)(p.ws + OFF_TR + TR_G0);
  const bf16_t* WO = (const bf16_t*)(p.ws + w_off(layer)) + W_WO;
  const int nlt = (layer == 3) ? 128 : 136;
  for (int t = blockIdx.x; t < xcd_rounds(nlt, 8) * (int)gridDim.x; t += gridDim.x) {
    int lt, nt_;
    if (!xcd_tile(t, nlt, 8, lt, nt_)) continue;
    const int n0 = nt_ * 128;
    const int gt = half_gtile(hf, lt);
    f32x16 acc[2][2];
    gemm_mainloop(Y + (size_t)lt * 128 * 1024, 1024, WO + (size_t)n0 * 1024, 1024, 1024, smem, acc);
    const float* gate = mods_ptr(p, layer, mod_row(gt * 128)) + 2048 + n0;
    float* xr = resid_row(p, gt * 128) + n0;
    const float* xs = layer == 0 ? input_row(p, gt * 128) + n0 : xr;
    EPI8_BEGIN
      resid_update(xr + (size_t)row * D + col, xs + (size_t)row * D + col, gate + col, v);
    EPI8_END
  }
}

DI void phase_mlp1(const P& p, int layer, char* smem) {
  const int tidx = opaque_tid();
  const bf16_t* H2 = (const bf16_t*)(p.ws + OFF_TR + TR_H2);
  const bf16_t* W1 = (const bf16_t*)(p.ws + w_off(layer)) + W_M1;
  bf16_t* HID = (bf16_t*)(p.ws + OFF_TR + TR_HID);
  const int nmt = (layer == 3) ? 256 : 272;
  const int ngrp = nmt / 16;
  (void)ngrp;
  for (int t = blockIdx.x; t < xcd_rounds(nmt, 32) * (int)gridDim.x; t += gridDim.x) {
    int gt, nt;
    if (!xcd_tile(t, nmt, 32, gt, nt)) continue;
    f32x16 acc[2][2];
    gemm_mainloop(H2 + (size_t)gt * 128 * 1024, 1024, W1 + (size_t)nt * 128 * 1024, 1024, 1024, smem, acc);
    EPI8_BEGIN
#pragma unroll
      for (int e = 0; e < 8; e++) { const float rl = fmaxf(v[e], 0.f); v[e] = rl * rl; }
      *(uint4*)(HID + (size_t)(gt * 128 + row) * 4096 + nt * 128 + col) = pack8(v);
    EPI8_END
  }
}
DI void phase_mlp2(const P& p, int layer, char* smem) {
  const int tidx = opaque_tid();
  const bf16_t* HID = (const bf16_t*)(p.ws + OFF_TR + TR_HID);
  const bf16_t* W2 = (const bf16_t*)(p.ws + w_off(layer)) + W_M2;
  const int nmt = (layer == 3) ? 256 : 272;
  for (int t = blockIdx.x; t < xcd_rounds(nmt, 8) * (int)gridDim.x; t += gridDim.x) {
    int gt, nt_;
    if (!xcd_tile(t, nmt, 8, gt, nt_)) continue;
    const int n0 = nt_ * 128;
    f32x16 acc[2][2];
    gemm_mainloop(HID + (size_t)gt * 128 * 4096, 4096, W2 + (size_t)n0 * 4096, 4096, 4096, smem, acc);
    const float* gate = mods_ptr(p, layer, mod_row(gt * 128)) + 5120 + n0;
    float* xr = resid_row(p, gt * 128) + n0;
    EPI8_BEGIN
      resid_update(xr + (size_t)row * D + col, xr + (size_t)row * D + col, gate + col, v);
    EPI8_END
  }
}

DI void phase_qkv(const P& p, int layer, char* smem) {
  const int tidx = opaque_tid();
  const bf16_t* H = (const bf16_t*)(p.ws + OFF_TR + TR_H);
  const bf16_t* WQ = (const bf16_t*)(p.ws + w_off(layer)) + W_QKV;
  bf16_t* Q = (bf16_t*)(p.ws + OFF_TR + TR_Q);
  bf16_t* Kb = (bf16_t*)(p.ws + OFF_TR + TR_KK);
  bf16_t* VT = (bf16_t*)(p.ws + OFF_TR + TR_VT);
  const float* cosT = (const float*)(p.ws + OFF_MISC);
  const float* sinT = cosT + 1024;
  for (int t = blockIdx.x; t < xcd_rounds(272, 24) * (int)gridDim.x; t += gridDim.x) {
    int gt, nt;
    if (!xcd_tile(t, 272, 24, gt, nt)) continue;
    f32x16 acc[2][2];
    gemm_mainloop(H + (size_t)gt * 128 * 1024, 1024, WQ + (size_t)nt * 128 * 1024, 1024, 1024, smem, acc);
    const bool lat = gt < 256;
    const int b = lat ? gt / 32 : (gt - 256) / 2;
    const int t0 = lat ? (gt % 32) * 128 : (gt - 256) % 2 * 128;
    const int tq0 = lat ? t0 : SL + t0;
    const int typ = nt / 8, h = nt % 8;
    if (typ < 2) {
      bf16_t* dst = typ == 0 ? Q : Kb;
      const float qs = typ == 0 ? 0.125f * 1.44269504088896f : 1.f;
      float kmx = 0.f;
      EPI8_BEGIN
        const int sidx = col >> 6, d0 = col & 63;
        if (lat) {
          const float4 pa = *(const float4*)(es + row * EST + (col ^ 16));
          const float4 pb = *(const float4*)(es + row * EST + (col ^ 16) + 4);
          const float pr[8] = {pa.x, pa.y, pa.z, pa.w, pb.x, pb.y, pb.z, pb.w};
          const int tt = t0 + row;
          const int pos = (d0 < 32) ? (tt >> 6) : (tt & 63);
          const float4 ca = *(const float4*)(cosT + pos * 16 + (d0 & 8)), cb = *(const float4*)(cosT + pos * 16 + (d0 & 8) + 4);
          const float4 sa = *(const float4*)(sinT + pos * 16 + (d0 & 8)), sb = *(const float4*)(sinT + pos * 16 + (d0 & 8) + 4);
          const float cs[8] = {ca.x, ca.y, ca.z, ca.w, cb.x, cb.y, cb.z, cb.w};
          const float sn[8] = {sa.x, sa.y, sa.z, sa.w, sb.x, sb.y, sb.z, sb.w};
          const float sgn = (d0 & 16) ? 1.f : -1.f;
#pragma unroll
          for (int e = 0; e < 8; e++) v[e] = v[e] * cs[e] + sgn * pr[e] * sn[e];
        }
#pragma unroll
        for (int e = 0; e < 8; e++) v[e] *= qs;
        const uint4 pk_ = pack8(v);
        *(uint4*)(dst + ((size_t)((b * 8 + h) * 2 + sidx) * TK + tq0 + row) * 64 + d0) = pk_;
        if (typ == 1) {
          float rv_[8];
          unpack8(pk_, rv_);
          float ssq_ = 0.f;
#pragma unroll
          for (int e = 0; e < 8; e++) ssq_ += rv_[e] * rv_[e];
          ssq_ += __shfl_xor(ssq_, 1); ssq_ += __shfl_xor(ssq_, 2); ssq_ += __shfl_xor(ssq_, 4);
          kmx = fmaxf(kmx, ssq_);
        }
      EPI8_END
      if (typ == 1) {
        kmx = fmaxf(kmx, __shfl_xor(kmx, 16));
        kmx = fmaxf(kmx, __shfl_xor(kmx, 32));
        if ((tidx & 55) == 0)
          atomicMax((unsigned*)(p.ws + OFF_MISC) + 4096 + (layer >> 1) * 128 + (b * 8 + h) * 2 + ((tidx >> 3) & 1), __float_as_uint(kmx));
      }
    } else {
      float* es = (float*)smem;
      acc_to_lds(acc, es);
      __syncthreads();
      for (int pass = 0; pass < 8; pass++) {
        const int d = tidx & 127, tg = pass * 2 + (tidx >> 7);
        float v[8];
#pragma unroll
        for (int e = 0; e < 8; e++) v[e] = es[(tg * 8 + e) * EST + d];
        *(uint4*)(VT + ((size_t)(b * 8 + h) * 128 + d) * TK + tq0 + tg * 8) = pack8(v);
      }
      __syncthreads();
    }
  }
}

typedef _Float16 hv2 __attribute__((ext_vector_type(2)));
DI unsigned packh2(float a, float b) { hv2 r = {(_Float16)a, (_Float16)b}; return __builtin_bit_cast(unsigned, r); }
DI float lo_h(unsigned u) { hv2 r = __builtin_bit_cast(hv2, u); return (float)r[0]; }
DI float hi_h(unsigned u) { hv2 r = __builtin_bit_cast(hv2, u); return (float)r[1]; }

DI void phase_attn(const P& p, int layer, char* smem) {
  const int tidx = opaque_tid();
  const int j = layer / 2;
  const bool ctxq = layer != 3;
  const bf16_t* Q = (const bf16_t*)(p.ws + OFF_TR + TR_Q);
  const bf16_t* Kb = (const bf16_t*)(p.ws + OFF_TR + TR_KK);
  const bf16_t* VT = (const bf16_t*)(p.ws + OFF_TR + TR_VT);
  bf16_t* O = (bf16_t*)(p.ws + OFF_TR + TR_H);
  const float lam = ((const float*)(p.ws + OFF_MISC))[2048 + j];
  const float* kmax2 = (const float*)(p.ws + OFF_MISC) + 4096 + j * 128;
  const float oml = 1.f - lambda_init(layer);
  const float* subg = p.da_subln_g + (size_t)j * 128;
  constexpr int LDV = 68;
  bf16_t* sK = (bf16_t*)smem;
  bf16_t* sV = sK + 2 * 64 * LDT;
  const int tid = tidx, lane = tid & 63, w = tid >> 6, g = lane >> 5, l31 = lane & 31;
  const int nitems = 2048 + (ctxq ? 128 : 0);
  const int spx = gridDim.x >> 3, gpr = spx >> 5;
  const int lat_rounds = 64 / (8 * gpr);
  for (int it0 = blockIdx.x; it0 < lat_rounds * (int)gridDim.x + (ctxq ? 128 : 0); it0 += gridDim.x) {
    int item;
    if (it0 < lat_rounds * (int)gridDim.x) {
      const int r = it0 % (int)gridDim.x, round = it0 / (int)gridDim.x;
      const int xcd = r & 7, li = r >> 3;
      const int bh = (round * 8 + xcd) * gpr + (li >> 5);
      item = bh * 32 + (li & 31);
    } else {
      item = 2048 + (it0 - lat_rounds * (int)gridDim.x);
    }
    (void)nitems;
    int b, h, q0, kbeg, ntiles;
    if (item < 2048) { b = item >> 8; h = (item >> 5) & 7; q0 = (item & 31) * 128; kbeg = 0; ntiles = TK / 64; }
    else { const int it = item - 2048; b = it >> 4; h = (it >> 1) & 7; q0 = SL + (it & 1) * 128; kbeg = SL; ntiles = CL / 64; }
    const bf16_t* Vp0 = VT + (size_t)(b * 8 + h) * 128 * TK;
    const int tq = q0 + w * 32 + l31;
    const size_t grow = tq < SL ? (size_t)b * SL + tq : (size_t)NLAT + (size_t)b * CL + (tq - SL);
    bf16_t* op = O + grow * 1024 + h * 128;
    for (int s = 0; s < 2; s++) {
      const bf16_t* Kp0 = Kb + (size_t)((b * 8 + h) * 2 + s) * TK * 64;
      const bf16_t* Qp = Q + ((size_t)((b * 8 + h) * 2 + s) * TK + tq) * 64 + g * 8;
      bf16x8 qf[4];
      float qss = 0.f;
#pragma unroll
      for (int kk = 0; kk < 4; kk++) {
        const uint4 u = *(const uint4*)(Qp + kk * 16);
        qf[kk] = __builtin_bit_cast(bf16x8, u);
        float qv[8];
        unpack8(u, qv);
#pragma unroll
        for (int e = 0; e < 8; e++) qss += qv[e] * qv[e];
      }
      qss += __shfl_xor(qss, 32);
      const float nmq = -sqrtf(qss * kmax2[(b * 8 + h) * 2 + s]);
      f32x16 o[4];
#pragma unroll
      for (int db = 0; db < 4; db++)
#pragma unroll
        for (int r = 0; r < 16; r++) o[db][r] = 0.f;
      float l = 0.f;
      uint4 rk0, rk1, rv0, rv1, rv2, rv3;
      const unsigned kvo = (unsigned)((tid >> 3) * 64 + (tid & 7) * 8);
      const unsigned vvo = (unsigned)((tid >> 3) * TK + (tid & 7) * 8);
      const unsigned sko = (unsigned)((tid >> 3) * LDT + (tid & 7) * 8);
      const unsigned svo = (unsigned)((tid >> 3) * LDV + (tid & 7) * 8);
#define ISSUE_KV(kt_)                                                             \
      {                                                                           \
        const bf16_t* kb_ = Kp0 + (size_t)(kbeg + (kt_) * 64) * 64;               \
        const bf16_t* vb_ = Vp0 + (kbeg + (kt_) * 64);                            \
        unsigned kvo_ = kvo, vvo_ = vvo;                                          \
        asm volatile("" : "+v"(kvo_), "+v"(vvo_));     \
        rk0 = *(const uint4*)(kb_ + kvo_);                                        \
        rk1 = *(const uint4*)(kb_ + (kvo_ + 32u * 64u));                          \
        rv0 = *(const uint4*)(vb_ + vvo_);                                        \
        rv1 = *(const uint4*)(vb_ + (vvo_ + 32u * (unsigned)TK));                 \
        rv2 = *(const uint4*)(vb_ + (vvo_ + 64u * (unsigned)TK));                 \
        rv3 = *(const uint4*)(vb_ + (vvo_ + 96u * (unsigned)TK));                 \
      }
#define ST_V(ptr_, r_) { *(uint2*)(ptr_) = make_uint2(r_.x, r_.y); *(uint2*)((ptr_) + 4) = make_uint2(r_.z, r_.w); }
#define STAGE_KV(buf_)                                                            \
      {                                                                           \
        bf16_t* ks_ = sK + (buf_) * 64 * LDT + sko;                               \
        bf16_t* vs_ = sV + (buf_) * 128 * LDV + svo;                              \
        *(uint4*)(ks_) = rk0;                                                     \
        *(uint4*)(ks_ + 32 * LDT) = rk1;                                          \
        ST_V(vs_, rv0); ST_V(vs_ + 32 * LDV, rv1); ST_V(vs_ + 64 * LDV, rv2); ST_V(vs_ + 96 * LDV, rv3); \
      }
      __syncthreads();
      ISSUE_KV(0);
      STAGE_KV(0);
      __syncthreads();
      for (int kt = 0; kt < ntiles; kt++) {
        const int buf = kt & 1;
        const bool more = kt + 1 < ntiles;
        if (more) ISSUE_KV(kt + 1);
        __builtin_amdgcn_sched_barrier(0);
        const bf16_t* kS = sK + buf * 64 * LDT;
        const bf16_t* vS = sV + buf * 128 * LDV;
#pragma unroll
        for (int kb = 0; kb < 2; kb++) {
          bf16x8 kf[4];
#pragma unroll
          for (int kk = 0; kk < 4; kk++) kf[kk] = *(const bf16x8*)(kS + (kb * 32 + l31) * LDT + kk * 16 + g * 8);
          __builtin_amdgcn_sched_barrier(0);
          f32x16 st;
#pragma unroll
          for (int r = 0; r < 16; r++) st[r] = nmq;
#pragma unroll
          for (int kk = 0; kk < 4; kk++) st = MFMA32(kf[kk], qf[kk], st);
          uint4 vf0[4];
#pragma unroll
          for (int db = 0; db < 4; db++) {
            const bf16_t* vp = vS + (db * 32 + l31) * LDV + kb * 32 + 4 * g;
            const uint2 lo = *(const uint2*)vp;
            const uint2 hi = *(const uint2*)(vp + 8);
            vf0[db] = make_uint4(lo.x, lo.y, hi.x, hi.y);
          }
          __builtin_amdgcn_sched_barrier(0);
          float ls = 0.f;
          bf16x8 pk[2];
#pragma unroll
          for (int hh = 0; hh < 2; hh++) {
            float e[8];
#pragma unroll
            for (int i = 0; i < 8; i++) { e[i] = __builtin_amdgcn_exp2f(st[hh * 8 + i]); ls += e[i]; }
            const uint4 u = make_uint4(pack2(e[0], e[1]), pack2(e[2], e[3]), pack2(e[4], e[5]), pack2(e[6], e[7]));
            pk[hh] = __builtin_bit_cast(bf16x8, u);
          }
          l += ls;
          uint4 vf1[4];
#pragma unroll
          for (int db = 0; db < 4; db++) {
            const bf16_t* vp = vS + (db * 32 + l31) * LDV + kb * 32 + 16 + 4 * g;
            const uint2 lo = *(const uint2*)vp;
            const uint2 hi = *(const uint2*)(vp + 8);
            vf1[db] = make_uint4(lo.x, lo.y, hi.x, hi.y);
          }
          __builtin_amdgcn_sched_barrier(0);
#pragma unroll
          for (int db = 0; db < 4; db++) o[db] = MFMA32(__builtin_bit_cast(bf16x8, vf0[db]), pk[0], o[db]);
#pragma unroll
          for (int db = 0; db < 4; db++) o[db] = MFMA32(__builtin_bit_cast(bf16x8, vf1[db]), pk[1], o[db]);
        }
        __builtin_amdgcn_sched_barrier(0);
        if (more) STAGE_KV(buf ^ 1);
        __syncthreads();
      }
      const float lt = l + __shfl_xor(l, 32);
      if (s == 0) {
        const float inv = 1.f / lt;
#pragma unroll
        for (int db = 0; db < 4; db++)
#pragma unroll
          for (int rq = 0; rq < 4; rq++) {
            const int d = db * 32 + 8 * rq + 4 * g;
            *(uint2*)(op + d) = make_uint2(packh2(o[db][4 * rq] * inv, o[db][4 * rq + 1] * inv), packh2(o[db][4 * rq + 2] * inv, o[db][4 * rq + 3] * inv));
          }
      } else {
        const float inv = lam / lt;
        float ssq = 0.f;
#pragma unroll
        for (int db = 0; db < 4; db++)
#pragma unroll
          for (int rq = 0; rq < 4; rq++) {
            const int d = db * 32 + 8 * rq + 4 * g;
            const uint2 u0 = *(const uint2*)(op + d);
            const float a0 = lo_h(u0.x) - o[db][4 * rq] * inv, a1 = hi_h(u0.x) - o[db][4 * rq + 1] * inv;
            const float a2 = lo_h(u0.y) - o[db][4 * rq + 2] * inv, a3 = hi_h(u0.y) - o[db][4 * rq + 3] * inv;
            o[db][4 * rq] = a0; o[db][4 * rq + 1] = a1; o[db][4 * rq + 2] = a2; o[db][4 * rq + 3] = a3;
            ssq += a0 * a0 + a1 * a1 + a2 * a2 + a3 * a3;
          }
        ssq += __shfl_xor(ssq, 32);
        const float rs = rsqrtf(ssq * (1.f / 128.f) + 1e-5f) * oml;
#pragma unroll
        for (int db = 0; db < 4; db++)
#pragma unroll
          for (int rq = 0; rq < 4; rq++) {
            const int d = db * 32 + 8 * rq + 4 * g;
            const float4 sg = *(const float4*)(subg + d);
            *(uint2*)(op + d) = make_uint2(pack2(o[db][4 * rq] * rs * sg.x, o[db][4 * rq + 1] * rs * sg.y),
                                           pack2(o[db][4 * rq + 2] * rs * sg.z, o[db][4 * rq + 3] * rs * sg.w));
          }
      }
    }
  }
}

DI void phase_at_out(const P& p, int layer, char* smem) {
  const int tidx = opaque_tid();
  const bf16_t* O = (const bf16_t*)(p.ws + OFF_TR + TR_H);
  const bf16_t* WO = (const bf16_t*)(p.ws + w_off(layer)) + W_WO;
  const int nmt = (layer == 3) ? 256 : 272;
  for (int t = blockIdx.x; t < xcd_rounds(nmt, 8) * (int)gridDim.x; t += gridDim.x) {
    int gt, nt_;
    if (!xcd_tile(t, nmt, 8, gt, nt_)) continue;
    const int n0 = nt_ * 128;
    f32x16 acc[2][2];
    gemm_mainloop(O + (size_t)gt * 128 * 1024, 1024, WO + (size_t)n0 * 1024, 1024, 1024, smem, acc);
    const float* gate = mods_ptr(p, layer, mod_row(gt * 128)) + 2048 + n0;
    float* xr = resid_row(p, gt * 128) + n0;
    EPI8_BEGIN
      resid_update(xr + (size_t)row * D + col, xr + (size_t)row * D + col, gate + col, v);
    EPI8_END
  }
}

DI void phase_final(const P& p) {
  const int tidx = opaque_tid();
  const int lane = tidx & 63, wv = tidx >> 6;
  for (int row = blockIdx.x * 4 + wv; row < NLAT; row += gridDim.x * 4) {
    float* xr = p.out + (size_t)row * D;
    float4 v[4];
    float ss = 0.f;
#pragma unroll
    for (int jx = 0; jx < 4; jx++) { v[jx] = *(const float4*)(xr + jx * 256 + lane * 4); ss += v[jx].x * v[jx].x + v[jx].y * v[jx].y + v[jx].z * v[jx].z + v[jx].w * v[jx].w; }
    ss = wave_sum(ss);
    const float rs = rsqrtf(ss * (1.f / 1024.f) + 1e-6f);
#pragma unroll
    for (int jx = 0; jx < 4; jx++) {
      const float4 g = *(const float4*)(p.final_g + jx * 256 + lane * 4);
      *(float4*)(xr + jx * 256 + lane * 4) = make_float4(v[jx].x * rs * g.x, v[jx].y * rs * g.y, v[jx].z * rs * g.z, v[jx].w * rs * g.w);
    }
  }
}

#define XB_TMO      128
#define XB_XCNT(j)  (256  + 64 * (j))
#define XB_XSUB(j)  (1280 + 64 * (j))
#define XB_XGEN(j)  (2304 + 64 * (j))
#define XB_TOP      3328
#define XB_TOPGEN   3392
#define XCD_BAR_WORDS 3456
#define XB_SPIN_CAP (1u << 22)
#define LAS __attribute__((address_space(3)))
DI unsigned xb_ld(unsigned* p) { return __hip_atomic_load(p, __ATOMIC_RELAXED, __HIP_MEMORY_SCOPE_AGENT); }
DI unsigned xb_add(unsigned* p, unsigned v) { return __hip_atomic_fetch_add(p, v, __ATOMIC_RELAXED, __HIP_MEMORY_SCOPE_AGENT); }
DI unsigned xb_xcc_id() { return (unsigned)__builtin_amdgcn_s_getreg((3 << 11) | 20) & 0xFu; }
#define XB_SPIN(cond, bar) do { unsigned _sp = 0; while (cond) { __builtin_amdgcn_s_sleep(1); \
    if ((++_sp & 255u) == 0u) { if (xb_ld(&(bar)[XB_TMO])) break; if (_sp > XB_SPIN_CAP) { atomicAdd(&(bar)[XB_TMO], 1u); break; } } } } while (0)
struct XcdBarrier { unsigned* bar; unsigned x; volatile LAS unsigned* st; };
DI XcdBarrier xcd_barrier_post(unsigned* bar, volatile LAS unsigned* st) {
  XcdBarrier b; b.bar = bar; b.x = xb_xcc_id(); b.st = st;
  if (threadIdx.x == 0) (void)xb_add(&bar[XB_XCNT(b.x)], 1u);
  return b;
}
DI void xcd_barrier_complete(unsigned* bar, unsigned x, unsigned& nloc, unsigned& nx) {
  const unsigned G = gridDim.x * gridDim.y * gridDim.z;
  unsigned sum, cnt, mine, sp = 0u;
  for (;;) {
    sum = 0u; cnt = 0u; mine = 0u;
#pragma unroll
    for (unsigned j = 0; j < 16; ++j) { const unsigned c = xb_ld(&bar[XB_XCNT(j)]); sum += c; cnt += (c > 0u) ? 1u : 0u; mine = (j == x) ? c : mine; }
    if (sum == G) break;
    __builtin_amdgcn_s_sleep(1);
    if ((++sp & 255u) == 0u) { if (xb_ld(&bar[XB_TMO])) break; if (sp > XB_SPIN_CAP) { atomicAdd(&bar[XB_TMO], 1u); break; } }
  }
  nloc = mine > 0u ? mine : 1u; nx = cnt > 0u ? cnt : 1u;
}
DI void xcd_barrier(const XcdBarrier& b) {
  asm volatile("s_waitcnt vmcnt(0)" ::: "memory");
  __syncthreads();
  if (threadIdx.x == 0) {
    unsigned* bar = b.bar;
    __builtin_amdgcn_s_waitcnt(0);
    unsigned nloc = b.st[0], nx = b.st[1];
    if (nloc == 0u) { xcd_barrier_complete(bar, b.x, nloc, nx); b.st[0] = nloc; b.st[1] = nx; }
    const unsigned old = xb_add(&bar[XB_XSUB(b.x)], 1u);
    const unsigned gen = old / nloc;
    if (old + 1u == (gen + 1u) * nloc) {
      __builtin_amdgcn_fence(__ATOMIC_RELEASE, "agent");
      asm volatile("s_waitcnt vmcnt(0)" ::: "memory");
      const unsigned og = xb_add(&bar[XB_TOP], 1u);
      const unsigned tg = og / nx;
      if (og + 1u == (tg + 1u) * nx) xb_add(&bar[XB_TOPGEN], 1u);
      else XB_SPIN(xb_ld(&bar[XB_TOPGEN]) == tg, bar);
      __builtin_amdgcn_fence(__ATOMIC_ACQUIRE, "agent");
      xb_add(&bar[XB_XGEN(b.x)], 1u);
      asm volatile("s_waitcnt vmcnt(0)" ::: "memory");
    } else {
      XB_SPIN(xb_ld(&bar[XB_XGEN(b.x)]) == gen, bar);
      __builtin_amdgcn_fence(__ATOMIC_ACQUIRE, "agent");
      asm volatile("s_waitcnt vmcnt(0)" ::: "memory");
    }
  }
  __syncthreads();
}
constexpr size_t OFF_BAR = OFF_MISC + 65536;

typedef __attribute__((address_space(1))) const float GCF;
typedef __attribute__((address_space(1))) float GF;
typedef __attribute__((address_space(1))) char GC;
DI unsigned long long lds_word(const unsigned long long* tbl, int i) {
  int z = i;
  asm volatile("" : "+v"(z));
  const unsigned long long v = tbl[z];
  const unsigned lo = __builtin_amdgcn_readfirstlane((unsigned)v), hi = __builtin_amdgcn_readfirstlane((unsigned)(v >> 32));
  return ((unsigned long long)hi << 32) | lo;
}
DI void load_params(P& q, const unsigned long long* tbl) {
  const float** fp = (const float**)&q;
#pragma unroll
  for (int i = 0; i < 36; i++) fp[i] = (const float*)(GCF*)lds_word(tbl, i);
  q.out = (float*)(GF*)lds_word(tbl, 36);
  q.ws = (char*)(GC*)lds_word(tbl, 37);
  q.only = 0;
  q.pad = 0;
}
__global__ void __launch_bounds__(256, 2) mega(P p) {
  __shared__ __attribute__((aligned(16))) char smem[73728];
  __shared__ unsigned long long s_tbl[40];
  {
#if defined(__HIP_DEVICE_COMPILE__)
    typedef __attribute__((address_space(4))) const unsigned long long KW;
    KW* kp = (KW*)__builtin_amdgcn_kernarg_segment_ptr();
    if (threadIdx.x < 39) s_tbl[threadIdx.x] = kp[threadIdx.x];
#endif
    __syncthreads();
  }
  const int only = (int)(unsigned)lds_word(s_tbl, 38);
  cg::grid_group grid = cg::this_grid();
  __shared__ uint4 xb_words;
  if (threadIdx.x == 0) xb_words = make_uint4(0u, 0u, 0u, 0u);
  __syncthreads();
  XcdBarrier xb;
  {
    P q;
    load_params(q, s_tbl);
    xb = xcd_barrier_post((unsigned*)(q.ws + OFF_BAR), (volatile LAS unsigned*)&xb_words);
  }
  int step = 0;
#define GSYNC() { if (step == 1) grid.sync(); else xcd_barrier(xb); }
#define STEP(body)                                   \
  {                                                  \
    if (only < 0 || only == step) {              \
      P q;                                           \
      load_params(q, s_tbl);                         \
      body;                                          \
    }                                                \
    step++;                                          \
    if (only < 0) GSYNC();                         \
  }
#ifndef DUP
#define DUP 0
#endif
#define STEPD(id, body)                              \
  {                                                  \
    if (only < 0 || only == step) {                  \
      P q;                                           \
      load_params(q, s_tbl);                         \
      body;                                          \
      if (DUP == id) { __syncthreads(); body; }      \
    }                                                \
    step++;                                          \
    if (only < 0) GSYNC();                           \
  }
  STEP(phase_init(q, smem); __syncthreads(); phase_conv(q, 0, smem, blockIdx.x, gridDim.x));
  for (int layer = 0; layer < 4; layer++) {
    if ((layer & 1) == 0) {
      for (int hf = 0; hf < 2; hf++) {
        STEP(phase_prep(q, layer, 0, hf, true, (bf16_t*)(q.ws + OFF_TR + TR_HX), 2048, false));
        STEPD(3, phase_t1(q, layer, smem));
        STEPD(4, phase_feat(q, layer, hf, smem));
        STEPD(5, phase_scan(q, layer, smem);
              if (hf == 0) { __syncthreads(); phase_conv(q, layer + 1, smem, gridDim.x > 256 ? (int)blockIdx.x - 256 : (int)blockIdx.x, gridDim.x > 256 ? (int)gridDim.x - 256 : (int)gridDim.x); });
        STEP(phase_combine(q, layer));
        STEP(phase_rw_out(q, layer, hf, smem));
      }
    } else {
      STEP(phase_prep(q, layer, 0, -1, false, (bf16_t*)(q.ws + OFF_TR + TR_H), 1024, false);
           if (layer + 1 < 4) { __syncthreads(); phase_conv(q, layer + 1, smem, blockIdx.x, gridDim.x); });
      STEPD(7, phase_qkv(q, layer, smem));
      STEPD(8, phase_attn(q, layer, smem));
      STEP(phase_at_out(q, layer, smem));
    }
    STEP(phase_prep(q, layer, 1, -1, false, (bf16_t*)(q.ws + OFF_TR + TR_H2), 1024, layer == 3));
    STEPD(9, phase_mlp1(q, layer, smem));
    STEP(phase_mlp2(q, layer, smem));
  }
  STEP(phase_final(q));
}

#ifndef MULTI_LAUNCH
#define MULTI_LAUNCH 0
#endif
constexpr int NSTEPS = 1 + 2 * (12 + 3) + 2 * (4 + 3) + 1;

extern "C" void kernel_launch(void* const* d_in, const int* in_sizes, int n_in, void* d_out, int out_size, void* d_ws, size_t ws_size,
                              hipStream_t stream) {
  static int grid_blocks = 0;
  if (!grid_blocks) {
    int dev = 0, cus = 0, per_cu = 0;
    hipGetDevice(&dev);
    hipDeviceGetAttribute(&cus, hipDeviceAttributeMultiprocessorCount, dev);
    hipOccupancyMaxActiveBlocksPerMultiprocessor(&per_cu, mega, 256, 0);
    if (per_cu < 1) per_cu = 1;
    if (per_cu > 2) per_cu = 2;
    grid_blocks = cus * per_cu;
  }
  P p{};
  const float** fp = (const float**)&p;
  for (int i = 0; i < 36; i++) fp[i] = (const float*)d_in[i];
  p.out = (float*)d_out;
  p.ws = (char*)d_ws;
  p.pad = 0;
#if MULTI_LAUNCH
  for (int s = 0; s < NSTEPS; s++) {
    p.only = s;
    void* args[] = {&p};
    hipError_t e = hipLaunchCooperativeKernel((void*)mega, dim3(grid_blocks), dim3(256), args, 0, stream);
    if (e != hipSuccess) { fprintf(stderr, "launch failed: %s\n", hipGetErrorString(e)); break; }
  }
#else
  p.only = -1;
  hipMemsetAsync((char*)d_ws + OFF_BAR, 0, XCD_BAR_WORDS * 4, stream);
  void* args[] = {&p};
  hipError_t e = hipLaunchCooperativeKernel((void*)mega, dim3(grid_blocks), dim3(256), args, 0, stream);
  if (e != hipSuccess) fprintf(stderr, "cooperative launch failed: %s (grid %d)\n", hipGetErrorString(e), grid_blocks);
#endif
}
```

```cpp
#include <hip/hip_runtime.h>
#include <hip/hip_cooperative_groups.h>
#include <cstdio>
namespace cg = cooperative_groups;

#define DI __device__ __forceinline__
typedef unsigned short bf16_t;
using bf16x8 = __attribute__((ext_vector_type(8))) short;
using f32x16 = __attribute__((ext_vector_type(16))) float;
typedef __bf16 bfv2 __attribute__((ext_vector_type(2)));
typedef float fv2 __attribute__((ext_vector_type(2)));
#define MFMA32(a, b, c) __builtin_amdgcn_mfma_f32_32x32x16_bf16((a), (b), (c), 0, 0, 0)

constexpr int D = 1024, NB = 8, SL = 4096, CL = 256;
constexpr int NLAT = NB * SL, NCTX = NB * CL, NTOK = NLAT + NCTX;
constexpr int HROWS = NTOK / 2;
constexpr int TK = SL + CL;
constexpr size_t MiB = 1048576;
constexpr size_t OFF_W2 = 476 * MiB;
constexpr size_t OFF_W = 0, OFF_XC = 36 * MiB, OFF_MODS = 44 * MiB, OFF_MISC = 45 * MiB, OFF_VF = 46 * MiB, OFF_TR = 114 * MiB;
constexpr size_t W_RKV = 0;
constexpr size_t W_L1 = W_RKV + 3072ull * 2048;
constexpr size_t W_W2 = W_L1 + 640ull * 2048;
constexpr size_t W_A2 = W_W2 + 2ull * 65536;
constexpr size_t W_G2 = W_A2 + 65536;
constexpr size_t W_V2 = W_G2 + 2ull * 196608;
constexpr size_t W_WO = W_V2 + 65536;
constexpr size_t W_M1 = W_WO + 1048576;
constexpr size_t W_M2 = W_M1 + 4194304;
constexpr size_t W_QKV = 0;
constexpr size_t HALF_ARR = (size_t)HROWS * 1024 * 2;
constexpr size_t TR_HX = 0;
constexpr size_t TR_T1 = 2 * HALF_ARR;
constexpr size_t TR_R = TR_T1 + (size_t)HROWS * 640 * 2;
constexpr size_t TR_K = TR_R + HALF_ARR, TR_V = TR_K + HALF_ARR, TR_A = TR_V + HALF_ARR;
constexpr size_t TR_WL0 = TR_A + HALF_ARR, TR_WL1 = TR_WL0 + HALF_ARR, TR_G0 = TR_WL1 + HALF_ARR, TR_G1 = TR_G0 + HALF_ARR;
constexpr size_t FULL_ARR = (size_t)NTOK * 1024 * 2;
constexpr size_t TR_H = 0, TR_Q = FULL_ARR, TR_KK = 2 * FULL_ARR, TR_VT = 3 * FULL_ARR;
constexpr size_t TR_H2 = 0, TR_HID = FULL_ARR;

struct P {
  const float *x, *c, *ctx, *c_ctx, *ada_w, *ada_b, *norm_g, *final_g;
  const float *rw_mix, *rw_w_rkv, *rw_w0, *rw_w1, *rw_w2, *rw_a0, *rw_a1, *rw_a2, *rw_g1, *rw_g2, *rw_kk, *rw_ka, *rw_rk, *rw_ln_g, *rw_ln_b, *rw_w_o, *rw_v0, *rw_v1, *rw_v2;
  const float *da_w_qkv, *da_w_o, *da_lq1, *da_lk1, *da_lq2, *da_lk2, *da_subln_g, *mlp_w1, *mlp_w2;
  float* out;
  char* ws;
  int only;
  int pad;
};

DI float bf2f(bf16_t h) { return __uint_as_float(((unsigned)h) << 16); }
DI unsigned pack2(float a, float b) { fv2 v = {a, b}; bfv2 r = __builtin_convertvector(v, bfv2); return __builtin_bit_cast(unsigned, r); }
DI bf16_t f2bf(float a) { return (bf16_t)(pack2(a, 0.f) & 0xffffu); }
DI float lo_bf(unsigned u) { return __uint_as_float(u << 16); }
DI float hi_bf(unsigned u) { return __uint_as_float(u & 0xffff0000u); }
DI float sigmoidf_(float x) { return __builtin_amdgcn_rcpf(1.f + __expf(-x)); }
DI float tanhf_(float x) { return 1.f - 2.f * __builtin_amdgcn_rcpf(1.f + __expf(2.f * x)); }
DI float wave_sum(float v) {
#pragma unroll
  for (int o = 32; o > 0; o >>= 1) v += __shfl_xor(v, o);
  return v;
}
template <int N> DI float ror_add(float x) { return x + __builtin_bit_cast(float, __builtin_amdgcn_mov_dpp(__builtin_bit_cast(int, x), 0x120 + N, 0xf, 0xf, true)); }
DI float rowsum16(float x) { x = ror_add<8>(x); x = ror_add<4>(x); x = ror_add<2>(x); x = ror_add<1>(x); return x; }

DI int opaque_tid() { int t = threadIdx.x; asm volatile("" : "+v"(t)); return t; }
DI float* resid_row(const P& p, int gr) { return gr < NLAT ? p.out + (size_t)gr * D : (float*)(p.ws + OFF_XC) + (size_t)(gr - NLAT) * D; }
DI const float* input_row(const P& p, int gr) { return gr < NLAT ? p.x + (size_t)gr * D : p.ctx + (size_t)(gr - NLAT) * D; }
DI int mod_row(int gr) { return gr < NLAT ? gr / SL : 8; }
DI const float* mods_ptr(const P& p, int layer, int mrow) { return (const float*)(p.ws + OFF_MODS) + ((size_t)layer * 9 + mrow) * 6144; }
DI int half_gtile(int hf, int lt) { return lt < 128 ? hf * 128 + lt : 256 + hf * 8 + (lt - 128); }
DI int first_tile(int base) { int g = gridDim.x; int s = (int)blockIdx.x - (base % g); if (s < 0) s += g; return s; }
DI size_t w_off(int layer) { return (layer & 1) ? OFF_W2 : OFF_W; }
DI float lambda_init(int layer) { return 0.8f - 0.6f * expf(-0.3f * (float)layer); }

DI void phase_init(const P& p, char* smem) {
  const int tidx = opaque_tid();
  const int tid = tidx;
  float* sc = (float*)smem;
  float* mods = (float*)(p.ws + OFF_MODS);
  for (int item = blockIdx.x; item < 96; item += gridDim.x) {
    const int layer = item / 24, cb = item % 24;
    __syncthreads();
    for (int i = tid; i < 9 * 1024; i += 256) {
      int r = i >> 10, k = i & 1023;
      float v = r < 8 ? p.c[r * 1024 + k] : p.c_ctx[k];
      sc[i] = v / (1.f + expf(-v));
    }
    __syncthreads();
    const int w = tid >> 6, q = tid & 63;
    float4 acc[9];
#pragma unroll
    for (int r = 0; r < 9; r++) acc[r] = make_float4(0.f, 0.f, 0.f, 0.f);
    const float* wp = p.ada_w + (size_t)layer * 1024 * 6144 + cb * 256 + q * 4;
    for (int k = w * 256; k < w * 256 + 256; k++) {
      float4 wv = *(const float4*)(wp + (size_t)k * 6144);
#pragma unroll
      for (int r = 0; r < 9; r++) {
        float s = sc[r * 1024 + k];
        acc[r].x += s * wv.x; acc[r].y += s * wv.y; acc[r].z += s * wv.z; acc[r].w += s * wv.w;
      }
    }
    __syncthreads();
    float4* red = (float4*)smem;
#pragma unroll
    for (int r = 0; r < 9; r++) red[(w * 9 + r) * 64 + q] = acc[r];
    __syncthreads();
    for (int i = tid; i < 9 * 64; i += 256) {
      int r = i / 64, qq = i % 64;
      float4 s0 = red[(0 * 9 + r) * 64 + qq], s1 = red[(1 * 9 + r) * 64 + qq], s2 = red[(2 * 9 + r) * 64 + qq], s3 = red[(3 * 9 + r) * 64 + qq];
      float4 bb = *(const float4*)(p.ada_b + layer * 6144 + cb * 256 + qq * 4);
      float4 o = make_float4(s0.x + s1.x + s2.x + s3.x + bb.x, s0.y + s1.y + s2.y + s3.y + bb.y, s0.z + s1.z + s2.z + s3.z + bb.z, s0.w + s1.w + s2.w + s3.w + bb.w);
      *(float4*)(mods + ((size_t)layer * 9 + r) * 6144 + cb * 256 + qq * 4) = o;
    }
  }
  if (blockIdx.x == gridDim.x - 1) {
    float* misc = (float*)(p.ws + OFF_MISC);
    for (int i = tid; i < 1024; i += 256) {
      int pos = i / 16, f = i % 16;
      float inv = powf(10000.f, -(float)f / 16.f);
      float ang = (float)pos * inv;
      misc[i] = cosf(ang);
      misc[1024 + i] = sinf(ang);
    }
    misc[4096 + tid] = 0.f;
    if (tid < 2) {
      float s1 = 0.f, s2 = 0.f;
      for (int k = 0; k < 64; k++) { s1 += p.da_lq1[tid * 64 + k] * p.da_lk1[tid * 64 + k]; s2 += p.da_lq2[tid * 64 + k] * p.da_lk2[tid * 64 + k]; }
      misc[2048 + tid] = expf(s1) - expf(s2) + lambda_init(2 * tid + 1);
    }
  }
}

DI void conv_mat(const float* __restrict__ src, int K, int N, bf16_t* __restrict__ dst, int ldd, int koff, const float* __restrict__ scale,
                 int Kp, int Np, float* sm, int& base, int vb, int vg) {
  const int tidx = opaque_tid();
  const int tid = tidx;
  const int tk = Kp / 64, tn = Np / 64, nt = tk * tn;
  int t0_ = vb - (base % vg);
  if (t0_ < 0) t0_ += vg;
  for (int t = t0_; t < nt; t += vg) {
    const int k0 = (t / tn) * 64, n0 = (t % tn) * 64;
    __syncthreads();
#pragma unroll
    for (int i = 0; i < 4; i++) {
      int kr = (tid >> 4) + 16 * i, nc = (tid & 15) * 4;
      float4 v = make_float4(0.f, 0.f, 0.f, 0.f);
      if (src != nullptr && k0 + kr < K && n0 + nc < N) {
        v = *(const float4*)(src + (size_t)(k0 + kr) * N + n0 + nc);
        if (scale) { float s = scale[k0 + kr]; v.x *= s; v.y *= s; v.z *= s; v.w *= s; }
      }
      sm[kr * 65 + nc + 0] = v.x; sm[kr * 65 + nc + 1] = v.y; sm[kr * 65 + nc + 2] = v.z; sm[kr * 65 + nc + 3] = v.w;
    }
    __syncthreads();
    const int n = tid >> 2, kb = (tid & 3) * 16;
    unsigned o[8];
#pragma unroll
    for (int i = 0; i < 8; i++) o[i] = pack2(sm[(kb + 2 * i) * 65 + n], sm[(kb + 2 * i + 1) * 65 + n]);
    uint4* dp = (uint4*)(dst + (size_t)(n0 + n) * ldd + koff + k0 + kb);
    dp[0] = make_uint4(o[0], o[1], o[2], o[3]);
    dp[1] = make_uint4(o[4], o[5], o[6], o[7]);
  }
  base += nt;
}

DI void phase_conv(const P& p, int layer, char* smem, int vb, int vg) {
  if (vb < 0) return;
  float* sm = (float*)smem;
  bf16_t* W = (bf16_t*)(p.ws + w_off(layer));
  int base = 0;
  const int j = layer / 2;
  if ((layer & 1) == 0) {
    for (int s = 0; s < 3; s++) {
      const float* src = p.rw_w_rkv + ((size_t)j * 3 + s) * 1048576;
      conv_mat(src, 1024, 1024, W + W_RKV + (size_t)s * 1024 * 2048, 2048, 0, nullptr, 1024, 1024, sm, base, vb, vg);
    }
    for (int pass = 0; pass < 2; pass++) {
      const int ko = pass * 1024;
      const float* m1 = pass ? p.rw_mix + ((size_t)j * 6 + 1) * 1024 : nullptr;
      const float* m4 = pass ? p.rw_mix + ((size_t)j * 6 + 4) * 1024 : nullptr;
      const float* m5 = pass ? p.rw_mix + ((size_t)j * 6 + 5) * 1024 : nullptr;
      const float* m3 = pass ? p.rw_mix + ((size_t)j * 6 + 3) * 1024 : nullptr;
      bf16_t* L1 = W + W_L1;
      conv_mat(p.rw_w1 + ((size_t)j * 2 + 0) * 65536, 1024, 64, L1 + 0ull * 2048, 2048, ko, m1, 1024, 64, sm, base, vb, vg);
      conv_mat(p.rw_w1 + ((size_t)j * 2 + 1) * 65536, 1024, 64, L1 + 64ull * 2048, 2048, ko, m1, 1024, 64, sm, base, vb, vg);
      conv_mat(p.rw_a1 + (size_t)j * 65536, 1024, 64, L1 + 128ull * 2048, 2048, ko, m4, 1024, 64, sm, base, vb, vg);
      conv_mat(p.rw_g1 + ((size_t)j * 2 + 0) * 163840, 1024, 160, L1 + 256ull * 2048, 2048, ko, m5, 1024, 192, sm, base, vb, vg);
      conv_mat(p.rw_g1 + ((size_t)j * 2 + 1) * 163840, 1024, 160, L1 + 448ull * 2048, 2048, ko, m5, 1024, 192, sm, base, vb, vg);
      conv_mat(j > 0 ? p.rw_v1 + (size_t)(j - 1) * 32768 : nullptr, 1024, 32, L1 + 192ull * 2048, 2048, ko, m3, 1024, 64, sm, base, vb, vg);
    }
    conv_mat(p.rw_w2 + ((size_t)j * 2 + 0) * 65536, 64, 1024, W + W_W2, 64, 0, nullptr, 64, 1024, sm, base, vb, vg);
    conv_mat(p.rw_w2 + ((size_t)j * 2 + 1) * 65536, 64, 1024, W + W_W2 + 65536, 64, 0, nullptr, 64, 1024, sm, base, vb, vg);
    conv_mat(p.rw_a2 + (size_t)j * 65536, 64, 1024, W + W_A2, 64, 0, nullptr, 64, 1024, sm, base, vb, vg);
    conv_mat(p.rw_g2 + ((size_t)j * 2 + 0) * 163840, 160, 1024, W + W_G2, 192, 0, nullptr, 192, 1024, sm, base, vb, vg);
    conv_mat(p.rw_g2 + ((size_t)j * 2 + 1) * 163840, 160, 1024, W + W_G2 + 196608, 192, 0, nullptr, 192, 1024, sm, base, vb, vg);
    conv_mat(j > 0 ? p.rw_v2 + (size_t)(j - 1) * 32768 : nullptr, 32, 1024, W + W_V2, 64, 0, nullptr, 64, 1024, sm, base, vb, vg);
    conv_mat(p.rw_w_o + (size_t)j * 1048576, 1024, 1024, W + W_WO, 1024, 0, nullptr, 1024, 1024, sm, base, vb, vg);
  } else {
    conv_mat(p.da_w_qkv + (size_t)j * 3145728, 1024, 3072, W + W_QKV, 1024, 0, nullptr, 1024, 3072, sm, base, vb, vg);
    conv_mat(p.da_w_o + (size_t)j * 1048576, 1024, 1024, W + W_WO, 1024, 0, nullptr, 1024, 1024, sm, base, vb, vg);
  }
  conv_mat(p.mlp_w1 + (size_t)layer * 4194304, 1024, 4096, W + W_M1, 1024, 0, nullptr, 1024, 4096, sm, base, vb, vg);
  conv_mat(p.mlp_w2 + (size_t)layer * 4194304, 4096, 1024, W + W_M2, 4096, 0, nullptr, 4096, 1024, sm, base, vb, vg);
}

DI void phase_prep(const P& p, int layer, int sub, int hf, bool shift, bf16_t* H, int ldh, bool skip_ctx) {
  const int tidx = opaque_tid();
  const int lane = tidx & 63, wv = tidx >> 6;
  const int nrows = hf < 0 ? (skip_ctx ? NLAT : NTOK) : HROWS;
  const int nseg = nrows / 8;
  const float* ng = p.norm_g + ((size_t)layer * 2 + sub) * 1024;
  for (int seg = blockIdx.x * 4 + wv; seg < nseg; seg += gridDim.x * 4) {
    const int lr0 = seg * 8;
    const int gr0 = hf < 0 ? lr0 : (lr0 < 16384 ? hf * 16384 + lr0 : NLAT + hf * 1024 + (lr0 - 16384));
    const bool lat = gr0 < NLAT;
    const int T = lat ? SL : CL;
    const int t0 = lat ? (gr0 % SL) : ((gr0 - NLAT) % CL);
    const float* xbase = (layer == 0 && sub == 0) ? input_row(p, gr0) : resid_row(p, gr0);
    const float* md = mods_ptr(p, layer, mod_row(gr0));
    float4 g4[4], sc4[4], sh4[4];
#pragma unroll
    for (int jx = 0; jx < 4; jx++) {
      int ch = jx * 256 + lane * 4;
      g4[jx] = *(const float4*)(ng + ch);
      sh4[jx] = *(const float4*)(md + sub * 3072 + ch);
      sc4[jx] = *(const float4*)(md + sub * 3072 + 1024 + ch);
      g4[jx].x *= (1.f + sc4[jx].x); g4[jx].y *= (1.f + sc4[jx].y); g4[jx].z *= (1.f + sc4[jx].z); g4[jx].w *= (1.f + sc4[jx].w);
    }
    float4 hp[4], hc[4], hn[4];
    const int tb = shift ? -1 : 0, te = shift ? 9 : 8;
    for (int tt = tb; tt < te; tt++) {
      const int t = t0 + tt;
      if (t >= 0 && t < T) {
        const float* xr = xbase + (ptrdiff_t)tt * D;
        float ss = 0.f;
#pragma unroll
        for (int jx = 0; jx < 4; jx++) {
          hn[jx] = *(const float4*)(xr + jx * 256 + lane * 4);
          ss += hn[jx].x * hn[jx].x + hn[jx].y * hn[jx].y + hn[jx].z * hn[jx].z + hn[jx].w * hn[jx].w;
        }
        ss = wave_sum(ss);
        const float rs = rsqrtf(ss * (1.f / 1024.f) + 1e-6f);
#pragma unroll
        for (int jx = 0; jx < 4; jx++) {
          hn[jx].x = hn[jx].x * rs * g4[jx].x + sh4[jx].x; hn[jx].y = hn[jx].y * rs * g4[jx].y + sh4[jx].y;
          hn[jx].z = hn[jx].z * rs * g4[jx].z + sh4[jx].z; hn[jx].w = hn[jx].w * rs * g4[jx].w + sh4[jx].w;
        }
      } else {
#pragma unroll
        for (int jx = 0; jx < 4; jx++) hn[jx] = make_float4(0.f, 0.f, 0.f, 0.f);
      }
      if (!shift) {
        bf16_t* hr = H + (size_t)(lr0 + tt) * ldh;
#pragma unroll
        for (int jx = 0; jx < 4; jx++) *(uint2*)(hr + jx * 256 + lane * 4) = make_uint2(pack2(hn[jx].x, hn[jx].y), pack2(hn[jx].z, hn[jx].w));
      } else if (tt >= 1) {
        bf16_t* hr = H + (size_t)(lr0 + tt - 1) * ldh;
#pragma unroll
        for (int jx = 0; jx < 4; jx++) {
          *(uint2*)(hr + jx * 256 + lane * 4) = make_uint2(pack2(hc[jx].x, hc[jx].y), pack2(hc[jx].z, hc[jx].w));
          float4 xx;
          xx.x = 0.5f * (hp[jx].x + hn[jx].x) - hc[jx].x; xx.y = 0.5f * (hp[jx].y + hn[jx].y) - hc[jx].y;
          xx.z = 0.5f * (hp[jx].z + hn[jx].z) - hc[jx].z; xx.w = 0.5f * (hp[jx].w + hn[jx].w) - hc[jx].w;
          *(uint2*)(hr + 1024 + jx * 256 + lane * 4) = make_uint2(pack2(xx.x, xx.y), pack2(xx.z, xx.w));
        }
      }
#pragma unroll
      for (int jx = 0; jx < 4; jx++) { hp[jx] = hc[jx]; hc[jx] = hn[jx]; }
    }
  }
}

constexpr int LDT = 72;
DI void gemm_mainloop(const bf16_t* __restrict__ A, int lda, const bf16_t* __restrict__ Bt, int ldb, int K, char* smem, f32x16 (&acc)[2][2]) {
  const int tidx = opaque_tid();
  bf16_t* sA = (bf16_t*)smem;
  bf16_t* sB = sA + 2 * 128 * LDT;
  const int tid = tidx, lane = tid & 63, w = tid >> 6, wm = w >> 1, wn = w & 1;
  const int lrow = tid >> 3, lkc = (tid & 7) * 8;
#pragma unroll
  for (int mi = 0; mi < 2; mi++)
#pragma unroll
    for (int ni = 0; ni < 2; ni++)
#pragma unroll
      for (int r = 0; r < 16; r++) acc[mi][ni][r] = 0.f;
  const unsigned ao = (unsigned)(lrow * lda + lkc), bo = (unsigned)(lrow * ldb + lkc);
  const unsigned a32 = (unsigned)(32 * lda), b32 = (unsigned)(32 * ldb);
  uint4 ra0, ra1, ra2, ra3, rb0, rb1, rb2, rb3;
#define G_LOAD(Ab, Bb)                                                                                   \
  {                                                                                                      \
    ra0 = *(const uint4*)((Ab) + ao); ra1 = *(const uint4*)((Ab) + (ao + a32));                          \
    ra2 = *(const uint4*)((Ab) + (ao + 2 * a32)); ra3 = *(const uint4*)((Ab) + (ao + 3 * a32));          \
    rb0 = *(const uint4*)((Bb) + bo); rb1 = *(const uint4*)((Bb) + (bo + b32));                          \
    rb2 = *(const uint4*)((Bb) + (bo + 2 * b32)); rb3 = *(const uint4*)((Bb) + (bo + 3 * b32));          \
  }
#define G_STORE(sa_, sb_)                                                                                \
  {                                                                                                      \
    bf16_t* a_w = (sa_) + lrow * LDT + lkc;                                                              \
    bf16_t* b_w = (sb_) + lrow * LDT + lkc;                                                              \
    *(uint4*)(a_w) = ra0; *(uint4*)(a_w + 32 * LDT) = ra1; *(uint4*)(a_w + 64 * LDT) = ra2; *(uint4*)(a_w + 96 * LDT) = ra3; \
    *(uint4*)(b_w) = rb0; *(uint4*)(b_w + 32 * LDT) = rb1; *(uint4*)(b_w + 64 * LDT) = rb2; *(uint4*)(b_w + 96 * LDT) = rb3; \
  }
  G_LOAD(A, Bt);
  G_STORE(sA, sB);
  __syncthreads();
  const int nk = K >> 6;
  const int aoff = (wm * 64 + (lane & 31)) * LDT + (lane >> 5) * 8;
  const int boff = (wn * 64 + (lane & 31)) * LDT + (lane >> 5) * 8;
  for (int kt = 0; kt < nk; kt++) {
    const int cur = kt & 1;
    if (kt + 1 < nk) {
      const bf16_t* A1 = A + (kt + 1) * 64;
      const bf16_t* B1 = Bt + (kt + 1) * 64;
      G_LOAD(A1, B1);
    }
    __builtin_amdgcn_sched_barrier(0);
    __builtin_amdgcn_s_setprio(1);
    const bf16_t* a_s = sA + cur * 128 * LDT + aoff;
    const bf16_t* b_s = sB + cur * 128 * LDT + boff;
#pragma unroll
    for (int kk = 0; kk < 4; kk++) {
      bf16x8 af[2], bq[2];
#pragma unroll
      for (int mi = 0; mi < 2; mi++) af[mi] = *(const bf16x8*)(a_s + mi * 32 * LDT + kk * 16);
#pragma unroll
      for (int ni = 0; ni < 2; ni++) bq[ni] = *(const bf16x8*)(b_s + ni * 32 * LDT + kk * 16);
#pragma unroll
      for (int mi = 0; mi < 2; mi++)
#pragma unroll
        for (int ni = 0; ni < 2; ni++) acc[mi][ni] = MFMA32(af[mi], bq[ni], acc[mi][ni]);
    }
    __builtin_amdgcn_s_setprio(0);
    __builtin_amdgcn_sched_barrier(0);
    if (kt + 1 < nk) G_STORE(sA + (cur ^ 1) * 128 * LDT, sB + (cur ^ 1) * 128 * LDT);
    __syncthreads();
  }
}
DI uint4 mix8(const uint4 h, const uint4 x, const float4 m0, const float4 m1) {
  uint4 o;
  o.x = pack2(lo_bf(h.x) + lo_bf(x.x) * m0.x, hi_bf(h.x) + hi_bf(x.x) * m0.y);
  o.y = pack2(lo_bf(h.y) + lo_bf(x.y) * m0.z, hi_bf(h.y) + hi_bf(x.y) * m0.w);
  o.z = pack2(lo_bf(h.z) + lo_bf(x.z) * m1.x, hi_bf(h.z) + hi_bf(x.z) * m1.y);
  o.w = pack2(lo_bf(h.w) + lo_bf(x.w) * m1.z, hi_bf(h.w) + hi_bf(x.w) * m1.w);
  return o;
}
DI void gemm_mainloop_mix(const bf16_t* __restrict__ HX, const float* __restrict__ mix, const bf16_t* __restrict__ Bt, int ldb, char* smem, f32x16 (&acc)[2][2]) {
  const int tidx = opaque_tid();
  bf16_t* sA = (bf16_t*)smem;
  bf16_t* sB = sA + 2 * 128 * LDT;
  const int tid = tidx, lane = tid & 63, w = tid >> 6, wm = w >> 1, wn = w & 1;
  const int lrow = tid >> 3, lkc = (tid & 7) * 8;
#pragma unroll
  for (int mi = 0; mi < 2; mi++)
#pragma unroll
    for (int ni = 0; ni < 2; ni++)
#pragma unroll
      for (int r = 0; r < 16; r++) acc[mi][ni][r] = 0.f;
  const unsigned ao = (unsigned)(lrow * 2048 + lkc), bo = (unsigned)(lrow * ldb + lkc);
  const unsigned a32 = 32u * 2048u, b32 = (unsigned)(32 * ldb);
  uint4 h0, h1, h2, h3, x0, x1, x2, x3, rb0, rb1, rb2, rb3;
  float4 m0, m1;
#define GM_LOAD(kstep_)                                                                                  \
  {                                                                                                      \
    const bf16_t* Ab_ = HX + (kstep_) * 64;                                                              \
    const bf16_t* Bb_ = Bt + (kstep_) * 64;                                                              \
    h0 = *(const uint4*)(Ab_ + ao); h1 = *(const uint4*)(Ab_ + (ao + a32));                              \
    h2 = *(const uint4*)(Ab_ + (ao + 2 * a32)); h3 = *(const uint4*)(Ab_ + (ao + 3 * a32));              \
    x0 = *(const uint4*)(Ab_ + (ao + 1024u)); x1 = *(const uint4*)(Ab_ + (ao + a32 + 1024u));            \
    x2 = *(const uint4*)(Ab_ + (ao + 2 * a32 + 1024u)); x3 = *(const uint4*)(Ab_ + (ao + 3 * a32 + 1024u)); \
    rb0 = *(const uint4*)(Bb_ + bo); rb1 = *(const uint4*)(Bb_ + (bo + b32));                            \
    rb2 = *(const uint4*)(Bb_ + (bo + 2 * b32)); rb3 = *(const uint4*)(Bb_ + (bo + 3 * b32));            \
    m0 = *(const float4*)(mix + (kstep_) * 64 + lkc); m1 = *(const float4*)(mix + (kstep_) * 64 + lkc + 4); \
  }
#define GM_STORE(buf_)                                                                                   \
  {                                                                                                      \
    bf16_t* a_w = sA + (buf_) * 128 * LDT + lrow * LDT + lkc;                                            \
    bf16_t* b_w = sB + (buf_) * 128 * LDT + lrow * LDT + lkc;                                            \
    *(uint4*)(a_w) = mix8(h0, x0, m0, m1); *(uint4*)(a_w + 32 * LDT) = mix8(h1, x1, m0, m1);             \
    *(uint4*)(a_w + 64 * LDT) = mix8(h2, x2, m0, m1); *(uint4*)(a_w + 96 * LDT) = mix8(h3, x3, m0, m1);  \
    *(uint4*)(b_w) = rb0; *(uint4*)(b_w + 32 * LDT) = rb1; *(uint4*)(b_w + 64 * LDT) = rb2; *(uint4*)(b_w + 96 * LDT) = rb3; \
  }
  GM_LOAD(0);
  GM_STORE(0);
  __syncthreads();
  const int aoff = (wm * 64 + (lane & 31)) * LDT + (lane >> 5) * 8;
  const int boff = (wn * 64 + (lane & 31)) * LDT + (lane >> 5) * 8;
  for (int kt = 0; kt < 16; kt++) {
    const int cur = kt & 1;
    if (kt + 1 < 16) GM_LOAD(kt + 1);
    __builtin_amdgcn_sched_barrier(0);
    __builtin_amdgcn_s_setprio(1);
    const bf16_t* a_s = sA + cur * 128 * LDT + aoff;
    const bf16_t* b_s = sB + cur * 128 * LDT + boff;
#pragma unroll
    for (int kk = 0; kk < 4; kk++) {
      bf16x8 af[2], bq[2];
#pragma unroll
      for (int mi = 0; mi < 2; mi++) af[mi] = *(const bf16x8*)(a_s + mi * 32 * LDT + kk * 16);
#pragma unroll
      for (int ni = 0; ni < 2; ni++) bq[ni] = *(const bf16x8*)(b_s + ni * 32 * LDT + kk * 16);
#pragma unroll
      for (int mi = 0; mi < 2; mi++)
#pragma unroll
        for (int ni = 0; ni < 2; ni++) acc[mi][ni] = MFMA32(af[mi], bq[ni], acc[mi][ni]);
    }
    __builtin_amdgcn_s_setprio(0);
    __builtin_amdgcn_sched_barrier(0);
    if (kt + 1 < 16) GM_STORE(cur ^ 1);
    __syncthreads();
  }
}

constexpr int EST = 132;
DI void acc_to_lds(const f32x16 (&acc)[2][2], float* es) {
  const int tidx = opaque_tid();
  const int lane = tidx & 63, w = tidx >> 6, wm = w >> 1, wn = w & 1;
#pragma unroll
  for (int mi = 0; mi < 2; mi++)
#pragma unroll
    for (int ni = 0; ni < 2; ni++)
#pragma unroll
      for (int r = 0; r < 16; r++)
        es[(wm * 64 + mi * 32 + (r & 3) + 8 * (r >> 2) + 4 * (lane >> 5)) * EST + wn * 64 + ni * 32 + (lane & 31)] = acc[mi][ni][r];
}
#define EPI8_BEGIN                                                                   \
  {                                                                                  \
    float* es = (float*)smem;                                                        \
    acc_to_lds(acc, es);                                                             \
    __syncthreads();                                                                 \
    for (int pass = 0; pass < 8; pass++) {                                           \
      const int row = pass * 16 + (tidx >> 4), col = (tidx & 15) * 8;  \
      const float4 e_va = *(const float4*)(es + row * EST + col);                    \
      const float4 e_vb = *(const float4*)(es + row * EST + col + 4);                \
      float v[8] = {e_va.x, e_va.y, e_va.z, e_va.w, e_vb.x, e_vb.y, e_vb.z, e_vb.w};
#define EPI8_END                                                                     \
    }                                                                                \
    __syncthreads();                                                                 \
  }
DI uint4 pack8(const float (&v)[8]) { return make_uint4(pack2(v[0], v[1]), pack2(v[2], v[3]), pack2(v[4], v[5]), pack2(v[6], v[7])); }
DI void unpack8(const uint4 u, float (&v)[8]) {
  v[0] = lo_bf(u.x); v[1] = hi_bf(u.x); v[2] = lo_bf(u.y); v[3] = hi_bf(u.y); v[4] = lo_bf(u.z); v[5] = hi_bf(u.z); v[6] = lo_bf(u.w); v[7] = hi_bf(u.w);
}
DI void resid_update(float* xp, const float* xsrc, const float* gate, const float (&v)[8]) {
  float4 x0 = *(const float4*)xsrc, x1 = *(const float4*)(xsrc + 4);
  const float4 g0 = *(const float4*)gate, g1 = *(const float4*)(gate + 4);
  x0.x += g0.x * v[0]; x0.y += g0.y * v[1]; x0.z += g0.z * v[2]; x0.w += g0.w * v[3];
  x1.x += g1.x * v[4]; x1.y += g1.y * v[5]; x1.z += g1.z * v[6]; x1.w += g1.w * v[7];
  *(float4*)xp = x0; *(float4*)(xp + 4) = x1;
}

DI bool xcd_tile(int t, int Mt, int Nt, int& mt, int& nt) {
  const int G = gridDim.x, spx = G >> 3, tn = spx >> 3;
  const int r = t % G, round = t / G;
  const int xcd = r & 7, li = r >> 3;
  const int smn = Mt >> 3, snn = Nt / tn;
  const int st = round * 8 + xcd;
  if (st >= smn * snn) return false;
  const int smi = st % smn, sni = st / smn;
  mt = smi * 8 + (li & 7);
  nt = sni * tn + (li >> 3);
  return true;
}
DI int xcd_rounds(int Mt, int Nt) { const int tn = gridDim.x >> 6; return ((Mt >> 3) * (Nt / tn) + 7) >> 3; }

DI void phase_t1(const P& p, int layer, char* smem) {
  const int j = layer / 2;
  const int tidx = opaque_tid();
  const bf16_t* HX = (const bf16_t*)(p.ws + OFF_TR + TR_HX);
  const bf16_t* WL1 = (const bf16_t*)(p.ws + w_off(0)) + W_L1;
  bf16_t* T1 = (bf16_t*)(p.ws + OFF_TR + TR_T1);
  for (int t = blockIdx.x; t < 136 * 5; t += gridDim.x) {
    const int nt = t % 5, lt = t / 5;
    f32x16 acc[2][2];
    if (nt == 1) gemm_mainloop(HX + (size_t)lt * 128 * 2048, 2048, WL1 + (size_t)nt * 128 * 2048, 2048, 2048, smem, acc);
    else gemm_mainloop_mix(HX + (size_t)lt * 128 * 2048, p.rw_mix + ((size_t)j * 6 + (nt == 0 ? 1 : 5)) * 1024, WL1 + (size_t)nt * 128 * 2048, 2048, smem, acc);
    EPI8_BEGIN
      const int c = nt * 128 + col;
      if (c < 128) {
#pragma unroll
        for (int e = 0; e < 8; e++) v[e] = tanhf_(v[e]);
      } else if (c >= 256) {
#pragma unroll
        for (int e = 0; e < 8; e++) v[e] = sigmoidf_(v[e]);
      }
      *(uint4*)(T1 + (size_t)(lt * 128 + row) * 640 + c) = pack8(v);
    EPI8_END
  }
}

DI void phase_feat(const P& p, int layer, int hf, char* smem) {
  const int tidx = opaque_tid();
  const int j = layer / 2;
  const bf16_t* W = (const bf16_t*)(p.ws + w_off(layer));
  const bf16_t* HX = (const bf16_t*)(p.ws + OFF_TR + TR_HX);
  const bf16_t* T1 = (const bf16_t*)(p.ws + OFF_TR + TR_T1);
  bf16_t* VF = (bf16_t*)(p.ws + OFF_VF);
  for (int t = blockIdx.x; t < xcd_rounds(136, 24) * (int)gridDim.x; t += gridDim.x) {
    int lt, nt;
    if (!xcd_tile(t, 136, 24, lt, nt)) continue;
    const int s = nt / 8, n0 = (nt % 8) * 128;
    const int gt = half_gtile(hf, lt);
    f32x16 acc[2][2];
    bf16_t* outp = (bf16_t*)(p.ws + OFF_TR + (s == 0 ? TR_R : (s == 1 ? TR_K : TR_V)));
    if (s == 2 && j > 0) {
      gemm_mainloop(T1 + (size_t)lt * 128 * 640 + 192, 640, W + W_V2 + (size_t)n0 * 64, 64, 64, smem, acc);
      const float* v0 = p.rw_v0 + (size_t)(j - 1) * 1024;
      EPI8_BEGIN
        const int c = n0 + col;
#pragma unroll
        for (int e = 0; e < 8; e++) v[e] = sigmoidf_(v0[c + e] + v[e]);
        *(uint4*)(outp + (size_t)(lt * 128 + row) * 1024 + c) = pack8(v);
      EPI8_END
    }
    {
      const int mixsel = s == 0 ? 0 : (s == 1 ? 2 : 3);
      gemm_mainloop_mix(HX + (size_t)lt * 128 * 2048, p.rw_mix + ((size_t)j * 6 + mixsel) * 1024, W + W_RKV + ((size_t)s * 1024 + n0) * 2048, 2048, smem, acc);
    }
    if (s < 2) {
      EPI8_BEGIN
        *(uint4*)(outp + (size_t)(lt * 128 + row) * 1024 + n0 + col) = pack8(v);
      EPI8_END
    } else if (j == 0) {
      EPI8_BEGIN
        const uint4 u = pack8(v);
        *(uint4*)(outp + (size_t)(lt * 128 + row) * 1024 + n0 + col) = u;
        *(uint4*)(VF + (size_t)(gt * 128 + row) * 1024 + n0 + col) = u;
      EPI8_END
    } else {
      EPI8_BEGIN
        const size_t oi = (size_t)(lt * 128 + row) * 1024 + n0 + col;
        float sg[8], vf[8];
        unpack8(*(const uint4*)(outp + oi), sg);
        unpack8(*(const uint4*)(VF + (size_t)(gt * 128 + row) * 1024 + n0 + col), vf);
#pragma unroll
        for (int e = 0; e < 8; e++) v[e] = v[e] + (vf[e] - v[e]) * sg[e];
        *(uint4*)(outp + oi) = pack8(v);
      EPI8_END
    }
  }
  for (int t = blockIdx.x; t < xcd_rounds(136, 40) * (int)gridDim.x; t += gridDim.x) {
    int lt, nt;
    if (!xcd_tile(t, 136, 40, lt, nt)) continue;
    const int s = nt / 8, n0 = (nt % 8) * 128;
    f32x16 acc[2][2];
    if (s == 0) {
      gemm_mainloop(T1 + (size_t)lt * 128 * 640 + 128, 640, W + W_A2 + (size_t)n0 * 64, 64, 64, smem, acc);
      bf16_t* outp = (bf16_t*)(p.ws + OFF_TR + TR_A);
      const float* a0 = p.rw_a0 + (size_t)j * 1024;
      EPI8_BEGIN
#pragma unroll
        for (int e = 0; e < 8; e++) v[e] = sigmoidf_(a0[n0 + col + e] + v[e]);
        *(uint4*)(outp + (size_t)(lt * 128 + row) * 1024 + n0 + col) = pack8(v);
      EPI8_END
    } else if (s < 3) {
      const int d = s - 1;
      gemm_mainloop(T1 + (size_t)lt * 128 * 640 + d * 64, 640, W + W_W2 + (size_t)d * 65536 + (size_t)n0 * 64, 64, 64, smem, acc);
      bf16_t* outp = (bf16_t*)(p.ws + OFF_TR + (d ? TR_WL1 : TR_WL0));
      const float* w0 = p.rw_w0 + ((size_t)j * 2 + d) * 1024;
      EPI8_BEGIN
#pragma unroll
        for (int e = 0; e < 8; e++) v[e] = -0.60653065971263342f * sigmoidf_(w0[n0 + col + e] + v[e]);
        *(uint4*)(outp + (size_t)(lt * 128 + row) * 1024 + n0 + col) = pack8(v);
      EPI8_END
    } else {
      const int d = s - 3;
      gemm_mainloop(T1 + (size_t)lt * 128 * 640 + 256 + d * 192, 640, W + W_G2 + (size_t)d * 196608 + (size_t)n0 * 192, 192, 192, smem, acc);
      bf16_t* outp = (bf16_t*)(p.ws + OFF_TR + (d ? TR_G1 : TR_G0));
      EPI8_BEGIN
        *(uint4*)(outp + (size_t)(lt * 128 + row) * 1024 + n0 + col) = pack8(v);
      EPI8_END
    }
  }
}

DI int scan_row(int bl, int dir, int pos) {
  if (pos < CL) { int t = dir ? (CL - 1 - pos) : pos; return 16384 + bl * CL + t; }
  int t = pos - CL; if (dir) t = SL - 1 - t;
  return bl * SL + t;
}

DI void phase_scan(const P& p, int layer, char* smem) {
  const int tidx = opaque_tid();
  const int j = layer / 2;
  const int tid = tidx;
  const bf16_t* R = (const bf16_t*)(p.ws + OFF_TR + TR_R);
  const bf16_t* Kx = (const bf16_t*)(p.ws + OFF_TR + TR_K);
  const bf16_t* V = (const bf16_t*)(p.ws + OFF_TR + TR_V);
  const bf16_t* Aa = (const bf16_t*)(p.ws + OFF_TR + TR_A);
  float* sbuf = (float*)smem;
  constexpr int BUFF = 5 * 16 * 64 + 512;
  constexpr int POP = 144;
  float* pobuf = sbuf + 2 * BUFF;
  const int ss = tid >> 4, c4 = tid & 15;
  const int rl = tid >> 4, cg = tid & 15;
  for (int item = blockIdx.x; item < 256; item += gridDim.x) {
    const int q2 = item & 1, dir = (item >> 1) & 1, head = (item >> 2) & 15, bl = item >> 6;
    const bf16_t* WL = (const bf16_t*)(p.ws + OFF_TR + (dir ? TR_WL1 : TR_WL0));
    bf16_t* O = (bf16_t*)(p.ws + OFF_TR + TR_HX) + (dir ? (size_t)HROWS * 1024 : 0);
    const int ch = head * 64 + c4 * 4;
    const float4 kkw = *(const float4*)(p.rw_kk + (size_t)j * 1024 + ch);
    const float4 kaw = *(const float4*)(p.rw_ka + (size_t)j * 1024 + ch);
    fv2 SA01 = {0.f, 0.f}, SA23 = {0.f, 0.f}, SB01 = {0.f, 0.f}, SB23 = {0.f, 0.f};
    uint2 gr_, gk_, ga_, gw_, gv_;
    gv_ = make_uint2(0, 0);
#define SC_ISSUE(chunk_)                                                                   \
    {                                                                                      \
      const size_t ro = (size_t)scan_row(bl, dir, (chunk_) * 16 + ss) * 1024;              \
      gr_ = *(const uint2*)(R + ro + ch); gk_ = *(const uint2*)(Kx + ro + ch);             \
      ga_ = *(const uint2*)(Aa + ro + ch); gw_ = *(const uint2*)(WL + ro + ch);            \
      if (c4 < 8) gv_ = *(const uint2*)(V + ro + head * 64 + q2 * 32 + c4 * 4);            \
    }
#define SC_STAGE(buf_)                                                                     \
    {                                                                                      \
      float* sb_ = sbuf + (buf_) * BUFF;                                                   \
      float r0 = lo_bf(gr_.x), r1 = hi_bf(gr_.x), r2 = lo_bf(gr_.y), r3 = hi_bf(gr_.y);    \
      float k0 = lo_bf(gk_.x), k1 = hi_bf(gk_.x), k2 = lo_bf(gk_.y), k3 = hi_bf(gk_.y);    \
      float a0 = lo_bf(ga_.x), a1 = hi_bf(ga_.x), a2 = lo_bf(ga_.y), a3 = hi_bf(ga_.y);    \
      float w0 = lo_bf(gw_.x), w1 = hi_bf(gw_.x), w2 = lo_bf(gw_.y), w3 = hi_bf(gw_.y);    \
      float u0 = k0 * kkw.x, u1 = k1 * kkw.y, u2 = k2 * kkw.z, u3 = k3 * kkw.w;            \
      float sq = rowsum16(u0 * u0 + u1 * u1 + u2 * u2 + u3 * u3);                          \
      float inv = rsqrtf(fmaxf(sq, 1e-24f));                                               \
      u0 *= inv; u1 *= inv; u2 *= inv; u3 *= inv;                                          \
      const int o_ = ss * 64 + c4 * 4;                                                     \
      *(float4*)(sb_ + 0 * 1024 + o_) = make_float4(__expf(w0), __expf(w1), __expf(w2), __expf(w3)); \
      *(float4*)(sb_ + 1 * 1024 + o_) = make_float4(k0 * (1.f + (a0 - 1.f) * kaw.x), k1 * (1.f + (a1 - 1.f) * kaw.y), k2 * (1.f + (a2 - 1.f) * kaw.z), k3 * (1.f + (a3 - 1.f) * kaw.w)); \
      *(float4*)(sb_ + 2 * 1024 + o_) = make_float4(-u0, -u1, -u2, -u3);                   \
      *(float4*)(sb_ + 3 * 1024 + o_) = make_float4(u0 * a0, u1 * a1, u2 * a2, u3 * a3);   \
      *(float4*)(sb_ + 4 * 1024 + o_) = make_float4(r0, r1, r2, r3);                       \
      if (c4 < 8) *(float4*)(sb_ + 5 * 1024 + ss * 32 + c4 * 4) = make_float4(lo_bf(gv_.x), hi_bf(gv_.x), lo_bf(gv_.y), hi_bf(gv_.y)); \
    }
    __syncthreads();
    SC_ISSUE(0);
    SC_STAGE(0);
    __syncthreads();
    constexpr int NCH = TK / 16;
    float* po_wa = pobuf + rl * POP + cg;
    float* po_wb = pobuf + (rl + 16) * POP + cg;
    const float* po_r = pobuf + (rl + 16 * (cg >> 3)) * POP + (cg & 7) * 16;
    for (int chunk = 0; chunk < NCH; chunk++) {
      const int buf = chunk & 1;
      if (chunk + 1 < NCH) SC_ISSUE(chunk + 1);
      __builtin_amdgcn_sched_barrier(0);
      const float* sb = sbuf + buf * BUFF + cg * 4;
      const float* sv = sbuf + buf * BUFF + 5 * 1024 + rl;
      float4 w4 = *(const float4*)(sb + 0 * 1024), k4 = *(const float4*)(sb + 1 * 1024), n4 = *(const float4*)(sb + 2 * 1024);
      float4 b4 = *(const float4*)(sb + 3 * 1024), r4 = *(const float4*)(sb + 4 * 1024);
      float va = sv[0], vb = sv[16];
#pragma unroll
      for (int s = 0; s < 16; s++) {
        float4 w4n = w4, k4n = k4, n4n = n4, b4n = b4, r4n = r4;
        float van = va, vbn = vb;
        if (s + 1 < 16) {
          w4n = *(const float4*)(sb + 0 * 1024 + (s + 1) * 64); k4n = *(const float4*)(sb + 1 * 1024 + (s + 1) * 64);
          n4n = *(const float4*)(sb + 2 * 1024 + (s + 1) * 64); b4n = *(const float4*)(sb + 3 * 1024 + (s + 1) * 64);
          r4n = *(const float4*)(sb + 4 * 1024 + (s + 1) * 64); van = sv[(s + 1) * 32]; vbn = sv[(s + 1) * 32 + 16];
        }
        const fv2 w01 = {w4.x, w4.y}, w23 = {w4.z, w4.w}, k01 = {k4.x, k4.y}, k23 = {k4.z, k4.w}, n01 = {n4.x, n4.y}, n23 = {n4.z, n4.w};
        const fv2 b01 = {b4.x, b4.y}, b23 = {b4.z, b4.w}, r01 = {r4.x, r4.y}, r23 = {r4.z, r4.w};
        const fv2 va2 = {va, va}, vb2 = {vb, vb};
        const fv2 vka01 = va2 * k01, vka23 = va2 * k23, vkb01 = vb2 * k01, vkb23 = vb2 * k23;
        fv2 ppa = SA01 * n01, ppb = SB01 * n01;
        ppa = __builtin_elementwise_fma(SA23, n23, ppa);
        ppb = __builtin_elementwise_fma(SB23, n23, ppb);
        float saa = ppa.x + ppa.y, sab = ppb.x + ppb.y;
        saa = ror_add<8>(saa); sab = ror_add<8>(sab);
        saa = ror_add<4>(saa); sab = ror_add<4>(sab);
        saa = ror_add<2>(saa); sab = ror_add<2>(sab);
        saa = ror_add<1>(saa); sab = ror_add<1>(sab);
        const fv2 saa2 = {saa, saa}, sab2 = {sab, sab};
        const fv2 ta01 = __builtin_elementwise_fma(saa2, b01, vka01), ta23 = __builtin_elementwise_fma(saa2, b23, vka23);
        const fv2 tb01 = __builtin_elementwise_fma(sab2, b01, vkb01), tb23 = __builtin_elementwise_fma(sab2, b23, vkb23);
        SA01 = __builtin_elementwise_fma(SA01, w01, ta01);
        SA23 = __builtin_elementwise_fma(SA23, w23, ta23);
        SB01 = __builtin_elementwise_fma(SB01, w01, tb01);
        SB23 = __builtin_elementwise_fma(SB23, w23, tb23);
        fv2 qa = SA01 * r01, qb = SB01 * r01;
        qa = __builtin_elementwise_fma(SA23, r23, qa);
        qb = __builtin_elementwise_fma(SB23, r23, qb);
        po_wa[(s & 7) * 16] = qa.x + qa.y;
        po_wb[(s & 7) * 16] = qb.x + qb.y;
        w4 = w4n; k4 = k4n; n4 = n4n; b4 = b4n; r4 = r4n; va = van; vb = vbn;
        __builtin_amdgcn_sched_barrier(0);
        if ((s & 7) == 7) {
          const float4 p0 = *(const float4*)(po_r), p1 = *(const float4*)(po_r + 4), p2 = *(const float4*)(po_r + 8), p3 = *(const float4*)(po_r + 12);
          const float ov = ((p0.x + p0.y) + (p0.z + p0.w)) + ((p1.x + p1.y) + (p1.z + p1.w)) + ((p2.x + p2.y) + (p2.z + p2.w)) + ((p3.x + p3.y) + (p3.z + p3.w));
          const size_t ro = (size_t)scan_row(bl, dir, chunk * 16 + (s & 8) + (cg & 7)) * 1024;
          O[ro + head * 64 + q2 * 32 + rl + 16 * (cg >> 3)] = f2bf(ov);
          __builtin_amdgcn_sched_barrier(0);
        }
      }
      if (chunk + 1 < NCH) SC_STAGE(buf ^ 1);
      __syncthreads();
    }
  }
}

DI void phase_combine(const P& p, int layer) {
  const int tidx = opaque_tid();
  const int j = layer / 2;
  const bf16_t* Of = (const bf16_t*)(p.ws + OFF_TR + TR_HX);
  const bf16_t* Ob = Of + (size_t)HROWS * 1024;
  const bf16_t* R = (const bf16_t*)(p.ws + OFF_TR + TR_R);
  const bf16_t* Kx = (const bf16_t*)(p.ws + OFF_TR + TR_K);
  const bf16_t* V = (const bf16_t*)(p.ws + OFF_TR + TR_V);
  const bf16_t* Aa = (const bf16_t*)(p.ws + OFF_TR + TR_A);
  bf16_t* G0 = (bf16_t*)(p.ws + OFF_TR + TR_G0);
  const bf16_t* G1 = (const bf16_t*)(p.ws + OFF_TR + TR_G1);
  const size_t total = (size_t)HROWS * 128;
  for (size_t i = (size_t)blockIdx.x * 256 + tidx; i < total; i += (size_t)gridDim.x * 256) {
    const int c0 = (int)(i & 127) * 8;
    const size_t off = (i >> 7) * 1024 + c0;
    const uint4 uof = *(const uint4*)(Of + off), uob = *(const uint4*)(Ob + off), ur = *(const uint4*)(R + off), uk = *(const uint4*)(Kx + off);
    const uint4 ua = *(const uint4*)(Aa + off), uv = *(const uint4*)(V + off), ug0 = *(const uint4*)(G0 + off), ug1 = *(const uint4*)(G1 + off);
    const unsigned aof[4] = {uof.x, uof.y, uof.z, uof.w}, aob[4] = {uob.x, uob.y, uob.z, uob.w}, ar[4] = {ur.x, ur.y, ur.z, ur.w}, ak[4] = {uk.x, uk.y, uk.z, uk.w};
    const unsigned aa[4] = {ua.x, ua.y, ua.z, ua.w}, av[4] = {uv.x, uv.y, uv.z, uv.w}, ag0[4] = {ug0.x, ug0.y, ug0.z, ug0.w}, ag1[4] = {ug1.x, ug1.y, ug1.z, ug1.w};
    const float* ka = p.rw_ka + (size_t)j * 1024 + c0;
    const float* rk = p.rw_rk + (size_t)j * 1024 + c0;
    const float* lg = p.rw_ln_g + (size_t)j * 1024 + c0;
    const float* lb = p.rw_ln_b + (size_t)j * 1024 + c0;
    float of[8], obv[8];
    float sf = 0.f, sf2 = 0.f, sb = 0.f, sb2 = 0.f, br = 0.f;
#pragma unroll
    for (int e = 0; e < 8; e++) {
      const int w = e >> 1;
      of[e] = (e & 1) ? hi_bf(aof[w]) : lo_bf(aof[w]);
      obv[e] = (e & 1) ? hi_bf(aob[w]) : lo_bf(aob[w]);
      const float r = (e & 1) ? hi_bf(ar[w]) : lo_bf(ar[w]);
      const float k = (e & 1) ? hi_bf(ak[w]) : lo_bf(ak[w]);
      const float a = (e & 1) ? hi_bf(aa[w]) : lo_bf(aa[w]);
      sf += of[e]; sf2 += of[e] * of[e]; sb += obv[e]; sb2 += obv[e] * obv[e];
      br += r * k * (1.f + (a - 1.f) * ka[e]) * rk[e];
    }
#pragma unroll
    for (int o = 1; o < 8; o <<= 1) { sf += __shfl_xor(sf, o); sf2 += __shfl_xor(sf2, o); sb += __shfl_xor(sb, o); sb2 += __shfl_xor(sb2, o); br += __shfl_xor(br, o); }
    const float muf = sf * (1.f / 64.f), mub = sb * (1.f / 64.f);
    const float rsf = rsqrtf(fmaxf(sf2 * (1.f / 64.f) - muf * muf, 0.f) + 64e-5f);
    const float rsb = rsqrtf(fmaxf(sb2 * (1.f / 64.f) - mub * mub, 0.f) + 64e-5f);
    float y[8];
#pragma unroll
    for (int e = 0; e < 8; e++) {
      const int w = e >> 1;
      const float v = (e & 1) ? hi_bf(av[w]) : lo_bf(av[w]);
      const float g0 = (e & 1) ? hi_bf(ag0[w]) : lo_bf(ag0[w]);
      const float g1 = (e & 1) ? hi_bf(ag1[w]) : lo_bf(ag1[w]);
      const float bonus = br * v;
      y[e] = ((of[e] - muf) * rsf * lg[e] + lb[e] + bonus) * g0 + ((obv[e] - mub) * rsb * lg[e] + lb[e] + bonus) * g1;
    }
    *(uint4*)(G0 + off) = make_uint4(pack2(y[0], y[1]), pack2(y[2], y[3]), pack2(y[4], y[5]), pack2(y[6], y[7]));
  }
}

DI void phase_rw_out(const P& p, int layer, int hf, char* smem) {
  const int tidx = opaque_tid();
  const bf16_t* Y = (const bf16_t*)(p.ws + OFF_TR + TR_G0);
  const bf16_t* WO = (const bf16_t*)(p.ws + w_off(layer)) + W_WO;
  const int nlt = (layer == 3) ? 128 : 136;
  for (int t = blockIdx.x; t < xcd_rounds(nlt, 8) * (int)gridDim.x; t += gridDim.x) {
    int lt, nt_;
    if (!xcd_tile(t, nlt, 8, lt, nt_)) continue;
    const int n0 = nt_ * 128;
    const int gt = half_gtile(hf, lt);
    f32x16 acc[2][2];
    gemm_mainloop(Y + (size_t)lt * 128 * 1024, 1024, WO + (size_t)n0 * 1024, 1024, 1024, smem, acc);
    const float* gate = mods_ptr(p, layer, mod_row(gt * 128)) + 2048 + n0;
    float* xr = resid_row(p, gt * 128) + n0;
    const float* xs = layer == 0 ? input_row(p, gt * 128) + n0 : xr;
    EPI8_BEGIN
      resid_update(xr + (size_t)row * D + col, xs + (size_t)row * D + col, gate + col, v);
    EPI8_END
  }
}

DI void phase_mlp1(const P& p, int layer, char* smem) {
  const int tidx = opaque_tid();
  const bf16_t* H2 = (const bf16_t*)(p.ws + OFF_TR + TR_H2);
  const bf16_t* W1 = (const bf16_t*)(p.ws + w_off(layer)) + W_M1;
  bf16_t* HID = (bf16_t*)(p.ws + OFF_TR + TR_HID);
  const int nmt = (layer == 3) ? 256 : 272;
  const int ngrp = nmt / 16;
  (void)ngrp;
  for (int t = blockIdx.x; t < xcd_rounds(nmt, 32) * (int)gridDim.x; t += gridDim.x) {
    int gt, nt;
    if (!xcd_tile(t, nmt, 32, gt, nt)) continue;
    f32x16 acc[2][2];
    gemm_mainloop(H2 + (size_t)gt * 128 * 1024, 1024, W1 + (size_t)nt * 128 * 1024, 1024, 1024, smem, acc);
    EPI8_BEGIN
#pragma unroll
      for (int e = 0; e < 8; e++) { const float rl = fmaxf(v[e], 0.f); v[e] = rl * rl; }
      *(uint4*)(HID + (size_t)(gt * 128 + row) * 4096 + nt * 128 + col) = pack8(v);
    EPI8_END
  }
}
DI void phase_mlp2(const P& p, int layer, char* smem) {
  const int tidx = opaque_tid();
  const bf16_t* HID = (const bf16_t*)(p.ws + OFF_TR + TR_HID);
  const bf16_t* W2 = (const bf16_t*)(p.ws + w_off(layer)) + W_M2;
  const int nmt = (layer == 3) ? 256 : 272;
  for (int t = blockIdx.x; t < xcd_rounds(nmt, 8) * (int)gridDim.x; t += gridDim.x) {
    int gt, nt_;
    if (!xcd_tile(t, nmt, 8, gt, nt_)) continue;
    const int n0 = nt_ * 128;
    f32x16 acc[2][2];
    gemm_mainloop(HID + (size_t)gt * 128 * 4096, 4096, W2 + (size_t)n0 * 4096, 4096, 4096, smem, acc);
    const float* gate = mods_ptr(p, layer, mod_row(gt * 128)) + 5120 + n0;
    float* xr = resid_row(p, gt * 128) + n0;
    EPI8_BEGIN
      resid_update(xr + (size_t)row * D + col, xr + (size_t)row * D + col, gate + col, v);
    EPI8_END
  }
}

DI void phase_qkv(const P& p, int layer, char* smem) {
  const int tidx = opaque_tid();
  const bf16_t* H = (const bf16_t*)(p.ws + OFF_TR + TR_H);
  const bf16_t* WQ = (const bf16_t*)(p.ws + w_off(layer)) + W_QKV;
  bf16_t* Q = (bf16_t*)(p.ws + OFF_TR + TR_Q);
  bf16_t* Kb = (bf16_t*)(p.ws + OFF_TR + TR_KK);
  bf16_t* VT = (bf16_t*)(p.ws + OFF_TR + TR_VT);
  const float* cosT = (const float*)(p.ws + OFF_MISC);
  const float* sinT = cosT + 1024;
  for (int t = blockIdx.x; t < xcd_rounds(272, 24) * (int)gridDim.x; t += gridDim.x) {
    int gt, nt;
    if (!xcd_tile(t, 272, 24, gt, nt)) continue;
    f32x16 acc[2][2];
    gemm_mainloop(H + (size_t)gt * 128 * 1024, 1024, WQ + (size_t)nt * 128 * 1024, 1024, 1024, smem, acc);
    const bool lat = gt < 256;
    const int b = lat ? gt / 32 : (gt - 256) / 2;
    const int t0 = lat ? (gt % 32) * 128 : (gt - 256) % 2 * 128;
    const int tq0 = lat ? t0 : SL + t0;
    const int typ = nt / 8, h = nt % 8;
    if (typ < 2) {
      bf16_t* dst = typ == 0 ? Q : Kb;
      const float qs = typ == 0 ? 0.125f * 1.44269504088896f : 1.f;
      float kmx = 0.f;
      EPI8_BEGIN
        const int sidx = col >> 6, d0 = col & 63;
        if (lat) {
          const float4 pa = *(const float4*)(es + row * EST + (col ^ 16));
          const float4 pb = *(const float4*)(es + row * EST + (col ^ 16) + 4);
          const float pr[8] = {pa.x, pa.y, pa.z, pa.w, pb.x, pb.y, pb.z, pb.w};
          const int tt = t0 + row;
          const int pos = (d0 < 32) ? (tt >> 6) : (tt & 63);
          const float4 ca = *(const float4*)(cosT + pos * 16 + (d0 & 8)), cb = *(const float4*)(cosT + pos * 16 + (d0 & 8) + 4);
          const float4 sa = *(const float4*)(sinT + pos * 16 + (d0 & 8)), sb = *(const float4*)(sinT + pos * 16 + (d0 & 8) + 4);
          const float cs[8] = {ca.x, ca.y, ca.z, ca.w, cb.x, cb.y, cb.z, cb.w};
          const float sn[8] = {sa.x, sa.y, sa.z, sa.w, sb.x, sb.y, sb.z, sb.w};
          const float sgn = (d0 & 16) ? 1.f : -1.f;
#pragma unroll
          for (int e = 0; e < 8; e++) v[e] = v[e] * cs[e] + sgn * pr[e] * sn[e];
        }
#pragma unroll
        for (int e = 0; e < 8; e++) v[e] *= qs;
        const uint4 pk_ = pack8(v);
        *(uint4*)(dst + ((size_t)((b * 8 + h) * 2 + sidx) * TK + tq0 + row) * 64 + d0) = pk_;
        if (typ == 1) {
          float rv_[8];
          unpack8(pk_, rv_);
          float ssq_ = 0.f;
#pragma unroll
          for (int e = 0; e < 8; e++) ssq_ += rv_[e] * rv_[e];
          ssq_ += __shfl_xor(ssq_, 1); ssq_ += __shfl_xor(ssq_, 2); ssq_ += __shfl_xor(ssq_, 4);
          kmx = fmaxf(kmx, ssq_);
        }
      EPI8_END
      if (typ == 1) {
        kmx = fmaxf(kmx, __shfl_xor(kmx, 16));
        kmx = fmaxf(kmx, __shfl_xor(kmx, 32));
        if ((tidx & 55) == 0)
          atomicMax((unsigned*)(p.ws + OFF_MISC) + 4096 + (layer >> 1) * 128 + (b * 8 + h) * 2 + ((tidx >> 3) & 1), __float_as_uint(kmx));
      }
    } else {
      float* es = (float*)smem;
      acc_to_lds(acc, es);
      __syncthreads();
      for (int pass = 0; pass < 8; pass++) {
        const int d = tidx & 127, tg = pass * 2 + (tidx >> 7);
        float v[8];
#pragma unroll
        for (int e = 0; e < 8; e++) v[e] = es[(tg * 8 + e) * EST + d];
        *(uint4*)(VT + ((size_t)(b * 8 + h) * 128 + d) * TK + tq0 + tg * 8) = pack8(v);
      }
      __syncthreads();
    }
  }
}

typedef _Float16 hv2 __attribute__((ext_vector_type(2)));
DI unsigned packh2(float a, float b) { hv2 r = {(_Float16)a, (_Float16)b}; return __builtin_bit_cast(unsigned, r); }
DI float lo_h(unsigned u) { hv2 r = __builtin_bit_cast(hv2, u); return (float)r[0]; }
DI float hi_h(unsigned u) { hv2 r = __builtin_bit_cast(hv2, u); return (float)r[1]; }

DI void phase_attn(const P& p, int layer, char* smem) {
  const int tidx = opaque_tid();
  const int j = layer / 2;
  const bool ctxq = layer != 3;
  const bf16_t* Q = (const bf16_t*)(p.ws + OFF_TR + TR_Q);
  const bf16_t* Kb = (const bf16_t*)(p.ws + OFF_TR + TR_KK);
  const bf16_t* VT = (const bf16_t*)(p.ws + OFF_TR + TR_VT);
  bf16_t* O = (bf16_t*)(p.ws + OFF_TR + TR_H);
  const float lam = ((const float*)(p.ws + OFF_MISC))[2048 + j];
  const float* kmax2 = (const float*)(p.ws + OFF_MISC) + 4096 + j * 128;
  const float oml = 1.f - lambda_init(layer);
  const float* subg = p.da_subln_g + (size_t)j * 128;
  constexpr int LDV = 68;
  bf16_t* sK = (bf16_t*)smem;
  bf16_t* sV = sK + 2 * 64 * LDT;
  const int tid = tidx, lane = tid & 63, w = tid >> 6, g = lane >> 5, l31 = lane & 31;
  const int nitems = 2048 + (ctxq ? 128 : 0);
  const int spx = gridDim.x >> 3, gpr = spx >> 5;
  const int lat_rounds = 64 / (8 * gpr);
  for (int it0 = blockIdx.x; it0 < lat_rounds * (int)gridDim.x + (ctxq ? 128 : 0); it0 += gridDim.x) {
    int item;
    if (it0 < lat_rounds * (int)gridDim.x) {
      const int r = it0 % (int)gridDim.x, round = it0 / (int)gridDim.x;
      const int xcd = r & 7, li = r >> 3;
      const int bh = (round * 8 + xcd) * gpr + (li >> 5);
      item = bh * 32 + (li & 31);
    } else {
      item = 2048 + (it0 - lat_rounds * (int)gridDim.x);
    }
    (void)nitems;
    int b, h, q0, kbeg, ntiles;
    if (item < 2048) { b = item >> 8; h = (item >> 5) & 7; q0 = (item & 31) * 128; kbeg = 0; ntiles = TK / 64; }
    else { const int it = item - 2048; b = it >> 4; h = (it >> 1) & 7; q0 = SL + (it & 1) * 128; kbeg = SL; ntiles = CL / 64; }
    const bf16_t* Vp0 = VT + (size_t)(b * 8 + h) * 128 * TK;
    const int tq = q0 + w * 32 + l31;
    const size_t grow = tq < SL ? (size_t)b * SL + tq : (size_t)NLAT + (size_t)b * CL + (tq - SL);
    bf16_t* op = O + grow * 1024 + h * 128;
    for (int s = 0; s < 2; s++) {
      const bf16_t* Kp0 = Kb + (size_t)((b * 8 + h) * 2 + s) * TK * 64;
      const bf16_t* Qp = Q + ((size_t)((b * 8 + h) * 2 + s) * TK + tq) * 64 + g * 8;
      bf16x8 qf[4];
      float qss = 0.f;
#pragma unroll
      for (int kk = 0; kk < 4; kk++) {
        const uint4 u = *(const uint4*)(Qp + kk * 16);
        qf[kk] = __builtin_bit_cast(bf16x8, u);
        float qv[8];
        unpack8(u, qv);
#pragma unroll
        for (int e = 0; e < 8; e++) qss += qv[e] * qv[e];
      }
      qss += __shfl_xor(qss, 32);
      const float nmq = -sqrtf(qss * kmax2[(b * 8 + h) * 2 + s]);
      f32x16 o[4];
#pragma unroll
      for (int db = 0; db < 4; db++)
#pragma unroll
        for (int r = 0; r < 16; r++) o[db][r] = 0.f;
      float l = 0.f;
      uint4 rk0, rk1, rv0, rv1, rv2, rv3;
      const unsigned kvo = (unsigned)((tid >> 3) * 64 + (tid & 7) * 8);
      const unsigned vvo = (unsigned)((tid >> 3) * TK + (tid & 7) * 8);
      const unsigned sko = (unsigned)((tid >> 3) * LDT + (tid & 7) * 8);
      const unsigned svo = (unsigned)((tid >> 3) * LDV + (tid & 7) * 8);
#define ISSUE_KV(kt_)                                                             \
      {                                                                           \
        const bf16_t* kb_ = Kp0 + (size_t)(kbeg + (kt_) * 64) * 64;               \
        const bf16_t* vb_ = Vp0 + (kbeg + (kt_) * 64);                            \
        unsigned kvo_ = kvo, vvo_ = vvo;                                          \
        asm volatile("" : "+v"(kvo_), "+v"(vvo_));     \
        rk0 = *(const uint4*)(kb_ + kvo_);                                        \
        rk1 = *(const uint4*)(kb_ + (kvo_ + 32u * 64u));                          \
        rv0 = *(const uint4*)(vb_ + vvo_);                                        \
        rv1 = *(const uint4*)(vb_ + (vvo_ + 32u * (unsigned)TK));                 \
        rv2 = *(const uint4*)(vb_ + (vvo_ + 64u * (unsigned)TK));                 \
        rv3 = *(const uint4*)(vb_ + (vvo_ + 96u * (unsigned)TK));                 \
      }
#define ST_V(ptr_, r_) { *(uint2*)(ptr_) = make_uint2(r_.x, r_.y); *(uint2*)((ptr_) + 4) = make_uint2(r_.z, r_.w); }
#define STAGE_KV(buf_)                                                            \
      {                                                                           \
        bf16_t* ks_ = sK + (buf_) * 64 * LDT + sko;                               \
        bf16_t* vs_ = sV + (buf_) * 128 * LDV + svo;                              \
        *(uint4*)(ks_) = rk0;                                                     \
        *(uint4*)(ks_ + 32 * LDT) = rk1;                                          \
        ST_V(vs_, rv0); ST_V(vs_ + 32 * LDV, rv1); ST_V(vs_ + 64 * LDV, rv2); ST_V(vs_ + 96 * LDV, rv3); \
      }
      __syncthreads();
      ISSUE_KV(0);
      STAGE_KV(0);
      __syncthreads();
      for (int kt = 0; kt < ntiles; kt++) {
        const int buf = kt & 1;
        const bool more = kt + 1 < ntiles;
        if (more) ISSUE_KV(kt + 1);
        __builtin_amdgcn_sched_barrier(0);
        const bf16_t* kS = sK + buf * 64 * LDT;
        const bf16_t* vS = sV + buf * 128 * LDV;
#pragma unroll
        for (int kb = 0; kb < 2; kb++) {
          bf16x8 kf[4];
#pragma unroll
          for (int kk = 0; kk < 4; kk++) kf[kk] = *(const bf16x8*)(kS + (kb * 32 + l31) * LDT + kk * 16 + g * 8);
          __builtin_amdgcn_sched_barrier(0);
          f32x16 st;
#pragma unroll
          for (int r = 0; r < 16; r++) st[r] = nmq;
#pragma unroll
          for (int kk = 0; kk < 4; kk++) st = MFMA32(kf[kk], qf[kk], st);
          uint4 vf0[4];
#pragma unroll
          for (int db = 0; db < 4; db++) {
            const bf16_t* vp = vS + (db * 32 + l31) * LDV + kb * 32 + 4 * g;
            const uint2 lo = *(const uint2*)vp;
            const uint2 hi = *(const uint2*)(vp + 8);
            vf0[db] = make_uint4(lo.x, lo.y, hi.x, hi.y);
          }
          __builtin_amdgcn_sched_barrier(0);
          float ls = 0.f;
          bf16x8 pk[2];
#pragma unroll
          for (int hh = 0; hh < 2; hh++) {
            float e[8];
#pragma unroll
            for (int i = 0; i < 8; i++) { e[i] = __builtin_amdgcn_exp2f(st[hh * 8 + i]); ls += e[i]; }
            const uint4 u = make_uint4(pack2(e[0], e[1]), pack2(e[2], e[3]), pack2(e[4], e[5]), pack2(e[6], e[7]));
            pk[hh] = __builtin_bit_cast(bf16x8, u);
          }
          l += ls;
          uint4 vf1[4];
#pragma unroll
          for (int db = 0; db < 4; db++) {
            const bf16_t* vp = vS + (db * 32 + l31) * LDV + kb * 32 + 16 + 4 * g;
            const uint2 lo = *(const uint2*)vp;
            const uint2 hi = *(const uint2*)(vp + 8);
            vf1[db] = make_uint4(lo.x, lo.y, hi.x, hi.y);
          }
          __builtin_amdgcn_sched_barrier(0);
#pragma unroll
          for (int db = 0; db < 4; db++) o[db] = MFMA32(__builtin_bit_cast(bf16x8, vf0[db]), pk[0], o[db]);
#pragma unroll
          for (int db = 0; db < 4; db++) o[db] = MFMA32(__builtin_bit_cast(bf16x8, vf1[db]), pk[1], o[db]);
        }
        __builtin_amdgcn_sched_barrier(0);
        if (more) STAGE_KV(buf ^ 1);
        __syncthreads();
      }
      const float lt = l + __shfl_xor(l, 32);
      if (s == 0) {
        const float inv = 1.f / lt;
#pragma unroll
        for (int db = 0; db < 4; db++)
#pragma unroll
          for (int rq = 0; rq < 4; rq++) {
            const int d = db * 32 + 8 * rq + 4 * g;
            *(uint2*)(op + d) = make_uint2(packh2(o[db][4 * rq] * inv, o[db][4 * rq + 1] * inv), packh2(o[db][4 * rq + 2] * inv, o[db][4 * rq + 3] * inv));
          }
      } else {
        const float inv = lam / lt;
        float ssq = 0.f;
#pragma unroll
        for (int db = 0; db < 4; db++)
#pragma unroll
          for (int rq = 0; rq < 4; rq++) {
            const int d = db * 32 + 8 * rq + 4 * g;
            const uint2 u0 = *(const uint2*)(op + d);
            const float a0 = lo_h(u0.x) - o[db][4 * rq] * inv, a1 = hi_h(u0.x) - o[db][4 * rq + 1] * inv;
            const float a2 = lo_h(u0.y) - o[db][4 * rq + 2] * inv, a3 = hi_h(u0.y) - o[db][4 * rq + 3] * inv;
            o[db][4 * rq] = a0; o[db][4 * rq + 1] = a1; o[db][4 * rq + 2] = a2; o[db][4 * rq + 3] = a3;
            ssq += a0 * a0 + a1 * a1 + a2 * a2 + a3 * a3;
          }
        ssq += __shfl_xor(ssq, 32);
        const float rs = rsqrtf(ssq * (1.f / 128.f) + 1e-5f) * oml;
#pragma unroll
        for (int db = 0; db < 4; db++)
#pragma unroll
          for (int rq = 0; rq < 4; rq++) {
            const int d = db * 32 + 8 * rq + 4 * g;
            const float4 sg = *(const float4*)(subg + d);
            *(uint2*)(op + d) = make_uint2(pack2(o[db][4 * rq] * rs * sg.x, o[db][4 * rq + 1] * rs * sg.y),
                                           pack2(o[db][4 * rq + 2] * rs * sg.z, o[db][4 * rq + 3] * rs * sg.w));
          }
      }
    }
  }
}

DI void phase_at_out(const P& p, int layer, char* smem) {
  const int tidx = opaque_tid();
  const bf16_t* O = (const bf16_t*)(p.ws + OFF_TR + TR_H);
  const bf16_t* WO = (const bf16_t*)(p.ws + w_off(layer)) + W_WO;
  const int nmt = (layer == 3) ? 256 : 272;
  for (int t = blockIdx.x; t < xcd_rounds(nmt, 8) * (int)gridDim.x; t += gridDim.x) {
    int gt, nt_;
    if (!xcd_tile(t, nmt, 8, gt, nt_)) continue;
    const int n0 = nt_ * 128;
    f32x16 acc[2][2];
    gemm_mainloop(O + (size_t)gt * 128 * 1024, 1024, WO + (size_t)n0 * 1024, 1024, 1024, smem, acc);
    const float* gate = mods_ptr(p, layer, mod_row(gt * 128)) + 2048 + n0;
    float* xr = resid_row(p, gt * 128) + n0;
    EPI8_BEGIN
      resid_update(xr + (size_t)row * D + col, xr + (size_t)row * D + col, gate + col, v);
    EPI8_END
  }
}

DI void phase_final(const P& p) {
  const int tidx = opaque_tid();
  const int lane = tidx & 63, wv = tidx >> 6;
  for (int row = blockIdx.x * 4 + wv; row < NLAT; row += gridDim.x * 4) {
    float* xr = p.out + (size_t)row * D;
    float4 v[4];
    float ss = 0.f;
#pragma unroll
    for (int jx = 0; jx < 4; jx++) { v[jx] = *(const float4*)(xr + jx * 256 + lane * 4); ss += v[jx].x * v[jx].x + v[jx].y * v[jx].y + v[jx].z * v[jx].z + v[jx].w * v[jx].w; }
    ss = wave_sum(ss);
    const float rs = rsqrtf(ss * (1.f / 1024.f) + 1e-6f);
#pragma unroll
    for (int jx = 0; jx < 4; jx++) {
      const float4 g = *(const float4*)(p.final_g + jx * 256 + lane * 4);
      *(float4*)(xr + jx * 256 + lane * 4) = make_float4(v[jx].x * rs * g.x, v[jx].y * rs * g.y, v[jx].z * rs * g.z, v[jx].w * rs * g.w);
    }
  }
}

#define XB_TMO      128
#define XB_XCNT(j)  (256  + 64 * (j))
#define XB_XSUB(j)  (1280 + 64 * (j))
#define XB_XGEN(j)  (2304 + 64 * (j))
#define XB_TOP      3328
#define XB_TOPGEN   3392
#define XCD_BAR_WORDS 3456
#define XB_SPIN_CAP (1u << 22)
#define LAS __attribute__((address_space(3)))
DI unsigned xb_ld(unsigned* p) { return __hip_atomic_load(p, __ATOMIC_RELAXED, __HIP_MEMORY_SCOPE_AGENT); }
DI unsigned xb_add(unsigned* p, unsigned v) { return __hip_atomic_fetch_add(p, v, __ATOMIC_RELAXED, __HIP_MEMORY_SCOPE_AGENT); }
DI unsigned xb_xcc_id() { return (unsigned)__builtin_amdgcn_s_getreg((3 << 11) | 20) & 0xFu; }
#define XB_SPIN(cond, bar) do { unsigned _sp = 0; while (cond) { __builtin_amdgcn_s_sleep(1); \
    if ((++_sp & 255u) == 0u) { if (xb_ld(&(bar)[XB_TMO])) break; if (_sp > XB_SPIN_CAP) { atomicAdd(&(bar)[XB_TMO], 1u); break; } } } } while (0)
struct XcdBarrier { unsigned* bar; unsigned x; volatile LAS unsigned* st; };
DI XcdBarrier xcd_barrier_post(unsigned* bar, volatile LAS unsigned* st) {
  XcdBarrier b; b.bar = bar; b.x = xb_xcc_id(); b.st = st;
  if (threadIdx.x == 0) (void)xb_add(&bar[XB_XCNT(b.x)], 1u);
  return b;
}
DI void xcd_barrier_complete(unsigned* bar, unsigned x, unsigned& nloc, unsigned& nx) {
  const unsigned G = gridDim.x * gridDim.y * gridDim.z;
  unsigned sum, cnt, mine, sp = 0u;
  for (;;) {
    sum = 0u; cnt = 0u; mine = 0u;
#pragma unroll
    for (unsigned j = 0; j < 16; ++j) { const unsigned c = xb_ld(&bar[XB_XCNT(j)]); sum += c; cnt += (c > 0u) ? 1u : 0u; mine = (j == x) ? c : mine; }
    if (sum == G) break;
    __builtin_amdgcn_s_sleep(1);
    if ((++sp & 255u) == 0u) { if (xb_ld(&bar[XB_TMO])) break; if (sp > XB_SPIN_CAP) { atomicAdd(&bar[XB_TMO], 1u); break; } }
  }
  nloc = mine > 0u ? mine : 1u; nx = cnt > 0u ? cnt : 1u;
}
DI void xcd_barrier(const XcdBarrier& b) {
  asm volatile("s_waitcnt vmcnt(0)" ::: "memory");
  __syncthreads();
  if (threadIdx.x == 0) {
    unsigned* bar = b.bar;
    __builtin_amdgcn_s_waitcnt(0);
    unsigned nloc = b.st[0], nx = b.st[1];
    if (nloc == 0u) { xcd_barrier_complete(bar, b.x, nloc, nx); b.st[0] = nloc; b.st[1] = nx; }
    const unsigned old = xb_add(&bar[XB_XSUB(b.x)], 1u);
    const unsigned gen = old / nloc;
    if (old + 1u == (gen + 1u) * nloc) {
      __builtin_amdgcn_fence(__ATOMIC_RELEASE, "agent");
      asm volatile("s_waitcnt vmcnt(0)" ::: "memory");
      const unsigned og = xb_add(&bar[XB_TOP], 1u);
      const unsigned tg = og / nx;
      if (og + 1u == (tg + 1u) * nx) xb_add(&bar[XB_TOPGEN], 1u);
      else XB_SPIN(xb_ld(&bar[XB_TOPGEN]) == tg, bar);
      __builtin_amdgcn_fence(__ATOMIC_ACQUIRE, "agent");
      xb_add(&bar[XB_XGEN(b.x)], 1u);
      asm volatile("s_waitcnt vmcnt(0)" ::: "memory");
    } else {
      XB_SPIN(xb_ld(&bar[XB_XGEN(b.x)]) == gen, bar);
      __builtin_amdgcn_fence(__ATOMIC_ACQUIRE, "agent");
      asm volatile("s_waitcnt vmcnt(0)" ::: "memory");
    }
  }
  __syncthreads();
}
constexpr size_t OFF_BAR = OFF_MISC + 65536;

typedef __attribute__((address_space(1))) const float GCF;
typedef __attribute__((address_space(1))) float GF;
typedef __attribute__((address_space(1))) char GC;
DI unsigned long long lds_word(const unsigned long long* tbl, int i) {
  int z = i;
  asm volatile("" : "+v"(z));
  const unsigned long long v = tbl[z];
  const unsigned lo = __builtin_amdgcn_readfirstlane((unsigned)v), hi = __builtin_amdgcn_readfirstlane((unsigned)(v >> 32));
  return ((unsigned long long)hi << 32) | lo;
}
DI void load_params(P& q, const unsigned long long* tbl) {
  const float** fp = (const float**)&q;
#pragma unroll
  for (int i = 0; i < 36; i++) fp[i] = (const float*)(GCF*)lds_word(tbl, i);
  q.out = (float*)(GF*)lds_word(tbl, 36);
  q.ws = (char*)(GC*)lds_word(tbl, 37);
  q.only = 0;
  q.pad = 0;
}
__global__ void __launch_bounds__(256, 2) mega(P p) {
  __shared__ __attribute__((aligned(16))) char smem[73728];
  __shared__ unsigned long long s_tbl[40];
  {
#if defined(__HIP_DEVICE_COMPILE__)
    typedef __attribute__((address_space(4))) const unsigned long long KW;
    KW* kp = (KW*)__builtin_amdgcn_kernarg_segment_ptr();
    if (threadIdx.x < 39) s_tbl[threadIdx.x] = kp[threadIdx.x];
#endif
    __syncthreads();
  }
  const int only = (int)(unsigned)lds_word(s_tbl, 38);
  cg::grid_group grid = cg::this_grid();
  __shared__ uint4 xb_words;
  if (threadIdx.x == 0) xb_words = make_uint4(0u, 0u, 0u, 0u);
  __syncthreads();
  XcdBarrier xb;
  {
    P q;
    load_params(q, s_tbl);
    xb = xcd_barrier_post((unsigned*)(q.ws + OFF_BAR), (volatile LAS unsigned*)&xb_words);
  }
  int step = 0;
#define GSYNC() { if (step == 1) grid.sync(); else xcd_barrier(xb); }
#define STEP(body)                                   \
  {                                                  \
    if (only < 0 || only == step) {              \
      P q;                                           \
      load_params(q, s_tbl);                         \
      body;                                          \
    }                                                \
    step++;                                          \
    if (only < 0) GSYNC();                         \
  }
#ifndef DUP
#define DUP 0
#endif
#define STEPD(id, body)                              \
  {                                                  \
    if (only < 0 || only == step) {                  \
      P q;                                           \
      load_params(q, s_tbl);                         \
      body;                                          \
      if (DUP == id) { __syncthreads(); body; }      \
    }                                                \
    step++;                                          \
    if (only < 0) GSYNC();                           \
  }
  STEP(phase_init(q, smem); __syncthreads(); phase_conv(q, 0, smem, blockIdx.x, gridDim.x));
  for (int layer = 0; layer < 4; layer++) {
    if ((layer & 1) == 0) {
      for (int hf = 0; hf < 2; hf++) {
        STEPD(2, phase_prep(q, layer, 0, hf, true, (bf16_t*)(q.ws + OFF_TR + TR_HX), 2048, false));
        STEPD(3, phase_t1(q, layer, smem));
        STEPD(4, phase_feat(q, layer, hf, smem));
        STEPD(5, phase_scan(q, layer, smem);
              if (hf == 0) { __syncthreads(); phase_conv(q, layer + 1, smem, gridDim.x > 256 ? (int)blockIdx.x - 256 : (int)blockIdx.x, gridDim.x > 256 ? (int)gridDim.x - 256 : (int)gridDim.x); });
        STEP(phase_combine(q, layer));
        STEP(phase_rw_out(q, layer, hf, smem));
      }
    } else {
      STEP(phase_prep(q, layer, 0, -1, false, (bf16_t*)(q.ws + OFF_TR + TR_H), 1024, false);
           if (layer + 1 < 4) { __syncthreads(); phase_conv(q, layer + 1, smem, blockIdx.x, gridDim.x); });
      STEPD(7, phase_qkv(q, layer, smem));
      STEPD(8, phase_attn(q, layer, smem));
      STEP(phase_at_out(q, layer, smem));
    }
    STEPD(2, phase_prep(q, layer, 1, -1, false, (bf16_t*)(q.ws + OFF_TR + TR_H2), 1024, layer == 3));
    STEPD(9, phase_mlp1(q, layer, smem));
    STEP(phase_mlp2(q, layer, smem));
  }
  STEP(phase_final(q));
}

#ifndef MULTI_LAUNCH
#define MULTI_LAUNCH 0
#endif
constexpr int NSTEPS = 1 + 2 * (12 + 3) + 2 * (4 + 3) + 1;

extern "C" void kernel_launch(void* const* d_in, const int* in_sizes, int n_in, void* d_out, int out_size, void* d_ws, size_t ws_size,
                              hipStream_t stream) {
  static int grid_blocks = 0;
  if (!grid_blocks) {
    int dev = 0, cus = 0, per_cu = 0;
    hipGetDevice(&dev);
    hipDeviceGetAttribute(&cus, hipDeviceAttributeMultiprocessorCount, dev);
    hipOccupancyMaxActiveBlocksPerMultiprocessor(&per_cu, mega, 256, 0);
    if (per_cu < 1) per_cu = 1;
    if (per_cu > 2) per_cu = 2;
    grid_blocks = cus * per_cu;
  }
  P p{};
  const float** fp = (const float**)&p;
  for (int i = 0; i < 36; i++) fp[i] = (const float*)d_in[i];
  p.out = (float*)d_out;
  p.ws = (char*)d_ws;
  p.pad = 0;
#if MULTI_LAUNCH
  for (int s = 0; s < NSTEPS; s++) {
    p.only = s;
    void* args[] = {&p};
    hipError_t e = hipLaunchCooperativeKernel((void*)mega, dim3(grid_blocks), dim3(256), args, 0, stream);
    if (e != hipSuccess) { fprintf(stderr, "launch failed: %s\n", hipGetErrorString(e)); break; }
  }
#else
  p.only = -1;
  hipMemsetAsync((char*)d_ws + OFF_BAR, 0, XCD_BAR_WORDS * 4, stream);
  void* args[] = {&p};
  hipError_t e = hipLaunchCooperativeKernel((void*)mega, dim3(grid_blocks), dim3(256), args, 0, stream);
  if (e != hipSuccess) fprintf(stderr, "cooperative launch failed: %s (grid %d)\n", hipGetErrorString(e), grid_blocks);
#endif
}
```

```cpp
#include <hip/hip_runtime.h>
#include <hip/hip_cooperative_groups.h>
#include <cstdio>
namespace cg = cooperative_groups;

#define DI __device__ __forceinline__
typedef unsigned short bf16_t;
using bf16x8 = __attribute__((ext_vector_type(8))) short;
using f32x16 = __attribute__((ext_vector_type(16))) float;
typedef __bf16 bfv2 __attribute__((ext_vector_type(2)));
typedef float fv2 __attribute__((ext_vector_type(2)));
#define MFMA32(a, b, c) __builtin_amdgcn_mfma_f32_32x32x16_bf16((a), (b), (c), 0, 0, 0)

constexpr int D = 1024, NB = 8, SL = 4096, CL = 256;
constexpr int NLAT = NB * SL, NCTX = NB * CL, NTOK = NLAT + NCTX;
constexpr int HROWS = NTOK / 2;
constexpr int TK = SL + CL;
constexpr size_t MiB = 1048576;
constexpr size_t OFF_W2 = 476 * MiB;
constexpr size_t OFF_W = 0, OFF_XC = 36 * MiB, OFF_MODS = 44 * MiB, OFF_MISC = 45 * MiB, OFF_VF = 46 * MiB, OFF_TR = 114 * MiB;
constexpr size_t W_RKV = 0;
constexpr size_t W_L1 = W_RKV + 3072ull * 2048;
constexpr size_t W_W2 = W_L1 + 640ull * 2048;
constexpr size_t W_A2 = W_W2 + 2ull * 65536;
constexpr size_t W_G2 = W_A2 + 65536;
constexpr size_t W_V2 = W_G2 + 2ull * 196608;
constexpr size_t W_WO = W_V2 + 65536;
constexpr size_t W_M1 = W_WO + 1048576;
constexpr size_t W_M2 = W_M1 + 4194304;
constexpr size_t W_QKV = 0;
constexpr size_t HALF_ARR = (size_t)HROWS * 1024 * 2;
constexpr size_t TR_HX = 0;
constexpr size_t TR_T1 = 2 * HALF_ARR;
constexpr size_t TR_R = TR_T1 + (size_t)HROWS * 640 * 2;
constexpr size_t TR_K = TR_R + HALF_ARR, TR_V = TR_K + HALF_ARR, TR_A = TR_V + HALF_ARR;
constexpr size_t TR_WL0 = TR_A + HALF_ARR, TR_WL1 = TR_WL0 + HALF_ARR, TR_G0 = TR_WL1 + HALF_ARR, TR_G1 = TR_G0 + HALF_ARR;
constexpr size_t FULL_ARR = (size_t)NTOK * 1024 * 2;
constexpr size_t TR_H = 0, TR_Q = FULL_ARR, TR_KK = 2 * FULL_ARR, TR_VT = 3 * FULL_ARR;
constexpr size_t TR_H2 = 0, TR_HID = FULL_ARR;

struct P {
  const float *x, *c, *ctx, *c_ctx, *ada_w, *ada_b, *norm_g, *final_g;
  const float *rw_mix, *rw_w_rkv, *rw_w0, *rw_w1, *rw_w2, *rw_a0, *rw_a1, *rw_a2, *rw_g1, *rw_g2, *rw_kk, *rw_ka, *rw_rk, *rw_ln_g, *rw_ln_b, *rw_w_o, *rw_v0, *rw_v1, *rw_v2;
  const float *da_w_qkv, *da_w_o, *da_lq1, *da_lk1, *da_lq2, *da_lk2, *da_subln_g, *mlp_w1, *mlp_w2;
  float* out;
  char* ws;
  int only;
  int pad;
};

DI float bf2f(bf16_t h) { return __uint_as_float(((unsigned)h) << 16); }
DI unsigned pack2(float a, float b) { fv2 v = {a, b}; bfv2 r = __builtin_convertvector(v, bfv2); return __builtin_bit_cast(unsigned, r); }
DI bf16_t f2bf(float a) { return (bf16_t)(pack2(a, 0.f) & 0xffffu); }
DI float lo_bf(unsigned u) { return __uint_as_float(u << 16); }
DI float hi_bf(unsigned u) { return __uint_as_float(u & 0xffff0000u); }
DI float sigmoidf_(float x) { return __builtin_amdgcn_rcpf(1.f + __expf(-x)); }
DI float tanhf_(float x) { return 1.f - 2.f * __builtin_amdgcn_rcpf(1.f + __expf(2.f * x)); }
DI float wave_sum(float v) {
#pragma unroll
  for (int o = 32; o > 0; o >>= 1) v += __shfl_xor(v, o);
  return v;
}
template <int N> DI float ror_add(float x) { return x + __builtin_bit_cast(float, __builtin_amdgcn_mov_dpp(__builtin_bit_cast(int, x), 0x120 + N, 0xf, 0xf, true)); }
DI float rowsum16(float x) { x = ror_add<8>(x); x = ror_add<4>(x); x = ror_add<2>(x); x = ror_add<1>(x); return x; }

DI int opaque_tid() { int t = threadIdx.x; asm volatile("" : "+v"(t)); return t; }
DI float* resid_row(const P& p, int gr) { return gr < NLAT ? p.out + (size_t)gr * D : (float*)(p.ws + OFF_XC) + (size_t)(gr - NLAT) * D; }
DI const float* input_row(const P& p, int gr) { return gr < NLAT ? p.x + (size_t)gr * D : p.ctx + (size_t)(gr - NLAT) * D; }
DI int mod_row(int gr) { return gr < NLAT ? gr / SL : 8; }
DI const float* mods_ptr(const P& p, int layer, int mrow) { return (const float*)(p.ws + OFF_MODS) + ((size_t)layer * 9 + mrow) * 6144; }
DI int half_gtile(int hf, int lt) { return lt < 128 ? hf * 128 + lt : 256 + hf * 8 + (lt - 128); }
DI int first_tile(int base) { int g = gridDim.x; int s = (int)blockIdx.x - (base % g); if (s < 0) s += g; return s; }
DI size_t w_off(int layer) { return (layer & 1) ? OFF_W2 : OFF_W; }
DI float lambda_init(int layer) { return 0.8f - 0.6f * expf(-0.3f * (float)layer); }

DI void phase_init(const P& p, char* smem) {
  const int tidx = opaque_tid();
  const int tid = tidx;
  float* sc = (float*)smem;
  float* mods = (float*)(p.ws + OFF_MODS);
  for (int item = blockIdx.x; item < 96; item += gridDim.x) {
    const int layer = item / 24, cb = item % 24;
    __syncthreads();
    for (int i = tid; i < 9 * 1024; i += 256) {
      int r = i >> 10, k = i & 1023;
      float v = r < 8 ? p.c[r * 1024 + k] : p.c_ctx[k];
      sc[i] = v / (1.f + expf(-v));
    }
    __syncthreads();
    const int w = tid >> 6, q = tid & 63;
    float4 acc[9];
#pragma unroll
    for (int r = 0; r < 9; r++) acc[r] = make_float4(0.f, 0.f, 0.f, 0.f);
    const float* wp = p.ada_w + (size_t)layer * 1024 * 6144 + cb * 256 + q * 4;
    for (int k = w * 256; k < w * 256 + 256; k++) {
      float4 wv = *(const float4*)(wp + (size_t)k * 6144);
#pragma unroll
      for (int r = 0; r < 9; r++) {
        float s = sc[r * 1024 + k];
        acc[r].x += s * wv.x; acc[r].y += s * wv.y; acc[r].z += s * wv.z; acc[r].w += s * wv.w;
      }
    }
    __syncthreads();
    float4* red = (float4*)smem;
#pragma unroll
    for (int r = 0; r < 9; r++) red[(w * 9 + r) * 64 + q] = acc[r];
    __syncthreads();
    for (int i = tid; i < 9 * 64; i += 256) {
      int r = i / 64, qq = i % 64;
      float4 s0 = red[(0 * 9 + r) * 64 + qq], s1 = red[(1 * 9 + r) * 64 + qq], s2 = red[(2 * 9 + r) * 64 + qq], s3 = red[(3 * 9 + r) * 64 + qq];
      float4 bb = *(const float4*)(p.ada_b + layer * 6144 + cb * 256 + qq * 4);
      float4 o = make_float4(s0.x + s1.x + s2.x + s3.x + bb.x, s0.y + s1.y + s2.y + s3.y + bb.y, s0.z + s1.z + s2.z + s3.z + bb.z, s0.w + s1.w + s2.w + s3.w + bb.w);
      *(float4*)(mods + ((size_t)layer * 9 + r) * 6144 + cb * 256 + qq * 4) = o;
    }
  }
  if (blockIdx.x == gridDim.x - 1) {
    float* misc = (float*)(p.ws + OFF_MISC);
    for (int i = tid; i < 1024; i += 256) {
      int pos = i / 16, f = i % 16;
      float inv = powf(10000.f, -(float)f / 16.f);
      float ang = (float)pos * inv;
      misc[i] = cosf(ang);
      misc[1024 + i] = sinf(ang);
    }
    misc[4096 + tid] = 0.f;
    if (tid < 2) {
      float s1 = 0.f, s2 = 0.f;
      for (int k = 0; k < 64; k++) { s1 += p.da_lq1[tid * 64 + k] * p.da_lk1[tid * 64 + k]; s2 += p.da_lq2[tid * 64 + k] * p.da_lk2[tid * 64 + k]; }
      misc[2048 + tid] = expf(s1) - expf(s2) + lambda_init(2 * tid + 1);
    }
  }
}

DI void conv_mat(const float* __restrict__ src, int K, int N, bf16_t* __restrict__ dst, int ldd, int koff, const float* __restrict__ scale,
                 int Kp, int Np, float* sm, int& base, int vb, int vg) {
  const int tidx = opaque_tid();
  const int tid = tidx;
  const int tk = Kp / 64, tn = Np / 64, nt = tk * tn;
  int t0_ = vb - (base % vg);
  if (t0_ < 0) t0_ += vg;
  for (int t = t0_; t < nt; t += vg) {
    const int k0 = (t / tn) * 64, n0 = (t % tn) * 64;
    __syncthreads();
#pragma unroll
    for (int i = 0; i < 4; i++) {
      int kr = (tid >> 4) + 16 * i, nc = (tid & 15) * 4;
      float4 v = make_float4(0.f, 0.f, 0.f, 0.f);
      if (src != nullptr && k0 + kr < K && n0 + nc < N) {
        v = *(const float4*)(src + (size_t)(k0 + kr) * N + n0 + nc);
        if (scale) { float s = scale[k0 + kr]; v.x *= s; v.y *= s; v.z *= s; v.w *= s; }
      }
      sm[kr * 65 + nc + 0] = v.x; sm[kr * 65 + nc + 1] = v.y; sm[kr * 65 + nc + 2] = v.z; sm[kr * 65 + nc + 3] = v.w;
    }
    __syncthreads();
    const int n = tid >> 2, kb = (tid & 3) * 16;
    unsigned o[8];
#pragma unroll
    for (int i = 0; i < 8; i++) o[i] = pack2(sm[(kb + 2 * i) * 65 + n], sm[(kb + 2 * i + 1) * 65 + n]);
    uint4* dp = (uint4*)(dst + (size_t)(n0 + n) * ldd + koff + k0 + kb);
    dp[0] = make_uint4(o[0], o[1], o[2], o[3]);
    dp[1] = make_uint4(o[4], o[5], o[6], o[7]);
  }
  base += nt;
}

DI void phase_conv(const P& p, int layer, char* smem, int vb, int vg) {
  if (vb < 0) return;
  float* sm = (float*)smem;
  bf16_t* W = (bf16_t*)(p.ws + w_off(layer));
  int base = 0;
  const int j = layer / 2;
  if ((layer & 1) == 0) {
    for (int s = 0; s < 3; s++) {
      const float* src = p.rw_w_rkv + ((size_t)j * 3 + s) * 1048576;
      conv_mat(src, 1024, 1024, W + W_RKV + (size_t)s * 1024 * 2048, 2048, 0, nullptr, 1024, 1024, sm, base, vb, vg);
    }
    for (int pass = 0; pass < 2; pass++) {
      const int ko = pass * 1024;
      const float* m1 = pass ? p.rw_mix + ((size_t)j * 6 + 1) * 1024 : nullptr;
      const float* m4 = pass ? p.rw_mix + ((size_t)j * 6 + 4) * 1024 : nullptr;
      const float* m5 = pass ? p.rw_mix + ((size_t)j * 6 + 5) * 1024 : nullptr;
      const float* m3 = pass ? p.rw_mix + ((size_t)j * 6 + 3) * 1024 : nullptr;
      bf16_t* L1 = W + W_L1;
      conv_mat(p.rw_w1 + ((size_t)j * 2 + 0) * 65536, 1024, 64, L1 + 0ull * 2048, 2048, ko, m1, 1024, 64, sm, base, vb, vg);
      conv_mat(p.rw_w1 + ((size_t)j * 2 + 1) * 65536, 1024, 64, L1 + 64ull * 2048, 2048, ko, m1, 1024, 64, sm, base, vb, vg);
      conv_mat(p.rw_a1 + (size_t)j * 65536, 1024, 64, L1 + 128ull * 2048, 2048, ko, m4, 1024, 64, sm, base, vb, vg);
      conv_mat(p.rw_g1 + ((size_t)j * 2 + 0) * 163840, 1024, 160, L1 + 256ull * 2048, 2048, ko, m5, 1024, 192, sm, base, vb, vg);
      conv_mat(p.rw_g1 + ((size_t)j * 2 + 1) * 163840, 1024, 160, L1 + 448ull * 2048, 2048, ko, m5, 1024, 192, sm, base, vb, vg);
      conv_mat(j > 0 ? p.rw_v1 + (size_t)(j - 1) * 32768 : nullptr, 1024, 32, L1 + 192ull * 2048, 2048, ko, m3, 1024, 64, sm, base, vb, vg);
    }
    conv_mat(p.rw_w2 + ((size_t)j * 2 + 0) * 65536, 64, 1024, W + W_W2, 64, 0, nullptr, 64, 1024, sm, base, vb, vg);
    conv_mat(p.rw_w2 + ((size_t)j * 2 + 1) * 65536, 64, 1024, W + W_W2 + 65536, 64, 0, nullptr, 64, 1024, sm, base, vb, vg);
    conv_mat(p.rw_a2 + (size_t)j * 65536, 64, 1024, W + W_A2, 64, 0, nullptr, 64, 1024, sm, base, vb, vg);
    conv_mat(p.rw_g2 + ((size_t)j * 2 + 0) * 163840, 160, 1024, W + W_G2, 192, 0, nullptr, 192, 1024, sm, base, vb, vg);
    conv_mat(p.rw_g2 + ((size_t)j * 2 + 1) * 163840, 160, 1024, W + W_G2 + 196608, 192, 0, nullptr, 192, 1024, sm, base, vb, vg);
    conv_mat(j > 0 ? p.rw_v2 + (size_t)(j - 1) * 32768 : nullptr, 32, 1024, W + W_V2, 64, 0, nullptr, 64, 1024, sm, base, vb, vg);
    conv_mat(p.rw_w_o + (size_t)j * 1048576, 1024, 1024, W + W_WO, 1024, 0, nullptr, 1024, 1024, sm, base, vb, vg);
  } else {
    conv_mat(p.da_w_qkv + (size_t)j * 3145728, 1024, 3072, W + W_QKV, 1024, 0, nullptr, 1024, 3072, sm, base, vb, vg);
    conv_mat(p.da_w_o + (size_t)j * 1048576, 1024, 1024, W + W_WO, 1024, 0, nullptr, 1024, 1024, sm, base, vb, vg);
  }
  conv_mat(p.mlp_w1 + (size_t)layer * 4194304, 1024, 4096, W + W_M1, 1024, 0, nullptr, 1024, 4096, sm, base, vb, vg);
  conv_mat(p.mlp_w2 + (size_t)layer * 4194304, 4096, 1024, W + W_M2, 4096, 0, nullptr, 4096, 1024, sm, base, vb, vg);
}

DI void phase_prep(const P& p, int layer, int sub, int hf, bool shift, bf16_t* H, int ldh, bool skip_ctx) {
  const int tidx = opaque_tid();
  const int lane = tidx & 63, wv = tidx >> 6;
  const int nrows = hf < 0 ? (skip_ctx ? NLAT : NTOK) : HROWS;
  const int nseg = nrows / 8;
  const float* ng = p.norm_g + ((size_t)layer * 2 + sub) * 1024;
  for (int seg = blockIdx.x * 4 + wv; seg < nseg; seg += gridDim.x * 4) {
    const int lr0 = seg * 8;
    const int gr0 = hf < 0 ? lr0 : (lr0 < 16384 ? hf * 16384 + lr0 : NLAT + hf * 1024 + (lr0 - 16384));
    const bool lat = gr0 < NLAT;
    const int T = lat ? SL : CL;
    const int t0 = lat ? (gr0 % SL) : ((gr0 - NLAT) % CL);
    const float* xbase = (layer == 0 && sub == 0) ? input_row(p, gr0) : resid_row(p, gr0);
    const float* md = mods_ptr(p, layer, mod_row(gr0));
    float4 g4[4], sc4[4], sh4[4];
#pragma unroll
    for (int jx = 0; jx < 4; jx++) {
      int ch = jx * 256 + lane * 4;
      g4[jx] = *(const float4*)(ng + ch);
      sh4[jx] = *(const float4*)(md + sub * 3072 + ch);
      sc4[jx] = *(const float4*)(md + sub * 3072 + 1024 + ch);
      g4[jx].x *= (1.f + sc4[jx].x); g4[jx].y *= (1.f + sc4[jx].y); g4[jx].z *= (1.f + sc4[jx].z); g4[jx].w *= (1.f + sc4[jx].w);
    }
    float4 hp[4], hc[4], hn[4];
    const int tb = shift ? -1 : 0, te = shift ? 9 : 8;
    for (int tt = tb; tt < te; tt++) {
      const int t = t0 + tt;
      if (t >= 0 && t < T) {
        const float* xr = xbase + (ptrdiff_t)tt * D;
        float ss = 0.f;
#pragma unroll
        for (int jx = 0; jx < 4; jx++) {
          hn[jx] = *(const float4*)(xr + jx * 256 + lane * 4);
          ss += hn[jx].x * hn[jx].x + hn[jx].y * hn[jx].y + hn[jx].z * hn[jx].z + hn[jx].w * hn[jx].w;
        }
        ss = wave_sum(ss);
        const float rs = rsqrtf(ss * (1.f / 1024.f) + 1e-6f);
#pragma unroll
        for (int jx = 0; jx < 4; jx++) {
          hn[jx].x = hn[jx].x * rs * g4[jx].x + sh4[jx].x; hn[jx].y = hn[jx].y * rs * g4[jx].y + sh4[jx].y;
          hn[jx].z = hn[jx].z * rs * g4[jx].z + sh4[jx].z; hn[jx].w = hn[jx].w * rs * g4[jx].w + sh4[jx].w;
        }
      } else {
#pragma unroll
        for (int jx = 0; jx < 4; jx++) hn[jx] = make_float4(0.f, 0.f, 0.f, 0.f);
      }
      if (!shift) {
        bf16_t* hr = H + (size_t)(lr0 + tt) * ldh;
#pragma unroll
        for (int jx = 0; jx < 4; jx++) *(uint2*)(hr + jx * 256 + lane * 4) = make_uint2(pack2(hn[jx].x, hn[jx].y), pack2(hn[jx].z, hn[jx].w));
      } else if (tt >= 1) {
        bf16_t* hr = H + (size_t)(lr0 + tt - 1) * ldh;
#pragma unroll
        for (int jx = 0; jx < 4; jx++) {
          *(uint2*)(hr + jx * 256 + lane * 4) = make_uint2(pack2(hc[jx].x, hc[jx].y), pack2(hc[jx].z, hc[jx].w));
          float4 xx;
          xx.x = 0.5f * (hp[jx].x + hn[jx].x) - hc[jx].x; xx.y = 0.5f * (hp[jx].y + hn[jx].y) - hc[jx].y;
          xx.z = 0.5f * (hp[jx].z + hn[jx].z) - hc[jx].z; xx.w = 0.5f * (hp[jx].w + hn[jx].w) - hc[jx].w;
          *(uint2*)(hr + 1024 + jx * 256 + lane * 4) = make_uint2(pack2(xx.x, xx.y), pack2(xx.z, xx.w));
        }
      }
#pragma unroll
      for (int jx = 0; jx < 4; jx++) { hp[jx] = hc[jx]; hc[jx] = hn[jx]; }
    }
  }
}

constexpr int LDT = 72;
DI void gemm_mainloop(const bf16_t* __restrict__ A, int lda, const bf16_t* __restrict__ Bt, int ldb, int K, char* smem, f32x16 (&acc)[2][2]) {
  const int tidx = opaque_tid();
  bf16_t* sA = (bf16_t*)smem;
  bf16_t* sB = sA + 2 * 128 * LDT;
  const int tid = tidx, lane = tid & 63, w = tid >> 6, wm = w >> 1, wn = w & 1;
  const int lrow = tid >> 3, lkc = (tid & 7) * 8;
#pragma unroll
  for (int mi = 0; mi < 2; mi++)
#pragma unroll
    for (int ni = 0; ni < 2; ni++)
#pragma unroll
      for (int r = 0; r < 16; r++) acc[mi][ni][r] = 0.f;
  const unsigned ao = (unsigned)(lrow * lda + lkc), bo = (unsigned)(lrow * ldb + lkc);
  const unsigned a32 = (unsigned)(32 * lda), b32 = (unsigned)(32 * ldb);
  uint4 ra0, ra1, ra2, ra3, rb0, rb1, rb2, rb3;
#define G_LOAD(Ab, Bb)                                                                                   \
  {                                                                                                      \
    ra0 = *(const uint4*)((Ab) + ao); ra1 = *(const uint4*)((Ab) + (ao + a32));                          \
    ra2 = *(const uint4*)((Ab) + (ao + 2 * a32)); ra3 = *(const uint4*)((Ab) + (ao + 3 * a32));          \
    rb0 = *(const uint4*)((Bb) + bo); rb1 = *(const uint4*)((Bb) + (bo + b32));                          \
    rb2 = *(const uint4*)((Bb) + (bo + 2 * b32)); rb3 = *(const uint4*)((Bb) + (bo + 3 * b32));          \
  }
#define G_STORE(sa_, sb_)                                                                                \
  {                                                                                                      \
    bf16_t* a_w = (sa_) + lrow * LDT + lkc;                                                              \
    bf16_t* b_w = (sb_) + lrow * LDT + lkc;                                                              \
    *(uint4*)(a_w) = ra0; *(uint4*)(a_w + 32 * LDT) = ra1; *(uint4*)(a_w + 64 * LDT) = ra2; *(uint4*)(a_w + 96 * LDT) = ra3; \
    *(uint4*)(b_w) = rb0; *(uint4*)(b_w + 32 * LDT) = rb1; *(uint4*)(b_w + 64 * LDT) = rb2; *(uint4*)(b_w + 96 * LDT) = rb3; \
  }
  G_LOAD(A, Bt);
  G_STORE(sA, sB);
  __syncthreads();
  const int nk = K >> 6;
  const int aoff = (wm * 64 + (lane & 31)) * LDT + (lane >> 5) * 8;
  const int boff = (wn * 64 + (lane & 31)) * LDT + (lane >> 5) * 8;
  for (int kt = 0; kt < nk; kt++) {
    const int cur = kt & 1;
    if (kt + 1 < nk) {
      const bf16_t* A1 = A + (kt + 1) * 64;
      const bf16_t* B1 = Bt + (kt + 1) * 64;
      G_LOAD(A1, B1);
    }
    __builtin_amdgcn_sched_barrier(0);
    __builtin_amdgcn_s_setprio(1);
    const bf16_t* a_s = sA + cur * 128 * LDT + aoff;
    const bf16_t* b_s = sB + cur * 128 * LDT + boff;
#pragma unroll
    for (int kk = 0; kk < 4; kk++) {
      bf16x8 af[2], bq[2];
#pragma unroll
      for (int mi = 0; mi < 2; mi++) af[mi] = *(const bf16x8*)(a_s + mi * 32 * LDT + kk * 16);
#pragma unroll
      for (int ni = 0; ni < 2; ni++) bq[ni] = *(const bf16x8*)(b_s + ni * 32 * LDT + kk * 16);
#pragma unroll
      for (int mi = 0; mi < 2; mi++)
#pragma unroll
        for (int ni = 0; ni < 2; ni++) acc[mi][ni] = MFMA32(af[mi], bq[ni], acc[mi][ni]);
    }
    __builtin_amdgcn_s_setprio(0);
    __builtin_amdgcn_sched_barrier(0);
    if (kt + 1 < nk) G_STORE(sA + (cur ^ 1) * 128 * LDT, sB + (cur ^ 1) * 128 * LDT);
    __syncthreads();
  }
}
DI uint4 mix8(const uint4 h, const uint4 x, const float4 m0, const float4 m1) {
  uint4 o;
  o.x = pack2(lo_bf(h.x) + lo_bf(x.x) * m0.x, hi_bf(h.x) + hi_bf(x.x) * m0.y);
  o.y = pack2(lo_bf(h.y) + lo_bf(x.y) * m0.z, hi_bf(h.y) + hi_bf(x.y) * m0.w);
  o.z = pack2(lo_bf(h.z) + lo_bf(x.z) * m1.x, hi_bf(h.z) + hi_bf(x.z) * m1.y);
  o.w = pack2(lo_bf(h.w) + lo_bf(x.w) * m1.z, hi_bf(h.w) + hi_bf(x.w) * m1.w);
  return o;
}
DI void gemm_mainloop_mix(const bf16_t* __restrict__ HX, const float* __restrict__ mix, const bf16_t* __restrict__ Bt, int ldb, char* smem, f32x16 (&acc)[2][2]) {
  const int tidx = opaque_tid();
  bf16_t* sA = (bf16_t*)smem;
  bf16_t* sB = sA + 2 * 128 * LDT;
  const int tid = tidx, lane = tid & 63, w = tid >> 6, wm = w >> 1, wn = w & 1;
  const int lrow = tid >> 3, lkc = (tid & 7) * 8;
#pragma unroll
  for (int mi = 0; mi < 2; mi++)
#pragma unroll
    for (int ni = 0; ni < 2; ni++)
#pragma unroll
      for (int r = 0; r < 16; r++) acc[mi][ni][r] = 0.f;
  const unsigned ao = (unsigned)(lrow * 2048 + lkc), bo = (unsigned)(lrow * ldb + lkc);
  const unsigned a32 = 32u * 2048u, b32 = (unsigned)(32 * ldb);
  uint4 h0, h1, h2, h3, x0, x1, x2, x3, rb0, rb1, rb2, rb3;
  float4 m0, m1;
#define GM_LOAD(kstep_)                                                                                  \
  {                                                                                                      \
    const bf16_t* Ab_ = HX + (kstep_) * 64;                                                              \
    const bf16_t* Bb_ = Bt + (kstep_) * 64;                                                              \
    h0 = *(const uint4*)(Ab_ + ao); h1 = *(const uint4*)(Ab_ + (ao + a32));                              \
    h2 = *(const uint4*)(Ab_ + (ao + 2 * a32)); h3 = *(const uint4*)(Ab_ + (ao + 3 * a32));              \
    x0 = *(const uint4*)(Ab_ + (ao + 1024u)); x1 = *(const uint4*)(Ab_ + (ao + a32 + 1024u));            \
    x2 = *(const uint4*)(Ab_ + (ao + 2 * a32 + 1024u)); x3 = *(const uint4*)(Ab_ + (ao + 3 * a32 + 1024u)); \
    rb0 = *(const uint4*)(Bb_ + bo); rb1 = *(const uint4*)(Bb_ + (bo + b32));                            \
    rb2 = *(const uint4*)(Bb_ + (bo + 2 * b32)); rb3 = *(const uint4*)(Bb_ + (bo + 3 * b32));            \
    m0 = *(const float4*)(mix + (kstep_) * 64 + lkc); m1 = *(const float4*)(mix + (kstep_) * 64 + lkc + 4); \
  }
#define GM_STORE(buf_)                                                                                   \
  {                                                                                                      \
    bf16_t* a_w = sA + (buf_) * 128 * LDT + lrow * LDT + lkc;                                            \
    bf16_t* b_w = sB + (buf_) * 128 * LDT + lrow * LDT + lkc;                                            \
    *(uint4*)(a_w) = mix8(h0, x0, m0, m1); *(uint4*)(a_w + 32 * LDT) = mix8(h1, x1, m0, m1);             \
    *(uint4*)(a_w + 64 * LDT) = mix8(h2, x2, m0, m1); *(uint4*)(a_w + 96 * LDT) = mix8(h3, x3, m0, m1);  \
    *(uint4*)(b_w) = rb0; *(uint4*)(b_w + 32 * LDT) = rb1; *(uint4*)(b_w + 64 * LDT) = rb2; *(uint4*)(b_w + 96 * LDT) = rb3; \
  }
  GM_LOAD(0);
  GM_STORE(0);
  __syncthreads();
  const int aoff = (wm * 64 + (lane & 31)) * LDT + (lane >> 5) * 8;
  const int boff = (wn * 64 + (lane & 31)) * LDT + (lane >> 5) * 8;
  for (int kt = 0; kt < 16; kt++) {
    const int cur = kt & 1;
    if (kt + 1 < 16) GM_LOAD(kt + 1);
    __builtin_amdgcn_sched_barrier(0);
    __builtin_amdgcn_s_setprio(1);
    const bf16_t* a_s = sA + cur * 128 * LDT + aoff;
    const bf16_t* b_s = sB + cur * 128 * LDT + boff;
#pragma unroll
    for (int kk = 0; kk < 4; kk++) {
      bf16x8 af[2], bq[2];
#pragma unroll
      for (int mi = 0; mi < 2; mi++) af[mi] = *(const bf16x8*)(a_s + mi * 32 * LDT + kk * 16);
#pragma unroll
      for (int ni = 0; ni < 2; ni++) bq[ni] = *(const bf16x8*)(b_s + ni * 32 * LDT + kk * 16);
#pragma unroll
      for (int mi = 0; mi < 2; mi++)
#pragma unroll
        for (int ni = 0; ni < 2; ni++) acc[mi][ni] = MFMA32(af[mi], bq[ni], acc[mi][ni]);
    }
    __builtin_amdgcn_s_setprio(0);
    __builtin_amdgcn_sched_barrier(0);
    if (kt + 1 < 16) GM_STORE(cur ^ 1);
    __syncthreads();
  }
}

constexpr int EST = 132;
DI void acc_to_lds(const f32x16 (&acc)[2][2], float* es) {
  const int tidx = opaque_tid();
  const int lane = tidx & 63, w = tidx >> 6, wm = w >> 1, wn = w & 1;
#pragma unroll
  for (int mi = 0; mi < 2; mi++)
#pragma unroll
    for (int ni = 0; ni < 2; ni++)
#pragma unroll
      for (int r = 0; r < 16; r++)
        es[(wm * 64 + mi * 32 + (r & 3) + 8 * (r >> 2) + 4 * (lane >> 5)) * EST + wn * 64 + ni * 32 + (lane & 31)] = acc[mi][ni][r];
}
#define EPI8_BEGIN                                                                   \
  {                                                                                  \
    float* es = (float*)smem;                                                        \
    acc_to_lds(acc, es);                                                             \
    __syncthreads();                                                                 \
    for (int pass = 0; pass < 8; pass++) {                                           \
      const int row = pass * 16 + (tidx >> 4), col = (tidx & 15) * 8;  \
      const float4 e_va = *(const float4*)(es + row * EST + col);                    \
      const float4 e_vb = *(const float4*)(es + row * EST + col + 4);                \
      float v[8] = {e_va.x, e_va.y, e_va.z, e_va.w, e_vb.x, e_vb.y, e_vb.z, e_vb.w};
#define EPI8_END                                                                     \
    }                                                                                \
    __syncthreads();                                                                 \
  }
DI uint4 pack8(const float (&v)[8]) { return make_uint4(pack2(v[0], v[1]), pack2(v[2], v[3]), pack2(v[4], v[5]), pack2(v[6], v[7])); }
DI void unpack8(const uint4 u, float (&v)[8]) {
  v[0] = lo_bf(u.x); v[1] = hi_bf(u.x); v[2] = lo_bf(u.y); v[3] = hi_bf(u.y); v[4] = lo_bf(u.z); v[5] = hi_bf(u.z); v[6] = lo_bf(u.w); v[7] = hi_bf(u.w);
}
DI void resid_update(float* xp, const float* xsrc, const float* gate, const float (&v)[8]) {
  float4 x0 = *(const float4*)xsrc, x1 = *(const float4*)(xsrc + 4);
  const float4 g0 = *(const float4*)gate, g1 = *(const float4*)(gate + 4);
  x0.x += g0.x * v[0]; x0.y += g0.y * v[1]; x0.z += g0.z * v[2]; x0.w += g0.w * v[3];
  x1.x += g1.x * v[4]; x1.y += g1.y * v[5]; x1.z += g1.z * v[6]; x1.w += g1.w * v[7];
  *(float4*)xp = x0; *(float4*)(xp + 4) = x1;
}

DI bool xcd_tile(int t, int Mt, int Nt, int& mt, int& nt) {
  const int G = gridDim.x;
  if ((G & 63) != 0 || (Nt % (G >> 6)) != 0 || (Mt & 7) != 0) {
    if (t >= Mt * Nt) return false;
    mt = t / Nt; nt = t % Nt;
    return true;
  }
  const int spx = G >> 3, tn = spx >> 3;
  const int r = t % G, round = t / G;
  const int xcd = r & 7, li = r >> 3;
  const int smn = Mt >> 3, snn = Nt / tn;
  const int st = round * 8 + xcd;
  if (st >= smn * snn) return false;
  const int smi = st % smn, sni = st / smn;
  mt = smi * 8 + (li & 7);
  nt = sni * tn + (li >> 3);
  return true;
}
DI int xcd_rounds(int Mt, int Nt) {
  const int G = gridDim.x;
  if ((G & 63) != 0 || (Nt % (G >> 6)) != 0 || (Mt & 7) != 0) return (Mt * Nt + G - 1) / G;
  const int tn = G >> 6;
  return ((Mt >> 3) * (Nt / tn) + 7) >> 3;
}

DI void phase_t1(const P& p, int layer, char* smem) {
  const int j = layer / 2;
  const int tidx = opaque_tid();
  const bf16_t* HX = (const bf16_t*)(p.ws + OFF_TR + TR_HX);
  const bf16_t* WL1 = (const bf16_t*)(p.ws + w_off(0)) + W_L1;
  bf16_t* T1 = (bf16_t*)(p.ws + OFF_TR + TR_T1);
  for (int t = blockIdx.x; t < 136 * 5; t += gridDim.x) {
    const int nt = t % 5, lt = t / 5;
    f32x16 acc[2][2];
    if (nt == 1) gemm_mainloop(HX + (size_t)lt * 128 * 2048, 2048, WL1 + (size_t)nt * 128 * 2048, 2048, 2048, smem, acc);
    else gemm_mainloop_mix(HX + (size_t)lt * 128 * 2048, p.rw_mix + ((size_t)j * 6 + (nt == 0 ? 1 : 5)) * 1024, WL1 + (size_t)nt * 128 * 2048, 2048, smem, acc);
    EPI8_BEGIN
      const int c = nt * 128 + col;
      if (c < 128) {
#pragma unroll
        for (int e = 0; e < 8; e++) v[e] = tanhf_(v[e]);
      } else if (c >= 256) {
#pragma unroll
        for (int e = 0; e < 8; e++) v[e] = sigmoidf_(v[e]);
      }
      *(uint4*)(T1 + (size_t)(lt * 128 + row) * 640 + c) = pack8(v);
    EPI8_END
  }
}

DI void phase_feat(const P& p, int layer, int hf, char* smem) {
  const int tidx = opaque_tid();
  const int j = layer / 2;
  const bf16_t* W = (const bf16_t*)(p.ws + w_off(layer));
  const bf16_t* HX = (const bf16_t*)(p.ws + OFF_TR + TR_HX);
  const bf16_t* T1 = (const bf16_t*)(p.ws + OFF_TR + TR_T1);
  bf16_t* VF = (bf16_t*)(p.ws + OFF_VF);
  for (int t = blockIdx.x; t < xcd_rounds(136, 24) * (int)gridDim.x; t += gridDim.x) {
    int lt, nt;
    if (!xcd_tile(t, 136, 24, lt, nt)) continue;
    const int s = nt / 8, n0 = (nt % 8) * 128;
    const int gt = half_gtile(hf, lt);
    f32x16 acc[2][2];
    bf16_t* outp = (bf16_t*)(p.ws + OFF_TR + (s == 0 ? TR_R : (s == 1 ? TR_K : TR_V)));
    if (s == 2 && j > 0) {
      gemm_mainloop(T1 + (size_t)lt * 128 * 640 + 192, 640, W + W_V2 + (size_t)n0 * 64, 64, 64, smem, acc);
      const float* v0 = p.rw_v0 + (size_t)(j - 1) * 1024;
      EPI8_BEGIN
        const int c = n0 + col;
#pragma unroll
        for (int e = 0; e < 8; e++) v[e] = sigmoidf_(v0[c + e] + v[e]);
        *(uint4*)(outp + (size_t)(lt * 128 + row) * 1024 + c) = pack8(v);
      EPI8_END
    }
    {
      const int mixsel = s == 0 ? 0 : (s == 1 ? 2 : 3);
      gemm_mainloop_mix(HX + (size_t)lt * 128 * 2048, p.rw_mix + ((size_t)j * 6 + mixsel) * 1024, W + W_RKV + ((size_t)s * 1024 + n0) * 2048, 2048, smem, acc);
    }
    if (s < 2) {
      EPI8_BEGIN
        *(uint4*)(outp + (size_t)(lt * 128 + row) * 1024 + n0 + col) = pack8(v);
      EPI8_END
    } else if (j == 0) {
      EPI8_BEGIN
        const uint4 u = pack8(v);
        *(uint4*)(outp + (size_t)(lt * 128 + row) * 1024 + n0 + col) = u;
        *(uint4*)(VF + (size_t)(gt * 128 + row) * 1024 + n0 + col) = u;
      EPI8_END
    } else {
      EPI8_BEGIN
        const size_t oi = (size_t)(lt * 128 + row) * 1024 + n0 + col;
        float sg[8], vf[8];
        unpack8(*(const uint4*)(outp + oi), sg);
        unpack8(*(const uint4*)(VF + (size_t)(gt * 128 + row) * 1024 + n0 + col), vf);
#pragma unroll
        for (int e = 0; e < 8; e++) v[e] = v[e] + (vf[e] - v[e]) * sg[e];
        *(uint4*)(outp + oi) = pack8(v);
      EPI8_END
    }
  }
  for (int t = blockIdx.x; t < xcd_rounds(136, 40) * (int)gridDim.x; t += gridDim.x) {
    int lt, nt;
    if (!xcd_tile(t, 136, 40, lt, nt)) continue;
    const int s = nt / 8, n0 = (nt % 8) * 128;
    f32x16 acc[2][2];
    if (s == 0) {
      gemm_mainloop(T1 + (size_t)lt * 128 * 640 + 128, 640, W + W_A2 + (size_t)n0 * 64, 64, 64, smem, acc);
      bf16_t* outp = (bf16_t*)(p.ws + OFF_TR + TR_A);
      const float* a0 = p.rw_a0 + (size_t)j * 1024;
      EPI8_BEGIN
#pragma unroll
        for (int e = 0; e < 8; e++) v[e] = sigmoidf_(a0[n0 + col + e] + v[e]);
        *(uint4*)(outp + (size_t)(lt * 128 + row) * 1024 + n0 + col) = pack8(v);
      EPI8_END
    } else if (s < 3) {
      const int d = s - 1;
      gemm_mainloop(T1 + (size_t)lt * 128 * 640 + d * 64, 640, W + W_W2 + (size_t)d * 65536 + (size_t)n0 * 64, 64, 64, smem, acc);
      bf16_t* outp = (bf16_t*)(p.ws + OFF_TR + (d ? TR_WL1 : TR_WL0));
      const float* w0 = p.rw_w0 + ((size_t)j * 2 + d) * 1024;
      EPI8_BEGIN
#pragma unroll
        for (int e = 0; e < 8; e++) v[e] = -0.60653065971263342f * sigmoidf_(w0[n0 + col + e] + v[e]);
        *(uint4*)(outp + (size_t)(lt * 128 + row) * 1024 + n0 + col) = pack8(v);
      EPI8_END
    } else {
      const int d = s - 3;
      gemm_mainloop(T1 + (size_t)lt * 128 * 640 + 256 + d * 192, 640, W + W_G2 + (size_t)d * 196608 + (size_t)n0 * 192, 192, 192, smem, acc);
      bf16_t* outp = (bf16_t*)(p.ws + OFF_TR + (d ? TR_G1 : TR_G0));
      EPI8_BEGIN
        *(uint4*)(outp + (size_t)(lt * 128 + row) * 1024 + n0 + col) = pack8(v);
      EPI8_END
    }
  }
}

DI int scan_row(int bl, int dir, int pos) {
  if (pos < CL) { int t = dir ? (CL - 1 - pos) : pos; return 16384 + bl * CL + t; }
  int t = pos - CL; if (dir) t = SL - 1 - t;
  return bl * SL + t;
}

DI void phase_scan(const P& p, int layer, char* smem) {
  const int tidx = opaque_tid();
  const int j = layer / 2;
  const int tid = tidx;
  const bf16_t* R = (const bf16_t*)(p.ws + OFF_TR + TR_R);
  const bf16_t* Kx = (const bf16_t*)(p.ws + OFF_TR + TR_K);
  const bf16_t* V = (const bf16_t*)(p.ws + OFF_TR + TR_V);
  const bf16_t* Aa = (const bf16_t*)(p.ws + OFF_TR + TR_A);
  float* sbuf = (float*)smem;
  constexpr int BUFF = 5 * 16 * 64 + 512;
  constexpr int POP = 144;
  float* pobuf = sbuf + 2 * BUFF;
  const int ss = tid >> 4, c4 = tid & 15;
  const int rl = tid >> 4, cg = tid & 15;
  for (int item = blockIdx.x; item < 256; item += gridDim.x) {
    const int q2 = item & 1, dir = (item >> 1) & 1, head = (item >> 2) & 15, bl = item >> 6;
    const bf16_t* WL = (const bf16_t*)(p.ws + OFF_TR + (dir ? TR_WL1 : TR_WL0));
    bf16_t* O = (bf16_t*)(p.ws + OFF_TR + TR_HX) + (dir ? (size_t)HROWS * 1024 : 0);
    const int ch = head * 64 + c4 * 4;
    const float4 kkw = *(const float4*)(p.rw_kk + (size_t)j * 1024 + ch);
    const float4 kaw = *(const float4*)(p.rw_ka + (size_t)j * 1024 + ch);
    fv2 SA01 = {0.f, 0.f}, SA23 = {0.f, 0.f}, SB01 = {0.f, 0.f}, SB23 = {0.f, 0.f};
    uint2 gr_, gk_, ga_, gw_, gv_;
    gv_ = make_uint2(0, 0);
#define SC_ISSUE(chunk_)                                                                   \
    {                                                                                      \
      const size_t ro = (size_t)scan_row(bl, dir, (chunk_) * 16 + ss) * 1024;              \
      gr_ = *(const uint2*)(R + ro + ch); gk_ = *(const uint2*)(Kx + ro + ch);             \
      ga_ = *(const uint2*)(Aa + ro + ch); gw_ = *(const uint2*)(WL + ro + ch);            \
      if (c4 < 8) gv_ = *(const uint2*)(V + ro + head * 64 + q2 * 32 + c4 * 4);            \
    }
#define SC_STAGE(buf_)                                                                     \
    {                                                                                      \
      float* sb_ = sbuf + (buf_) * BUFF;                                                   \
      float r0 = lo_bf(gr_.x), r1 = hi_bf(gr_.x), r2 = lo_bf(gr_.y), r3 = hi_bf(gr_.y);    \
      float k0 = lo_bf(gk_.x), k1 = hi_bf(gk_.x), k2 = lo_bf(gk_.y), k3 = hi_bf(gk_.y);    \
      float a0 = lo_bf(ga_.x), a1 = hi_bf(ga_.x), a2 = lo_bf(ga_.y), a3 = hi_bf(ga_.y);    \
      float w0 = lo_bf(gw_.x), w1 = hi_bf(gw_.x), w2 = lo_bf(gw_.y), w3 = hi_bf(gw_.y);    \
      float u0 = k0 * kkw.x, u1 = k1 * kkw.y, u2 = k2 * kkw.z, u3 = k3 * kkw.w;            \
      float sq = rowsum16(u0 * u0 + u1 * u1 + u2 * u2 + u3 * u3);                          \
      float inv = rsqrtf(fmaxf(sq, 1e-24f));                                               \
      u0 *= inv; u1 *= inv; u2 *= inv; u3 *= inv;                                          \
      const int o_ = ss * 64 + c4 * 4;                                                     \
      *(float4*)(sb_ + 0 * 1024 + o_) = make_float4(__expf(w0), __expf(w1), __expf(w2), __expf(w3)); \
      *(float4*)(sb_ + 1 * 1024 + o_) = make_float4(k0 * (1.f + (a0 - 1.f) * kaw.x), k1 * (1.f + (a1 - 1.f) * kaw.y), k2 * (1.f + (a2 - 1.f) * kaw.z), k3 * (1.f + (a3 - 1.f) * kaw.w)); \
      *(float4*)(sb_ + 2 * 1024 + o_) = make_float4(-u0, -u1, -u2, -u3);                   \
      *(float4*)(sb_ + 3 * 1024 + o_) = make_float4(u0 * a0, u1 * a1, u2 * a2, u3 * a3);   \
      *(float4*)(sb_ + 4 * 1024 + o_) = make_float4(r0, r1, r2, r3);                       \
      if (c4 < 8) *(float4*)(sb_ + 5 * 1024 + ss * 32 + c4 * 4) = make_float4(lo_bf(gv_.x), hi_bf(gv_.x), lo_bf(gv_.y), hi_bf(gv_.y)); \
    }
    __syncthreads();
    SC_ISSUE(0);
    SC_STAGE(0);
    __syncthreads();
    constexpr int NCH = TK / 16;
    float* po_wa = pobuf + rl * POP + cg;
    float* po_wb = pobuf + (rl + 16) * POP + cg;
    const float* po_r = pobuf + (rl + 16 * (cg >> 3)) * POP + (cg & 7) * 16;
    for (int chunk = 0; chunk < NCH; chunk++) {
      const int buf = chunk & 1;
      if (chunk + 1 < NCH) SC_ISSUE(chunk + 1);
      __builtin_amdgcn_sched_barrier(0);
      const float* sb = sbuf + buf * BUFF + cg * 4;
      const float* sv = sbuf + buf * BUFF + 5 * 1024 + rl;
      float4 w4 = *(const float4*)(sb + 0 * 1024), k4 = *(const float4*)(sb + 1 * 1024), n4 = *(const float4*)(sb + 2 * 1024);
      float4 b4 = *(const float4*)(sb + 3 * 1024), r4 = *(const float4*)(sb + 4 * 1024);
      float va = sv[0], vb = sv[16];
#pragma unroll
      for (int s = 0; s < 16; s++) {
        float4 w4n = w4, k4n = k4, n4n = n4, b4n = b4, r4n = r4;
        float van = va, vbn = vb;
        if (s + 1 < 16) {
          w4n = *(const float4*)(sb + 0 * 1024 + (s + 1) * 64); k4n = *(const float4*)(sb + 1 * 1024 + (s + 1) * 64);
          n4n = *(const float4*)(sb + 2 * 1024 + (s + 1) * 64); b4n = *(const float4*)(sb + 3 * 1024 + (s + 1) * 64);
          r4n = *(const float4*)(sb + 4 * 1024 + (s + 1) * 64); van = sv[(s + 1) * 32]; vbn = sv[(s + 1) * 32 + 16];
        }
        const fv2 w01 = {w4.x, w4.y}, w23 = {w4.z, w4.w}, k01 = {k4.x, k4.y}, k23 = {k4.z, k4.w}, n01 = {n4.x, n4.y}, n23 = {n4.z, n4.w};
        const fv2 b01 = {b4.x, b4.y}, b23 = {b4.z, b4.w}, r01 = {r4.x, r4.y}, r23 = {r4.z, r4.w};
        const fv2 va2 = {va, va}, vb2 = {vb, vb};
        const fv2 vka01 = va2 * k01, vka23 = va2 * k23, vkb01 = vb2 * k01, vkb23 = vb2 * k23;
        fv2 ppa = SA01 * n01, ppb = SB01 * n01;
        ppa = __builtin_elementwise_fma(SA23, n23, ppa);
        ppb = __builtin_elementwise_fma(SB23, n23, ppb);
        float saa = ppa.x + ppa.y, sab = ppb.x + ppb.y;
        saa = ror_add<8>(saa); sab = ror_add<8>(sab);
        saa = ror_add<4>(saa); sab = ror_add<4>(sab);
        saa = ror_add<2>(saa); sab = ror_add<2>(sab);
        saa = ror_add<1>(saa); sab = ror_add<1>(sab);
        const fv2 saa2 = {saa, saa}, sab2 = {sab, sab};
        const fv2 ta01 = __builtin_elementwise_fma(saa2, b01, vka01), ta23 = __builtin_elementwise_fma(saa2, b23, vka23);
        const fv2 tb01 = __builtin_elementwise_fma(sab2, b01, vkb01), tb23 = __builtin_elementwise_fma(sab2, b23, vkb23);
        SA01 = __builtin_elementwise_fma(SA01, w01, ta01);
        SA23 = __builtin_elementwise_fma(SA23, w23, ta23);
        SB01 = __builtin_elementwise_fma(SB01, w01, tb01);
        SB23 = __builtin_elementwise_fma(SB23, w23, tb23);
        fv2 qa = SA01 * r01, qb = SB01 * r01;
        qa = __builtin_elementwise_fma(SA23, r23, qa);
        qb = __builtin_elementwise_fma(SB23, r23, qb);
        po_wa[(s & 7) * 16] = qa.x + qa.y;
        po_wb[(s & 7) * 16] = qb.x + qb.y;
        w4 = w4n; k4 = k4n; n4 = n4n; b4 = b4n; r4 = r4n; va = van; vb = vbn;
        __builtin_amdgcn_sched_barrier(0);
        if ((s & 7) == 7) {
          const float4 p0 = *(const float4*)(po_r), p1 = *(const float4*)(po_r + 4), p2 = *(const float4*)(po_r + 8), p3 = *(const float4*)(po_r + 12);
          const float ov = ((p0.x + p0.y) + (p0.z + p0.w)) + ((p1.x + p1.y) + (p1.z + p1.w)) + ((p2.x + p2.y) + (p2.z + p2.w)) + ((p3.x + p3.y) + (p3.z + p3.w));
          const size_t ro = (size_t)scan_row(bl, dir, chunk * 16 + (s & 8) + (cg & 7)) * 1024;
          O[ro + head * 64 + q2 * 32 + rl + 16 * (cg >> 3)] = f2bf(ov);
          __builtin_amdgcn_sched_barrier(0);
        }
      }
      if (chunk + 1 < NCH) SC_STAGE(buf ^ 1);
      __syncthreads();
    }
  }
}

DI void phase_combine(const P& p, int layer) {
  const int tidx = opaque_tid();
  const int j = layer / 2;
  const bf16_t* Of = (const bf16_t*)(p.ws + OFF_TR + TR_HX);
  const bf16_t* Ob = Of + (size_t)HROWS * 1024;
  const bf16_t* R = (const bf16_t*)(p.ws + OFF_TR + TR_R);
  const bf16_t* Kx = (const bf16_t*)(p.ws + OFF_TR + TR_K);
  const bf16_t* V = (const bf16_t*)(p.ws + OFF_TR + TR_V);
  const bf16_t* Aa = (const bf16_t*)(p.ws + OFF_TR + TR_A);
  bf16_t* G0 = (bf16_t*)(p.ws + OFF_TR + TR_G0);
  const bf16_t* G1 = (const bf16_t*)(p.ws + OFF_TR + TR_G1);
  const size_t total = (size_t)HROWS * 128;
  for (size_t i = (size_t)blockIdx.x * 256 + tidx; i < total; i += (size_t)gridDim.x * 256) {
    const int c0 = (int)(i & 127) * 8;
    const size_t off = (i >> 7) * 1024 + c0;
    const uint4 uof = *(const uint4*)(Of + off), uob = *(const uint4*)(Ob + off), ur = *(const uint4*)(R + off), uk = *(const uint4*)(Kx + off);
    const uint4 ua = *(const uint4*)(Aa + off), uv = *(const uint4*)(V + off), ug0 = *(const uint4*)(G0 + off), ug1 = *(const uint4*)(G1 + off);
    const unsigned aof[4] = {uof.x, uof.y, uof.z, uof.w}, aob[4] = {uob.x, uob.y, uob.z, uob.w}, ar[4] = {ur.x, ur.y, ur.z, ur.w}, ak[4] = {uk.x, uk.y, uk.z, uk.w};
    const unsigned aa[4] = {ua.x, ua.y, ua.z, ua.w}, av[4] = {uv.x, uv.y, uv.z, uv.w}, ag0[4] = {ug0.x, ug0.y, ug0.z, ug0.w}, ag1[4] = {ug1.x, ug1.y, ug1.z, ug1.w};
    const float* ka = p.rw_ka + (size_t)j * 1024 + c0;
    const float* rk = p.rw_rk + (size_t)j * 1024 + c0;
    const float* lg = p.rw_ln_g + (size_t)j * 1024 + c0;
    const float* lb = p.rw_ln_b + (size_t)j * 1024 + c0;
    float of[8], obv[8];
    float sf = 0.f, sf2 = 0.f, sb = 0.f, sb2 = 0.f, br = 0.f;
#pragma unroll
    for (int e = 0; e < 8; e++) {
      const int w = e >> 1;
      of[e] = (e & 1) ? hi_bf(aof[w]) : lo_bf(aof[w]);
      obv[e] = (e & 1) ? hi_bf(aob[w]) : lo_bf(aob[w]);
      const float r = (e & 1) ? hi_bf(ar[w]) : lo_bf(ar[w]);
      const float k = (e & 1) ? hi_bf(ak[w]) : lo_bf(ak[w]);
      const float a = (e & 1) ? hi_bf(aa[w]) : lo_bf(aa[w]);
      sf += of[e]; sf2 += of[e] * of[e]; sb += obv[e]; sb2 += obv[e] * obv[e];
      br += r * k * (1.f + (a - 1.f) * ka[e]) * rk[e];
    }
#pragma unroll
    for (int o = 1; o < 8; o <<= 1) { sf += __shfl_xor(sf, o); sf2 += __shfl_xor(sf2, o); sb += __shfl_xor(sb, o); sb2 += __shfl_xor(sb2, o); br += __shfl_xor(br, o); }
    const float muf = sf * (1.f / 64.f), mub = sb * (1.f / 64.f);
    const float rsf = rsqrtf(fmaxf(sf2 * (1.f / 64.f) - muf * muf, 0.f) + 64e-5f);
    const float rsb = rsqrtf(fmaxf(sb2 * (1.f / 64.f) - mub * mub, 0.f) + 64e-5f);
    float y[8];
#pragma unroll
    for (int e = 0; e < 8; e++) {
      const int w = e >> 1;
      const float v = (e & 1) ? hi_bf(av[w]) : lo_bf(av[w]);
      const float g0 = (e & 1) ? hi_bf(ag0[w]) : lo_bf(ag0[w]);
      const float g1 = (e & 1) ? hi_bf(ag1[w]) : lo_bf(ag1[w]);
      const float bonus = br * v;
      y[e] = ((of[e] - muf) * rsf * lg[e] + lb[e] + bonus) * g0 + ((obv[e] - mub) * rsb * lg[e] + lb[e] + bonus) * g1;
    }
    *(uint4*)(G0 + off) = make_uint4(pack2(y[0], y[1]), pack2(y[2], y[3]), pack2(y[4], y[5]), pack2(y[6], y[7]));
  }
}

DI void phase_rw_out(const P& p, int layer, int hf, char* smem) {
  const int tidx = opaque_tid();
  const bf16_t* Y = (const bf16_t*)(p.ws + OFF_TR + TR_G0);
  const bf16_t* WO = (const bf16_t*)(p.ws + w_off(layer)) + W_WO;
  const int nlt = (layer == 3) ? 128 : 136;
  for (int t = blockIdx.x; t < xcd_rounds(nlt, 8) * (int)gridDim.x; t += gridDim.x) {
    int lt, nt_;
    if (!xcd_tile(t, nlt, 8, lt, nt_)) continue;
    const int n0 = nt_ * 128;
    const int gt = half_gtile(hf, lt);
    f32x16 acc[2][2];
    gemm_mainloop(Y + (size_t)lt * 128 * 1024, 1024, WO + (size_t)n0 * 1024, 1024, 1024, smem, acc);
    const float* gate = mods_ptr(p, layer, mod_row(gt * 128)) + 2048 + n0;
    float* xr = resid_row(p, gt * 128) + n0;
    const float* xs = layer == 0 ? input_row(p, gt * 128) + n0 : xr;
    EPI8_BEGIN
      resid_update(xr + (size_t)row * D + col, xs + (size_t)row * D + col, gate + col, v);
    EPI8_END
  }
}

DI void phase_mlp1(const P& p, int layer, char* smem) {
  const int tidx = opaque_tid();
  const bf16_t* H2 = (const bf16_t*)(p.ws + OFF_TR + TR_H2);
  const bf16_t* W1 = (const bf16_t*)(p.ws + w_off(layer)) + W_M1;
  bf16_t* HID = (bf16_t*)(p.ws + OFF_TR + TR_HID);
  const int nmt = (layer == 3) ? 256 : 272;
  const int ngrp = nmt / 16;
  (void)ngrp;
  for (int t = blockIdx.x; t < xcd_rounds(nmt, 32) * (int)gridDim.x; t += gridDim.x) {
    int gt, nt;
    if (!xcd_tile(t, nmt, 32, gt, nt)) continue;
    f32x16 acc[2][2];
    gemm_mainloop(H2 + (size_t)gt * 128 * 1024, 1024, W1 + (size_t)nt * 128 * 1024, 1024, 1024, smem, acc);
    EPI8_BEGIN
#pragma unroll
      for (int e = 0; e < 8; e++) { const float rl = fmaxf(v[e], 0.f); v[e] = rl * rl; }
      *(uint4*)(HID + (size_t)(gt * 128 + row) * 4096 + nt * 128 + col) = pack8(v);
    EPI8_END
  }
}
DI void phase_mlp2(const P& p, int layer, char* smem) {
  const int tidx = opaque_tid();
  const bf16_t* HID = (const bf16_t*)(p.ws + OFF_TR + TR_HID);
  const bf16_t* W2 = (const bf16_t*)(p.ws + w_off(layer)) + W_M2;
  const int nmt = (layer == 3) ? 256 : 272;
  for (int t = blockIdx.x; t < xcd_rounds(nmt, 8) * (int)gridDim.x; t += gridDim.x) {
    int gt, nt_;
    if (!xcd_tile(t, nmt, 8, gt, nt_)) continue;
    const int n0 = nt_ * 128;
    f32x16 acc[2][2];
    gemm_mainloop(HID + (size_t)gt * 128 * 4096, 4096, W2 + (size_t)n0 * 4096, 4096, 4096, smem, acc);
    const float* gate = mods_ptr(p, layer, mod_row(gt * 128)) + 5120 + n0;
    float* xr = resid_row(p, gt * 128) + n0;
    EPI8_BEGIN
      resid_update(xr + (size_t)row * D + col, xr + (size_t)row * D + col, gate + col, v);
    EPI8_END
  }
}

DI void phase_qkv(const P& p, int layer, char* smem) {
  const int tidx = opaque_tid();
  const bf16_t* H = (const bf16_t*)(p.ws + OFF_TR + TR_H);
  const bf16_t* WQ = (const bf16_t*)(p.ws + w_off(layer)) + W_QKV;
  bf16_t* Q = (bf16_t*)(p.ws + OFF_TR + TR_Q);
  bf16_t* Kb = (bf16_t*)(p.ws + OFF_TR + TR_KK);
  bf16_t* VT = (bf16_t*)(p.ws + OFF_TR + TR_VT);
  const float* cosT = (const float*)(p.ws + OFF_MISC);
  const float* sinT = cosT + 1024;
  for (int t = blockIdx.x; t < xcd_rounds(272, 24) * (int)gridDim.x; t += gridDim.x) {
    int gt, nt;
    if (!xcd_tile(t, 272, 24, gt, nt)) continue;
    f32x16 acc[2][2];
    gemm_mainloop(H + (size_t)gt * 128 * 1024, 1024, WQ + (size_t)nt * 128 * 1024, 1024, 1024, smem, acc);
    const bool lat = gt < 256;
    const int b = lat ? gt / 32 : (gt - 256) / 2;
    const int t0 = lat ? (gt % 32) * 128 : (gt - 256) % 2 * 128;
    const int tq0 = lat ? t0 : SL + t0;
    const int typ = nt / 8, h = nt % 8;
    if (typ < 2) {
      bf16_t* dst = typ == 0 ? Q : Kb;
      const float qs = typ == 0 ? 0.125f * 1.44269504088896f : 1.f;
      float kmx = 0.f;
      EPI8_BEGIN
        const int sidx = col >> 6, d0 = col & 63;
        if (lat) {
          const float4 pa = *(const float4*)(es + row * EST + (col ^ 16));
          const float4 pb = *(const float4*)(es + row * EST + (col ^ 16) + 4);
          const float pr[8] = {pa.x, pa.y, pa.z, pa.w, pb.x, pb.y, pb.z, pb.w};
          const int tt = t0 + row;
          const int pos = (d0 < 32) ? (tt >> 6) : (tt & 63);
          const float4 ca = *(const float4*)(cosT + pos * 16 + (d0 & 8)), cb = *(const float4*)(cosT + pos * 16 + (d0 & 8) + 4);
          const float4 sa = *(const float4*)(sinT + pos * 16 + (d0 & 8)), sb = *(const float4*)(sinT + pos * 16 + (d0 & 8) + 4);
          const float cs[8] = {ca.x, ca.y, ca.z, ca.w, cb.x, cb.y, cb.z, cb.w};
          const float sn[8] = {sa.x, sa.y, sa.z, sa.w, sb.x, sb.y, sb.z, sb.w};
          const float sgn = (d0 & 16) ? 1.f : -1.f;
#pragma unroll
          for (int e = 0; e < 8; e++) v[e] = v[e] * cs[e] + sgn * pr[e] * sn[e];
        }
#pragma unroll
        for (int e = 0; e < 8; e++) v[e] *= qs;
        const uint4 pk_ = pack8(v);
        *(uint4*)(dst + ((size_t)((b * 8 + h) * 2 + sidx) * TK + tq0 + row) * 64 + d0) = pk_;
        if (typ == 1) {
          float rv_[8];
          unpack8(pk_, rv_);
          float ssq_ = 0.f;
#pragma unroll
          for (int e = 0; e < 8; e++) ssq_ += rv_[e] * rv_[e];
          ssq_ += __shfl_xor(ssq_, 1); ssq_ += __shfl_xor(ssq_, 2); ssq_ += __shfl_xor(ssq_, 4);
          kmx = fmaxf(kmx, ssq_);
        }
      EPI8_END
      if (typ == 1) {
        kmx = fmaxf(kmx, __shfl_xor(kmx, 16));
        kmx = fmaxf(kmx, __shfl_xor(kmx, 32));
        if ((tidx & 55) == 0)
          atomicMax((unsigned*)(p.ws + OFF_MISC) + 4096 + (layer >> 1) * 128 + (b * 8 + h) * 2 + ((tidx >> 3) & 1), __float_as_uint(kmx));
      }
    } else {
      float* es = (float*)smem;
      acc_to_lds(acc, es);
      __syncthreads();
      for (int pass = 0; pass < 8; pass++) {
        const int d = tidx & 127, tg = pass * 2 + (tidx >> 7);
        float v[8];
#pragma unroll
        for (int e = 0; e < 8; e++) v[e] = es[(tg * 8 + e) * EST + d];
        *(uint4*)(VT + ((size_t)(b * 8 + h) * 128 + d) * TK + tq0 + tg * 8) = pack8(v);
      }
      __syncthreads();
    }
  }
}

typedef _Float16 hv2 __attribute__((ext_vector_type(2)));
DI unsigned packh2(float a, float b) { hv2 r = {(_Float16)a, (_Float16)b}; return __builtin_bit_cast(unsigned, r); }
DI float lo_h(unsigned u) { hv2 r = __builtin_bit_cast(hv2, u); return (float)r[0]; }
DI float hi_h(unsigned u) { hv2 r = __builtin_bit_cast(hv2, u); return (float)r[1]; }

DI void phase_attn(const P& p, int layer, char* smem) {
  const int tidx = opaque_tid();
  const int j = layer / 2;
  const bool ctxq = layer != 3;
  const bf16_t* Q = (const bf16_t*)(p.ws + OFF_TR + TR_Q);
  const bf16_t* Kb = (const bf16_t*)(p.ws + OFF_TR + TR_KK);
  const bf16_t* VT = (const bf16_t*)(p.ws + OFF_TR + TR_VT);
  bf16_t* O = (bf16_t*)(p.ws + OFF_TR + TR_H);
  const float lam = ((const float*)(p.ws + OFF_MISC))[2048 + j];
  const float* kmax2 = (const float*)(p.ws + OFF_MISC) + 4096 + j * 128;
  const float oml = 1.f - lambda_init(layer);
  const float* subg = p.da_subln_g + (size_t)j * 128;
  constexpr int LDV = 72;
  bf16_t* sK = (bf16_t*)smem;
  bf16_t* sV = sK + 2 * 64 * LDT;
  const int tid = tidx, lane = tid & 63, w = tid >> 6, g = lane >> 5, l31 = lane & 31;
  const int nitems = 2048 + (ctxq ? 128 : 0);
  const int spx = gridDim.x >> 3, gpr = spx >> 5;
  const bool xmap = (gridDim.x == 256u || gridDim.x == 512u);
  const int lat_rounds = xmap ? 64 / (8 * gpr) : (2048 + (int)gridDim.x - 1) / (int)gridDim.x;
  for (int it0 = blockIdx.x; it0 < lat_rounds * (int)gridDim.x + (ctxq ? 128 : 0); it0 += gridDim.x) {
    int item;
    if (!xmap) {
      item = it0 < lat_rounds * (int)gridDim.x ? it0 : 2048 + (it0 - lat_rounds * (int)gridDim.x);
      if (it0 < lat_rounds * (int)gridDim.x && it0 >= 2048) continue;
    } else if (it0 < lat_rounds * (int)gridDim.x) {
      const int r = it0 % (int)gridDim.x, round = it0 / (int)gridDim.x;
      const int xcd = r & 7, li = r >> 3;
      const int bh = (round * 8 + xcd) * gpr + (li >> 5);
      item = bh * 32 + (li & 31);
    } else {
      item = 2048 + (it0 - lat_rounds * (int)gridDim.x);
    }
    (void)nitems;
    int b, h, q0, kbeg, ntiles;
    if (item < 2048) { b = item >> 8; h = (item >> 5) & 7; q0 = (item & 31) * 128; kbeg = 0; ntiles = TK / 64; }
    else { const int it = item - 2048; b = it >> 4; h = (it >> 1) & 7; q0 = SL + (it & 1) * 128; kbeg = SL; ntiles = CL / 64; }
    const bf16_t* Vp0 = VT + (size_t)(b * 8 + h) * 128 * TK;
    const int tq = q0 + w * 32 + l31;
    const size_t grow = tq < SL ? (size_t)b * SL + tq : (size_t)NLAT + (size_t)b * CL + (tq - SL);
    bf16_t* op = O + grow * 1024 + h * 128;
    for (int s = 0; s < 2; s++) {
      const bf16_t* Kp0 = Kb + (size_t)((b * 8 + h) * 2 + s) * TK * 64;
      const bf16_t* Qp = Q + ((size_t)((b * 8 + h) * 2 + s) * TK + tq) * 64 + g * 8;
      bf16x8 qf[4];
      float qss = 0.f;
#pragma unroll
      for (int kk = 0; kk < 4; kk++) {
        const uint4 u = *(const uint4*)(Qp + kk * 16);
        qf[kk] = __builtin_bit_cast(bf16x8, u);
        float qv[8];
        unpack8(u, qv);
#pragma unroll
        for (int e = 0; e < 8; e++) qss += qv[e] * qv[e];
      }
      qss += __shfl_xor(qss, 32);
      const float nmq = -sqrtf(qss * kmax2[(b * 8 + h) * 2 + s]);
      f32x16 o[4];
#pragma unroll
      for (int db = 0; db < 4; db++)
#pragma unroll
        for (int r = 0; r < 16; r++) o[db][r] = 0.f;
      float l = 0.f;
      uint4 rk0, rk1, rv0, rv1, rv2, rv3;
      const unsigned kvo = (unsigned)((tid >> 3) * 64 + (tid & 7) * 8);
      const unsigned vvo = (unsigned)((tid >> 3) * TK + (tid & 7) * 8);
      const unsigned sko = (unsigned)((tid >> 3) * LDT + (tid & 7) * 8);
      const unsigned svo = (unsigned)((tid >> 3) * LDV + ((tid & 7) >> 1) * 16 + (tid & 1) * 4);
#define ISSUE_KV(kt_)                                                             \
      {                                                                           \
        const bf16_t* kb_ = Kp0 + (size_t)(kbeg + (kt_) * 64) * 64;               \
        const bf16_t* vb_ = Vp0 + (kbeg + (kt_) * 64);                            \
        unsigned kvo_ = kvo, vvo_ = vvo;                                          \
        asm volatile("" : "+v"(kvo_), "+v"(vvo_));     \
        rk0 = *(const uint4*)(kb_ + kvo_);                                        \
        rk1 = *(const uint4*)(kb_ + (kvo_ + 32u * 64u));                          \
        rv0 = *(const uint4*)(vb_ + vvo_);                                        \
        rv1 = *(const uint4*)(vb_ + (vvo_ + 32u * (unsigned)TK));                 \
        rv2 = *(const uint4*)(vb_ + (vvo_ + 64u * (unsigned)TK));                 \
        rv3 = *(const uint4*)(vb_ + (vvo_ + 96u * (unsigned)TK));                 \
      }
#define ST_V(ptr_, r_) { *(uint2*)(ptr_) = make_uint2(r_.x, r_.y); *(uint2*)((ptr_) + 8) = make_uint2(r_.z, r_.w); }
#define STAGE_KV(buf_)                                                            \
      {                                                                           \
        bf16_t* ks_ = sK + (buf_) * 64 * LDT + sko;                               \
        bf16_t* vs_ = sV + (buf_) * 128 * LDV + svo;                              \
        *(uint4*)(ks_) = rk0;                                                     \
        *(uint4*)(ks_ + 32 * LDT) = rk1;                                          \
        ST_V(vs_, rv0); ST_V(vs_ + 32 * LDV, rv1); ST_V(vs_ + 64 * LDV, rv2); ST_V(vs_ + 96 * LDV, rv3); \
      }
      __syncthreads();
      ISSUE_KV(0);
      STAGE_KV(0);
      __syncthreads();
      for (int kt = 0; kt < ntiles; kt++) {
        const int buf = kt & 1;
        const bool more = kt + 1 < ntiles;
        if (more) ISSUE_KV(kt + 1);
        __builtin_amdgcn_sched_barrier(0);
        const bf16_t* kS = sK + buf * 64 * LDT;
        const bf16_t* vS = sV + buf * 128 * LDV;
#pragma unroll
        for (int kb = 0; kb < 2; kb++) {
          bf16x8 kf[4];
#pragma unroll
          for (int kk = 0; kk < 4; kk++) kf[kk] = *(const bf16x8*)(kS + (kb * 32 + l31) * LDT + kk * 16 + g * 8);
          __builtin_amdgcn_sched_barrier(0);
          f32x16 st;
#pragma unroll
          for (int r = 0; r < 16; r++) st[r] = nmq;
#pragma unroll
          for (int kk = 0; kk < 4; kk++) st = MFMA32(kf[kk], qf[kk], st);
          uint4 vf0[4];
#pragma unroll
          for (int db = 0; db < 4; db++) {
            vf0[db] = *(const uint4*)(vS + (db * 32 + l31) * LDV + kb * 32 + 8 * g);
          }
          __builtin_amdgcn_sched_barrier(0);
          float ls = 0.f;
          bf16x8 pk[2];
#pragma unroll
          for (int hh = 0; hh < 2; hh++) {
            float e[8];
#pragma unroll
            for (int i = 0; i < 8; i++) { e[i] = __builtin_amdgcn_exp2f(st[hh * 8 + i]); ls += e[i]; }
            const uint4 u = make_uint4(pack2(e[0], e[1]), pack2(e[2], e[3]), pack2(e[4], e[5]), pack2(e[6], e[7]));
            pk[hh] = __builtin_bit_cast(bf16x8, u);
          }
          l += ls;
          uint4 vf1[4];
#pragma unroll
          for (int db = 0; db < 4; db++) {
            vf1[db] = *(const uint4*)(vS + (db * 32 + l31) * LDV + kb * 32 + 16 + 8 * g);
          }
          __builtin_amdgcn_sched_barrier(0);
#pragma unroll
          for (int db = 0; db < 4; db++) o[db] = MFMA32(__builtin_bit_cast(bf16x8, vf0[db]), pk[0], o[db]);
#pragma unroll
          for (int db = 0; db < 4; db++) o[db] = MFMA32(__builtin_bit_cast(bf16x8, vf1[db]), pk[1], o[db]);
        }
        __builtin_amdgcn_sched_barrier(0);
        if (more) STAGE_KV(buf ^ 1);
        __syncthreads();
      }
      const float lt = l + __shfl_xor(l, 32);
      if (s == 0) {
        const float inv = 1.f / lt;
#pragma unroll
        for (int db = 0; db < 4; db++)
#pragma unroll
          for (int rq = 0; rq < 4; rq++) {
            const int d = db * 32 + 8 * rq + 4 * g;
            *(uint2*)(op + d) = make_uint2(packh2(o[db][4 * rq] * inv, o[db][4 * rq + 1] * inv), packh2(o[db][4 * rq + 2] * inv, o[db][4 * rq + 3] * inv));
          }
      } else {
        const float inv = lam / lt;
        float ssq = 0.f;
#pragma unroll
        for (int db = 0; db < 4; db++)
#pragma unroll
          for (int rq = 0; rq < 4; rq++) {
            const int d = db * 32 + 8 * rq + 4 * g;
            const uint2 u0 = *(const uint2*)(op + d);
            const float a0 = lo_h(u0.x) - o[db][4 * rq] * inv, a1 = hi_h(u0.x) - o[db][4 * rq + 1] * inv;
            const float a2 = lo_h(u0.y) - o[db][4 * rq + 2] * inv, a3 = hi_h(u0.y) - o[db][4 * rq + 3] * inv;
            o[db][4 * rq] = a0; o[db][4 * rq + 1] = a1; o[db][4 * rq + 2] = a2; o[db][4 * rq + 3] = a3;
            ssq += a0 * a0 + a1 * a1 + a2 * a2 + a3 * a3;
          }
        ssq += __shfl_xor(ssq, 32);
        const float rs = rsqrtf(ssq * (1.f / 128.f) + 1e-5f) * oml;
#pragma unroll
        for (int db = 0; db < 4; db++)
#pragma unroll
          for (int rq = 0; rq < 4; rq++) {
            const int d = db * 32 + 8 * rq + 4 * g;
            const float4 sg = *(const float4*)(subg + d);
            *(uint2*)(op + d) = make_uint2(pack2(o[db][4 * rq] * rs * sg.x, o[db][4 * rq + 1] * rs * sg.y),
                                           pack2(o[db][4 * rq + 2] * rs * sg.z, o[db][4 * rq + 3] * rs * sg.w));
          }
      }
    }
  }
}

DI void phase_at_out(const P& p, int layer, char* smem) {
  const int tidx = opaque_tid();
  const bf16_t* O = (const bf16_t*)(p.ws + OFF_TR + TR_H);
  const bf16_t* WO = (const bf16_t*)(p.ws + w_off(layer)) + W_WO;
  const int nmt = (layer == 3) ? 256 : 272;
  for (int t = blockIdx.x; t < xcd_rounds(nmt, 8) * (int)gridDim.x; t += gridDim.x) {
    int gt, nt_;
    if (!xcd_tile(t, nmt, 8, gt, nt_)) continue;
    const int n0 = nt_ * 128;
    f32x16 acc[2][2];
    gemm_mainloop(O + (size_t)gt * 128 * 1024, 1024, WO + (size_t)n0 * 1024, 1024, 1024, smem, acc);
    const float* gate = mods_ptr(p, layer, mod_row(gt * 128)) + 2048 + n0;
    float* xr = resid_row(p, gt * 128) + n0;
    EPI8_BEGIN
      resid_update(xr + (size_t)row * D + col, xr + (size_t)row * D + col, gate + col, v);
    EPI8_END
  }
}

DI void phase_final(const P& p) {
  const int tidx = opaque_tid();
  const int lane = tidx & 63, wv = tidx >> 6;
  for (int row = blockIdx.x * 4 + wv; row < NLAT; row += gridDim.x * 4) {
    float* xr = p.out + (size_t)row * D;
    float4 v[4];
    float ss = 0.f;
#pragma unroll
    for (int jx = 0; jx < 4; jx++) { v[jx] = *(const float4*)(xr + jx * 256 + lane * 4); ss += v[jx].x * v[jx].x + v[jx].y * v[jx].y + v[jx].z * v[jx].z + v[jx].w * v[jx].w; }
    ss = wave_sum(ss);
    const float rs = rsqrtf(ss * (1.f / 1024.f) + 1e-6f);
#pragma unroll
    for (int jx = 0; jx < 4; jx++) {
      const float4 g = *(const float4*)(p.final_g + jx * 256 + lane * 4);
      *(float4*)(xr + jx * 256 + lane * 4) = make_float4(v[jx].x * rs * g.x, v[jx].y * rs * g.y, v[jx].z * rs * g.z, v[jx].w * rs * g.w);
    }
  }
}

#define XB_TMO      128
#define XB_XCNT(j)  (256  + 64 * (j))
#define XB_XSUB(j)  (1280 + 64 * (j))
#define XB_XGEN(j)  (2304 + 64 * (j))
#define XB_TOP      3328
#define XB_TOPGEN   3392
#define XCD_BAR_WORDS 3456
#define XB_SPIN_CAP (1u << 22)
#define LAS __attribute__((address_space(3)))
DI unsigned xb_ld(unsigned* p) { return __hip_atomic_load(p, __ATOMIC_RELAXED, __HIP_MEMORY_SCOPE_AGENT); }
DI unsigned xb_add(unsigned* p, unsigned v) { return __hip_atomic_fetch_add(p, v, __ATOMIC_RELAXED, __HIP_MEMORY_SCOPE_AGENT); }
DI unsigned xb_xcc_id() { return (unsigned)__builtin_amdgcn_s_getreg((3 << 11) | 20) & 0xFu; }
#define XB_SPIN(cond, bar) do { unsigned _sp = 0; while (cond) { __builtin_amdgcn_s_sleep(1); \
    if ((++_sp & 255u) == 0u) { if (xb_ld(&(bar)[XB_TMO])) break; if (_sp > XB_SPIN_CAP) { atomicAdd(&(bar)[XB_TMO], 1u); break; } } } } while (0)
struct XcdBarrier { unsigned* bar; unsigned x; volatile LAS unsigned* st; };
DI XcdBarrier xcd_barrier_post(unsigned* bar, volatile LAS unsigned* st) {
  XcdBarrier b; b.bar = bar; b.x = xb_xcc_id(); b.st = st;
  if (threadIdx.x == 0) (void)xb_add(&bar[XB_XCNT(b.x)], 1u);
  return b;
}
DI void xcd_barrier_complete(unsigned* bar, unsigned x, unsigned& nloc, unsigned& nx) {
  const unsigned G = gridDim.x * gridDim.y * gridDim.z;
  unsigned sum, cnt, mine, sp = 0u;
  for (;;) {
    sum = 0u; cnt = 0u; mine = 0u;
#pragma unroll
    for (unsigned j = 0; j < 16; ++j) { const unsigned c = xb_ld(&bar[XB_XCNT(j)]); sum += c; cnt += (c > 0u) ? 1u : 0u; mine = (j == x) ? c : mine; }
    if (sum == G) break;
    __builtin_amdgcn_s_sleep(1);
    if ((++sp & 255u) == 0u) { if (xb_ld(&bar[XB_TMO])) break; if (sp > XB_SPIN_CAP) { atomicAdd(&bar[XB_TMO], 1u); break; } }
  }
  nloc = mine > 0u ? mine : 1u; nx = cnt > 0u ? cnt : 1u;
}
DI void xcd_barrier(const XcdBarrier& b) {
  asm volatile("s_waitcnt vmcnt(0)" ::: "memory");
  __syncthreads();
  if (threadIdx.x == 0) {
    unsigned* bar = b.bar;
    __builtin_amdgcn_s_waitcnt(0);
    unsigned nloc = b.st[0], nx = b.st[1];
    if (nloc == 0u) { xcd_barrier_complete(bar, b.x, nloc, nx); b.st[0] = nloc; b.st[1] = nx; }
    const unsigned old = xb_add(&bar[XB_XSUB(b.x)], 1u);
    const unsigned gen = old / nloc;
    if (old + 1u == (gen + 1u) * nloc) {
      __builtin_amdgcn_fence(__ATOMIC_RELEASE, "agent");
      asm volatile("s_waitcnt vmcnt(0)" ::: "memory");
      const unsigned og = xb_add(&bar[XB_TOP], 1u);
      const unsigned tg = og / nx;
      if (og + 1u == (tg + 1u) * nx) xb_add(&bar[XB_TOPGEN], 1u);
      else XB_SPIN(xb_ld(&bar[XB_TOPGEN]) == tg, bar);
      __builtin_amdgcn_fence(__ATOMIC_ACQUIRE, "agent");
      xb_add(&bar[XB_XGEN(b.x)], 1u);
      asm volatile("s_waitcnt vmcnt(0)" ::: "memory");
    } else {
      XB_SPIN(xb_ld(&bar[XB_XGEN(b.x)]) == gen, bar);
      __builtin_amdgcn_fence(__ATOMIC_ACQUIRE, "agent");
      asm volatile("s_waitcnt vmcnt(0)" ::: "memory");
    }
  }
  __syncthreads();
}
constexpr size_t OFF_BAR = OFF_MISC + 65536;

typedef __attribute__((address_space(1))) const float GCF;
typedef __attribute__((address_space(1))) float GF;
typedef __attribute__((address_space(1))) char GC;
DI unsigned long long lds_word(const unsigned long long* tbl, int i) {
  int z = i;
  asm volatile("" : "+v"(z));
  const unsigned long long v = tbl[z];
  const unsigned lo = __builtin_amdgcn_readfirstlane((unsigned)v), hi = __builtin_amdgcn_readfirstlane((unsigned)(v >> 32));
  return ((unsigned long long)hi << 32) | lo;
}
DI void load_params(P& q, const unsigned long long* tbl) {
  const float** fp = (const float**)&q;
#pragma unroll
  for (int i = 0; i < 36; i++) fp[i] = (const float*)(GCF*)lds_word(tbl, i);
  q.out = (float*)(GF*)lds_word(tbl, 36);
  q.ws = (char*)(GC*)lds_word(tbl, 37);
  q.only = 0;
  q.pad = 0;
}
__global__ void __launch_bounds__(256, 2) mega(P p) {
  __shared__ __attribute__((aligned(16))) char smem[73728];
  __shared__ unsigned long long s_tbl[40];
  {
#if defined(__HIP_DEVICE_COMPILE__)
    typedef __attribute__((address_space(4))) const unsigned long long KW;
    KW* kp = (KW*)__builtin_amdgcn_kernarg_segment_ptr();
    if (threadIdx.x < 39) s_tbl[threadIdx.x] = kp[threadIdx.x];
#endif
    __syncthreads();
  }
  const int only = (int)(unsigned)lds_word(s_tbl, 38);
  cg::grid_group grid = cg::this_grid();
  __shared__ uint4 xb_words;
  if (threadIdx.x == 0) xb_words = make_uint4(0u, 0u, 0u, 0u);
  __syncthreads();
  XcdBarrier xb;
  {
    P q;
    load_params(q, s_tbl);
    xb = xcd_barrier_post((unsigned*)(q.ws + OFF_BAR), (volatile LAS unsigned*)&xb_words);
  }
  int step = 0;
#define GSYNC() { if (step == 1) grid.sync(); else xcd_barrier(xb); }
#define STEP(body)                                   \
  {                                                  \
    if (only < 0 || only == step) {              \
      P q;                                           \
      load_params(q, s_tbl);                         \
      body;                                          \
    }                                                \
    step++;                                          \
    if (only < 0) GSYNC();                         \
  }
#ifndef DUP
#define DUP 0
#endif
#define STEPD(id, body)                              \
  {                                                  \
    if (only < 0 || only == step) {                  \
      P q;                                           \
      load_params(q, s_tbl);                         \
      body;                                          \
      if (DUP == id) { __syncthreads(); body; }      \
    }                                                \
    step++;                                          \
    if (only < 0) GSYNC();                           \
  }
  STEP(phase_init(q, smem); __syncthreads(); phase_conv(q, 0, smem, blockIdx.x, gridDim.x));
  for (int layer = 0; layer < 4; layer++) {
    if ((layer & 1) == 0) {
      for (int hf = 0; hf < 2; hf++) {
        STEPD(2, phase_prep(q, layer, 0, hf, true, (bf16_t*)(q.ws + OFF_TR + TR_HX), 2048, false));
        STEPD(3, phase_t1(q, layer, smem));
        STEPD(4, phase_feat(q, layer, hf, smem));
        STEPD(5, phase_scan(q, layer, smem);
              if (hf == 0) { __syncthreads(); phase_conv(q, layer + 1, smem, gridDim.x > 256 ? (int)blockIdx.x - 256 : (int)blockIdx.x, gridDim.x > 256 ? (int)gridDim.x - 256 : (int)gridDim.x); });
        STEP(phase_combine(q, layer));
        STEP(phase_rw_out(q, layer, hf, smem));
      }
    } else {
      STEP(phase_prep(q, layer, 0, -1, false, (bf16_t*)(q.ws + OFF_TR + TR_H), 1024, false);
           if (layer + 1 < 4) { __syncthreads(); phase_conv(q, layer + 1, smem, blockIdx.x, gridDim.x); });
      STEPD(7, phase_qkv(q, layer, smem));
      STEPD(8, phase_attn(q, layer, smem));
      STEP(phase_at_out(q, layer, smem));
    }
    STEPD(2, phase_prep(q, layer, 1, -1, false, (bf16_t*)(q.ws + OFF_TR + TR_H2), 1024, layer == 3));
    STEPD(9, phase_mlp1(q, layer, smem));
    STEP(phase_mlp2(q, layer, smem));
  }
  STEP(phase_final(q));
}

#ifndef MULTI_LAUNCH
#define MULTI_LAUNCH 0
#endif
constexpr int NSTEPS = 1 + 2 * (12 + 3) + 2 * (4 + 3) + 1;

extern "C" void kernel_launch(void* const* d_in, const int* in_sizes, int n_in, void* d_out, int out_size, void* d_ws, size_t ws_size,
                              hipStream_t stream) {
  static int grid_blocks = 0;
  if (!grid_blocks) {
    int dev = 0, cus = 0, per_cu = 0;
    hipGetDevice(&dev);
    hipDeviceGetAttribute(&cus, hipDeviceAttributeMultiprocessorCount, dev);
    hipOccupancyMaxActiveBlocksPerMultiprocessor(&per_cu, mega, 256, 0);
    if (per_cu < 1) per_cu = 1;
    if (per_cu > 2) per_cu = 2;
    grid_blocks = cus * per_cu;
  }
  P p{};
  const float** fp = (const float**)&p;
  for (int i = 0; i < 36; i++) fp[i] = (const float*)d_in[i];
  p.out = (float*)d_out;
  p.ws = (char*)d_ws;
  p.pad = 0;
#if MULTI_LAUNCH
  for (int s = 0; s < NSTEPS; s++) {
    p.only = s;
    void* args[] = {&p};
    hipError_t e = hipLaunchCooperativeKernel((void*)mega, dim3(grid_blocks), dim3(256), args, 0, stream);
    if (e != hipSuccess) { fprintf(stderr, "launch failed: %s\n", hipGetErrorString(e)); break; }
  }
#else
  p.only = -1;
  hipMemsetAsync((char*)d_ws + OFF_BAR, 0, XCD_BAR_WORDS * 4, stream);
  void* args[] = {&p};
  hipError_t e = hipLaunchCooperativeKernel((void*)mega, dim3(grid_blocks), dim3(256), args, 0, stream);
  if (e != hipSuccess) fprintf(stderr, "cooperative launch failed: %s (grid %d)\n", hipGetErrorString(e), grid_blocks);
#endif
}
```

```cpp
#include <hip/hip_runtime.h>
#include <hip/hip_cooperative_groups.h>
#include <cstdio>
namespace cg = cooperative_groups;

#define DI __device__ __forceinline__
typedef unsigned short bf16_t;
using bf16x8 = __attribute__((ext_vector_type(8))) short;
using f32x16 = __attribute__((ext_vector_type(16))) float;
typedef __bf16 bfv2 __attribute__((ext_vector_type(2)));
typedef float fv2 __attribute__((ext_vector_type(2)));
#define MFMA32(a, b, c) __builtin_amdgcn_mfma_f32_32x32x16_bf16((a), (b), (c), 0, 0, 0)

constexpr int D = 1024, NB = 8, SL = 4096, CL = 256;
constexpr int NLAT = NB * SL, NCTX = NB * CL, NTOK = NLAT + NCTX;
constexpr int HROWS = NTOK / 2;
constexpr int TK = SL + CL;
constexpr size_t MiB = 1048576;
constexpr size_t OFF_W2 = 476 * MiB;
constexpr size_t OFF_W = 0, OFF_XC = 36 * MiB, OFF_MODS = 44 * MiB, OFF_MISC = 45 * MiB, OFF_VF = 46 * MiB, OFF_TR = 114 * MiB;
constexpr size_t W_RKV = 0;
constexpr size_t W_L1 = W_RKV + 3072ull * 2048;
constexpr size_t W_W2 = W_L1 + 640ull * 2048;
constexpr size_t W_A2 = W_W2 + 2ull * 65536;
constexpr size_t W_G2 = W_A2 + 65536;
constexpr size_t W_V2 = W_G2 + 2ull * 196608;
constexpr size_t W_WO = W_V2 + 65536;
constexpr size_t W_M1 = W_WO + 1048576;
constexpr size_t W_M2 = W_M1 + 4194304;
constexpr size_t W_QKV = 0;
constexpr size_t HALF_ARR = (size_t)HROWS * 1024 * 2;
constexpr size_t TR_HX = 0;
constexpr size_t TR_T1 = 2 * HALF_ARR;
constexpr size_t TR_R = TR_T1 + (size_t)HROWS * 640 * 2;
constexpr size_t TR_K = TR_R + HALF_ARR, TR_V = TR_K + HALF_ARR, TR_A = TR_V + HALF_ARR;
constexpr size_t TR_WL0 = TR_A + HALF_ARR, TR_WL1 = TR_WL0 + HALF_ARR, TR_G0 = TR_WL1 + HALF_ARR, TR_G1 = TR_G0 + HALF_ARR;
constexpr size_t FULL_ARR = (size_t)NTOK * 1024 * 2;
constexpr size_t TR_H = 0, TR_Q = FULL_ARR, TR_KK = 2 * FULL_ARR, TR_VT = 3 * FULL_ARR;
constexpr size_t TR_H2 = 0, TR_HID = FULL_ARR;

struct P {
  const float *x, *c, *ctx, *c_ctx, *ada_w, *ada_b, *norm_g, *final_g;
  const float *rw_mix, *rw_w_rkv, *rw_w0, *rw_w1, *rw_w2, *rw_a0, *rw_a1, *rw_a2, *rw_g1, *rw_g2, *rw_kk, *rw_ka, *rw_rk, *rw_ln_g, *rw_ln_b, *rw_w_o, *rw_v0, *rw_v1, *rw_v2;
  const float *da_w_qkv, *da_w_o, *da_lq1, *da_lk1, *da_lq2, *da_lk2, *da_subln_g, *mlp_w1, *mlp_w2;
  float* out;
  char* ws;
  int only;
  int pad;
};

DI float bf2f(bf16_t h) { return __uint_as_float(((unsigned)h) << 16); }
DI unsigned pack2(float a, float b) { fv2 v = {a, b}; bfv2 r = __builtin_convertvector(v, bfv2); return __builtin_bit_cast(unsigned, r); }
DI bf16_t f2bf(float a) { return (bf16_t)(pack2(a, 0.f) & 0xffffu); }
DI float lo_bf(unsigned u) { return __uint_as_float(u << 16); }
DI float hi_bf(unsigned u) { return __uint_as_float(u & 0xffff0000u); }
DI float sigmoidf_(float x) { return __builtin_amdgcn_rcpf(1.f + __expf(-x)); }
DI float tanhf_(float x) { return 1.f - 2.f * __builtin_amdgcn_rcpf(1.f + __expf(2.f * x)); }
DI float wave_sum(float v) {
#pragma unroll
  for (int o = 32; o > 0; o >>= 1) v += __shfl_xor(v, o);
  return v;
}
template <int N> DI float ror_add(float x) { return x + __builtin_bit_cast(float, __builtin_amdgcn_mov_dpp(__builtin_bit_cast(int, x), 0x120 + N, 0xf, 0xf, true)); }
DI float rowsum16(float x) { x = ror_add<8>(x); x = ror_add<4>(x); x = ror_add<2>(x); x = ror_add<1>(x); return x; }

DI int opaque_tid() { int t = threadIdx.x; asm volatile("" : "+v"(t)); return t; }
DI float* resid_row(const P& p, int gr) { return gr < NLAT ? p.out + (size_t)gr * D : (float*)(p.ws + OFF_XC) + (size_t)(gr - NLAT) * D; }
DI const float* input_row(const P& p, int gr) { return gr < NLAT ? p.x + (size_t)gr * D : p.ctx + (size_t)(gr - NLAT) * D; }
DI int mod_row(int gr) { return gr < NLAT ? gr / SL : 8; }
DI const float* mods_ptr(const P& p, int layer, int mrow) { return (const float*)(p.ws + OFF_MODS) + ((size_t)layer * 9 + mrow) * 6144; }
DI int half_gtile(int hf, int lt) { return lt < 128 ? hf * 128 + lt : 256 + hf * 8 + (lt - 128); }
DI int first_tile(int base) { int g = gridDim.x; int s = (int)blockIdx.x - (base % g); if (s < 0) s += g; return s; }
DI size_t w_off(int layer) { return (layer & 1) ? OFF_W2 : OFF_W; }
DI float lambda_init(int layer) { return 0.8f - 0.6f * expf(-0.3f * (float)layer); }

DI void phase_init(const P& p, char* smem) {
  const int tidx = opaque_tid();
  const int tid = tidx;
  float* sc = (float*)smem;
  float* mods = (float*)(p.ws + OFF_MODS);
  for (int item = blockIdx.x; item < 96; item += gridDim.x) {
    const int layer = item / 24, cb = item % 24;
    __syncthreads();
    for (int i = tid; i < 9 * 1024; i += 256) {
      int r = i >> 10, k = i & 1023;
      float v = r < 8 ? p.c[r * 1024 + k] : p.c_ctx[k];
      sc[i] = v / (1.f + expf(-v));
    }
    __syncthreads();
    const int w = tid >> 6, q = tid & 63;
    float4 acc[9];
#pragma unroll
    for (int r = 0; r < 9; r++) acc[r] = make_float4(0.f, 0.f, 0.f, 0.f);
    const float* wp = p.ada_w + (size_t)layer * 1024 * 6144 + cb * 256 + q * 4;
    for (int k = w * 256; k < w * 256 + 256; k++) {
      float4 wv = *(const float4*)(wp + (size_t)k * 6144);
#pragma unroll
      for (int r = 0; r < 9; r++) {
        float s = sc[r * 1024 + k];
        acc[r].x += s * wv.x; acc[r].y += s * wv.y; acc[r].z += s * wv.z; acc[r].w += s * wv.w;
      }
    }
    __syncthreads();
    float4* red = (float4*)smem;
#pragma unroll
    for (int r = 0; r < 9; r++) red[(w * 9 + r) * 64 + q] = acc[r];
    __syncthreads();
    for (int i = tid; i < 9 * 64; i += 256) {
      int r = i / 64, qq = i % 64;
      float4 s0 = red[(0 * 9 + r) * 64 + qq], s1 = red[(1 * 9 + r) * 64 + qq], s2 = red[(2 * 9 + r) * 64 + qq], s3 = red[(3 * 9 + r) * 64 + qq];
      float4 bb = *(const float4*)(p.ada_b + layer * 6144 + cb * 256 + qq * 4);
      float4 o = make_float4(s0.x + s1.x + s2.x + s3.x + bb.x, s0.y + s1.y + s2.y + s3.y + bb.y, s0.z + s1.z + s2.z + s3.z + bb.z, s0.w + s1.w + s2.w + s3.w + bb.w);
      *(float4*)(mods + ((size_t)layer * 9 + r) * 6144 + cb * 256 + qq * 4) = o;
    }
  }
  if (blockIdx.x == gridDim.x - 1) {
    float* misc = (float*)(p.ws + OFF_MISC);
    for (int i = tid; i < 1024; i += 256) {
      int pos = i / 16, f = i % 16;
      float inv = powf(10000.f, -(float)f / 16.f);
      float ang = (float)pos * inv;
      misc[i] = cosf(ang);
      misc[1024 + i] = sinf(ang);
    }
    misc[4096 + tid] = 0.f;
    if (tid < 2) {
      float s1 = 0.f, s2 = 0.f;
      for (int k = 0; k < 64; k++) { s1 += p.da_lq1[tid * 64 + k] * p.da_lk1[tid * 64 + k]; s2 += p.da_lq2[tid * 64 + k] * p.da_lk2[tid * 64 + k]; }
      misc[2048 + tid] = expf(s1) - expf(s2) + lambda_init(2 * tid + 1);
    }
  }
}

DI void conv_mat(const float* __restrict__ src, int K, int N, bf16_t* __restrict__ dst, int ldd, int koff, const float* __restrict__ scale,
                 int Kp, int Np, float* sm, int& base, int vb, int vg) {
  const int tidx = opaque_tid();
  const int tid = tidx;
  const int tk = Kp / 64, tn = Np / 64, nt = tk * tn;
  int t0_ = vb - (base % vg);
  if (t0_ < 0) t0_ += vg;
  for (int t = t0_; t < nt; t += vg) {
    const int k0 = (t / tn) * 64, n0 = (t % tn) * 64;
    __syncthreads();
#pragma unroll
    for (int i = 0; i < 4; i++) {
      int kr = (tid >> 4) + 16 * i, nc = (tid & 15) * 4;
      float4 v = make_float4(0.f, 0.f, 0.f, 0.f);
      if (src != nullptr && k0 + kr < K && n0 + nc < N) {
        v = *(const float4*)(src + (size_t)(k0 + kr) * N + n0 + nc);
        if (scale) { float s = scale[k0 + kr]; v.x *= s; v.y *= s; v.z *= s; v.w *= s; }
      }
      sm[kr * 65 + nc + 0] = v.x; sm[kr * 65 + nc + 1] = v.y; sm[kr * 65 + nc + 2] = v.z; sm[kr * 65 + nc + 3] = v.w;
    }
    __syncthreads();
    const int n = tid >> 2, kb = (tid & 3) * 16;
    unsigned o[8];
#pragma unroll
    for (int i = 0; i < 8; i++) o[i] = pack2(sm[(kb + 2 * i) * 65 + n], sm[(kb + 2 * i + 1) * 65 + n]);
    uint4* dp = (uint4*)(dst + (size_t)(n0 + n) * ldd + koff + k0 + kb);
    dp[0] = make_uint4(o[0], o[1], o[2], o[3]);
    dp[1] = make_uint4(o[4], o[5], o[6], o[7]);
  }
  base += nt;
}

DI void phase_conv(const P& p, int layer, char* smem, int vb, int vg) {
  if (vb < 0) return;
  float* sm = (float*)smem;
  bf16_t* W = (bf16_t*)(p.ws + w_off(layer));
  int base = 0;
  const int j = layer / 2;
  if ((layer & 1) == 0) {
    for (int s = 0; s < 3; s++) {
      const float* src = p.rw_w_rkv + ((size_t)j * 3 + s) * 1048576;
      conv_mat(src, 1024, 1024, W + W_RKV + (size_t)s * 1024 * 2048, 2048, 0, nullptr, 1024, 1024, sm, base, vb, vg);
    }
    for (int pass = 0; pass < 2; pass++) {
      const int ko = pass * 1024;
      const float* m1 = pass ? p.rw_mix + ((size_t)j * 6 + 1) * 1024 : nullptr;
      const float* m4 = pass ? p.rw_mix + ((size_t)j * 6 + 4) * 1024 : nullptr;
      const float* m5 = pass ? p.rw_mix + ((size_t)j * 6 + 5) * 1024 : nullptr;
      const float* m3 = pass ? p.rw_mix + ((size_t)j * 6 + 3) * 1024 : nullptr;
      bf16_t* L1 = W + W_L1;
      conv_mat(p.rw_w1 + ((size_t)j * 2 + 0) * 65536, 1024, 64, L1 + 0ull * 2048, 2048, ko, m1, 1024, 64, sm, base, vb, vg);
      conv_mat(p.rw_w1 + ((size_t)j * 2 + 1) * 65536, 1024, 64, L1 + 64ull * 2048, 2048, ko, m1, 1024, 64, sm, base, vb, vg);
      conv_mat(p.rw_a1 + (size_t)j * 65536, 1024, 64, L1 + 128ull * 2048, 2048, ko, m4, 1024, 64, sm, base, vb, vg);
      conv_mat(p.rw_g1 + ((size_t)j * 2 + 0) * 163840, 1024, 160, L1 + 256ull * 2048, 2048, ko, m5, 1024, 192, sm, base, vb, vg);
      conv_mat(p.rw_g1 + ((size_t)j * 2 + 1) * 163840, 1024, 160, L1 + 448ull * 2048, 2048, ko, m5, 1024, 192, sm, base, vb, vg);
      conv_mat(j > 0 ? p.rw_v1 + (size_t)(j - 1) * 32768 : nullptr, 1024, 32, L1 + 192ull * 2048, 2048, ko, m3, 1024, 64, sm, base, vb, vg);
    }
    conv_mat(p.rw_w2 + ((size_t)j * 2 + 0) * 65536, 64, 1024, W + W_W2, 64, 0, nullptr, 64, 1024, sm, base, vb, vg);
    conv_mat(p.rw_w2 + ((size_t)j * 2 + 1) * 65536, 64, 1024, W + W_W2 + 65536, 64, 0, nullptr, 64, 1024, sm, base, vb, vg);
    conv_mat(p.rw_a2 + (size_t)j * 65536, 64, 1024, W + W_A2, 64, 0, nullptr, 64, 1024, sm, base, vb, vg);
    conv_mat(p.rw_g2 + ((size_t)j * 2 + 0) * 163840, 160, 1024, W + W_G2, 192, 0, nullptr, 192, 1024, sm, base, vb, vg);
    conv_mat(p.rw_g2 + ((size_t)j * 2 + 1) * 163840, 160, 1024, W + W_G2 + 196608, 192, 0, nullptr, 192, 1024, sm, base, vb, vg);
    conv_mat(j > 0 ? p.rw_v2 + (size_t)(j - 1) * 32768 : nullptr, 32, 1024, W + W_V2, 64, 0, nullptr, 64, 1024, sm, base, vb, vg);
    conv_mat(p.rw_w_o + (size_t)j * 1048576, 1024, 1024, W + W_WO, 1024, 0, nullptr, 1024, 1024, sm, base, vb, vg);
  } else {
    conv_mat(p.da_w_qkv + (size_t)j * 3145728, 1024, 3072, W + W_QKV, 1024, 0, nullptr, 1024, 3072, sm, base, vb, vg);
    conv_mat(p.da_w_o + (size_t)j * 1048576, 1024, 1024, W + W_WO, 1024, 0, nullptr, 1024, 1024, sm, base, vb, vg);
  }
  conv_mat(p.mlp_w1 + (size_t)layer * 4194304, 1024, 4096, W + W_M1, 1024, 0, nullptr, 1024, 4096, sm, base, vb, vg);
  conv_mat(p.mlp_w2 + (size_t)layer * 4194304, 4096, 1024, W + W_M2, 4096, 0, nullptr, 4096, 1024, sm, base, vb, vg);
}

DI void phase_prep(const P& p, int layer, int sub, int hf, bool shift, bf16_t* H, int ldh, bool skip_ctx) {
  const int tidx = opaque_tid();
  const int lane = tidx & 63, wv = tidx >> 6;
  const int nrows = hf < 0 ? (skip_ctx ? NLAT : NTOK) : HROWS;
  const int nseg = nrows / 8;
  const float* ng = p.norm_g + ((size_t)layer * 2 + sub) * 1024;
  for (int seg = blockIdx.x * 4 + wv; seg < nseg; seg += gridDim.x * 4) {
    const int lr0 = seg * 8;
    const int gr0 = hf < 0 ? lr0 : (lr0 < 16384 ? hf * 16384 + lr0 : NLAT + hf * 1024 + (lr0 - 16384));
    const bool lat = gr0 < NLAT;
    const int T = lat ? SL : CL;
    const int t0 = lat ? (gr0 % SL) : ((gr0 - NLAT) % CL);
    const float* xbase = (layer == 0 && sub == 0) ? input_row(p, gr0) : resid_row(p, gr0);
    const float* md = mods_ptr(p, layer, mod_row(gr0));
    float4 g4[4], sc4[4], sh4[4];
#pragma unroll
    for (int jx = 0; jx < 4; jx++) {
      int ch = jx * 256 + lane * 4;
      g4[jx] = *(const float4*)(ng + ch);
      sh4[jx] = *(const float4*)(md + sub * 3072 + ch);
      sc4[jx] = *(const float4*)(md + sub * 3072 + 1024 + ch);
      g4[jx].x *= (1.f + sc4[jx].x); g4[jx].y *= (1.f + sc4[jx].y); g4[jx].z *= (1.f + sc4[jx].z); g4[jx].w *= (1.f + sc4[jx].w);
    }
    float4 hp[4], hc[4], hn[4];
    const int tb = shift ? -1 : 0, te = shift ? 9 : 8;
    for (int tt = tb; tt < te; tt++) {
      const int t = t0 + tt;
      if (t >= 0 && t < T) {
        const float* xr = xbase + (ptrdiff_t)tt * D;
        float ss = 0.f;
#pragma unroll
        for (int jx = 0; jx < 4; jx++) {
          hn[jx] = *(const float4*)(xr + jx * 256 + lane * 4);
          ss += hn[jx].x * hn[jx].x + hn[jx].y * hn[jx].y + hn[jx].z * hn[jx].z + hn[jx].w * hn[jx].w;
        }
        ss = wave_sum(ss);
        const float rs = rsqrtf(ss * (1.f / 1024.f) + 1e-6f);
#pragma unroll
        for (int jx = 0; jx < 4; jx++) {
          hn[jx].x = hn[jx].x * rs * g4[jx].x + sh4[jx].x; hn[jx].y = hn[jx].y * rs * g4[jx].y + sh4[jx].y;
          hn[jx].z = hn[jx].z * rs * g4[jx].z + sh4[jx].z; hn[jx].w = hn[jx].w * rs * g4[jx].w + sh4[jx].w;
        }
      } else {
#pragma unroll
        for (int jx = 0; jx < 4; jx++) hn[jx] = make_float4(0.f, 0.f, 0.f, 0.f);
      }
      if (!shift) {
        bf16_t* hr = H + (size_t)(lr0 + tt) * ldh;
#pragma unroll
        for (int jx = 0; jx < 4; jx++) *(uint2*)(hr + jx * 256 + lane * 4) = make_uint2(pack2(hn[jx].x, hn[jx].y), pack2(hn[jx].z, hn[jx].w));
      } else if (tt >= 1) {
        bf16_t* hr = H + (size_t)(lr0 + tt - 1) * ldh;
#pragma unroll
        for (int jx = 0; jx < 4; jx++) {
          *(uint2*)(hr + jx * 256 + lane * 4) = make_uint2(pack2(hc[jx].x, hc[jx].y), pack2(hc[jx].z, hc[jx].w));
          float4 xx;
          xx.x = 0.5f * (hp[jx].x + hn[jx].x) - hc[jx].x; xx.y = 0.5f * (hp[jx].y + hn[jx].y) - hc[jx].y;
          xx.z = 0.5f * (hp[jx].z + hn[jx].z) - hc[jx].z; xx.w = 0.5f * (hp[jx].w + hn[jx].w) - hc[jx].w;
          *(uint2*)(hr + 1024 + jx * 256 + lane * 4) = make_uint2(pack2(xx.x, xx.y), pack2(xx.z, xx.w));
        }
      }
#pragma unroll
      for (int jx = 0; jx < 4; jx++) { hp[jx] = hc[jx]; hc[jx] = hn[jx]; }
    }
  }
}

constexpr int LDT = 72;
DI void gemm_mainloop(const bf16_t* __restrict__ A, int lda, const bf16_t* __restrict__ Bt, int ldb, int K, char* smem, f32x16 (&acc)[2][2]) {
  const int tidx = opaque_tid();
  bf16_t* sA = (bf16_t*)smem;
  bf16_t* sB = sA + 2 * 128 * LDT;
  const int tid = tidx, lane = tid & 63, w = tid >> 6, wm = w >> 1, wn = w & 1;
  const int lrow = tid >> 3, lkc = (tid & 7) * 8;
#pragma unroll
  for (int mi = 0; mi < 2; mi++)
#pragma unroll
    for (int ni = 0; ni < 2; ni++)
#pragma unroll
      for (int r = 0; r < 16; r++) acc[mi][ni][r] = 0.f;
  const unsigned ao = (unsigned)(lrow * lda + lkc), bo = (unsigned)(lrow * ldb + lkc);
  const unsigned a32 = (unsigned)(32 * lda), b32 = (unsigned)(32 * ldb);
  uint4 ra0, ra1, ra2, ra3, rb0, rb1, rb2, rb3;
#define G_LOAD(Ab, Bb)                                                                                   \
  {                                                                                                      \
    ra0 = *(const uint4*)((Ab) + ao); ra1 = *(const uint4*)((Ab) + (ao + a32));                          \
    ra2 = *(const uint4*)((Ab) + (ao + 2 * a32)); ra3 = *(const uint4*)((Ab) + (ao + 3 * a32));          \
    rb0 = *(const uint4*)((Bb) + bo); rb1 = *(const uint4*)((Bb) + (bo + b32));                          \
    rb2 = *(const uint4*)((Bb) + (bo + 2 * b32)); rb3 = *(const uint4*)((Bb) + (bo + 3 * b32));          \
  }
#define G_STORE(sa_, sb_)                                                                                \
  {                                                                                                      \
    bf16_t* a_w = (sa_) + lrow * LDT + lkc;                                                              \
    bf16_t* b_w = (sb_) + lrow * LDT + lkc;                                                              \
    *(uint4*)(a_w) = ra0; *(uint4*)(a_w + 32 * LDT) = ra1; *(uint4*)(a_w + 64 * LDT) = ra2; *(uint4*)(a_w + 96 * LDT) = ra3; \
    *(uint4*)(b_w) = rb0; *(uint4*)(b_w + 32 * LDT) = rb1; *(uint4*)(b_w + 64 * LDT) = rb2; *(uint4*)(b_w + 96 * LDT) = rb3; \
  }
  G_LOAD(A, Bt);
  G_STORE(sA, sB);
  __syncthreads();
  const int nk = K >> 6;
  const int aoff = (wm * 64 + (lane & 31)) * LDT + (lane >> 5) * 8;
  const int boff = (wn * 64 + (lane & 31)) * LDT + (lane >> 5) * 8;
  for (int kt = 0; kt < nk; kt++) {
    const int cur = kt & 1;
    if (kt + 1 < nk) {
      const bf16_t* A1 = A + (kt + 1) * 64;
      const bf16_t* B1 = Bt + (kt + 1) * 64;
      G_LOAD(A1, B1);
    }
    __builtin_amdgcn_sched_barrier(0);
    __builtin_amdgcn_s_setprio(1);
    const bf16_t* a_s = sA + cur * 128 * LDT + aoff;
    const bf16_t* b_s = sB + cur * 128 * LDT + boff;
#pragma unroll
    for (int kk = 0; kk < 4; kk++) {
      bf16x8 af[2], bq[2];
#pragma unroll
      for (int mi = 0; mi < 2; mi++) af[mi] = *(const bf16x8*)(a_s + mi * 32 * LDT + kk * 16);
#pragma unroll
      for (int ni = 0; ni < 2; ni++) bq[ni] = *(const bf16x8*)(b_s + ni * 32 * LDT + kk * 16);
#pragma unroll
      for (int mi = 0; mi < 2; mi++)
#pragma unroll
        for (int ni = 0; ni < 2; ni++) acc[mi][ni] = MFMA32(af[mi], bq[ni], acc[mi][ni]);
    }
    __builtin_amdgcn_s_setprio(0);
    __builtin_amdgcn_sched_barrier(0);
    if (kt + 1 < nk) G_STORE(sA + (cur ^ 1) * 128 * LDT, sB + (cur ^ 1) * 128 * LDT);
    __syncthreads();
  }
}
DI uint4 mix8(const uint4 h, const uint4 x, const float4 m0, const float4 m1) {
  uint4 o;
  o.x = pack2(lo_bf(h.x) + lo_bf(x.x) * m0.x, hi_bf(h.x) + hi_bf(x.x) * m0.y);
  o.y = pack2(lo_bf(h.y) + lo_bf(x.y) * m0.z, hi_bf(h.y) + hi_bf(x.y) * m0.w);
  o.z = pack2(lo_bf(h.z) + lo_bf(x.z) * m1.x, hi_bf(h.z) + hi_bf(x.z) * m1.y);
  o.w = pack2(lo_bf(h.w) + lo_bf(x.w) * m1.z, hi_bf(h.w) + hi_bf(x.w) * m1.w);
  return o;
}
DI void gemm_mainloop_mix(const bf16_t* __restrict__ HX, const float* __restrict__ mix, const bf16_t* __restrict__ Bt, int ldb, char* smem, f32x16 (&acc)[2][2]) {
  const int tidx = opaque_tid();
  bf16_t* sA = (bf16_t*)smem;
  bf16_t* sB = sA + 2 * 128 * LDT;
  const int tid = tidx, lane = tid & 63, w = tid >> 6, wm = w >> 1, wn = w & 1;
  const int lrow = tid >> 3, lkc = (tid & 7) * 8;
#pragma unroll
  for (int mi = 0; mi < 2; mi++)
#pragma unroll
    for (int ni = 0; ni < 2; ni++)
#pragma unroll
      for (int r = 0; r < 16; r++) acc[mi][ni][r] = 0.f;
  const unsigned ao = (unsigned)(lrow * 2048 + lkc), bo = (unsigned)(lrow * ldb + lkc);
  const unsigned a32 = 32u * 2048u, b32 = (unsigned)(32 * ldb);
  uint4 h0, h1, h2, h3, x0, x1, x2, x3, rb0, rb1, rb2, rb3;
  float4 m0, m1;
#define GM_LOAD(kstep_)                                                                                  \
  {                                                                                                      \
    const bf16_t* Ab_ = HX + (kstep_) * 64;                                                              \
    const bf16_t* Bb_ = Bt + (kstep_) * 64;                                                              \
    h0 = *(const uint4*)(Ab_ + ao); h1 = *(const uint4*)(Ab_ + (ao + a32));                              \
    h2 = *(const uint4*)(Ab_ + (ao + 2 * a32)); h3 = *(const uint4*)(Ab_ + (ao + 3 * a32));              \
    x0 = *(const uint4*)(Ab_ + (ao + 1024u)); x1 = *(const uint4*)(Ab_ + (ao + a32 + 1024u));            \
    x2 = *(const uint4*)(Ab_ + (ao + 2 * a32 + 1024u)); x3 = *(const uint4*)(Ab_ + (ao + 3 * a32 + 1024u)); \
    rb0 = *(const uint4*)(Bb_ + bo); rb1 = *(const uint4*)(Bb_ + (bo + b32));                            \
    rb2 = *(const uint4*)(Bb_ + (bo + 2 * b32)); rb3 = *(const uint4*)(Bb_ + (bo + 3 * b32));            \
    m0 = *(const float4*)(mix + (kstep_) * 64 + lkc); m1 = *(const float4*)(mix + (kstep_) * 64 + lkc + 4); \
  }
#define GM_STORE(buf_)                                                                                   \
  {                                                                                                      \
    bf16_t* a_w = sA + (buf_) * 128 * LDT + lrow * LDT + lkc;                                            \
    bf16_t* b_w = sB + (buf_) * 128 * LDT + lrow * LDT + lkc;                                            \
    *(uint4*)(a_w) = mix8(h0, x0, m0, m1); *(uint4*)(a_w + 32 * LDT) = mix8(h1, x1, m0, m1);             \
    *(uint4*)(a_w + 64 * LDT) = mix8(h2, x2, m0, m1); *(uint4*)(a_w + 96 * LDT) = mix8(h3, x3, m0, m1);  \
    *(uint4*)(b_w) = rb0; *(uint4*)(b_w + 32 * LDT) = rb1; *(uint4*)(b_w + 64 * LDT) = rb2; *(uint4*)(b_w + 96 * LDT) = rb3; \
  }
  GM_LOAD(0);
  GM_STORE(0);
  __syncthreads();
  const int aoff = (wm * 64 + (lane & 31)) * LDT + (lane >> 5) * 8;
  const int boff = (wn * 64 + (lane & 31)) * LDT + (lane >> 5) * 8;
  for (int kt = 0; kt < 16; kt++) {
    const int cur = kt & 1;
    if (kt + 1 < 16) GM_LOAD(kt + 1);
    __builtin_amdgcn_sched_barrier(0);
    __builtin_amdgcn_s_setprio(1);
    const bf16_t* a_s = sA + cur * 128 * LDT + aoff;
    const bf16_t* b_s = sB + cur * 128 * LDT + boff;
#pragma unroll
    for (int kk = 0; kk < 4; kk++) {
      bf16x8 af[2], bq[2];
#pragma unroll
      for (int mi = 0; mi < 2; mi++) af[mi] = *(const bf16x8*)(a_s + mi * 32 * LDT + kk * 16);
#pragma unroll
      for (int ni = 0; ni < 2; ni++) bq[ni] = *(const bf16x8*)(b_s + ni * 32 * LDT + kk * 16);
#pragma unroll
      for (int mi = 0; mi < 2; mi++)
#pragma unroll
        for (int ni = 0; ni < 2; ni++) acc[mi][ni] = MFMA32(af[mi], bq[ni], acc[mi][ni]);
    }
    __builtin_amdgcn_s_setprio(0);
    __builtin_amdgcn_sched_barrier(0);
    if (kt + 1 < 16) GM_STORE(cur ^ 1);
    __syncthreads();
  }
}

constexpr int EST = 132;
DI void acc_to_lds(const f32x16 (&acc)[2][2], float* es) {
  const int tidx = opaque_tid();
  const int lane = tidx & 63, w = tidx >> 6, wm = w >> 1, wn = w & 1;
#pragma unroll
  for (int mi = 0; mi < 2; mi++)
#pragma unroll
    for (int ni = 0; ni < 2; ni++)
#pragma unroll
      for (int r = 0; r < 16; r++)
        es[(wm * 64 + mi * 32 + (r & 3) + 8 * (r >> 2) + 4 * (lane >> 5)) * EST + wn * 64 + ni * 32 + (lane & 31)] = acc[mi][ni][r];
}
#define EPI8_BEGIN                                                                   \
  {                                                                                  \
    float* es = (float*)smem;                                                        \
    acc_to_lds(acc, es);                                                             \
    __syncthreads();                                                                 \
    for (int pass = 0; pass < 8; pass++) {                                           \
      const int row = pass * 16 + (tidx >> 4), col = (tidx & 15) * 8;  \
      const float4 e_va = *(const float4*)(es + row * EST + col);                    \
      const float4 e_vb = *(const float4*)(es + row * EST + col + 4);                \
      float v[8] = {e_va.x, e_va.y, e_va.z, e_va.w, e_vb.x, e_vb.y, e_vb.z, e_vb.w};
#define EPI8_END                                                                     \
    }                                                                                \
    __syncthreads();                                                                 \
  }
DI uint4 pack8(const float (&v)[8]) { return make_uint4(pack2(v[0], v[1]), pack2(v[2], v[3]), pack2(v[4], v[5]), pack2(v[6], v[7])); }
DI void unpack8(const uint4 u, float (&v)[8]) {
  v[0] = lo_bf(u.x); v[1] = hi_bf(u.x); v[2] = lo_bf(u.y); v[3] = hi_bf(u.y); v[4] = lo_bf(u.z); v[5] = hi_bf(u.z); v[6] = lo_bf(u.w); v[7] = hi_bf(u.w);
}
DI void resid_update(float* xp, const float* xsrc, const float* gate, const float (&v)[8]) {
  float4 x0 = *(const float4*)xsrc, x1 = *(const float4*)(xsrc + 4);
  const float4 g0 = *(const float4*)gate, g1 = *(const float4*)(gate + 4);
  x0.x += g0.x * v[0]; x0.y += g0.y * v[1]; x0.z += g0.z * v[2]; x0.w += g0.w * v[3];
  x1.x += g1.x * v[4]; x1.y += g1.y * v[5]; x1.z += g1.z * v[6]; x1.w += g1.w * v[7];
  *(float4*)xp = x0; *(float4*)(xp + 4) = x1;
}

DI bool xcd_tile(int t, int Mt, int Nt, int& mt, int& nt) {
  const int G = gridDim.x;
  if ((G & 63) != 0 || (Nt % (G >> 6)) != 0 || (Mt & 7) != 0) {
    if (t >= Mt * Nt) return false;
    mt = t / Nt; nt = t % Nt;
    return true;
  }
  const int spx = G >> 3, tn = spx >> 3;
  const int r = t % G, round = t / G;
  const int xcd = r & 7, li = r >> 3;
  const int smn = Mt >> 3, snn = Nt / tn;
  const int st = round * 8 + xcd;
  if (st >= smn * snn) return false;
  const int smi = st % smn, sni = st / smn;
  mt = smi * 8 + (li & 7);
  nt = sni * tn + (li >> 3);
  return true;
}
DI int xcd_rounds(int Mt, int Nt) {
  const int G = gridDim.x;
  if ((G & 63) != 0 || (Nt % (G >> 6)) != 0 || (Mt & 7) != 0) return (Mt * Nt + G - 1) / G;
  const int tn = G >> 6;
  return ((Mt >> 3) * (Nt / tn) + 7) >> 3;
}

DI void phase_t1(const P& p, int layer, char* smem) {
  const int j = layer / 2;
  const int tidx = opaque_tid();
  const bf16_t* HX = (const bf16_t*)(p.ws + OFF_TR + TR_HX);
  const bf16_t* WL1 = (const bf16_t*)(p.ws + w_off(0)) + W_L1;
  bf16_t* T1 = (bf16_t*)(p.ws + OFF_TR + TR_T1);
  for (int t = blockIdx.x; t < 136 * 5; t += gridDim.x) {
    const int nt = t % 5, lt = t / 5;
    f32x16 acc[2][2];
    if (nt == 1) gemm_mainloop(HX + (size_t)lt * 128 * 2048, 2048, WL1 + (size_t)nt * 128 * 2048, 2048, 2048, smem, acc);
    else gemm_mainloop_mix(HX + (size_t)lt * 128 * 2048, p.rw_mix + ((size_t)j * 6 + (nt == 0 ? 1 : 5)) * 1024, WL1 + (size_t)nt * 128 * 2048, 2048, smem, acc);
    EPI8_BEGIN
      const int c = nt * 128 + col;
      if (c < 128) {
#pragma unroll
        for (int e = 0; e < 8; e++) v[e] = tanhf_(v[e]);
      } else if (c >= 256) {
#pragma unroll
        for (int e = 0; e < 8; e++) v[e] = sigmoidf_(v[e]);
      }
      *(uint4*)(T1 + (size_t)(lt * 128 + row) * 640 + c) = pack8(v);
    EPI8_END
  }
}

DI void phase_feat(const P& p, int layer, int hf, char* smem) {
  const int tidx = opaque_tid();
  const int j = layer / 2;
  const bf16_t* W = (const bf16_t*)(p.ws + w_off(layer));
  const bf16_t* HX = (const bf16_t*)(p.ws + OFF_TR + TR_HX);
  const bf16_t* T1 = (const bf16_t*)(p.ws + OFF_TR + TR_T1);
  bf16_t* VF = (bf16_t*)(p.ws + OFF_VF);
  for (int t = blockIdx.x; t < xcd_rounds(136, 24) * (int)gridDim.x; t += gridDim.x) {
    int lt, nt;
    if (!xcd_tile(t, 136, 24, lt, nt)) continue;
    const int s = nt / 8, n0 = (nt % 8) * 128;
    const int gt = half_gtile(hf, lt);
    f32x16 acc[2][2];
    bf16_t* outp = (bf16_t*)(p.ws + OFF_TR + (s == 0 ? TR_R : (s == 1 ? TR_K : TR_V)));
    if (s == 2 && j > 0) {
      gemm_mainloop(T1 + (size_t)lt * 128 * 640 + 192, 640, W + W_V2 + (size_t)n0 * 64, 64, 64, smem, acc);
      const float* v0 = p.rw_v0 + (size_t)(j - 1) * 1024;
      EPI8_BEGIN
        const int c = n0 + col;
#pragma unroll
        for (int e = 0; e < 8; e++) v[e] = sigmoidf_(v0[c + e] + v[e]);
        *(uint4*)(outp + (size_t)(lt * 128 + row) * 1024 + c) = pack8(v);
      EPI8_END
    }
    {
      const int mixsel = s == 0 ? 0 : (s == 1 ? 2 : 3);
      gemm_mainloop_mix(HX + (size_t)lt * 128 * 2048, p.rw_mix + ((size_t)j * 6 + mixsel) * 1024, W + W_RKV + ((size_t)s * 1024 + n0) * 2048, 2048, smem, acc);
    }
    if (s < 2) {
      EPI8_BEGIN
        *(uint4*)(outp + (size_t)(lt * 128 + row) * 1024 + n0 + col) = pack8(v);
      EPI8_END
    } else if (j == 0) {
      EPI8_BEGIN
        const uint4 u = pack8(v);
        *(uint4*)(outp + (size_t)(lt * 128 + row) * 1024 + n0 + col) = u;
        *(uint4*)(VF + (size_t)(gt * 128 + row) * 1024 + n0 + col) = u;
      EPI8_END
    } else {
      EPI8_BEGIN
        const size_t oi = (size_t)(lt * 128 + row) * 1024 + n0 + col;
        float sg[8], vf[8];
        unpack8(*(const uint4*)(outp + oi), sg);
        unpack8(*(const uint4*)(VF + (size_t)(gt * 128 + row) * 1024 + n0 + col), vf);
#pragma unroll
        for (int e = 0; e < 8; e++) v[e] = v[e] + (vf[e] - v[e]) * sg[e];
        *(uint4*)(outp + oi) = pack8(v);
      EPI8_END
    }
  }
  for (int t = blockIdx.x; t < xcd_rounds(136, 40) * (int)gridDim.x; t += gridDim.x) {
    int lt, nt;
    if (!xcd_tile(t, 136, 40, lt, nt)) continue;
    const int s = nt / 8, n0 = (nt % 8) * 128;
    f32x16 acc[2][2];
    if (s == 0) {
      gemm_mainloop(T1 + (size_t)lt * 128 * 640 + 128, 640, W + W_A2 + (size_t)n0 * 64, 64, 64, smem, acc);
      bf16_t* outp = (bf16_t*)(p.ws + OFF_TR + TR_A);
      const float* a0 = p.rw_a0 + (size_t)j * 1024;
      EPI8_BEGIN
#pragma unroll
        for (int e = 0; e < 8; e++) v[e] = sigmoidf_(a0[n0 + col + e] + v[e]);
        *(uint4*)(outp + (size_t)(lt * 128 + row) * 1024 + n0 + col) = pack8(v);
      EPI8_END
    } else if (s < 3) {
      const int d = s - 1;
      gemm_mainloop(T1 + (size_t)lt * 128 * 640 + d * 64, 640, W + W_W2 + (size_t)d * 65536 + (size_t)n0 * 64, 64, 64, smem, acc);
      bf16_t* outp = (bf16_t*)(p.ws + OFF_TR + (d ? TR_WL1 : TR_WL0));
      const float* w0 = p.rw_w0 + ((size_t)j * 2 + d) * 1024;
      EPI8_BEGIN
#pragma unroll
        for (int e = 0; e < 8; e++) v[e] = -0.60653065971263342f * sigmoidf_(w0[n0 + col + e] + v[e]);
        *(uint4*)(outp + (size_t)(lt * 128 + row) * 1024 + n0 + col) = pack8(v);
      EPI8_END
    } else {
      const int d = s - 3;
      gemm_mainloop(T1 + (size_t)lt * 128 * 640 + 256 + d * 192, 640, W + W_G2 + (size_t)d * 196608 + (size_t)n0 * 192, 192, 192, smem, acc);
      bf16_t* outp = (bf16_t*)(p.ws + OFF_TR + (d ? TR_G1 : TR_G0));
      EPI8_BEGIN
        *(uint4*)(outp + (size_t)(lt * 128 + row) * 1024 + n0 + col) = pack8(v);
      EPI8_END
    }
  }
}

DI int scan_row(int bl, int dir, int pos) {
  if (pos < CL) { int t = dir ? (CL - 1 - pos) : pos; return 16384 + bl * CL + t; }
  int t = pos - CL; if (dir) t = SL - 1 - t;
  return bl * SL + t;
}

DI void phase_scan(const P& p, int layer, char* smem) {
  const int tidx = opaque_tid();
  const int j = layer / 2;
  const int tid = tidx;
  const bf16_t* R = (const bf16_t*)(p.ws + OFF_TR + TR_R);
  const bf16_t* Kx = (const bf16_t*)(p.ws + OFF_TR + TR_K);
  const bf16_t* V = (const bf16_t*)(p.ws + OFF_TR + TR_V);
  const bf16_t* Aa = (const bf16_t*)(p.ws + OFF_TR + TR_A);
  float* sbuf = (float*)smem;
  constexpr int BUFF = 5 * 16 * 64 + 512;
  constexpr int POP = 144;
  float* pobuf = sbuf + 2 * BUFF;
  const int ss = tid >> 4, c4 = tid & 15;
  const int rl = tid >> 4, cg = tid & 15;
  for (int item = blockIdx.x; item < 256; item += gridDim.x) {
    const int q2 = item & 1, dir = (item >> 1) & 1, head = (item >> 2) & 15, bl = item >> 6;
    const bf16_t* WL = (const bf16_t*)(p.ws + OFF_TR + (dir ? TR_WL1 : TR_WL0));
    bf16_t* O = (bf16_t*)(p.ws + OFF_TR + TR_HX) + (dir ? (size_t)HROWS * 1024 : 0);
    const int ch = head * 64 + c4 * 4;
    const float4 kkw = *(const float4*)(p.rw_kk + (size_t)j * 1024 + ch);
    const float4 kaw = *(const float4*)(p.rw_ka + (size_t)j * 1024 + ch);
    fv2 SA01 = {0.f, 0.f}, SA23 = {0.f, 0.f}, SB01 = {0.f, 0.f}, SB23 = {0.f, 0.f};
    uint2 gr_, gk_, ga_, gw_, gv_;
    gv_ = make_uint2(0, 0);
#define SC_ISSUE(chunk_)                                                                   \
    {                                                                                      \
      const size_t ro = (size_t)scan_row(bl, dir, (chunk_) * 16 + ss) * 1024;              \
      gr_ = *(const uint2*)(R + ro + ch); gk_ = *(const uint2*)(Kx + ro + ch);             \
      ga_ = *(const uint2*)(Aa + ro + ch); gw_ = *(const uint2*)(WL + ro + ch);            \
      if (c4 < 8) gv_ = *(const uint2*)(V + ro + head * 64 + q2 * 32 + c4 * 4);            \
    }
#define SC_STAGE(buf_)                                                                     \
    {                                                                                      \
      float* sb_ = sbuf + (buf_) * BUFF;                                                   \
      float r0 = lo_bf(gr_.x), r1 = hi_bf(gr_.x), r2 = lo_bf(gr_.y), r3 = hi_bf(gr_.y);    \
      float k0 = lo_bf(gk_.x), k1 = hi_bf(gk_.x), k2 = lo_bf(gk_.y), k3 = hi_bf(gk_.y);    \
      float a0 = lo_bf(ga_.x), a1 = hi_bf(ga_.x), a2 = lo_bf(ga_.y), a3 = hi_bf(ga_.y);    \
      float w0 = lo_bf(gw_.x), w1 = hi_bf(gw_.x), w2 = lo_bf(gw_.y), w3 = hi_bf(gw_.y);    \
      float u0 = k0 * kkw.x, u1 = k1 * kkw.y, u2 = k2 * kkw.z, u3 = k3 * kkw.w;            \
      float sq = rowsum16(u0 * u0 + u1 * u1 + u2 * u2 + u3 * u3);                          \
      float inv = rsqrtf(fmaxf(sq, 1e-24f));                                               \
      u0 *= inv; u1 *= inv; u2 *= inv; u3 *= inv;                                          \
      const int o_ = ss * 64 + c4 * 4;                                                     \
      *(float4*)(sb_ + 0 * 1024 + o_) = make_float4(__expf(w0), __expf(w1), __expf(w2), __expf(w3)); \
      *(float4*)(sb_ + 1 * 1024 + o_) = make_float4(k0 * (1.f + (a0 - 1.f) * kaw.x), k1 * (1.f + (a1 - 1.f) * kaw.y), k2 * (1.f + (a2 - 1.f) * kaw.z), k3 * (1.f + (a3 - 1.f) * kaw.w)); \
      *(float4*)(sb_ + 2 * 1024 + o_) = make_float4(-u0, -u1, -u2, -u3);                   \
      *(float4*)(sb_ + 3 * 1024 + o_) = make_float4(u0 * a0, u1 * a1, u2 * a2, u3 * a3);   \
      *(float4*)(sb_ + 4 * 1024 + o_) = make_float4(r0, r1, r2, r3);                       \
      if (c4 < 8) *(float4*)(sb_ + 5 * 1024 + ss * 32 + c4 * 4) = make_float4(lo_bf(gv_.x), hi_bf(gv_.x), lo_bf(gv_.y), hi_bf(gv_.y)); \
    }
    __syncthreads();
    SC_ISSUE(0);
    SC_STAGE(0);
    __syncthreads();
    constexpr int NCH = TK / 16;
    float* po_wa = pobuf + rl * POP + cg;
    float* po_wb = pobuf + (rl + 16) * POP + cg;
    const float* po_r = pobuf + (rl + 16 * (cg >> 3)) * POP + (cg & 7) * 16;
    for (int chunk = 0; chunk < NCH; chunk++) {
      const int buf = chunk & 1;
      if (chunk + 1 < NCH) SC_ISSUE(chunk + 1);
      __builtin_amdgcn_sched_barrier(0);
      const float* sb = sbuf + buf * BUFF + cg * 4;
      const float* sv = sbuf + buf * BUFF + 5 * 1024 + rl;
      float4 w4 = *(const float4*)(sb + 0 * 1024), k4 = *(const float4*)(sb + 1 * 1024), n4 = *(const float4*)(sb + 2 * 1024);
      float4 b4 = *(const float4*)(sb + 3 * 1024), r4 = *(const float4*)(sb + 4 * 1024);
      float va = sv[0], vb = sv[16];
#pragma unroll
      for (int s = 0; s < 16; s++) {
        float4 w4n = w4, k4n = k4, n4n = n4, b4n = b4, r4n = r4;
        float van = va, vbn = vb;
        if (s + 1 < 16) {
          w4n = *(const float4*)(sb + 0 * 1024 + (s + 1) * 64); k4n = *(const float4*)(sb + 1 * 1024 + (s + 1) * 64);
          n4n = *(const float4*)(sb + 2 * 1024 + (s + 1) * 64); b4n = *(const float4*)(sb + 3 * 1024 + (s + 1) * 64);
          r4n = *(const float4*)(sb + 4 * 1024 + (s + 1) * 64); van = sv[(s + 1) * 32]; vbn = sv[(s + 1) * 32 + 16];
        }
        const fv2 w01 = {w4.x, w4.y}, w23 = {w4.z, w4.w}, k01 = {k4.x, k4.y}, k23 = {k4.z, k4.w}, n01 = {n4.x, n4.y}, n23 = {n4.z, n4.w};
        const fv2 b01 = {b4.x, b4.y}, b23 = {b4.z, b4.w}, r01 = {r4.x, r4.y}, r23 = {r4.z, r4.w};
        const fv2 va2 = {va, va}, vb2 = {vb, vb};
        const fv2 vka01 = va2 * k01, vka23 = va2 * k23, vkb01 = vb2 * k01, vkb23 = vb2 * k23;
        fv2 ppa = SA01 * n01, ppb = SB01 * n01;
        ppa = __builtin_elementwise_fma(SA23, n23, ppa);
        ppb = __builtin_elementwise_fma(SB23, n23, ppb);
        float saa = ppa.x + ppa.y, sab = ppb.x + ppb.y;
        saa = ror_add<8>(saa); sab = ror_add<8>(sab);
        saa = ror_add<4>(saa); sab = ror_add<4>(sab);
        saa = ror_add<2>(saa); sab = ror_add<2>(sab);
        saa = ror_add<1>(saa); sab = ror_add<1>(sab);
        const fv2 saa2 = {saa, saa}, sab2 = {sab, sab};
        const fv2 ta01 = __builtin_elementwise_fma(saa2, b01, vka01), ta23 = __builtin_elementwise_fma(saa2, b23, vka23);
        const fv2 tb01 = __builtin_elementwise_fma(sab2, b01, vkb01), tb23 = __builtin_elementwise_fma(sab2, b23, vkb23);
        SA01 = __builtin_elementwise_fma(SA01, w01, ta01);
        SA23 = __builtin_elementwise_fma(SA23, w23, ta23);
        SB01 = __builtin_elementwise_fma(SB01, w01, tb01);
        SB23 = __builtin_elementwise_fma(SB23, w23, tb23);
        fv2 qa = SA01 * r01, qb = SB01 * r01;
        qa = __builtin_elementwise_fma(SA23, r23, qa);
        qb = __builtin_elementwise_fma(SB23, r23, qb);
        po_wa[(s & 7) * 16] = qa.x + qa.y;
        po_wb[(s & 7) * 16] = qb.x + qb.y;
        w4 = w4n; k4 = k4n; n4 = n4n; b4 = b4n; r4 = r4n; va = van; vb = vbn;
        __builtin_amdgcn_sched_barrier(0);
        if ((s & 7) == 7) {
          const float4 p0 = *(const float4*)(po_r), p1 = *(const float4*)(po_r + 4), p2 = *(const float4*)(po_r + 8), p3 = *(const float4*)(po_r + 12);
          const float ov = ((p0.x + p0.y) + (p0.z + p0.w)) + ((p1.x + p1.y) + (p1.z + p1.w)) + ((p2.x + p2.y) + (p2.z + p2.w)) + ((p3.x + p3.y) + (p3.z + p3.w));
          const size_t ro = (size_t)scan_row(bl, dir, chunk * 16 + (s & 8) + (cg & 7)) * 1024;
          O[ro + head * 64 + q2 * 32 + rl + 16 * (cg >> 3)] = f2bf(ov);
          __builtin_amdgcn_sched_barrier(0);
        }
      }
      if (chunk + 1 < NCH) SC_STAGE(buf ^ 1);
      __syncthreads();
    }
  }
}

DI void phase_combine(const P& p, int layer) {
  const int tidx = opaque_tid();
  const int j = layer / 2;
  const bf16_t* Of = (const bf16_t*)(p.ws + OFF_TR + TR_HX);
  const bf16_t* Ob = Of + (size_t)HROWS * 1024;
  const bf16_t* R = (const bf16_t*)(p.ws + OFF_TR + TR_R);
  const bf16_t* Kx = (const bf16_t*)(p.ws + OFF_TR + TR_K);
  const bf16_t* V = (const bf16_t*)(p.ws + OFF_TR + TR_V);
  const bf16_t* Aa = (const bf16_t*)(p.ws + OFF_TR + TR_A);
  bf16_t* G0 = (bf16_t*)(p.ws + OFF_TR + TR_G0);
  const bf16_t* G1 = (const bf16_t*)(p.ws + OFF_TR + TR_G1);
  const size_t total = (size_t)HROWS * 128;
  for (size_t i = (size_t)blockIdx.x * 256 + tidx; i < total; i += (size_t)gridDim.x * 256) {
    const int c0 = (int)(i & 127) * 8;
    const size_t off = (i >> 7) * 1024 + c0;
    const uint4 uof = *(const uint4*)(Of + off), uob = *(const uint4*)(Ob + off), ur = *(const uint4*)(R + off), uk = *(const uint4*)(Kx + off);
    const uint4 ua = *(const uint4*)(Aa + off), uv = *(const uint4*)(V + off), ug0 = *(const uint4*)(G0 + off), ug1 = *(const uint4*)(G1 + off);
    const unsigned aof[4] = {uof.x, uof.y, uof.z, uof.w}, aob[4] = {uob.x, uob.y, uob.z, uob.w}, ar[4] = {ur.x, ur.y, ur.z, ur.w}, ak[4] = {uk.x, uk.y, uk.z, uk.w};
    const unsigned aa[4] = {ua.x, ua.y, ua.z, ua.w}, av[4] = {uv.x, uv.y, uv.z, uv.w}, ag0[4] = {ug0.x, ug0.y, ug0.z, ug0.w}, ag1[4] = {ug1.x, ug1.y, ug1.z, ug1.w};
    const float* ka = p.rw_ka + (size_t)j * 1024 + c0;
    const float* rk = p.rw_rk + (size_t)j * 1024 + c0;
    const float* lg = p.rw_ln_g + (size_t)j * 1024 + c0;
    const float* lb = p.rw_ln_b + (size_t)j * 1024 + c0;
    float of[8], obv[8];
    float sf = 0.f, sf2 = 0.f, sb = 0.f, sb2 = 0.f, br = 0.f;
#pragma unroll
    for (int e = 0; e < 8; e++) {
      const int w = e >> 1;
      of[e] = (e & 1) ? hi_bf(aof[w]) : lo_bf(aof[w]);
      obv[e] = (e & 1) ? hi_bf(aob[w]) : lo_bf(aob[w]);
      const float r = (e & 1) ? hi_bf(ar[w]) : lo_bf(ar[w]);
      const float k = (e & 1) ? hi_bf(ak[w]) : lo_bf(ak[w]);
      const float a = (e & 1) ? hi_bf(aa[w]) : lo_bf(aa[w]);
      sf += of[e]; sf2 += of[e] * of[e]; sb += obv[e]; sb2 += obv[e] * obv[e];
      br += r * k * (1.f + (a - 1.f) * ka[e]) * rk[e];
    }
#pragma unroll
    for (int o = 1; o < 8; o <<= 1) { sf += __shfl_xor(sf, o); sf2 += __shfl_xor(sf2, o); sb += __shfl_xor(sb, o); sb2 += __shfl_xor(sb2, o); br += __shfl_xor(br, o); }
    const float muf = sf * (1.f / 64.f), mub = sb * (1.f / 64.f);
    const float rsf = rsqrtf(fmaxf(sf2 * (1.f / 64.f) - muf * muf, 0.f) + 64e-5f);
    const float rsb = rsqrtf(fmaxf(sb2 * (1.f / 64.f) - mub * mub, 0.f) + 64e-5f);
    float y[8];
#pragma unroll
    for (int e = 0; e < 8; e++) {
      const int w = e >> 1;
      const float v = (e & 1) ? hi_bf(av[w]) : lo_bf(av[w]);
      const float g0 = (e & 1) ? hi_bf(ag0[w]) : lo_bf(ag0[w]);
      const float g1 = (e & 1) ? hi_bf(ag1[w]) : lo_bf(ag1[w]);
      const float bonus = br * v;
      y[e] = ((of[e] - muf) * rsf * lg[e] + lb[e] + bonus) * g0 + ((obv[e] - mub) * rsb * lg[e] + lb[e] + bonus) * g1;
    }
    *(uint4*)(G0 + off) = make_uint4(pack2(y[0], y[1]), pack2(y[2], y[3]), pack2(y[4], y[5]), pack2(y[6], y[7]));
  }
}

DI void phase_rw_out(const P& p, int layer, int hf, char* smem) {
  const int tidx = opaque_tid();
  const bf16_t* Y = (const bf16_t*)(p.ws + OFF_TR + TR_G0);
  const bf16_t* WO = (const bf16_t*)(p.ws + w_off(layer)) + W_WO;
  const int nlt = (layer == 3) ? 128 : 136;
  for (int t = blockIdx.x; t < xcd_rounds(nlt, 8) * (int)gridDim.x; t += gridDim.x) {
    int lt, nt_;
    if (!xcd_tile(t, nlt, 8, lt, nt_)) continue;
    const int n0 = nt_ * 128;
    const int gt = half_gtile(hf, lt);
    f32x16 acc[2][2];
    gemm_mainloop(Y + (size_t)lt * 128 * 1024, 1024, WO + (size_t)n0 * 1024, 1024, 1024, smem, acc);
    const float* gate = mods_ptr(p, layer, mod_row(gt * 128)) + 2048 + n0;
    float* xr = resid_row(p, gt * 128) + n0;
    const float* xs = layer == 0 ? input_row(p, gt * 128) + n0 : xr;
    EPI8_BEGIN
      resid_update(xr + (size_t)row * D + col, xs + (size_t)row * D + col, gate + col, v);
    EPI8_END
  }
}

DI void phase_mlp1(const P& p, int layer, char* smem) {
  const int tidx = opaque_tid();
  const bf16_t* H2 = (const bf16_t*)(p.ws + OFF_TR + TR_H2);
  const bf16_t* W1 = (const bf16_t*)(p.ws + w_off(layer)) + W_M1;
  bf16_t* HID = (bf16_t*)(p.ws + OFF_TR + TR_HID);
  const int nmt = (layer == 3) ? 256 : 272;
  const int ngrp = nmt / 16;
  (void)ngrp;
  for (int t = blockIdx.x; t < xcd_rounds(nmt, 32) * (int)gridDim.x; t += gridDim.x) {
    int gt, nt;
    if (!xcd_tile(t, nmt, 32, gt, nt)) continue;
    f32x16 acc[2][2];
    gemm_mainloop(H2 + (size_t)gt * 128 * 1024, 1024, W1 + (size_t)nt * 128 * 1024, 1024, 1024, smem, acc);
    EPI8_BEGIN
#pragma unroll
      for (int e = 0; e < 8; e++) { const float rl = fmaxf(v[e], 0.f); v[e] = rl * rl; }
      *(uint4*)(HID + (size_t)(gt * 128 + row) * 4096 + nt * 128 + col) = pack8(v);
    EPI8_END
  }
}
DI void phase_mlp2(const P& p, int layer, char* smem) {
  const int tidx = opaque_tid();
  const bf16_t* HID = (const bf16_t*)(p.ws + OFF_TR + TR_HID);
  const bf16_t* W2 = (const bf16_t*)(p.ws + w_off(layer)) + W_M2;
  const int nmt = (layer == 3) ? 256 : 272;
  for (int t = blockIdx.x; t < xcd_rounds(nmt, 8) * (int)gridDim.x; t += gridDim.x) {
    int gt, nt_;
    if (!xcd_tile(t, nmt, 8, gt, nt_)) continue;
    const int n0 = nt_ * 128;
    f32x16 acc[2][2];
    gemm_mainloop(HID + (size_t)gt * 128 * 4096, 4096, W2 + (size_t)n0 * 4096, 4096, 4096, smem, acc);
    const float* gate = mods_ptr(p, layer, mod_row(gt * 128)) + 5120 + n0;
    float* xr = resid_row(p, gt * 128) + n0;
    EPI8_BEGIN
      resid_update(xr + (size_t)row * D + col, xr + (size_t)row * D + col, gate + col, v);
    EPI8_END
  }
}

DI void phase_qkv(const P& p, int layer, char* smem) {
  const int tidx = opaque_tid();
  const bf16_t* H = (const bf16_t*)(p.ws + OFF_TR + TR_H);
  const bf16_t* WQ = (const bf16_t*)(p.ws + w_off(layer)) + W_QKV;
  bf16_t* Q = (bf16_t*)(p.ws + OFF_TR + TR_Q);
  bf16_t* Kb = (bf16_t*)(p.ws + OFF_TR + TR_KK);
  bf16_t* VT = (bf16_t*)(p.ws + OFF_TR + TR_VT);
  const float* cosT = (const float*)(p.ws + OFF_MISC);
  const float* sinT = cosT + 1024;
  for (int t = blockIdx.x; t < xcd_rounds(272, 24) * (int)gridDim.x; t += gridDim.x) {
    int gt, nt;
    if (!xcd_tile(t, 272, 24, gt, nt)) continue;
    f32x16 acc[2][2];
    gemm_mainloop(H + (size_t)gt * 128 * 1024, 1024, WQ + (size_t)nt * 128 * 1024, 1024, 1024, smem, acc);
    const bool lat = gt < 256;
    const int b = lat ? gt / 32 : (gt - 256) / 2;
    const int t0 = lat ? (gt % 32) * 128 : (gt - 256) % 2 * 128;
    const int tq0 = lat ? t0 : SL + t0;
    const int typ = nt / 8, h = nt % 8;
    if (typ < 2) {
      bf16_t* dst = typ == 0 ? Q : Kb;
      const float qs = typ == 0 ? 0.125f * 1.44269504088896f : 1.f;
      float kmx = 0.f;
      EPI8_BEGIN
        const int sidx = col >> 6, d0 = col & 63;
        if (lat) {
          const float4 pa = *(const float4*)(es + row * EST + (col ^ 16));
          const float4 pb = *(const float4*)(es + row * EST + (col ^ 16) + 4);
          const float pr[8] = {pa.x, pa.y, pa.z, pa.w, pb.x, pb.y, pb.z, pb.w};
          const int tt = t0 + row;
          const int pos = (d0 < 32) ? (tt >> 6) : (tt & 63);
          const float4 ca = *(const float4*)(cosT + pos * 16 + (d0 & 8)), cb = *(const float4*)(cosT + pos * 16 + (d0 & 8) + 4);
          const float4 sa = *(const float4*)(sinT + pos * 16 + (d0 & 8)), sb = *(const float4*)(sinT + pos * 16 + (d0 & 8) + 4);
          const float cs[8] = {ca.x, ca.y, ca.z, ca.w, cb.x, cb.y, cb.z, cb.w};
          const float sn[8] = {sa.x, sa.y, sa.z, sa.w, sb.x, sb.y, sb.z, sb.w};
          const float sgn = (d0 & 16) ? 1.f : -1.f;
#pragma unroll
          for (int e = 0; e < 8; e++) v[e] = v[e] * cs[e] + sgn * pr[e] * sn[e];
        }
#pragma unroll
        for (int e = 0; e < 8; e++) v[e] *= qs;
        const uint4 pk_ = pack8(v);
        *(uint4*)(dst + ((size_t)((b * 8 + h) * 2 + sidx) * TK + tq0 + row) * 64 + d0) = pk_;
        if (typ == 1) {
          float rv_[8];
          unpack8(pk_, rv_);
          float ssq_ = 0.f;
#pragma unroll
          for (int e = 0; e < 8; e++) ssq_ += rv_[e] * rv_[e];
          ssq_ += __shfl_xor(ssq_, 1); ssq_ += __shfl_xor(ssq_, 2); ssq_ += __shfl_xor(ssq_, 4);
          kmx = fmaxf(kmx, ssq_);
        }
      EPI8_END
      if (typ == 1) {
        kmx = fmaxf(kmx, __shfl_xor(kmx, 16));
        kmx = fmaxf(kmx, __shfl_xor(kmx, 32));
        if ((tidx & 55) == 0)
          atomicMax((unsigned*)(p.ws + OFF_MISC) + 4096 + (layer >> 1) * 128 + (b * 8 + h) * 2 + ((tidx >> 3) & 1), __float_as_uint(kmx));
      }
    } else {
      float* es = (float*)smem;
      acc_to_lds(acc, es);
      __syncthreads();
      for (int pass = 0; pass < 8; pass++) {
        const int d = tidx & 127, tg = pass * 2 + (tidx >> 7);
        float v[8];
#pragma unroll
        for (int e = 0; e < 8; e++) v[e] = es[(tg * 8 + e) * EST + d];
        *(uint4*)(VT + ((size_t)(b * 8 + h) * 128 + d) * TK + tq0 + tg * 8) = pack8(v);
      }
      __syncthreads();
    }
  }
}

typedef _Float16 hv2 __attribute__((ext_vector_type(2)));
DI unsigned packh2(float a, float b) { hv2 r = {(_Float16)a, (_Float16)b}; return __builtin_bit_cast(unsigned, r); }
DI float lo_h(unsigned u) { hv2 r = __builtin_bit_cast(hv2, u); return (float)r[0]; }
DI float hi_h(unsigned u) { hv2 r = __builtin_bit_cast(hv2, u); return (float)r[1]; }

DI void phase_attn(const P& p, int layer, char* smem) {
  const int tidx = opaque_tid();
  const int j = layer / 2;
  const bool ctxq = layer != 3;
  const bf16_t* Q = (const bf16_t*)(p.ws + OFF_TR + TR_Q);
  const bf16_t* Kb = (const bf16_t*)(p.ws + OFF_TR + TR_KK);
  const bf16_t* VT = (const bf16_t*)(p.ws + OFF_TR + TR_VT);
  bf16_t* O = (bf16_t*)(p.ws + OFF_TR + TR_H);
  const float lam = ((const float*)(p.ws + OFF_MISC))[2048 + j];
  const float* kmax2 = (const float*)(p.ws + OFF_MISC) + 4096 + j * 128;
  const float oml = 1.f - lambda_init(layer);
  const float* subg = p.da_subln_g + (size_t)j * 128;
  constexpr int LDV = 72;
  bf16_t* sK = (bf16_t*)smem;
  bf16_t* sV = sK + 2 * 64 * LDT;
  const int tid = tidx, lane = tid & 63, w = tid >> 6, g = lane >> 5, l31 = lane & 31;
  const int nitems = 2048 + (ctxq ? 128 : 0);
  const int spx = gridDim.x >> 3, gpr = spx >> 5;
  const bool xmap = (gridDim.x == 256u || gridDim.x == 512u);
  const int lat_rounds = xmap ? 64 / (8 * gpr) : (2048 + (int)gridDim.x - 1) / (int)gridDim.x;
  for (int it0 = blockIdx.x; it0 < lat_rounds * (int)gridDim.x + (ctxq ? 128 : 0); it0 += gridDim.x) {
    int item;
    if (!xmap) {
      item = it0 < lat_rounds * (int)gridDim.x ? it0 : 2048 + (it0 - lat_rounds * (int)gridDim.x);
      if (it0 < lat_rounds * (int)gridDim.x && it0 >= 2048) continue;
    } else if (it0 < lat_rounds * (int)gridDim.x) {
      const int r = it0 % (int)gridDim.x, round = it0 / (int)gridDim.x;
      const int xcd = r & 7, li = r >> 3;
      const int bh = (round * 8 + xcd) * gpr + (li >> 5);
      item = bh * 32 + (li & 31);
    } else {
      item = 2048 + (it0 - lat_rounds * (int)gridDim.x);
    }
    (void)nitems;
    int b, h, q0, kbeg, ntiles;
    if (item < 2048) { b = item >> 8; h = (item >> 5) & 7; q0 = (item & 31) * 128; kbeg = 0; ntiles = TK / 64; }
    else { const int it = item - 2048; b = it >> 4; h = (it >> 1) & 7; q0 = SL + (it & 1) * 128; kbeg = SL; ntiles = CL / 64; }
    const bf16_t* Vp0 = VT + (size_t)(b * 8 + h) * 128 * TK;
    const int tq = q0 + w * 32 + l31;
    const size_t grow = tq < SL ? (size_t)b * SL + tq : (size_t)NLAT + (size_t)b * CL + (tq - SL);
    bf16_t* op = O + grow * 1024 + h * 128;
    for (int s = 0; s < 2; s++) {
      const bf16_t* Kp0 = Kb + (size_t)((b * 8 + h) * 2 + s) * TK * 64;
      const bf16_t* Qp = Q + ((size_t)((b * 8 + h) * 2 + s) * TK + tq) * 64 + g * 8;
      bf16x8 qf[4];
      float qss = 0.f;
#pragma unroll
      for (int kk = 0; kk < 4; kk++) {
        const uint4 u = *(const uint4*)(Qp + kk * 16);
        qf[kk] = __builtin_bit_cast(bf16x8, u);
        float qv[8];
        unpack8(u, qv);
#pragma unroll
        for (int e = 0; e < 8; e++) qss += qv[e] * qv[e];
      }
      qss += __shfl_xor(qss, 32);
      const float nmq = -sqrtf(qss * kmax2[(b * 8 + h) * 2 + s]);
      f32x16 o[4];
#pragma unroll
      for (int db = 0; db < 4; db++)
#pragma unroll
        for (int r = 0; r < 16; r++) o[db][r] = 0.f;
      float l = 0.f;
      uint4 rk0, rk1, rv0, rv1, rv2, rv3;
      const unsigned kvo = (unsigned)((tid >> 3) * 64 + (tid & 7) * 8);
      const unsigned vvo = (unsigned)((tid >> 3) * TK + (tid & 7) * 8);
      const unsigned sko = (unsigned)((tid >> 3) * LDT + (tid & 7) * 8);
      const unsigned svo = (unsigned)((tid >> 3) * LDV + ((tid & 7) >> 1) * 16 + (tid & 1) * 4);
#define ISSUE_KV(kt_)                                                             \
      {                                                                           \
        const bf16_t* kb_ = Kp0 + (size_t)(kbeg + (kt_) * 64) * 64;               \
        const bf16_t* vb_ = Vp0 + (kbeg + (kt_) * 64);                            \
        unsigned kvo_ = kvo, vvo_ = vvo;                                          \
        asm volatile("" : "+v"(kvo_), "+v"(vvo_));     \
        rk0 = *(const uint4*)(kb_ + kvo_);                                        \
        rk1 = *(const uint4*)(kb_ + (kvo_ + 32u * 64u));                          \
        rv0 = *(const uint4*)(vb_ + vvo_);                                        \
        rv1 = *(const uint4*)(vb_ + (vvo_ + 32u * (unsigned)TK));                 \
        rv2 = *(const uint4*)(vb_ + (vvo_ + 64u * (unsigned)TK));                 \
        rv3 = *(const uint4*)(vb_ + (vvo_ + 96u * (unsigned)TK));                 \
      }
#define ST_V(ptr_, r_) { *(uint2*)(ptr_) = make_uint2(r_.x, r_.y); *(uint2*)((ptr_) + 8) = make_uint2(r_.z, r_.w); }
#define STAGE_KV(buf_)                                                            \
      {                                                                           \
        bf16_t* ks_ = sK + (buf_) * 64 * LDT + sko;                               \
        bf16_t* vs_ = sV + (buf_) * 128 * LDV + svo;                              \
        *(uint4*)(ks_) = rk0;                                                     \
        *(uint4*)(ks_ + 32 * LDT) = rk1;                                          \
        ST_V(vs_, rv0); ST_V(vs_ + 32 * LDV, rv1); ST_V(vs_ + 64 * LDV, rv2); ST_V(vs_ + 96 * LDV, rv3); \
      }
      __syncthreads();
      ISSUE_KV(0);
      STAGE_KV(0);
      __syncthreads();
      for (int kt = 0; kt < ntiles; kt++) {
        const int buf = kt & 1;
        const bool more = kt + 1 < ntiles;
        if (more) ISSUE_KV(kt + 1);
        __builtin_amdgcn_sched_barrier(0);
        const bf16_t* kS = sK + buf * 64 * LDT;
        const bf16_t* vS = sV + buf * 128 * LDV;
#pragma unroll
        for (int kb = 0; kb < 2; kb++) {
          bf16x8 kf[4];
#pragma unroll
          for (int kk = 0; kk < 4; kk++) kf[kk] = *(const bf16x8*)(kS + (kb * 32 + l31) * LDT + kk * 16 + g * 8);
          __builtin_amdgcn_sched_barrier(0);
          f32x16 st;
#pragma unroll
          for (int r = 0; r < 16; r++) st[r] = nmq;
#pragma unroll
          for (int kk = 0; kk < 4; kk++) st = MFMA32(kf[kk], qf[kk], st);
          uint4 vf0[4];
#pragma unroll
          for (int db = 0; db < 4; db++) {
            vf0[db] = *(const uint4*)(vS + (db * 32 + l31) * LDV + kb * 32 + 8 * g);
          }
          __builtin_amdgcn_sched_barrier(0);
          float ls = 0.f;
          bf16x8 pk[2];
#pragma unroll
          for (int hh = 0; hh < 2; hh++) {
            float e[8];
#pragma unroll
            for (int i = 0; i < 8; i++) { e[i] = __builtin_amdgcn_exp2f(st[hh * 8 + i]); ls += e[i]; }
            const uint4 u = make_uint4(pack2(e[0], e[1]), pack2(e[2], e[3]), pack2(e[4], e[5]), pack2(e[6], e[7]));
            pk[hh] = __builtin_bit_cast(bf16x8, u);
          }
          l += ls;
          uint4 vf1[4];
#pragma unroll
          for (int db = 0; db < 4; db++) {
            vf1[db] = *(const uint4*)(vS + (db * 32 + l31) * LDV + kb * 32 + 16 + 8 * g);
          }
          __builtin_amdgcn_sched_barrier(0);
#pragma unroll
          for (int db = 0; db < 4; db++) o[db] = MFMA32(__builtin_bit_cast(bf16x8, vf0[db]), pk[0], o[db]);
#pragma unroll
          for (int db = 0; db < 4; db++) o[db] = MFMA32(__builtin_bit_cast(bf16x8, vf1[db]), pk[1], o[db]);
        }
        __builtin_amdgcn_sched_barrier(0);
        if (more) STAGE_KV(buf ^ 1);
        __syncthreads();
      }
      const float lt = l + __shfl_xor(l, 32);
      if (s == 0) {
        const float inv = 1.f / lt;
#pragma unroll
        for (int db = 0; db < 4; db++)
#pragma unroll
          for (int rq = 0; rq < 4; rq++) {
            const int d = db * 32 + 8 * rq + 4 * g;
            *(uint2*)(op + d) = make_uint2(packh2(o[db][4 * rq] * inv, o[db][4 * rq + 1] * inv), packh2(o[db][4 * rq + 2] * inv, o[db][4 * rq + 3] * inv));
          }
      } else {
        const float inv = lam / lt;
        float ssq = 0.f;
#pragma unroll
        for (int db = 0; db < 4; db++)
#pragma unroll
          for (int rq = 0; rq < 4; rq++) {
            const int d = db * 32 + 8 * rq + 4 * g;
            const uint2 u0 = *(const uint2*)(op + d);
            const float a0 = lo_h(u0.x) - o[db][4 * rq] * inv, a1 = hi_h(u0.x) - o[db][4 * rq + 1] * inv;
            const float a2 = lo_h(u0.y) - o[db][4 * rq + 2] * inv, a3 = hi_h(u0.y) - o[db][4 * rq + 3] * inv;
            o[db][4 * rq] = a0; o[db][4 * rq + 1] = a1; o[db][4 * rq + 2] = a2; o[db][4 * rq + 3] = a3;
            ssq += a0 * a0 + a1 * a1 + a2 * a2 + a3 * a3;
          }
        ssq += __shfl_xor(ssq, 32);
        const float rs = rsqrtf(ssq * (1.f / 128.f) + 1e-5f) * oml;
#pragma unroll
        for (int db = 0; db < 4; db++)
#pragma unroll
          for (int rq = 0; rq < 4; rq++) {
            const int d = db * 32 + 8 * rq + 4 * g;
            const float4 sg = *(const float4*)(subg + d);
            *(uint2*)(op + d) = make_uint2(pack2(o[db][4 * rq] * rs * sg.x, o[db][4 * rq + 1] * rs * sg.y),
                                           pack2(o[db][4 * rq + 2] * rs * sg.z, o[db][4 * rq + 3] * rs * sg.w));
          }
      }
    }
  }
}

DI void phase_at_out(const P& p, int layer, char* smem) {
  const int tidx = opaque_tid();
  const bf16_t* O = (const bf16_t*)(p.ws + OFF_TR + TR_H);
  const bf16_t* WO = (const bf16_t*)(p.ws + w_off(layer)) + W_WO;
  const int nmt = (layer == 3) ? 256 : 272;
  for (int t = blockIdx.x; t < xcd_rounds(nmt, 8) * (int)gridDim.x; t += gridDim.x) {
    int gt, nt_;
    if (!xcd_tile(t, nmt, 8, gt, nt_)) continue;
    const int n0 = nt_ * 128;
    f32x16 acc[2][2];
    gemm_mainloop(O + (size_t)gt * 128 * 1024, 1024, WO + (size_t)n0 * 1024, 1024, 1024, smem, acc);
    const float* gate = mods_ptr(p, layer, mod_row(gt * 128)) + 2048 + n0;
    float* xr = resid_row(p, gt * 128) + n0;
    EPI8_BEGIN
      resid_update(xr + (size_t)row * D + col, xr + (size_t)row * D + col, gate + col, v);
    EPI8_END
  }
}

DI void phase_final(const P& p) {
  const int tidx = opaque_tid();
  const int lane = tidx & 63, wv = tidx >> 6;
  for (int row = blockIdx.x * 4 + wv; row < NLAT; row += gridDim.x * 4) {
    float* xr = p.out + (size_t)row * D;
    float4 v[4];
    float ss = 0.f;
#pragma unroll
    for (int jx = 0; jx < 4; jx++) { v[jx] = *(const float4*)(xr + jx * 256 + lane * 4); ss += v[jx].x * v[jx].x + v[jx].y * v[jx].y + v[jx].z * v[jx].z + v[jx].w * v[jx].w; }
    ss = wave_sum(ss);
    const float rs = rsqrtf(ss * (1.f / 1024.f) + 1e-6f);
#pragma unroll
    for (int jx = 0; jx < 4; jx++) {
      const float4 g = *(const float4*)(p.final_g + jx * 256 + lane * 4);
      *(float4*)(xr + jx * 256 + lane * 4) = make_float4(v[jx].x * rs * g.x, v[jx].y * rs * g.y, v[jx].z * rs * g.z, v[jx].w * rs * g.w);
    }
  }
}

#define XB_TMO      128
#define XB_XCNT(j)  (256  + 64 * (j))
#define XB_XSUB(j)  (1280 + 64 * (j))
#define XB_XGEN(j)  (2304 + 64 * (j))
#define XB_TOP      3328
#define XB_TOPGEN   3392
#define XCD_BAR_WORDS 3456
#define XB_SPIN_CAP (1u << 22)
#define LAS __attribute__((address_space(3)))
DI unsigned xb_ld(unsigned* p) { return __hip_atomic_load(p, __ATOMIC_RELAXED, __HIP_MEMORY_SCOPE_AGENT); }
DI unsigned xb_add(unsigned* p, unsigned v) { return __hip_atomic_fetch_add(p, v, __ATOMIC_RELAXED, __HIP_MEMORY_SCOPE_AGENT); }
DI unsigned xb_xcc_id() { return (unsigned)__builtin_amdgcn_s_getreg((3 << 11) | 20) & 0xFu; }
#define XB_SPIN(cond, bar) do { unsigned _sp = 0; while (cond) { __builtin_amdgcn_s_sleep(1); \
    if ((++_sp & 255u) == 0u) { if (xb_ld(&(bar)[XB_TMO])) break; if (_sp > XB_SPIN_CAP) { atomicAdd(&(bar)[XB_TMO], 1u); break; } } } } while (0)
struct XcdBarrier { unsigned* bar; unsigned x; volatile LAS unsigned* st; };
DI XcdBarrier xcd_barrier_post(unsigned* bar, volatile LAS unsigned* st) {
  XcdBarrier b; b.bar = bar; b.x = xb_xcc_id(); b.st = st;
  if (threadIdx.x == 0) (void)xb_add(&bar[XB_XCNT(b.x)], 1u);
  return b;
}
DI void xcd_barrier_complete(unsigned* bar, unsigned x, unsigned& nloc, unsigned& nx) {
  const unsigned G = gridDim.x * gridDim.y * gridDim.z;
  unsigned sum, cnt, mine, sp = 0u;
  for (;;) {
    sum = 0u; cnt = 0u; mine = 0u;
#pragma unroll
    for (unsigned j = 0; j < 16; ++j) { const unsigned c = xb_ld(&bar[XB_XCNT(j)]); sum += c; cnt += (c > 0u) ? 1u : 0u; mine = (j == x) ? c : mine; }
    if (sum == G) break;
    __builtin_amdgcn_s_sleep(1);
    if ((++sp & 255u) == 0u) { if (xb_ld(&bar[XB_TMO])) break; if (sp > XB_SPIN_CAP) { atomicAdd(&bar[XB_TMO], 1u); break; } }
  }
  nloc = mine > 0u ? mine : 1u; nx = cnt > 0u ? cnt : 1u;
}
DI void xcd_barrier(const XcdBarrier& b) {
  asm volatile("s_waitcnt vmcnt(0)" ::: "memory");
  __syncthreads();
  if (threadIdx.x == 0) {
    unsigned* bar = b.bar;
    __builtin_amdgcn_s_waitcnt(0);
    unsigned nloc = b.st[0], nx = b.st[1];
    if (nloc == 0u) { xcd_barrier_complete(bar, b.x, nloc, nx); b.st[0] = nloc; b.st[1] = nx; }
    const unsigned old = xb_add(&bar[XB_XSUB(b.x)], 1u);
    const unsigned gen = old / nloc;
    if (old + 1u == (gen + 1u) * nloc) {
      __builtin_amdgcn_fence(__ATOMIC_RELEASE, "agent");
      asm volatile("s_waitcnt vmcnt(0)" ::: "memory");
      const unsigned og = xb_add(&bar[XB_TOP], 1u);
      const unsigned tg = og / nx;
      if (og + 1u == (tg + 1u) * nx) xb_add(&bar[XB_TOPGEN], 1u);
      else XB_SPIN(xb_ld(&bar[XB_TOPGEN]) == tg, bar);
      __builtin_amdgcn_fence(__ATOMIC_ACQUIRE, "agent");
      xb_add(&bar[XB_XGEN(b.x)], 1u);
      asm volatile("s_waitcnt vmcnt(0)" ::: "memory");
    } else {
      XB_SPIN(xb_ld(&bar[XB_XGEN(b.x)]) == gen, bar);
      __builtin_amdgcn_fence(__ATOMIC_ACQUIRE, "agent");
      asm volatile("s_waitcnt vmcnt(0)" ::: "memory");
    }
  }
  __syncthreads();
}
constexpr size_t OFF_BAR = OFF_MISC + 65536;

typedef __attribute__((address_space(1))) const float GCF;
typedef __attribute__((address_space(1))) float GF;
typedef __attribute__((address_space(1))) char GC;
DI unsigned long long lds_word(const unsigned long long* tbl, int i) {
  int z = i;
  asm volatile("" : "+v"(z));
  const unsigned long long v = tbl[z];
  const unsigned lo = __builtin_amdgcn_readfirstlane((unsigned)v), hi = __builtin_amdgcn_readfirstlane((unsigned)(v >> 32));
  return ((unsigned long long)hi << 32) | lo;
}
DI void load_params(P& q, const unsigned long long* tbl) {
  const float** fp = (const float**)&q;
#pragma unroll
  for (int i = 0; i < 36; i++) fp[i] = (const float*)(GCF*)lds_word(tbl, i);
  q.out = (float*)(GF*)lds_word(tbl, 36);
  q.ws = (char*)(GC*)lds_word(tbl, 37);
  q.only = 0;
  q.pad = 0;
}
__global__ void __launch_bounds__(256, 2) mega(P p) {
  __shared__ __attribute__((aligned(16))) char smem[73728];
  __shared__ unsigned long long s_tbl[40];
  {
#if defined(__HIP_DEVICE_COMPILE__)
    typedef __attribute__((address_space(4))) const unsigned long long KW;
    KW* kp = (KW*)__builtin_amdgcn_kernarg_segment_ptr();
    if (threadIdx.x < 39) s_tbl[threadIdx.x] = kp[threadIdx.x];
#endif
    __syncthreads();
  }
  const int only = (int)(unsigned)lds_word(s_tbl, 38);
  cg::grid_group grid = cg::this_grid();
  __shared__ uint4 xb_words;
  if (threadIdx.x == 0) xb_words = make_uint4(0u, 0u, 0u, 0u);
  __syncthreads();
  XcdBarrier xb;
  {
    P q;
    load_params(q, s_tbl);
    xb = xcd_barrier_post((unsigned*)(q.ws + OFF_BAR), (volatile LAS unsigned*)&xb_words);
  }
  int step = 0;
#define GSYNC() { if (only == -2) grid.sync(); else xcd_barrier(xb); }
#define STEP(body)                                   \
  {                                                  \
    if (only < 0 || only == step) {              \
      P q;                                           \
      load_params(q, s_tbl);                         \
      body;                                          \
    }                                                \
    step++;                                          \
    if (only < 0) GSYNC();                         \
  }
#ifndef DUP
#define DUP 0
#endif
#define STEPD(id, body)                              \
  {                                                  \
    if (only < 0 || only == step) {                  \
      P q;                                           \
      load_params(q, s_tbl);                         \
      body;                                          \
      if (DUP == id) { __syncthreads(); body; }      \
    }                                                \
    step++;                                          \
    if (only < 0) GSYNC();                           \
  }
  STEP(phase_init(q, smem); __syncthreads(); phase_conv(q, 0, smem, blockIdx.x, gridDim.x));
  for (int layer = 0; layer < 4; layer++) {
    if ((layer & 1) == 0) {
      for (int hf = 0; hf < 2; hf++) {
        STEPD(2, phase_prep(q, layer, 0, hf, true, (bf16_t*)(q.ws + OFF_TR + TR_HX), 2048, false));
        STEPD(3, phase_t1(q, layer, smem));
        STEPD(4, phase_feat(q, layer, hf, smem));
        STEPD(5, phase_scan(q, layer, smem);
              if (hf == 0) { __syncthreads(); phase_conv(q, layer + 1, smem, gridDim.x > 256 ? (int)blockIdx.x - 256 : (int)blockIdx.x, gridDim.x > 256 ? (int)gridDim.x - 256 : (int)gridDim.x); });
        STEP(phase_combine(q, layer));
        STEP(phase_rw_out(q, layer, hf, smem));
      }
    } else {
      STEP(phase_prep(q, layer, 0, -1, false, (bf16_t*)(q.ws + OFF_TR + TR_H), 1024, false);
           if (layer + 1 < 4) { __syncthreads(); phase_conv(q, layer + 1, smem, blockIdx.x, gridDim.x); });
      STEPD(7, phase_qkv(q, layer, smem));
      STEPD(8, phase_attn(q, layer, smem));
      STEP(phase_at_out(q, layer, smem));
    }
    STEPD(2, phase_prep(q, layer, 1, -1, false, (bf16_t*)(q.ws + OFF_TR + TR_H2), 1024, layer == 3));
    STEPD(9, phase_mlp1(q, layer, smem));
    STEP(phase_mlp2(q, layer, smem));
  }
  STEP(phase_final(q));
}

#ifndef MULTI_LAUNCH
#define MULTI_LAUNCH 0
#endif
constexpr int NSTEPS = 1 + 2 * (12 + 3) + 2 * (4 + 3) + 1;

extern "C" void kernel_launch(void* const* d_in, const int* in_sizes, int n_in, void* d_out, int out_size, void* d_ws, size_t ws_size,
                              hipStream_t stream) {
  static int grid_blocks = 0;
  if (!grid_blocks) {
    int dev = 0, cus = 0, per_cu = 0;
    hipGetDevice(&dev);
    hipDeviceGetAttribute(&cus, hipDeviceAttributeMultiprocessorCount, dev);
    hipOccupancyMaxActiveBlocksPerMultiprocessor(&per_cu, mega, 256, 0);
    if (per_cu < 1) per_cu = 1;
    if (per_cu > 2) per_cu = 2;
    grid_blocks = cus * per_cu;
  }
  P p{};
  const float** fp = (const float**)&p;
  for (int i = 0; i < 36; i++) fp[i] = (const float*)d_in[i];
  p.out = (float*)d_out;
  p.ws = (char*)d_ws;
  p.pad = 0;
#if MULTI_LAUNCH
  for (int s = 0; s < NSTEPS; s++) {
    p.only = s;
    void* args[] = {&p};
    hipError_t e = hipLaunchCooperativeKernel((void*)mega, dim3(grid_blocks), dim3(256), args, 0, stream);
    if (e != hipSuccess) { fprintf(stderr, "launch failed: %s\n", hipGetErrorString(e)); break; }
  }
#else
  p.only = -1;
  hipMemsetAsync((char*)d_ws + OFF_BAR, 0, XCD_BAR_WORDS * 4, stream);
  void* args[] = {&p};
  hipError_t e = hipLaunchCooperativeKernel((void*)mega, dim3(grid_blocks), dim3(256), args, 0, stream);
  if (e != hipSuccess) fprintf(stderr, "cooperative launch failed: %s (grid %d)\n", hipGetErrorString(e), grid_blocks);
#endif
}
```

```cpp
#include <hip/hip_runtime.h>
#include <hip/hip_cooperative_groups.h>
#include <cstdio>
namespace cg = cooperative_groups;

#define DI __device__ __forceinline__
typedef unsigned short bf16_t;
using bf16x8 = __attribute__((ext_vector_type(8))) short;
using f32x16 = __attribute__((ext_vector_type(16))) float;
typedef __bf16 bfv2 __attribute__((ext_vector_type(2)));
typedef float fv2 __attribute__((ext_vector_type(2)));
#define MFMA32(a, b, c) __builtin_amdgcn_mfma_f32_32x32x16_bf16((a), (b), (c), 0, 0, 0)

constexpr int D = 1024, NB = 8, SL = 4096, CL = 256;
constexpr int NLAT = NB * SL, NCTX = NB * CL, NTOK = NLAT + NCTX;
constexpr int HROWS = NTOK / 2;
constexpr int TK = SL + CL;
constexpr size_t MiB = 1048576;
constexpr size_t OFF_W2 = 476 * MiB;
constexpr size_t OFF_W = 0, OFF_XC = 36 * MiB, OFF_MODS = 44 * MiB, OFF_MISC = 45 * MiB, OFF_VF = 46 * MiB, OFF_TR = 114 * MiB;
constexpr size_t W_RKV = 0;
constexpr size_t W_L1 = W_RKV + 3072ull * 2048;
constexpr size_t W_W2 = W_L1 + 640ull * 2048;
constexpr size_t W_A2 = W_W2 + 2ull * 65536;
constexpr size_t W_G2 = W_A2 + 65536;
constexpr size_t W_V2 = W_G2 + 2ull * 196608;
constexpr size_t W_WO = W_V2 + 65536;
constexpr size_t W_M1 = W_WO + 1048576;
constexpr size_t W_M2 = W_M1 + 4194304;
constexpr size_t W_QKV = 0;
constexpr size_t HALF_ARR = (size_t)HROWS * 1024 * 2;
constexpr size_t TR_HX = 0;
constexpr size_t TR_T1 = 2 * HALF_ARR;
constexpr size_t TR_R = TR_T1 + (size_t)HROWS * 640 * 2;
constexpr size_t TR_K = TR_R + HALF_ARR, TR_V = TR_K + HALF_ARR, TR_A = TR_V + HALF_ARR;
constexpr size_t TR_WL0 = TR_A + HALF_ARR, TR_WL1 = TR_WL0 + HALF_ARR, TR_G0 = TR_WL1 + HALF_ARR, TR_G1 = TR_G0 + HALF_ARR;
constexpr size_t FULL_ARR = (size_t)NTOK * 1024 * 2;
constexpr size_t TR_H = 0, TR_Q = FULL_ARR, TR_KK = 2 * FULL_ARR, TR_VT = 3 * FULL_ARR;
constexpr size_t TR_H2 = 0, TR_HID = FULL_ARR;

struct P {
  const float *x, *c, *ctx, *c_ctx, *ada_w, *ada_b, *norm_g, *final_g;
  const float *rw_mix, *rw_w_rkv, *rw_w0, *rw_w1, *rw_w2, *rw_a0, *rw_a1, *rw_a2, *rw_g1, *rw_g2, *rw_kk, *rw_ka, *rw_rk, *rw_ln_g, *rw_ln_b, *rw_w_o, *rw_v0, *rw_v1, *rw_v2;
  const float *da_w_qkv, *da_w_o, *da_lq1, *da_lk1, *da_lq2, *da_lk2, *da_subln_g, *mlp_w1, *mlp_w2;
  float* out;
  char* ws;
  int only;
  int pad;
};

DI float bf2f(bf16_t h) { return __uint_as_float(((unsigned)h) << 16); }
DI unsigned pack2(float a, float b) { fv2 v = {a, b}; bfv2 r = __builtin_convertvector(v, bfv2); return __builtin_bit_cast(unsigned, r); }
DI bf16_t f2bf(float a) { return (bf16_t)(pack2(a, 0.f) & 0xffffu); }
DI float lo_bf(unsigned u) { return __uint_as_float(u << 16); }
DI float hi_bf(unsigned u) { return __uint_as_float(u & 0xffff0000u); }
DI float sigmoidf_(float x) { return __builtin_amdgcn_rcpf(1.f + __expf(-x)); }
DI float tanhf_(float x) { return 1.f - 2.f * __builtin_amdgcn_rcpf(1.f + __expf(2.f * x)); }
DI float wave_sum(float v) {
#pragma unroll
  for (int o = 32; o > 0; o >>= 1) v += __shfl_xor(v, o);
  return v;
}
template <int N> DI float ror_add(float x) { return x + __builtin_bit_cast(float, __builtin_amdgcn_mov_dpp(__builtin_bit_cast(int, x), 0x120 + N, 0xf, 0xf, true)); }
DI float rowsum16(float x) { x = ror_add<8>(x); x = ror_add<4>(x); x = ror_add<2>(x); x = ror_add<1>(x); return x; }

DI int opaque_tid() { int t = threadIdx.x; asm volatile("" : "+v"(t)); return t; }
DI float* resid_row(const P& p, int gr) { return gr < NLAT ? p.out + (size_t)gr * D : (float*)(p.ws + OFF_XC) + (size_t)(gr - NLAT) * D; }
DI const float* input_row(const P& p, int gr) { return gr < NLAT ? p.x + (size_t)gr * D : p.ctx + (size_t)(gr - NLAT) * D; }
DI int mod_row(int gr) { return gr < NLAT ? gr / SL : 8; }
DI const float* mods_ptr(const P& p, int layer, int mrow) { return (const float*)(p.ws + OFF_MODS) + ((size_t)layer * 9 + mrow) * 6144; }
DI int half_gtile(int hf, int lt) { return lt < 128 ? hf * 128 + lt : 256 + hf * 8 + (lt - 128); }
DI int first_tile(int base) { int g = gridDim.x; int s = (int)blockIdx.x - (base % g); if (s < 0) s += g; return s; }
DI size_t w_off(int layer) { return (layer & 1) ? OFF_W2 : OFF_W; }
DI float lambda_init(int layer) { return 0.8f - 0.6f * expf(-0.3f * (float)layer); }

DI void phase_init(const P& p, char* smem) {
  const int tidx = opaque_tid();
  const int tid = tidx;
  float* sc = (float*)smem;
  float* mods = (float*)(p.ws + OFF_MODS);
  for (int item = blockIdx.x; item < 96; item += gridDim.x) {
    const int layer = item / 24, cb = item % 24;
    __syncthreads();
    for (int i = tid; i < 9 * 1024; i += 256) {
      int r = i >> 10, k = i & 1023;
      float v = r < 8 ? p.c[r * 1024 + k] : p.c_ctx[k];
      sc[i] = v / (1.f + expf(-v));
    }
    __syncthreads();
    const int w = tid >> 6, q = tid & 63;
    float4 acc[9];
#pragma unroll
    for (int r = 0; r < 9; r++) acc[r] = make_float4(0.f, 0.f, 0.f, 0.f);
    const float* wp = p.ada_w + (size_t)layer * 1024 * 6144 + cb * 256 + q * 4;
    for (int k = w * 256; k < w * 256 + 256; k++) {
      float4 wv = *(const float4*)(wp + (size_t)k * 6144);
#pragma unroll
      for (int r = 0; r < 9; r++) {
        float s = sc[r * 1024 + k];
        acc[r].x += s * wv.x; acc[r].y += s * wv.y; acc[r].z += s * wv.z; acc[r].w += s * wv.w;
      }
    }
    __syncthreads();
    float4* red = (float4*)smem;
#pragma unroll
    for (int r = 0; r < 9; r++) red[(w * 9 + r) * 64 + q] = acc[r];
    __syncthreads();
    for (int i = tid; i < 9 * 64; i += 256) {
      int r = i / 64, qq = i % 64;
      float4 s0 = red[(0 * 9 + r) * 64 + qq], s1 = red[(1 * 9 + r) * 64 + qq], s2 = red[(2 * 9 + r) * 64 + qq], s3 = red[(3 * 9 + r) * 64 + qq];
      float4 bb = *(const float4*)(p.ada_b + layer * 6144 + cb * 256 + qq * 4);
      float4 o = make_float4(s0.x + s1.x + s2.x + s3.x + bb.x, s0.y + s1.y + s2.y + s3.y + bb.y, s0.z + s1.z + s2.z + s3.z + bb.z, s0.w + s1.w + s2.w + s3.w + bb.w);
      *(float4*)(mods + ((size_t)layer * 9 + r) * 6144 + cb * 256 + qq * 4) = o;
    }
  }
  if (blockIdx.x == gridDim.x - 1) {
    float* misc = (float*)(p.ws + OFF_MISC);
    for (int i = tid; i < 1024; i += 256) {
      int pos = i / 16, f = i % 16;
      float inv = powf(10000.f, -(float)f / 16.f);
      float ang = (float)pos * inv;
      misc[i] = cosf(ang);
      misc[1024 + i] = sinf(ang);
    }
    misc[4096 + tid] = 0.f;
    if (tid < 2) {
      float s1 = 0.f, s2 = 0.f;
      for (int k = 0; k < 64; k++) { s1 += p.da_lq1[tid * 64 + k] * p.da_lk1[tid * 64 + k]; s2 += p.da_lq2[tid * 64 + k] * p.da_lk2[tid * 64 + k]; }
      misc[2048 + tid] = expf(s1) - expf(s2) + lambda_init(2 * tid + 1);
    }
  }
}

DI void conv_mat(const float* __restrict__ src, int K, int N, bf16_t* __restrict__ dst, int ldd, int koff, const float* __restrict__ scale,
                 int Kp, int Np, float* sm, int& base, int vb, int vg) {
  const int tidx = opaque_tid();
  const int tid = tidx;
  const int tk = Kp / 64, tn = Np / 64, nt = tk * tn;
  int t0_ = vb - (base % vg);
  if (t0_ < 0) t0_ += vg;
  for (int t = t0_; t < nt; t += vg) {
    const int k0 = (t / tn) * 64, n0 = (t % tn) * 64;
    __syncthreads();
#pragma unroll
    for (int i = 0; i < 4; i++) {
      int kr = (tid >> 4) + 16 * i, nc = (tid & 15) * 4;
      float4 v = make_float4(0.f, 0.f, 0.f, 0.f);
      if (src != nullptr && k0 + kr < K && n0 + nc < N) {
        v = *(const float4*)(src + (size_t)(k0 + kr) * N + n0 + nc);
        if (scale) { float s = scale[k0 + kr]; v.x *= s; v.y *= s; v.z *= s; v.w *= s; }
      }
      sm[kr * 65 + nc + 0] = v.x; sm[kr * 65 + nc + 1] = v.y; sm[kr * 65 + nc + 2] = v.z; sm[kr * 65 + nc + 3] = v.w;
    }
    __syncthreads();
    const int n = tid >> 2, kb = (tid & 3) * 16;
    unsigned o[8];
#pragma unroll
    for (int i = 0; i < 8; i++) o[i] = pack2(sm[(kb + 2 * i) * 65 + n], sm[(kb + 2 * i + 1) * 65 + n]);
    uint4* dp = (uint4*)(dst + (size_t)(n0 + n) * ldd + koff + k0 + kb);
    dp[0] = make_uint4(o[0], o[1], o[2], o[3]);
    dp[1] = make_uint4(o[4], o[5], o[6], o[7]);
  }
  base += nt;
}

DI void phase_conv(const P& p, int layer, char* smem, int vb, int vg) {
  if (vb < 0) return;
  float* sm = (float*)smem;
  bf16_t* W = (bf16_t*)(p.ws + w_off(layer));
  int base = 0;
  const int j = layer / 2;
  if ((layer & 1) == 0) {
    for (int s = 0; s < 3; s++) {
      const float* src = p.rw_w_rkv + ((size_t)j * 3 + s) * 1048576;
      conv_mat(src, 1024, 1024, W + W_RKV + (size_t)s * 1024 * 2048, 2048, 0, nullptr, 1024, 1024, sm, base, vb, vg);
    }
    for (int pass = 0; pass < 2; pass++) {
      const int ko = pass * 1024;
      const float* m1 = pass ? p.rw_mix + ((size_t)j * 6 + 1) * 1024 : nullptr;
      const float* m4 = pass ? p.rw_mix + ((size_t)j * 6 + 4) * 1024 : nullptr;
      const float* m5 = pass ? p.rw_mix + ((size_t)j * 6 + 5) * 1024 : nullptr;
      const float* m3 = pass ? p.rw_mix + ((size_t)j * 6 + 3) * 1024 : nullptr;
      bf16_t* L1 = W + W_L1;
      conv_mat(p.rw_w1 + ((size_t)j * 2 + 0) * 65536, 1024, 64, L1 + 0ull * 2048, 2048, ko, m1, 1024, 64, sm, base, vb, vg);
      conv_mat(p.rw_w1 + ((size_t)j * 2 + 1) * 65536, 1024, 64, L1 + 64ull * 2048, 2048, ko, m1, 1024, 64, sm, base, vb, vg);
      conv_mat(p.rw_a1 + (size_t)j * 65536, 1024, 64, L1 + 128ull * 2048, 2048, ko, m4, 1024, 64, sm, base, vb, vg);
      conv_mat(p.rw_g1 + ((size_t)j * 2 + 0) * 163840, 1024, 160, L1 + 256ull * 2048, 2048, ko, m5, 1024, 192, sm, base, vb, vg);
      conv_mat(p.rw_g1 + ((size_t)j * 2 + 1) * 163840, 1024, 160, L1 + 448ull * 2048, 2048, ko, m5, 1024, 192, sm, base, vb, vg);
      conv_mat(j > 0 ? p.rw_v1 + (size_t)(j - 1) * 32768 : nullptr, 1024, 32, L1 + 192ull * 2048, 2048, ko, m3, 1024, 64, sm, base, vb, vg);
    }
    conv_mat(p.rw_w2 + ((size_t)j * 2 + 0) * 65536, 64, 1024, W + W_W2, 64, 0, nullptr, 64, 1024, sm, base, vb, vg);
    conv_mat(p.rw_w2 + ((size_t)j * 2 + 1) * 65536, 64, 1024, W + W_W2 + 65536, 64, 0, nullptr, 64, 1024, sm, base, vb, vg);
    conv_mat(p.rw_a2 + (size_t)j * 65536, 64, 1024, W + W_A2, 64, 0, nullptr, 64, 1024, sm, base, vb, vg);
    conv_mat(p.rw_g2 + ((size_t)j * 2 + 0) * 163840, 160, 1024, W + W_G2, 192, 0, nullptr, 192, 1024, sm, base, vb, vg);
    conv_mat(p.rw_g2 + ((size_t)j * 2 + 1) * 163840, 160, 1024, W + W_G2 + 196608, 192, 0, nullptr, 192, 1024, sm, base, vb, vg);
    conv_mat(j > 0 ? p.rw_v2 + (size_t)(j - 1) * 32768 : nullptr, 32, 1024, W + W_V2, 64, 0, nullptr, 64, 1024, sm, base, vb, vg);
    conv_mat(p.rw_w_o + (size_t)j * 1048576, 1024, 1024, W + W_WO, 1024, 0, nullptr, 1024, 1024, sm, base, vb, vg);
  } else {
    conv_mat(p.da_w_qkv + (size_t)j * 3145728, 1024, 3072, W + W_QKV, 1024, 0, nullptr, 1024, 3072, sm, base, vb, vg);
    conv_mat(p.da_w_o + (size_t)j * 1048576, 1024, 1024, W + W_WO, 1024, 0, nullptr, 1024, 1024, sm, base, vb, vg);
  }
  conv_mat(p.mlp_w1 + (size_t)layer * 4194304, 1024, 4096, W + W_M1, 1024, 0, nullptr, 1024, 4096, sm, base, vb, vg);
  conv_mat(p.mlp_w2 + (size_t)layer * 4194304, 4096, 1024, W + W_M2, 4096, 0, nullptr, 4096, 1024, sm, base, vb, vg);
}

DI void phase_prep(const P& p, int layer, int sub, int hf, bool shift, bf16_t* H, int ldh, bool skip_ctx) {
  const int tidx = opaque_tid();
  const int lane = tidx & 63, wv = tidx >> 6;
  const int nrows = hf < 0 ? (skip_ctx ? NLAT : NTOK) : HROWS;
  const int nseg = nrows / 8;
  const float* ng = p.norm_g + ((size_t)layer * 2 + sub) * 1024;
  for (int seg = blockIdx.x * 4 + wv; seg < nseg; seg += gridDim.x * 4) {
    const int lr0 = seg * 8;
    const int gr0 = hf < 0 ? lr0 : (lr0 < 16384 ? hf * 16384 + lr0 : NLAT + hf * 1024 + (lr0 - 16384));
    const bool lat = gr0 < NLAT;
    const int T = lat ? SL : CL;
    const int t0 = lat ? (gr0 % SL) : ((gr0 - NLAT) % CL);
    const float* xbase = (layer == 0 && sub == 0) ? input_row(p, gr0) : resid_row(p, gr0);
    const float* md = mods_ptr(p, layer, mod_row(gr0));
    float4 g4[4], sc4[4], sh4[4];
#pragma unroll
    for (int jx = 0; jx < 4; jx++) {
      int ch = jx * 256 + lane * 4;
      g4[jx] = *(const float4*)(ng + ch);
      sh4[jx] = *(const float4*)(md + sub * 3072 + ch);
      sc4[jx] = *(const float4*)(md + sub * 3072 + 1024 + ch);
      g4[jx].x *= (1.f + sc4[jx].x); g4[jx].y *= (1.f + sc4[jx].y); g4[jx].z *= (1.f + sc4[jx].z); g4[jx].w *= (1.f + sc4[jx].w);
    }
    float4 hp[4], hc[4], hn[4];
    const int tb = shift ? -1 : 0, te = shift ? 9 : 8;
    for (int tt = tb; tt < te; tt++) {
      const int t = t0 + tt;
      if (t >= 0 && t < T) {
        const float* xr = xbase + (ptrdiff_t)tt * D;
        float ss = 0.f;
#pragma unroll
        for (int jx = 0; jx < 4; jx++) {
          hn[jx] = *(const float4*)(xr + jx * 256 + lane * 4);
          ss += hn[jx].x * hn[jx].x + hn[jx].y * hn[jx].y + hn[jx].z * hn[jx].z + hn[jx].w * hn[jx].w;
        }
        ss = wave_sum(ss);
        const float rs = rsqrtf(ss * (1.f / 1024.f) + 1e-6f);
#pragma unroll
        for (int jx = 0; jx < 4; jx++) {
          hn[jx].x = hn[jx].x * rs * g4[jx].x + sh4[jx].x; hn[jx].y = hn[jx].y * rs * g4[jx].y + sh4[jx].y;
          hn[jx].z = hn[jx].z * rs * g4[jx].z + sh4[jx].z; hn[jx].w = hn[jx].w * rs * g4[jx].w + sh4[jx].w;
        }
      } else {
#pragma unroll
        for (int jx = 0; jx < 4; jx++) hn[jx] = make_float4(0.f, 0.f, 0.f, 0.f);
      }
      if (!shift) {
        bf16_t* hr = H + (size_t)(lr0 + tt) * ldh;
#pragma unroll
        for (int jx = 0; jx < 4; jx++) *(uint2*)(hr + jx * 256 + lane * 4) = make_uint2(pack2(hn[jx].x, hn[jx].y), pack2(hn[jx].z, hn[jx].w));
      } else if (tt >= 1) {
        bf16_t* hr = H + (size_t)(lr0 + tt - 1) * ldh;
#pragma unroll
        for (int jx = 0; jx < 4; jx++) {
          *(uint2*)(hr + jx * 256 + lane * 4) = make_uint2(pack2(hc[jx].x, hc[jx].y), pack2(hc[jx].z, hc[jx].w));
          float4 xx;
          xx.x = 0.5f * (hp[jx].x + hn[jx].x) - hc[jx].x; xx.y = 0.5f * (hp[jx].y + hn[jx].y) - hc[jx].y;
          xx.z = 0.5f * (hp[jx].z + hn[jx].z) - hc[jx].z; xx.w = 0.5f * (hp[jx].w + hn[jx].w) - hc[jx].w;
          *(uint2*)(hr + 1024 + jx * 256 + lane * 4) = make_uint2(pack2(xx.x, xx.y), pack2(xx.z, xx.w));
        }
      }
#pragma unroll
      for (int jx = 0; jx < 4; jx++) { hp[jx] = hc[jx]; hc[jx] = hn[jx]; }
    }
  }
}

constexpr int LDT = 72;
DI void gemm_mainloop(const bf16_t* __restrict__ A, int lda, const bf16_t* __restrict__ Bt, int ldb, int K, char* smem, f32x16 (&acc)[2][2]) {
  const int tidx = opaque_tid();
  bf16_t* sA = (bf16_t*)smem;
  bf16_t* sB = sA + 2 * 128 * LDT;
  const int tid = tidx, lane = tid & 63, w = tid >> 6, wm = w >> 1, wn = w & 1;
  const int lrow = tid >> 3, lkc = (tid & 7) * 8;
#pragma unroll
  for (int mi = 0; mi < 2; mi++)
#pragma unroll
    for (int ni = 0; ni < 2; ni++)
#pragma unroll
      for (int r = 0; r < 16; r++) acc[mi][ni][r] = 0.f;
  const unsigned ao = (unsigned)(lrow * lda + lkc), bo = (unsigned)(lrow * ldb + lkc);
  const unsigned a32 = (unsigned)(32 * lda), b32 = (unsigned)(32 * ldb);
  uint4 ra0, ra1, ra2, ra3, rb0, rb1, rb2, rb3;
#define G_LOAD(Ab, Bb)                                                                                   \
  {                                                                                                      \
    ra0 = *(const uint4*)((Ab) + ao); ra1 = *(const uint4*)((Ab) + (ao + a32));                          \
    ra2 = *(const uint4*)((Ab) + (ao + 2 * a32)); ra3 = *(const uint4*)((Ab) + (ao + 3 * a32));          \
    rb0 = *(const uint4*)((Bb) + bo); rb1 = *(const uint4*)((Bb) + (bo + b32));                          \
    rb2 = *(const uint4*)((Bb) + (bo + 2 * b32)); rb3 = *(const uint4*)((Bb) + (bo + 3 * b32));          \
  }
#define G_STORE(sa_, sb_)                                                                                \
  {                                                                                                      \
    bf16_t* a_w = (sa_) + lrow * LDT + lkc;                                                              \
    bf16_t* b_w = (sb_) + lrow * LDT + lkc;                                                              \
    *(uint4*)(a_w) = ra0; *(uint4*)(a_w + 32 * LDT) = ra1; *(uint4*)(a_w + 64 * LDT) = ra2; *(uint4*)(a_w + 96 * LDT) = ra3; \
    *(uint4*)(b_w) = rb0; *(uint4*)(b_w + 32 * LDT) = rb1; *(uint4*)(b_w + 64 * LDT) = rb2; *(uint4*)(b_w + 96 * LDT) = rb3; \
  }
  G_LOAD(A, Bt);
  G_STORE(sA, sB);
  __syncthreads();
  const int nk = K >> 6;
  const int aoff = (wm * 64 + (lane & 31)) * LDT + (lane >> 5) * 8;
  const int boff = (wn * 64 + (lane & 31)) * LDT + (lane >> 5) * 8;
  for (int kt = 0; kt < nk; kt++) {
    const int cur = kt & 1;
    if (kt + 1 < nk) {
      const bf16_t* A1 = A + (kt + 1) * 64;
      const bf16_t* B1 = Bt + (kt + 1) * 64;
      G_LOAD(A1, B1);
    }
    __builtin_amdgcn_sched_barrier(0);
    __builtin_amdgcn_s_setprio(1);
    const bf16_t* a_s = sA + cur * 128 * LDT + aoff;
    const bf16_t* b_s = sB + cur * 128 * LDT + boff;
#pragma unroll
    for (int kk = 0; kk < 4; kk++) {
      bf16x8 af[2], bq[2];
#pragma unroll
      for (int mi = 0; mi < 2; mi++) af[mi] = *(const bf16x8*)(a_s + mi * 32 * LDT + kk * 16);
#pragma unroll
      for (int ni = 0; ni < 2; ni++) bq[ni] = *(const bf16x8*)(b_s + ni * 32 * LDT + kk * 16);
#pragma unroll
      for (int mi = 0; mi < 2; mi++)
#pragma unroll
        for (int ni = 0; ni < 2; ni++) acc[mi][ni] = MFMA32(af[mi], bq[ni], acc[mi][ni]);
    }
    __builtin_amdgcn_s_setprio(0);
    __builtin_amdgcn_sched_barrier(0);
    if (kt + 1 < nk) G_STORE(sA + (cur ^ 1) * 128 * LDT, sB + (cur ^ 1) * 128 * LDT);
    __syncthreads();
  }
}
DI float fma_s(float a, float b, float c) { float r; asm("v_fma_f32 %0, %1, %2, %3" : "=v"(r) : "v"(a), "v"(b), "v"(c)); return r; }
DI uint4 mix8(const uint4 h, const uint4 x, const float4 m0, const float4 m1) {
  uint4 o;
  o.x = pack2(fma_s(lo_bf(x.x), m0.x, lo_bf(h.x)), fma_s(hi_bf(x.x), m0.y, hi_bf(h.x)));
  o.y = pack2(fma_s(lo_bf(x.y), m0.z, lo_bf(h.y)), fma_s(hi_bf(x.y), m0.w, hi_bf(h.y)));
  o.z = pack2(fma_s(lo_bf(x.z), m1.x, lo_bf(h.z)), fma_s(hi_bf(x.z), m1.y, hi_bf(h.z)));
  o.w = pack2(fma_s(lo_bf(x.w), m1.z, lo_bf(h.w)), fma_s(hi_bf(x.w), m1.w, hi_bf(h.w)));
  return o;
}
DI void gemm_mainloop_mix(const bf16_t* __restrict__ HX, const float* __restrict__ mix, const bf16_t* __restrict__ Bt, int ldb, char* smem, f32x16 (&acc)[2][2]) {
  const int tidx = opaque_tid();
  bf16_t* sA = (bf16_t*)smem;
  bf16_t* sB = sA + 2 * 128 * LDT;
  const int tid = tidx, lane = tid & 63, w = tid >> 6, wm = w >> 1, wn = w & 1;
  const int lrow = tid >> 3, lkc = (tid & 7) * 8;
#pragma unroll
  for (int mi = 0; mi < 2; mi++)
#pragma unroll
    for (int ni = 0; ni < 2; ni++)
#pragma unroll
      for (int r = 0; r < 16; r++) acc[mi][ni][r] = 0.f;
  const unsigned ao = (unsigned)(lrow * 2048 + lkc), bo = (unsigned)(lrow * ldb + lkc);
  const unsigned a32 = 32u * 2048u, b32 = (unsigned)(32 * ldb);
  uint4 h0, h1, h2, h3, x0, x1, x2, x3, rb0, rb1, rb2, rb3;
  float4 m0, m1;
#define GM_LOAD(kstep_)                                                                                  \
  {                                                                                                      \
    const bf16_t* Ab_ = HX + (kstep_) * 64;                                                              \
    const bf16_t* Bb_ = Bt + (kstep_) * 64;                                                              \
    h0 = *(const uint4*)(Ab_ + ao); h1 = *(const uint4*)(Ab_ + (ao + a32));                              \
    h2 = *(const uint4*)(Ab_ + (ao + 2 * a32)); h3 = *(const uint4*)(Ab_ + (ao + 3 * a32));              \
    x0 = *(const uint4*)(Ab_ + (ao + 1024u)); x1 = *(const uint4*)(Ab_ + (ao + a32 + 1024u));            \
    x2 = *(const uint4*)(Ab_ + (ao + 2 * a32 + 1024u)); x3 = *(const uint4*)(Ab_ + (ao + 3 * a32 + 1024u)); \
    rb0 = *(const uint4*)(Bb_ + bo); rb1 = *(const uint4*)(Bb_ + (bo + b32));                            \
    rb2 = *(const uint4*)(Bb_ + (bo + 2 * b32)); rb3 = *(const uint4*)(Bb_ + (bo + 3 * b32));            \
    m0 = *(const float4*)(mix + (kstep_) * 64 + lkc); m1 = *(const float4*)(mix + (kstep_) * 64 + lkc + 4); \
  }
#define GM_STORE(buf_)                                                                                   \
  {                                                                                                      \
    bf16_t* a_w = sA + (buf_) * 128 * LDT + lrow * LDT + lkc;                                            \
    bf16_t* b_w = sB + (buf_) * 128 * LDT + lrow * LDT + lkc;                                            \
    *(uint4*)(a_w) = mix8(h0, x0, m0, m1); *(uint4*)(a_w + 32 * LDT) = mix8(h1, x1, m0, m1);             \
    *(uint4*)(a_w + 64 * LDT) = mix8(h2, x2, m0, m1); *(uint4*)(a_w + 96 * LDT) = mix8(h3, x3, m0, m1);  \
    *(uint4*)(b_w) = rb0; *(uint4*)(b_w + 32 * LDT) = rb1; *(uint4*)(b_w + 64 * LDT) = rb2; *(uint4*)(b_w + 96 * LDT) = rb3; \
  }
  GM_LOAD(0);
  GM_STORE(0);
  __syncthreads();
  const int aoff = (wm * 64 + (lane & 31)) * LDT + (lane >> 5) * 8;
  const int boff = (wn * 64 + (lane & 31)) * LDT + (lane >> 5) * 8;
  for (int kt = 0; kt < 16; kt++) {
    const int cur = kt & 1;
    if (kt + 1 < 16) GM_LOAD(kt + 1);
    __builtin_amdgcn_sched_barrier(0);
    __builtin_amdgcn_s_setprio(1);
    const bf16_t* a_s = sA + cur * 128 * LDT + aoff;
    const bf16_t* b_s = sB + cur * 128 * LDT + boff;
#pragma unroll
    for (int kk = 0; kk < 4; kk++) {
      bf16x8 af[2], bq[2];
#pragma unroll
      for (int mi = 0; mi < 2; mi++) af[mi] = *(const bf16x8*)(a_s + mi * 32 * LDT + kk * 16);
#pragma unroll
      for (int ni = 0; ni < 2; ni++) bq[ni] = *(const bf16x8*)(b_s + ni * 32 * LDT + kk * 16);
#pragma unroll
      for (int mi = 0; mi < 2; mi++)
#pragma unroll
        for (int ni = 0; ni < 2; ni++) acc[mi][ni] = MFMA32(af[mi], bq[ni], acc[mi][ni]);
    }
    __builtin_amdgcn_s_setprio(0);
    __builtin_amdgcn_sched_barrier(0);
    if (kt + 1 < 16) GM_STORE(cur ^ 1);
    __syncthreads();
  }
}

constexpr int EST = 132;
DI void acc_to_lds(const f32x16 (&acc)[2][2], float* es) {
  const int tidx = opaque_tid();
  const int lane = tidx & 63, w = tidx >> 6, wm = w >> 1, wn = w & 1;
#pragma unroll
  for (int mi = 0; mi < 2; mi++)
#pragma unroll
    for (int ni = 0; ni < 2; ni++)
#pragma unroll
      for (int r = 0; r < 16; r++)
        es[(wm * 64 + mi * 32 + (r & 3) + 8 * (r >> 2) + 4 * (lane >> 5)) * EST + wn * 64 + ni * 32 + (lane & 31)] = acc[mi][ni][r];
}
#define EPI8_BEGIN                                                                   \
  {                                                                                  \
    float* es = (float*)smem;                                                        \
    acc_to_lds(acc, es);                                                             \
    __syncthreads();                                                                 \
    for (int pass = 0; pass < 8; pass++) {                                           \
      const int row = pass * 16 + (tidx >> 4), col = (tidx & 15) * 8;  \
      const float4 e_va = *(const float4*)(es + row * EST + col);                    \
      const float4 e_vb = *(const float4*)(es + row * EST + col + 4);                \
      float v[8] = {e_va.x, e_va.y, e_va.z, e_va.w, e_vb.x, e_vb.y, e_vb.z, e_vb.w};
#define EPI8_END                                                                     \
    }                                                                                \
    __syncthreads();                                                                 \
  }
DI uint4 pack8(const float (&v)[8]) { return make_uint4(pack2(v[0], v[1]), pack2(v[2], v[3]), pack2(v[4], v[5]), pack2(v[6], v[7])); }
DI void unpack8(const uint4 u, float (&v)[8]) {
  v[0] = lo_bf(u.x); v[1] = hi_bf(u.x); v[2] = lo_bf(u.y); v[3] = hi_bf(u.y); v[4] = lo_bf(u.z); v[5] = hi_bf(u.z); v[6] = lo_bf(u.w); v[7] = hi_bf(u.w);
}
DI void resid_update(float* xp, const float* xsrc, const float* gate, const float (&v)[8]) {
  float4 x0 = *(const float4*)xsrc, x1 = *(const float4*)(xsrc + 4);
  const float4 g0 = *(const float4*)gate, g1 = *(const float4*)(gate + 4);
  x0.x += g0.x * v[0]; x0.y += g0.y * v[1]; x0.z += g0.z * v[2]; x0.w += g0.w * v[3];
  x1.x += g1.x * v[4]; x1.y += g1.y * v[5]; x1.z += g1.z * v[6]; x1.w += g1.w * v[7];
  *(float4*)xp = x0; *(float4*)(xp + 4) = x1;
}

DI bool xcd_tile(int t, int Mt, int Nt, int& mt, int& nt) {
  const int G = gridDim.x;
  if ((G & 63) != 0 || (Nt % (G >> 6)) != 0 || (Mt & 7) != 0) {
    if (t >= Mt * Nt) return false;
    mt = t / Nt; nt = t % Nt;
    return true;
  }
  const int spx = G >> 3, tn = spx >> 3;
  const int r = t % G, round = t / G;
  const int xcd = r & 7, li = r >> 3;
  const int smn = Mt >> 3, snn = Nt / tn;
  const int st = round * 8 + xcd;
  if (st >= smn * snn) return false;
  const int smi = st % smn, sni = st / smn;
  mt = smi * 8 + (li & 7);
  nt = sni * tn + (li >> 3);
  return true;
}
DI int xcd_rounds(int Mt, int Nt) {
  const int G = gridDim.x;
  if ((G & 63) != 0 || (Nt % (G >> 6)) != 0 || (Mt & 7) != 0) return (Mt * Nt + G - 1) / G;
  const int tn = G >> 6;
  return ((Mt >> 3) * (Nt / tn) + 7) >> 3;
}

DI void phase_t1(const P& p, int layer, char* smem) {
  const int j = layer / 2;
  const int tidx = opaque_tid();
  const bf16_t* HX = (const bf16_t*)(p.ws + OFF_TR + TR_HX);
  const bf16_t* WL1 = (const bf16_t*)(p.ws + w_off(0)) + W_L1;
  bf16_t* T1 = (bf16_t*)(p.ws + OFF_TR + TR_T1);
  for (int t = blockIdx.x; t < 136 * 5; t += gridDim.x) {
    const int nt = t % 5, lt = t / 5;
    f32x16 acc[2][2];
    if (nt == 1) gemm_mainloop(HX + (size_t)lt * 128 * 2048, 2048, WL1 + (size_t)nt * 128 * 2048, 2048, 2048, smem, acc);
    else gemm_mainloop_mix(HX + (size_t)lt * 128 * 2048, p.rw_mix + ((size_t)j * 6 + (nt == 0 ? 1 : 5)) * 1024, WL1 + (size_t)nt * 128 * 2048, 2048, smem, acc);
    EPI8_BEGIN
      const int c = nt * 128 + col;
      if (c < 128) {
#pragma unroll
        for (int e = 0; e < 8; e++) v[e] = tanhf_(v[e]);
      } else if (c >= 256) {
#pragma unroll
        for (int e = 0; e < 8; e++) v[e] = sigmoidf_(v[e]);
      }
      *(uint4*)(T1 + (size_t)(lt * 128 + row) * 640 + c) = pack8(v);
    EPI8_END
  }
}

DI void phase_feat(const P& p, int layer, int hf, char* smem) {
  const int tidx = opaque_tid();
  const int j = layer / 2;
  const bf16_t* W = (const bf16_t*)(p.ws + w_off(layer));
  const bf16_t* HX = (const bf16_t*)(p.ws + OFF_TR + TR_HX);
  const bf16_t* T1 = (const bf16_t*)(p.ws + OFF_TR + TR_T1);
  bf16_t* VF = (bf16_t*)(p.ws + OFF_VF);
  for (int t = blockIdx.x; t < xcd_rounds(136, 24) * (int)gridDim.x; t += gridDim.x) {
    int lt, nt;
    if (!xcd_tile(t, 136, 24, lt, nt)) continue;
    const int s = nt / 8, n0 = (nt % 8) * 128;
    const int gt = half_gtile(hf, lt);
    f32x16 acc[2][2];
    bf16_t* outp = (bf16_t*)(p.ws + OFF_TR + (s == 0 ? TR_R : (s == 1 ? TR_K : TR_V)));
    if (s == 2 && j > 0) {
      gemm_mainloop(T1 + (size_t)lt * 128 * 640 + 192, 640, W + W_V2 + (size_t)n0 * 64, 64, 64, smem, acc);
      const float* v0 = p.rw_v0 + (size_t)(j - 1) * 1024;
      EPI8_BEGIN
        const int c = n0 + col;
#pragma unroll
        for (int e = 0; e < 8; e++) v[e] = sigmoidf_(v0[c + e] + v[e]);
        *(uint4*)(outp + (size_t)(lt * 128 + row) * 1024 + c) = pack8(v);
      EPI8_END
    }
    {
      const int mixsel = s == 0 ? 0 : (s == 1 ? 2 : 3);
      gemm_mainloop_mix(HX + (size_t)lt * 128 * 2048, p.rw_mix + ((size_t)j * 6 + mixsel) * 1024, W + W_RKV + ((size_t)s * 1024 + n0) * 2048, 2048, smem, acc);
    }
    if (s < 2) {
      EPI8_BEGIN
        *(uint4*)(outp + (size_t)(lt * 128 + row) * 1024 + n0 + col) = pack8(v);
      EPI8_END
    } else if (j == 0) {
      EPI8_BEGIN
        const uint4 u = pack8(v);
        *(uint4*)(outp + (size_t)(lt * 128 + row) * 1024 + n0 + col) = u;
        *(uint4*)(VF + (size_t)(gt * 128 + row) * 1024 + n0 + col) = u;
      EPI8_END
    } else {
      EPI8_BEGIN
        const size_t oi = (size_t)(lt * 128 + row) * 1024 + n0 + col;
        float sg[8], vf[8];
        unpack8(*(const uint4*)(outp + oi), sg);
        unpack8(*(const uint4*)(VF + (size_t)(gt * 128 + row) * 1024 + n0 + col), vf);
#pragma unroll
        for (int e = 0; e < 8; e++) v[e] = v[e] + (vf[e] - v[e]) * sg[e];
        *(uint4*)(outp + oi) = pack8(v);
      EPI8_END
    }
  }
  for (int t = blockIdx.x; t < xcd_rounds(136, 40) * (int)gridDim.x; t += gridDim.x) {
    int lt, nt;
    if (!xcd_tile(t, 136, 40, lt, nt)) continue;
    const int s = nt / 8, n0 = (nt % 8) * 128;
    f32x16 acc[2][2];
    if (s == 0) {
      gemm_mainloop(T1 + (size_t)lt * 128 * 640 + 128, 640, W + W_A2 + (size_t)n0 * 64, 64, 64, smem, acc);
      bf16_t* outp = (bf16_t*)(p.ws + OFF_TR + TR_A);
      const float* a0 = p.rw_a0 + (size_t)j * 1024;
      EPI8_BEGIN
#pragma unroll
        for (int e = 0; e < 8; e++) v[e] = sigmoidf_(a0[n0 + col + e] + v[e]);
        *(uint4*)(outp + (size_t)(lt * 128 + row) * 1024 + n0 + col) = pack8(v);
      EPI8_END
    } else if (s < 3) {
      const int d = s - 1;
      gemm_mainloop(T1 + (size_t)lt * 128 * 640 + d * 64, 640, W + W_W2 + (size_t)d * 65536 + (size_t)n0 * 64, 64, 64, smem, acc);
      bf16_t* outp = (bf16_t*)(p.ws + OFF_TR + (d ? TR_WL1 : TR_WL0));
      const float* w0 = p.rw_w0 + ((size_t)j * 2 + d) * 1024;
      EPI8_BEGIN
#pragma unroll
        for (int e = 0; e < 8; e++) v[e] = -0.60653065971263342f * sigmoidf_(w0[n0 + col + e] + v[e]);
        *(uint4*)(outp + (size_t)(lt * 128 + row) * 1024 + n0 + col) = pack8(v);
      EPI8_END
    } else {
      const int d = s - 3;
      gemm_mainloop(T1 + (size_t)lt * 128 * 640 + 256 + d * 192, 640, W + W_G2 + (size_t)d * 196608 + (size_t)n0 * 192, 192, 192, smem, acc);
      bf16_t* outp = (bf16_t*)(p.ws + OFF_TR + (d ? TR_G1 : TR_G0));
      EPI8_BEGIN
        *(uint4*)(outp + (size_t)(lt * 128 + row) * 1024 + n0 + col) = pack8(v);
      EPI8_END
    }
  }
}

DI int scan_row(int bl, int dir, int pos) {
  if (pos < CL) { int t = dir ? (CL - 1 - pos) : pos; return 16384 + bl * CL + t; }
  int t = pos - CL; if (dir) t = SL - 1 - t;
  return bl * SL + t;
}

DI void phase_scan(const P& p, int layer, char* smem) {
  const int tidx = opaque_tid();
  const int j = layer / 2;
  const int tid = tidx;
  const bf16_t* R = (const bf16_t*)(p.ws + OFF_TR + TR_R);
  const bf16_t* Kx = (const bf16_t*)(p.ws + OFF_TR + TR_K);
  const bf16_t* V = (const bf16_t*)(p.ws + OFF_TR + TR_V);
  const bf16_t* Aa = (const bf16_t*)(p.ws + OFF_TR + TR_A);
  float* sbuf = (float*)smem;
  constexpr int BUFF = 5 * 16 * 64 + 512;
  constexpr int POP = 144;
  float* pobuf = sbuf + 2 * BUFF;
  const int ss = tid >> 4, c4 = tid & 15;
  const int rl = tid >> 4, cg = tid & 15;
  for (int item = blockIdx.x; item < 256; item += gridDim.x) {
    const int q2 = item & 1, dir = (item >> 1) & 1, head = (item >> 2) & 15, bl = item >> 6;
    const bf16_t* WL = (const bf16_t*)(p.ws + OFF_TR + (dir ? TR_WL1 : TR_WL0));
    bf16_t* O = (bf16_t*)(p.ws + OFF_TR + TR_HX) + (dir ? (size_t)HROWS * 1024 : 0);
    const int ch = head * 64 + c4 * 4;
    const float4 kkw = *(const float4*)(p.rw_kk + (size_t)j * 1024 + ch);
    const float4 kaw = *(const float4*)(p.rw_ka + (size_t)j * 1024 + ch);
    fv2 SA01 = {0.f, 0.f}, SA23 = {0.f, 0.f}, SB01 = {0.f, 0.f}, SB23 = {0.f, 0.f};
    uint2 gr_, gk_, ga_, gw_, gv_;
    gv_ = make_uint2(0, 0);
#define SC_ISSUE(chunk_)                                                                   \
    {                                                                                      \
      const size_t ro = (size_t)scan_row(bl, dir, (chunk_) * 16 + ss) * 1024;              \
      gr_ = *(const uint2*)(R + ro + ch); gk_ = *(const uint2*)(Kx + ro + ch);             \
      ga_ = *(const uint2*)(Aa + ro + ch); gw_ = *(const uint2*)(WL + ro + ch);            \
      if (c4 < 8) gv_ = *(const uint2*)(V + ro + head * 64 + q2 * 32 + c4 * 4);            \
    }
#define SC_STAGE(buf_)                                                                     \
    {                                                                                      \
      float* sb_ = sbuf + (buf_) * BUFF;                                                   \
      float r0 = lo_bf(gr_.x), r1 = hi_bf(gr_.x), r2 = lo_bf(gr_.y), r3 = hi_bf(gr_.y);    \
      float k0 = lo_bf(gk_.x), k1 = hi_bf(gk_.x), k2 = lo_bf(gk_.y), k3 = hi_bf(gk_.y);    \
      float a0 = lo_bf(ga_.x), a1 = hi_bf(ga_.x), a2 = lo_bf(ga_.y), a3 = hi_bf(ga_.y);    \
      float w0 = lo_bf(gw_.x), w1 = hi_bf(gw_.x), w2 = lo_bf(gw_.y), w3 = hi_bf(gw_.y);    \
      float u0 = k0 * kkw.x, u1 = k1 * kkw.y, u2 = k2 * kkw.z, u3 = k3 * kkw.w;            \
      float sq = rowsum16(u0 * u0 + u1 * u1 + u2 * u2 + u3 * u3);                          \
      float inv = rsqrtf(fmaxf(sq, 1e-24f));                                               \
      u0 *= inv; u1 *= inv; u2 *= inv; u3 *= inv;                                          \
      const int o_ = ss * 64 + c4 * 4;                                                     \
      *(float4*)(sb_ + 0 * 1024 + o_) = make_float4(__expf(w0), __expf(w1), __expf(w2), __expf(w3)); \
      *(float4*)(sb_ + 1 * 1024 + o_) = make_float4(k0 * (1.f + (a0 - 1.f) * kaw.x), k1 * (1.f + (a1 - 1.f) * kaw.y), k2 * (1.f + (a2 - 1.f) * kaw.z), k3 * (1.f + (a3 - 1.f) * kaw.w)); \
      *(float4*)(sb_ + 2 * 1024 + o_) = make_float4(-u0, -u1, -u2, -u3);                   \
      *(float4*)(sb_ + 3 * 1024 + o_) = make_float4(u0 * a0, u1 * a1, u2 * a2, u3 * a3);   \
      *(float4*)(sb_ + 4 * 1024 + o_) = make_float4(r0, r1, r2, r3);                       \
      if (c4 < 8) *(float4*)(sb_ + 5 * 1024 + ss * 32 + c4 * 4) = make_float4(lo_bf(gv_.x), hi_bf(gv_.x), lo_bf(gv_.y), hi_bf(gv_.y)); \
    }
    __syncthreads();
    SC_ISSUE(0);
    SC_STAGE(0);
    __syncthreads();
    constexpr int NCH = TK / 16;
    float* po_wa = pobuf + rl * POP + cg;
    float* po_wb = pobuf + (rl + 16) * POP + cg;
    const float* po_r = pobuf + (rl + 16 * (cg >> 3)) * POP + (cg & 7) * 16;
    for (int chunk = 0; chunk < NCH; chunk++) {
      const int buf = chunk & 1;
      if (chunk + 1 < NCH) SC_ISSUE(chunk + 1);
      __builtin_amdgcn_sched_barrier(0);
      const float* sb = sbuf + buf * BUFF + cg * 4;
      const float* sv = sbuf + buf * BUFF + 5 * 1024 + rl;
      float4 w4 = *(const float4*)(sb + 0 * 1024), k4 = *(const float4*)(sb + 1 * 1024), n4 = *(const float4*)(sb + 2 * 1024);
      float4 b4 = *(const float4*)(sb + 3 * 1024), r4 = *(const float4*)(sb + 4 * 1024);
      float va = sv[0], vb = sv[16];
#pragma unroll
      for (int s = 0; s < 16; s++) {
        float4 w4n = w4, k4n = k4, n4n = n4, b4n = b4, r4n = r4;
        float van = va, vbn = vb;
        if (s + 1 < 16) {
          w4n = *(const float4*)(sb + 0 * 1024 + (s + 1) * 64); k4n = *(const float4*)(sb + 1 * 1024 + (s + 1) * 64);
          n4n = *(const float4*)(sb + 2 * 1024 + (s + 1) * 64); b4n = *(const float4*)(sb + 3 * 1024 + (s + 1) * 64);
          r4n = *(const float4*)(sb + 4 * 1024 + (s + 1) * 64); van = sv[(s + 1) * 32]; vbn = sv[(s + 1) * 32 + 16];
        }
        const fv2 w01 = {w4.x, w4.y}, w23 = {w4.z, w4.w}, k01 = {k4.x, k4.y}, k23 = {k4.z, k4.w}, n01 = {n4.x, n4.y}, n23 = {n4.z, n4.w};
        const fv2 b01 = {b4.x, b4.y}, b23 = {b4.z, b4.w}, r01 = {r4.x, r4.y}, r23 = {r4.z, r4.w};
        const fv2 va2 = {va, va}, vb2 = {vb, vb};
        const fv2 vka01 = va2 * k01, vka23 = va2 * k23, vkb01 = vb2 * k01, vkb23 = vb2 * k23;
        fv2 ppa = SA01 * n01, ppb = SB01 * n01;
        ppa = __builtin_elementwise_fma(SA23, n23, ppa);
        ppb = __builtin_elementwise_fma(SB23, n23, ppb);
        float saa = ppa.x + ppa.y, sab = ppb.x + ppb.y;
        saa = ror_add<8>(saa); sab = ror_add<8>(sab);
        saa = ror_add<4>(saa); sab = ror_add<4>(sab);
        saa = ror_add<2>(saa); sab = ror_add<2>(sab);
        saa = ror_add<1>(saa); sab = ror_add<1>(sab);
        const fv2 saa2 = {saa, saa}, sab2 = {sab, sab};
        const fv2 ta01 = __builtin_elementwise_fma(saa2, b01, vka01), ta23 = __builtin_elementwise_fma(saa2, b23, vka23);
        const fv2 tb01 = __builtin_elementwise_fma(sab2, b01, vkb01), tb23 = __builtin_elementwise_fma(sab2, b23, vkb23);
        SA01 = __builtin_elementwise_fma(SA01, w01, ta01);
        SA23 = __builtin_elementwise_fma(SA23, w23, ta23);
        SB01 = __builtin_elementwise_fma(SB01, w01, tb01);
        SB23 = __builtin_elementwise_fma(SB23, w23, tb23);
        fv2 qa = SA01 * r01, qb = SB01 * r01;
        qa = __builtin_elementwise_fma(SA23, r23, qa);
        qb = __builtin_elementwise_fma(SB23, r23, qb);
        po_wa[(s & 7) * 16] = qa.x + qa.y;
        po_wb[(s & 7) * 16] = qb.x + qb.y;
        w4 = w4n; k4 = k4n; n4 = n4n; b4 = b4n; r4 = r4n; va = van; vb = vbn;
        __builtin_amdgcn_sched_barrier(0);
        if ((s & 7) == 7) {
          const float4 p0 = *(const float4*)(po_r), p1 = *(const float4*)(po_r + 4), p2 = *(const float4*)(po_r + 8), p3 = *(const float4*)(po_r + 12);
          const float ov = ((p0.x + p0.y) + (p0.z + p0.w)) + ((p1.x + p1.y) + (p1.z + p1.w)) + ((p2.x + p2.y) + (p2.z + p2.w)) + ((p3.x + p3.y) + (p3.z + p3.w));
          const size_t ro = (size_t)scan_row(bl, dir, chunk * 16 + (s & 8) + (cg & 7)) * 1024;
          O[ro + head * 64 + q2 * 32 + rl + 16 * (cg >> 3)] = f2bf(ov);
          __builtin_amdgcn_sched_barrier(0);
        }
      }
      if (chunk + 1 < NCH) SC_STAGE(buf ^ 1);
      __syncthreads();
    }
  }
}

DI void phase_combine(const P& p, int layer) {
  const int tidx = opaque_tid();
  const int j = layer / 2;
  const bf16_t* Of = (const bf16_t*)(p.ws + OFF_TR + TR_HX);
  const bf16_t* Ob = Of + (size_t)HROWS * 1024;
  const bf16_t* R = (const bf16_t*)(p.ws + OFF_TR + TR_R);
  const bf16_t* Kx = (const bf16_t*)(p.ws + OFF_TR + TR_K);
  const bf16_t* V = (const bf16_t*)(p.ws + OFF_TR + TR_V);
  const bf16_t* Aa = (const bf16_t*)(p.ws + OFF_TR + TR_A);
  bf16_t* G0 = (bf16_t*)(p.ws + OFF_TR + TR_G0);
  const bf16_t* G1 = (const bf16_t*)(p.ws + OFF_TR + TR_G1);
  const size_t total = (size_t)HROWS * 128;
  for (size_t i = (size_t)blockIdx.x * 256 + tidx; i < total; i += (size_t)gridDim.x * 256) {
    const int c0 = (int)(i & 127) * 8;
    const size_t off = (i >> 7) * 1024 + c0;
    const uint4 uof = *(const uint4*)(Of + off), uob = *(const uint4*)(Ob + off), ur = *(const uint4*)(R + off), uk = *(const uint4*)(Kx + off);
    const uint4 ua = *(const uint4*)(Aa + off), uv = *(const uint4*)(V + off), ug0 = *(const uint4*)(G0 + off), ug1 = *(const uint4*)(G1 + off);
    const unsigned aof[4] = {uof.x, uof.y, uof.z, uof.w}, aob[4] = {uob.x, uob.y, uob.z, uob.w}, ar[4] = {ur.x, ur.y, ur.z, ur.w}, ak[4] = {uk.x, uk.y, uk.z, uk.w};
    const unsigned aa[4] = {ua.x, ua.y, ua.z, ua.w}, av[4] = {uv.x, uv.y, uv.z, uv.w}, ag0[4] = {ug0.x, ug0.y, ug0.z, ug0.w}, ag1[4] = {ug1.x, ug1.y, ug1.z, ug1.w};
    const float* ka = p.rw_ka + (size_t)j * 1024 + c0;
    const float* rk = p.rw_rk + (size_t)j * 1024 + c0;
    const float* lg = p.rw_ln_g + (size_t)j * 1024 + c0;
    const float* lb = p.rw_ln_b + (size_t)j * 1024 + c0;
    float of[8], obv[8];
    float sf = 0.f, sf2 = 0.f, sb = 0.f, sb2 = 0.f, br = 0.f;
#pragma unroll
    for (int e = 0; e < 8; e++) {
      const int w = e >> 1;
      of[e] = (e & 1) ? hi_bf(aof[w]) : lo_bf(aof[w]);
      obv[e] = (e & 1) ? hi_bf(aob[w]) : lo_bf(aob[w]);
      const float r = (e & 1) ? hi_bf(ar[w]) : lo_bf(ar[w]);
      const float k = (e & 1) ? hi_bf(ak[w]) : lo_bf(ak[w]);
      const float a = (e & 1) ? hi_bf(aa[w]) : lo_bf(aa[w]);
      sf += of[e]; sf2 += of[e] * of[e]; sb += obv[e]; sb2 += obv[e] * obv[e];
      br += r * k * (1.f + (a - 1.f) * ka[e]) * rk[e];
    }
#pragma unroll
    for (int o = 1; o < 8; o <<= 1) { sf += __shfl_xor(sf, o); sf2 += __shfl_xor(sf2, o); sb += __shfl_xor(sb, o); sb2 += __shfl_xor(sb2, o); br += __shfl_xor(br, o); }
    const float muf = sf * (1.f / 64.f), mub = sb * (1.f / 64.f);
    const float rsf = rsqrtf(fmaxf(sf2 * (1.f / 64.f) - muf * muf, 0.f) + 64e-5f);
    const float rsb = rsqrtf(fmaxf(sb2 * (1.f / 64.f) - mub * mub, 0.f) + 64e-5f);
    float y[8];
#pragma unroll
    for (int e = 0; e < 8; e++) {
      const int w = e >> 1;
      const float v = (e & 1) ? hi_bf(av[w]) : lo_bf(av[w]);
      const float g0 = (e & 1) ? hi_bf(ag0[w]) : lo_bf(ag0[w]);
      const float g1 = (e & 1) ? hi_bf(ag1[w]) : lo_bf(ag1[w]);
      const float bonus = br * v;
      y[e] = ((of[e] - muf) * rsf * lg[e] + lb[e] + bonus) * g0 + ((obv[e] - mub) * rsb * lg[e] + lb[e] + bonus) * g1;
    }
    *(uint4*)(G0 + off) = make_uint4(pack2(y[0], y[1]), pack2(y[2], y[3]), pack2(y[4], y[5]), pack2(y[6], y[7]));
  }
}

DI void phase_rw_out(const P& p, int layer, int hf, char* smem) {
  const int tidx = opaque_tid();
  const bf16_t* Y = (const bf16_t*)(p.ws + OFF_TR + TR_G0);
  const bf16_t* WO = (const bf16_t*)(p.ws + w_off(layer)) + W_WO;
  const int nlt = (layer == 3) ? 128 : 136;
  for (int t = blockIdx.x; t < xcd_rounds(nlt, 8) * (int)gridDim.x; t += gridDim.x) {
    int lt, nt_;
    if (!xcd_tile(t, nlt, 8, lt, nt_)) continue;
    const int n0 = nt_ * 128;
    const int gt = half_gtile(hf, lt);
    f32x16 acc[2][2];
    gemm_mainloop(Y + (size_t)lt * 128 * 1024, 1024, WO + (size_t)n0 * 1024, 1024, 1024, smem, acc);
    const float* gate = mods_ptr(p, layer, mod_row(gt * 128)) + 2048 + n0;
    float* xr = resid_row(p, gt * 128) + n0;
    const float* xs = layer == 0 ? input_row(p, gt * 128) + n0 : xr;
    EPI8_BEGIN
      resid_update(xr + (size_t)row * D + col, xs + (size_t)row * D + col, gate + col, v);
    EPI8_END
  }
}

DI void phase_mlp1(const P& p, int layer, char* smem) {
  const int tidx = opaque_tid();
  const bf16_t* H2 = (const bf16_t*)(p.ws + OFF_TR + TR_H2);
  const bf16_t* W1 = (const bf16_t*)(p.ws + w_off(layer)) + W_M1;
  bf16_t* HID = (bf16_t*)(p.ws + OFF_TR + TR_HID);
  const int nmt = (layer == 3) ? 256 : 272;
  const int ngrp = nmt / 16;
  (void)ngrp;
  for (int t = blockIdx.x; t < xcd_rounds(nmt, 32) * (int)gridDim.x; t += gridDim.x) {
    int gt, nt;
    if (!xcd_tile(t, nmt, 32, gt, nt)) continue;
    f32x16 acc[2][2];
    gemm_mainloop(H2 + (size_t)gt * 128 * 1024, 1024, W1 + (size_t)nt * 128 * 1024, 1024, 1024, smem, acc);
    EPI8_BEGIN
#pragma unroll
      for (int e = 0; e < 8; e++) { const float rl = fmaxf(v[e], 0.f); v[e] = rl * rl; }
      *(uint4*)(HID + (size_t)(gt * 128 + row) * 4096 + nt * 128 + col) = pack8(v);
    EPI8_END
  }
}
DI void phase_mlp2(const P& p, int layer, char* smem) {
  const int tidx = opaque_tid();
  const bf16_t* HID = (const bf16_t*)(p.ws + OFF_TR + TR_HID);
  const bf16_t* W2 = (const bf16_t*)(p.ws + w_off(layer)) + W_M2;
  const int nmt = (layer == 3) ? 256 : 272;
  for (int t = blockIdx.x; t < xcd_rounds(nmt, 8) * (int)gridDim.x; t += gridDim.x) {
    int gt, nt_;
    if (!xcd_tile(t, nmt, 8, gt, nt_)) continue;
    const int n0 = nt_ * 128;
    f32x16 acc[2][2];
    gemm_mainloop(HID + (size_t)gt * 128 * 4096, 4096, W2 + (size_t)n0 * 4096, 4096, 4096, smem, acc);
    const float* gate = mods_ptr(p, layer, mod_row(gt * 128)) + 5120 + n0;
    float* xr = resid_row(p, gt * 128) + n0;
    EPI8_BEGIN
      resid_update(xr + (size_t)row * D + col, xr + (size_t)row * D + col, gate + col, v);
    EPI8_END
  }
}

DI void phase_qkv(const P& p, int layer, char* smem) {
  const int tidx = opaque_tid();
  const bf16_t* H = (const bf16_t*)(p.ws + OFF_TR + TR_H);
  const bf16_t* WQ = (const bf16_t*)(p.ws + w_off(layer)) + W_QKV;
  bf16_t* Q = (bf16_t*)(p.ws + OFF_TR + TR_Q);
  bf16_t* Kb = (bf16_t*)(p.ws + OFF_TR + TR_KK);
  bf16_t* VT = (bf16_t*)(p.ws + OFF_TR + TR_VT);
  const float* cosT = (const float*)(p.ws + OFF_MISC);
  const float* sinT = cosT + 1024;
  for (int t = blockIdx.x; t < xcd_rounds(272, 24) * (int)gridDim.x; t += gridDim.x) {
    int gt, nt;
    if (!xcd_tile(t, 272, 24, gt, nt)) continue;
    f32x16 acc[2][2];
    gemm_mainloop(H + (size_t)gt * 128 * 1024, 1024, WQ + (size_t)nt * 128 * 1024, 1024, 1024, smem, acc);
    const bool lat = gt < 256;
    const int b = lat ? gt / 32 : (gt - 256) / 2;
    const int t0 = lat ? (gt % 32) * 128 : (gt - 256) % 2 * 128;
    const int tq0 = lat ? t0 : SL + t0;
    const int typ = nt / 8, h = nt % 8;
    if (typ < 2) {
      bf16_t* dst = typ == 0 ? Q : Kb;
      const float qs = typ == 0 ? 0.125f * 1.44269504088896f : 1.f;
      float kmx = 0.f;
      EPI8_BEGIN
        const int sidx = col >> 6, d0 = col & 63;
        if (lat) {
          const float4 pa = *(const float4*)(es + row * EST + (col ^ 16));
          const float4 pb = *(const float4*)(es + row * EST + (col ^ 16) + 4);
          const float pr[8] = {pa.x, pa.y, pa.z, pa.w, pb.x, pb.y, pb.z, pb.w};
          const int tt = t0 + row;
          const int pos = (d0 < 32) ? (tt >> 6) : (tt & 63);
          const float4 ca = *(const float4*)(cosT + pos * 16 + (d0 & 8)), cb = *(const float4*)(cosT + pos * 16 + (d0 & 8) + 4);
          const float4 sa = *(const float4*)(sinT + pos * 16 + (d0 & 8)), sb = *(const float4*)(sinT + pos * 16 + (d0 & 8) + 4);
          const float cs[8] = {ca.x, ca.y, ca.z, ca.w, cb.x, cb.y, cb.z, cb.w};
          const float sn[8] = {sa.x, sa.y, sa.z, sa.w, sb.x, sb.y, sb.z, sb.w};
          const float sgn = (d0 & 16) ? 1.f : -1.f;
#pragma unroll
          for (int e = 0; e < 8; e++) v[e] = v[e] * cs[e] + sgn * pr[e] * sn[e];
        }
#pragma unroll
        for (int e = 0; e < 8; e++) v[e] *= qs;
        const uint4 pk_ = pack8(v);
        *(uint4*)(dst + ((size_t)((b * 8 + h) * 2 + sidx) * TK + tq0 + row) * 64 + d0) = pk_;
        if (typ == 1) {
          float rv_[8];
          unpack8(pk_, rv_);
          float ssq_ = 0.f;
#pragma unroll
          for (int e = 0; e < 8; e++) ssq_ += rv_[e] * rv_[e];
          ssq_ += __shfl_xor(ssq_, 1); ssq_ += __shfl_xor(ssq_, 2); ssq_ += __shfl_xor(ssq_, 4);
          kmx = fmaxf(kmx, ssq_);
        }
      EPI8_END
      if (typ == 1) {
        kmx = fmaxf(kmx, __shfl_xor(kmx, 16));
        kmx = fmaxf(kmx, __shfl_xor(kmx, 32));
        if ((tidx & 55) == 0)
          atomicMax((unsigned*)(p.ws + OFF_MISC) + 4096 + (layer >> 1) * 128 + (b * 8 + h) * 2 + ((tidx >> 3) & 1), __float_as_uint(kmx));
      }
    } else {
      float* es = (float*)smem;
      acc_to_lds(acc, es);
      __syncthreads();
      for (int pass = 0; pass < 8; pass++) {
        const int d = tidx & 127, tg = pass * 2 + (tidx >> 7);
        float v[8];
#pragma unroll
        for (int e = 0; e < 8; e++) v[e] = es[(tg * 8 + e) * EST + d];
        *(uint4*)(VT + ((size_t)(b * 8 + h) * 128 + d) * TK + tq0 + tg * 8) = pack8(v);
      }
      __syncthreads();
    }
  }
}

typedef _Float16 hv2 __attribute__((ext_vector_type(2)));
DI unsigned packh2(float a, float b) { hv2 r = {(_Float16)a, (_Float16)b}; return __builtin_bit_cast(unsigned, r); }
DI float lo_h(unsigned u) { hv2 r = __builtin_bit_cast(hv2, u); return (float)r[0]; }
DI float hi_h(unsigned u) { hv2 r = __builtin_bit_cast(hv2, u); return (float)r[1]; }

DI void phase_attn(const P& p, int layer, char* smem) {
  const int tidx = opaque_tid();
  const int j = layer / 2;
  const bool ctxq = layer != 3;
  const bf16_t* Q = (const bf16_t*)(p.ws + OFF_TR + TR_Q);
  const bf16_t* Kb = (const bf16_t*)(p.ws + OFF_TR + TR_KK);
  const bf16_t* VT = (const bf16_t*)(p.ws + OFF_TR + TR_VT);
  bf16_t* O = (bf16_t*)(p.ws + OFF_TR + TR_H);
  const float lam = ((const float*)(p.ws + OFF_MISC))[2048 + j];
  const float* kmax2 = (const float*)(p.ws + OFF_MISC) + 4096 + j * 128;
  const float oml = 1.f - lambda_init(layer);
  const float* subg = p.da_subln_g + (size_t)j * 128;
  constexpr int LDV = 72;
  bf16_t* sK = (bf16_t*)smem;
  bf16_t* sV = sK + 2 * 64 * LDT;
  const int tid = tidx, lane = tid & 63, w = tid >> 6, g = lane >> 5, l31 = lane & 31;
  const int nitems = 2048 + (ctxq ? 128 : 0);
  const int spx = gridDim.x >> 3, gpr = spx >> 5;
  const bool xmap = (gridDim.x == 256u || gridDim.x == 512u);
  const int lat_rounds = xmap ? 64 / (8 * gpr) : (2048 + (int)gridDim.x - 1) / (int)gridDim.x;
  for (int it0 = blockIdx.x; it0 < lat_rounds * (int)gridDim.x + (ctxq ? 128 : 0); it0 += gridDim.x) {
    int item;
    if (!xmap) {
      item = it0 < lat_rounds * (int)gridDim.x ? it0 : 2048 + (it0 - lat_rounds * (int)gridDim.x);
      if (it0 < lat_rounds * (int)gridDim.x && it0 >= 2048) continue;
    } else if (it0 < lat_rounds * (int)gridDim.x) {
      const int r = it0 % (int)gridDim.x, round = it0 / (int)gridDim.x;
      const int xcd = r & 7, li = r >> 3;
      const int bh = (round * 8 + xcd) * gpr + (li >> 5);
      item = bh * 32 + (li & 31);
    } else {
      item = 2048 + (it0 - lat_rounds * (int)gridDim.x);
    }
    (void)nitems;
    int b, h, q0, kbeg, ntiles;
    if (item < 2048) { b = item >> 8; h = (item >> 5) & 7; q0 = (item & 31) * 128; kbeg = 0; ntiles = TK / 64; }
    else { const int it = item - 2048; b = it >> 4; h = (it >> 1) & 7; q0 = SL + (it & 1) * 128; kbeg = SL; ntiles = CL / 64; }
    const bf16_t* Vp0 = VT + (size_t)(b * 8 + h) * 128 * TK;
    const int tq = q0 + w * 32 + l31;
    const size_t grow = tq < SL ? (size_t)b * SL + tq : (size_t)NLAT + (size_t)b * CL + (tq - SL);
    bf16_t* op = O + grow * 1024 + h * 128;
    for (int s = 0; s < 2; s++) {
      const bf16_t* Kp0 = Kb + (size_t)((b * 8 + h) * 2 + s) * TK * 64;
      const bf16_t* Qp = Q + ((size_t)((b * 8 + h) * 2 + s) * TK + tq) * 64 + g * 8;
      bf16x8 qf[4];
      float qss = 0.f;
#pragma unroll
      for (int kk = 0; kk < 4; kk++) {
        const uint4 u = *(const uint4*)(Qp + kk * 16);
        qf[kk] = __builtin_bit_cast(bf16x8, u);
        float qv[8];
        unpack8(u, qv);
#pragma unroll
        for (int e = 0; e < 8; e++) qss += qv[e] * qv[e];
      }
      qss += __shfl_xor(qss, 32);
      const float nmq = -sqrtf(qss * kmax2[(b * 8 + h) * 2 + s]);
      f32x16 o[4];
#pragma unroll
      for (int db = 0; db < 4; db++)
#pragma unroll
        for (int r = 0; r < 16; r++) o[db][r] = 0.f;
      float l = 0.f;
      uint4 rk0, rk1, rv0, rv1, rv2, rv3;
      const unsigned kvo = (unsigned)((tid >> 3) * 64 + (tid & 7) * 8);
      const unsigned vvo = (unsigned)((tid >> 3) * TK + (tid & 7) * 8);
      const unsigned sko = (unsigned)((tid >> 3) * LDT + (tid & 7) * 8);
      const unsigned svo = (unsigned)((tid >> 3) * LDV + ((tid & 7) >> 1) * 16 + (tid & 1) * 4);
#define ISSUE_KV(kt_)                                                             \
      {                                                                           \
        const bf16_t* kb_ = Kp0 + (size_t)(kbeg + (kt_) * 64) * 64;               \
        const bf16_t* vb_ = Vp0 + (kbeg + (kt_) * 64);                            \
        unsigned kvo_ = kvo, vvo_ = vvo;                                          \
        asm volatile("" : "+v"(kvo_), "+v"(vvo_));     \
        rk0 = *(const uint4*)(kb_ + kvo_);                                        \
        rk1 = *(const uint4*)(kb_ + (kvo_ + 32u * 64u));                          \
        rv0 = *(const uint4*)(vb_ + vvo_);                                        \
        rv1 = *(const uint4*)(vb_ + (vvo_ + 32u * (unsigned)TK));                 \
        rv2 = *(const uint4*)(vb_ + (vvo_ + 64u * (unsigned)TK));                 \
        rv3 = *(const uint4*)(vb_ + (vvo_ + 96u * (unsigned)TK));                 \
      }
#define ST_V(ptr_, r_) { *(uint2*)(ptr_) = make_uint2(r_.x, r_.y); *(uint2*)((ptr_) + 8) = make_uint2(r_.z, r_.w); }
#define STAGE_KV(buf_)                                                            \
      {                                                                           \
        bf16_t* ks_ = sK + (buf_) * 64 * LDT + sko;                               \
        bf16_t* vs_ = sV + (buf_) * 128 * LDV + svo;                              \
        *(uint4*)(ks_) = rk0;                                                     \
        *(uint4*)(ks_ + 32 * LDT) = rk1;                                          \
        ST_V(vs_, rv0); ST_V(vs_ + 32 * LDV, rv1); ST_V(vs_ + 64 * LDV, rv2); ST_V(vs_ + 96 * LDV, rv3); \
      }
      __syncthreads();
      ISSUE_KV(0);
      STAGE_KV(0);
      __syncthreads();
      for (int kt = 0; kt < ntiles; kt++) {
        const int buf = kt & 1;
        const bool more = kt + 1 < ntiles;
        if (more) ISSUE_KV(kt + 1);
        __builtin_amdgcn_sched_barrier(0);
        const bf16_t* kS = sK + buf * 64 * LDT;
        const bf16_t* vS = sV + buf * 128 * LDV;
#pragma unroll
        for (int kb = 0; kb < 2; kb++) {
          bf16x8 kf[4];
#pragma unroll
          for (int kk = 0; kk < 4; kk++) kf[kk] = *(const bf16x8*)(kS + (kb * 32 + l31) * LDT + kk * 16 + g * 8);
          __builtin_amdgcn_sched_barrier(0);
          f32x16 st;
#pragma unroll
          for (int r = 0; r < 16; r++) st[r] = nmq;
#pragma unroll
          for (int kk = 0; kk < 4; kk++) st = MFMA32(kf[kk], qf[kk], st);
          uint4 vf0[4];
#pragma unroll
          for (int db = 0; db < 4; db++) {
            vf0[db] = *(const uint4*)(vS + (db * 32 + l31) * LDV + kb * 32 + 8 * g);
          }
          __builtin_amdgcn_sched_barrier(0);
          float ls = 0.f;
          bf16x8 pk[2];
#pragma unroll
          for (int hh = 0; hh < 2; hh++) {
            float e[8];
#pragma unroll
            for (int i = 0; i < 8; i++) { e[i] = __builtin_amdgcn_exp2f(st[hh * 8 + i]); ls += e[i]; }
            const uint4 u = make_uint4(pack2(e[0], e[1]), pack2(e[2], e[3]), pack2(e[4], e[5]), pack2(e[6], e[7]));
            pk[hh] = __builtin_bit_cast(bf16x8, u);
          }
          l += ls;
          uint4 vf1[4];
#pragma unroll
          for (int db = 0; db < 4; db++) {
            vf1[db] = *(const uint4*)(vS + (db * 32 + l31) * LDV + kb * 32 + 16 + 8 * g);
          }
          __builtin_amdgcn_sched_barrier(0);
#pragma unroll
          for (int db = 0; db < 4; db++) o[db] = MFMA32(__builtin_bit_cast(bf16x8, vf0[db]), pk[0], o[db]);
#pragma unroll
          for (int db = 0; db < 4; db++) o[db] = MFMA32(__builtin_bit_cast(bf16x8, vf1[db]), pk[1], o[db]);
        }
        __builtin_amdgcn_sched_barrier(0);
        if (more) STAGE_KV(buf ^ 1);
        __syncthreads();
      }
      const float lt = l + __shfl_xor(l, 32);
      if (s == 0) {
        const float inv = 1.f / lt;
#pragma unroll
        for (int db = 0; db < 4; db++)
#pragma unroll
          for (int rq = 0; rq < 4; rq++) {
            const int d = db * 32 + 8 * rq + 4 * g;
            *(uint2*)(op + d) = make_uint2(packh2(o[db][4 * rq] * inv, o[db][4 * rq + 1] * inv), packh2(o[db][4 * rq + 2] * inv, o[db][4 * rq + 3] * inv));
          }
      } else {
        const float inv = lam / lt;
        float ssq = 0.f;
#pragma unroll
        for (int db = 0; db < 4; db++)
#pragma unroll
          for (int rq = 0; rq < 4; rq++) {
            const int d = db * 32 + 8 * rq + 4 * g;
            const uint2 u0 = *(const uint2*)(op + d);
            const float a0 = lo_h(u0.x) - o[db][4 * rq] * inv, a1 = hi_h(u0.x) - o[db][4 * rq + 1] * inv;
            const float a2 = lo_h(u0.y) - o[db][4 * rq + 2] * inv, a3 = hi_h(u0.y) - o[db][4 * rq + 3] * inv;
            o[db][4 * rq] = a0; o[db][4 * rq + 1] = a1; o[db][4 * rq + 2] = a2; o[db][4 * rq + 3] = a3;
            ssq += a0 * a0 + a1 * a1 + a2 * a2 + a3 * a3;
          }
        ssq += __shfl_xor(ssq, 32);
        const float rs = rsqrtf(ssq * (1.f / 128.f) + 1e-5f) * oml;
#pragma unroll
        for (int db = 0; db < 4; db++)
#pragma unroll
          for (int rq = 0; rq < 4; rq++) {
            const int d = db * 32 + 8 * rq + 4 * g;
            const float4 sg = *(const float4*)(subg + d);
            *(uint2*)(op + d) = make_uint2(pack2(o[db][4 * rq] * rs * sg.x, o[db][4 * rq + 1] * rs * sg.y),
                                           pack2(o[db][4 * rq + 2] * rs * sg.z, o[db][4 * rq + 3] * rs * sg.w));
          }
      }
    }
  }
}

DI void phase_at_out(const P& p, int layer, char* smem) {
  const int tidx = opaque_tid();
  const bf16_t* O = (const bf16_t*)(p.ws + OFF_TR + TR_H);
  const bf16_t* WO = (const bf16_t*)(p.ws + w_off(layer)) + W_WO;
  const int nmt = (layer == 3) ? 256 : 272;
  for (int t = blockIdx.x; t < xcd_rounds(nmt, 8) * (int)gridDim.x; t += gridDim.x) {
    int gt, nt_;
    if (!xcd_tile(t, nmt, 8, gt, nt_)) continue;
    const int n0 = nt_ * 128;
    f32x16 acc[2][2];
    gemm_mainloop(O + (size_t)gt * 128 * 1024, 1024, WO + (size_t)n0 * 1024, 1024, 1024, smem, acc);
    const float* gate = mods_ptr(p, layer, mod_row(gt * 128)) + 2048 + n0;
    float* xr = resid_row(p, gt * 128) + n0;
    EPI8_BEGIN
      resid_update(xr + (size_t)row * D + col, xr + (size_t)row * D + col, gate + col, v);
    EPI8_END
  }
}

DI void phase_final(const P& p) {
  const int tidx = opaque_tid();
  const int lane = tidx & 63, wv = tidx >> 6;
  for (int row = blockIdx.x * 4 + wv; row < NLAT; row += gridDim.x * 4) {
    float* xr = p.out + (size_t)row * D;
    float4 v[4];
    float ss = 0.f;
#pragma unroll
    for (int jx = 0; jx < 4; jx++) { v[jx] = *(const float4*)(xr + jx * 256 + lane * 4); ss += v[jx].x * v[jx].x + v[jx].y * v[jx].y + v[jx].z * v[jx].z + v[jx].w * v[jx].w; }
    ss = wave_sum(ss);
    const float rs = rsqrtf(ss * (1.f / 1024.f) + 1e-6f);
#pragma unroll
    for (int jx = 0; jx < 4; jx++) {
      const float4 g = *(const float4*)(p.final_g + jx * 256 + lane * 4);
      *(float4*)(xr + jx * 256 + lane * 4) = make_float4(v[jx].x * rs * g.x, v[jx].y * rs * g.y, v[jx].z * rs * g.z, v[jx].w * rs * g.w);
    }
  }
}

#define XB_TMO      128
#define XB_XCNT(j)  (256  + 64 * (j))
#define XB_XSUB(j)  (1280 + 64 * (j))
#define XB_XGEN(j)  (2304 + 64 * (j))
#define XB_TOP      3328
#define XB_TOPGEN   3392
#define XCD_BAR_WORDS 3456
#define XB_SPIN_CAP (1u << 22)
#define LAS __attribute__((address_space(3)))
DI unsigned xb_ld(unsigned* p) { return __hip_atomic_load(p, __ATOMIC_RELAXED, __HIP_MEMORY_SCOPE_AGENT); }
DI unsigned xb_add(unsigned* p, unsigned v) { return __hip_atomic_fetch_add(p, v, __ATOMIC_RELAXED, __HIP_MEMORY_SCOPE_AGENT); }
DI unsigned xb_xcc_id() { return (unsigned)__builtin_amdgcn_s_getreg((3 << 11) | 20) & 0xFu; }
#define XB_SPIN(cond, bar) do { unsigned _sp = 0; while (cond) { __builtin_amdgcn_s_sleep(1); \
    if ((++_sp & 255u) == 0u) { if (xb_ld(&(bar)[XB_TMO])) break; if (_sp > XB_SPIN_CAP) { atomicAdd(&(bar)[XB_TMO], 1u); break; } } } } while (0)
struct XcdBarrier { unsigned* bar; unsigned x; volatile LAS unsigned* st; };
DI XcdBarrier xcd_barrier_post(unsigned* bar, volatile LAS unsigned* st) {
  XcdBarrier b; b.bar = bar; b.x = xb_xcc_id(); b.st = st;
  if (threadIdx.x == 0) (void)xb_add(&bar[XB_XCNT(b.x)], 1u);
  return b;
}
DI void xcd_barrier_complete(unsigned* bar, unsigned x, unsigned& nloc, unsigned& nx) {
  const unsigned G = gridDim.x * gridDim.y * gridDim.z;
  unsigned sum, cnt, mine, sp = 0u;
  for (;;) {
    sum = 0u; cnt = 0u; mine = 0u;
#pragma unroll
    for (unsigned j = 0; j < 16; ++j) { const unsigned c = xb_ld(&bar[XB_XCNT(j)]); sum += c; cnt += (c > 0u) ? 1u : 0u; mine = (j == x) ? c : mine; }
    if (sum == G) break;
    __builtin_amdgcn_s_sleep(1);
    if ((++sp & 255u) == 0u) { if (xb_ld(&bar[XB_TMO])) break; if (sp > XB_SPIN_CAP) { atomicAdd(&bar[XB_TMO], 1u); break; } }
  }
  nloc = mine > 0u ? mine : 1u; nx = cnt > 0u ? cnt : 1u;
}
DI void xcd_barrier(const XcdBarrier& b) {
  asm volatile("s_waitcnt vmcnt(0)" ::: "memory");
  __syncthreads();
  if (threadIdx.x == 0) {
    unsigned* bar = b.bar;
    __builtin_amdgcn_s_waitcnt(0);
    unsigned nloc = b.st[0], nx = b.st[1];
    if (nloc == 0u) { xcd_barrier_complete(bar, b.x, nloc, nx); b.st[0] = nloc; b.st[1] = nx; }
    const unsigned old = xb_add(&bar[XB_XSUB(b.x)], 1u);
    const unsigned gen = old / nloc;
    if (old + 1u == (gen + 1u) * nloc) {
      __builtin_amdgcn_fence(__ATOMIC_RELEASE, "agent");
      asm volatile("s_waitcnt vmcnt(0)" ::: "memory");
      const unsigned og = xb_add(&bar[XB_TOP], 1u);
      const unsigned tg = og / nx;
      if (og + 1u == (tg + 1u) * nx) xb_add(&bar[XB_TOPGEN], 1u);
      else XB_SPIN(xb_ld(&bar[XB_TOPGEN]) == tg, bar);
      __builtin_amdgcn_fence(__ATOMIC_ACQUIRE, "agent");
      xb_add(&bar[XB_XGEN(b.x)], 1u);
      asm volatile("s_waitcnt vmcnt(0)" ::: "memory");
    } else {
      XB_SPIN(xb_ld(&bar[XB_XGEN(b.x)]) == gen, bar);
      __builtin_amdgcn_fence(__ATOMIC_ACQUIRE, "agent");
      asm volatile("s_waitcnt vmcnt(0)" ::: "memory");
    }
  }
  __syncthreads();
}
constexpr size_t OFF_BAR = OFF_MISC + 65536;

typedef __attribute__((address_space(1))) const float GCF;
typedef __attribute__((address_space(1))) float GF;
typedef __attribute__((address_space(1))) char GC;
DI unsigned long long lds_word(const unsigned long long* tbl, int i) {
  int z = i;
  asm volatile("" : "+v"(z));
  const unsigned long long v = tbl[z];
  const unsigned lo = __builtin_amdgcn_readfirstlane((unsigned)v), hi = __builtin_amdgcn_readfirstlane((unsigned)(v >> 32));
  return ((unsigned long long)hi << 32) | lo;
}
DI void load_params(P& q, const unsigned long long* tbl) {
  const float** fp = (const float**)&q;
#pragma unroll
  for (int i = 0; i < 36; i++) fp[i] = (const float*)(GCF*)lds_word(tbl, i);
  q.out = (float*)(GF*)lds_word(tbl, 36);
  q.ws = (char*)(GC*)lds_word(tbl, 37);
  q.only = 0;
  q.pad = 0;
}
__global__ void __launch_bounds__(256, 2) mega(P p) {
  __shared__ __attribute__((aligned(16))) char smem[73728];
  __shared__ unsigned long long s_tbl[40];
  {
#if defined(__HIP_DEVICE_COMPILE__)
    typedef __attribute__((address_space(4))) const unsigned long long KW;
    KW* kp = (KW*)__builtin_amdgcn_kernarg_segment_ptr();
    if (threadIdx.x < 39) s_tbl[threadIdx.x] = kp[threadIdx.x];
#endif
    __syncthreads();
  }
  const int only = (int)(unsigned)lds_word(s_tbl, 38);
  cg::grid_group grid = cg::this_grid();
  __shared__ uint4 xb_words;
  if (threadIdx.x == 0) xb_words = make_uint4(0u, 0u, 0u, 0u);
  __syncthreads();
  XcdBarrier xb;
  {
    P q;
    load_params(q, s_tbl);
    xb = xcd_barrier_post((unsigned*)(q.ws + OFF_BAR), (volatile LAS unsigned*)&xb_words);
  }
  int step = 0;
#define GSYNC() { if (only == -2) grid.sync(); else xcd_barrier(xb); }
#define STEP(body)                                   \
  {                                                  \
    if (only < 0 || only == step) {              \
      P q;                                           \
      load_params(q, s_tbl);                         \
      body;                                          \
    }                                                \
    step++;                                          \
    if (only < 0) GSYNC();                         \
  }
#ifndef DUP
#define DUP 0
#endif
#define STEPD(id, body)                              \
  {                                                  \
    if (only < 0 || only == step) {                  \
      P q;                                           \
      load_params(q, s_tbl);                         \
      body;                                          \
      if (DUP == id) { __syncthreads(); body; }      \
    }                                                \
    step++;                                          \
    if (only < 0) GSYNC();                           \
  }
  STEP(phase_init(q, smem); __syncthreads(); phase_conv(q, 0, smem, blockIdx.x, gridDim.x));
  for (int layer = 0; layer < 4; layer++) {
    if ((layer & 1) == 0) {
      for (int hf = 0; hf < 2; hf++) {
        STEPD(2, phase_prep(q, layer, 0, hf, true, (bf16_t*)(q.ws + OFF_TR + TR_HX), 2048, false));
        STEPD(3, phase_t1(q, layer, smem));
        STEPD(4, phase_feat(q, layer, hf, smem));
        STEPD(5, phase_scan(q, layer, smem);
              if (hf == 0) { __syncthreads(); phase_conv(q, layer + 1, smem, gridDim.x > 256 ? (int)blockIdx.x - 256 : (int)blockIdx.x, gridDim.x > 256 ? (int)gridDim.x - 256 : (int)gridDim.x); });
        STEP(phase_combine(q, layer));
        STEP(phase_rw_out(q, layer, hf, smem));
      }
    } else {
      STEP(phase_prep(q, layer, 0, -1, false, (bf16_t*)(q.ws + OFF_TR + TR_H), 1024, false);
           if (layer + 1 < 4) { __syncthreads(); phase_conv(q, layer + 1, smem, blockIdx.x, gridDim.x); });
      STEPD(7, phase_qkv(q, layer, smem));
      STEPD(8, phase_attn(q, layer, smem));
      STEP(phase_at_out(q, layer, smem));
    }
    STEPD(2, phase_prep(q, layer, 1, -1, false, (bf16_t*)(q.ws + OFF_TR + TR_H2), 1024, layer == 3));
    STEPD(9, phase_mlp1(q, layer, smem));
    STEP(phase_mlp2(q, layer, smem));
  }
  STEP(phase_final(q));
}

#ifndef MULTI_LAUNCH
#define MULTI_LAUNCH 0
#endif
constexpr int NSTEPS = 1 + 2 * (12 + 3) + 2 * (4 + 3) + 1;

extern "C" void kernel_launch(void* const* d_in, const int* in_sizes, int n_in, void* d_out, int out_size, void* d_ws, size_t ws_size,
                              hipStream_t stream) {
  static int grid_blocks = 0;
  if (!grid_blocks) {
    int dev = 0, cus = 0, per_cu = 0;
    hipGetDevice(&dev);
    hipDeviceGetAttribute(&cus, hipDeviceAttributeMultiprocessorCount, dev);
    hipOccupancyMaxActiveBlocksPerMultiprocessor(&per_cu, mega, 256, 0);
    if (per_cu < 1) per_cu = 1;
    if (per_cu > 2) per_cu = 2;
    grid_blocks = cus * per_cu;
  }
  P p{};
  const float** fp = (const float**)&p;
  for (int i = 0; i < 36; i++) fp[i] = (const float*)d_in[i];
  p.out = (float*)d_out;
  p.ws = (char*)d_ws;
  p.pad = 0;
#if MULTI_LAUNCH
  for (int s = 0; s < NSTEPS; s++) {
    p.only = s;
    void* args[] = {&p};
    hipError_t e = hipLaunchCooperativeKernel((void*)mega, dim3(grid_blocks), dim3(256), args, 0, stream);
    if (e != hipSuccess) { fprintf(stderr, "launch failed: %s\n", hipGetErrorString(e)); break; }
  }
#else
  p.only = -1;
  hipMemsetAsync((char*)d_ws + OFF_BAR, 0, XCD_BAR_WORDS * 4, stream);
  void* args[] = {&p};
  hipError_t e = hipLaunchCooperativeKernel((void*)mega, dim3(grid_blocks), dim3(256), args, 0, stream);
  if (e != hipSuccess) fprintf(stderr, "cooperative launch failed: %s (grid %d)\n", hipGetErrorString(e), grid_blocks);
#endif
}
```

```cpp
#include <hip/hip_runtime.h>
#include <hip/hip_cooperative_groups.h>
#include <cstdio>
namespace cg = cooperative_groups;

#define DI __device__ __forceinline__
typedef unsigned short bf16_t;
using bf16x8 = __attribute__((ext_vector_type(8))) short;
using f32x16 = __attribute__((ext_vector_type(16))) float;
typedef __bf16 bfv2 __attribute__((ext_vector_type(2)));
typedef float fv2 __attribute__((ext_vector_type(2)));
#define MFMA32(a, b, c) __builtin_amdgcn_mfma_f32_32x32x16_bf16((a), (b), (c), 0, 0, 0)

constexpr int D = 1024, NB = 8, SL = 4096, CL = 256;
constexpr int NLAT = NB * SL, NCTX = NB * CL, NTOK = NLAT + NCTX;
constexpr int HROWS = NTOK / 2;
constexpr int TK = SL + CL;
constexpr size_t MiB = 1048576;
constexpr size_t OFF_W2 = 476 * MiB;
constexpr size_t OFF_W = 0, OFF_XC = 36 * MiB, OFF_MODS = 44 * MiB, OFF_MISC = 45 * MiB, OFF_VF = 46 * MiB, OFF_TR = 114 * MiB;
constexpr size_t W_RKV = 0;
constexpr size_t W_L1 = W_RKV + 3072ull * 2048;
constexpr size_t W_W2 = W_L1 + 640ull * 2048;
constexpr size_t W_A2 = W_W2 + 2ull * 65536;
constexpr size_t W_G2 = W_A2 + 65536;
constexpr size_t W_V2 = W_G2 + 2ull * 196608;
constexpr size_t W_WO = W_V2 + 65536;
constexpr size_t W_M1 = W_WO + 1048576;
constexpr size_t W_M2 = W_M1 + 4194304;
constexpr size_t W_QKV = 0;
constexpr size_t HALF_ARR = (size_t)HROWS * 1024 * 2;
constexpr size_t TR_HX = 0;
constexpr size_t TR_T1 = 2 * HALF_ARR;
constexpr size_t TR_R = TR_T1 + (size_t)HROWS * 640 * 2;
constexpr size_t TR_K = TR_R + HALF_ARR, TR_V = TR_K + HALF_ARR, TR_A = TR_V + HALF_ARR;
constexpr size_t TR_WL0 = TR_A + HALF_ARR, TR_WL1 = TR_WL0 + HALF_ARR, TR_G0 = TR_WL1 + HALF_ARR, TR_G1 = TR_G0 + HALF_ARR;
constexpr size_t FULL_ARR = (size_t)NTOK * 1024 * 2;
constexpr size_t TR_H = 0, TR_Q = FULL_ARR, TR_KK = 2 * FULL_ARR, TR_VT = 3 * FULL_ARR;
constexpr size_t TR_H2 = 0, TR_HID = FULL_ARR;

struct P {
  const float *x, *c, *ctx, *c_ctx, *ada_w, *ada_b, *norm_g, *final_g;
  const float *rw_mix, *rw_w_rkv, *rw_w0, *rw_w1, *rw_w2, *rw_a0, *rw_a1, *rw_a2, *rw_g1, *rw_g2, *rw_kk, *rw_ka, *rw_rk, *rw_ln_g, *rw_ln_b, *rw_w_o, *rw_v0, *rw_v1, *rw_v2;
  const float *da_w_qkv, *da_w_o, *da_lq1, *da_lk1, *da_lq2, *da_lk2, *da_subln_g, *mlp_w1, *mlp_w2;
  float* out;
  char* ws;
  int only;
  int pad;
};

DI float bf2f(bf16_t h) { return __uint_as_float(((unsigned)h) << 16); }
DI unsigned pack2(float a, float b) { fv2 v = {a, b}; bfv2 r = __builtin_convertvector(v, bfv2); return __builtin_bit_cast(unsigned, r); }
DI bf16_t f2bf(float a) { return (bf16_t)(pack2(a, 0.f) & 0xffffu); }
DI float lo_bf(unsigned u) { return __uint_as_float(u << 16); }
DI float hi_bf(unsigned u) { return __uint_as_float(u & 0xffff0000u); }
DI float sigmoidf_(float x) { return __builtin_amdgcn_rcpf(1.f + __expf(-x)); }
DI float tanhf_(float x) { return 1.f - 2.f * __builtin_amdgcn_rcpf(1.f + __expf(2.f * x)); }
DI float wave_sum(float v) {
#pragma unroll
  for (int o = 32; o > 0; o >>= 1) v += __shfl_xor(v, o);
  return v;
}
template <int N> DI float ror_add(float x) { return x + __builtin_bit_cast(float, __builtin_amdgcn_mov_dpp(__builtin_bit_cast(int, x), 0x120 + N, 0xf, 0xf, true)); }
DI float rowsum16(float x) { x = ror_add<8>(x); x = ror_add<4>(x); x = ror_add<2>(x); x = ror_add<1>(x); return x; }

DI int opaque_tid() { int t = threadIdx.x; asm volatile("" : "+v"(t)); return t; }
DI float* resid_row(const P& p, int gr) { return gr < NLAT ? p.out + (size_t)gr * D : (float*)(p.ws + OFF_XC) + (size_t)(gr - NLAT) * D; }
DI const float* input_row(const P& p, int gr) { return gr < NLAT ? p.x + (size_t)gr * D : p.ctx + (size_t)(gr - NLAT) * D; }
DI int mod_row(int gr) { return gr < NLAT ? gr / SL : 8; }
DI const float* mods_ptr(const P& p, int layer, int mrow) { return (const float*)(p.ws + OFF_MODS) + ((size_t)layer * 9 + mrow) * 6144; }
DI int half_gtile(int hf, int lt) { return lt < 128 ? hf * 128 + lt : 256 + hf * 8 + (lt - 128); }
DI int first_tile(int base) { int g = gridDim.x; int s = (int)blockIdx.x - (base % g); if (s < 0) s += g; return s; }
DI size_t w_off(int layer) { return (layer & 1) ? OFF_W2 : OFF_W; }
DI float lambda_init(int layer) { return 0.8f - 0.6f * expf(-0.3f * (float)layer); }

DI void phase_init(const P& p, char* smem) {
  const int tidx = opaque_tid();
  const int tid = tidx;
  float* sc = (float*)smem;
  float* mods = (float*)(p.ws + OFF_MODS);
  for (int item = blockIdx.x; item < 96; item += gridDim.x) {
    const int layer = item / 24, cb = item % 24;
    __syncthreads();
    for (int i = tid; i < 9 * 1024; i += 256) {
      int r = i >> 10, k = i & 1023;
      float v = r < 8 ? p.c[r * 1024 + k] : p.c_ctx[k];
      sc[i] = v / (1.f + expf(-v));
    }
    __syncthreads();
    const int w = tid >> 6, q = tid & 63;
    float4 acc[9];
#pragma unroll
    for (int r = 0; r < 9; r++) acc[r] = make_float4(0.f, 0.f, 0.f, 0.f);
    const float* wp = p.ada_w + (size_t)layer * 1024 * 6144 + cb * 256 + q * 4;
    for (int k = w * 256; k < w * 256 + 256; k++) {
      float4 wv = *(const float4*)(wp + (size_t)k * 6144);
#pragma unroll
      for (int r = 0; r < 9; r++) {
        float s = sc[r * 1024 + k];
        acc[r].x += s * wv.x; acc[r].y += s * wv.y; acc[r].z += s * wv.z; acc[r].w += s * wv.w;
      }
    }
    __syncthreads();
    float4* red = (float4*)smem;
#pragma unroll
    for (int r = 0; r < 9; r++) red[(w * 9 + r) * 64 + q] = acc[r];
    __syncthreads();
    for (int i = tid; i < 9 * 64; i += 256) {
      int r = i / 64, qq = i % 64;
      float4 s0 = red[(0 * 9 + r) * 64 + qq], s1 = red[(1 * 9 + r) * 64 + qq], s2 = red[(2 * 9 + r) * 64 + qq], s3 = red[(3 * 9 + r) * 64 + qq];
      float4 bb = *(const float4*)(p.ada_b + layer * 6144 + cb * 256 + qq * 4);
      float4 o = make_float4(s0.x + s1.x + s2.x + s3.x + bb.x, s0.y + s1.y + s2.y + s3.y + bb.y, s0.z + s1.z + s2.z + s3.z + bb.z, s0.w + s1.w + s2.w + s3.w + bb.w);
      *(float4*)(mods + ((size_t)layer * 9 + r) * 6144 + cb * 256 + qq * 4) = o;
    }
  }
  if (blockIdx.x == gridDim.x - 1) {
    float* misc = (float*)(p.ws + OFF_MISC);
    for (int i = tid; i < 1024; i += 256) {
      int pos = i / 16, f = i % 16;
      float inv = powf(10000.f, -(float)f / 16.f);
      float ang = (float)pos * inv;
      misc[i] = cosf(ang);
      misc[1024 + i] = sinf(ang);
    }
    misc[4096 + tid] = 0.f;
    if (tid < 2) {
      float s1 = 0.f, s2 = 0.f;
      for (int k = 0; k < 64; k++) { s1 += p.da_lq1[tid * 64 + k] * p.da_lk1[tid * 64 + k]; s2 += p.da_lq2[tid * 64 + k] * p.da_lk2[tid * 64 + k]; }
      misc[2048 + tid] = expf(s1) - expf(s2) + lambda_init(2 * tid + 1);
    }
  }
}

DI void conv_mat(const float* __restrict__ src, int K, int N, bf16_t* __restrict__ dst, int ldd, int koff, const float* __restrict__ scale,
                 int Kp, int Np, float* sm, int& base, int vb, int vg) {
  const int tidx = opaque_tid();
  const int tid = tidx;
  const int tk = Kp / 64, tn = Np / 64, nt = tk * tn;
  int t0_ = vb - (base % vg);
  if (t0_ < 0) t0_ += vg;
  for (int t = t0_; t < nt; t += vg) {
    const int k0 = (t / tn) * 64, n0 = (t % tn) * 64;
    __syncthreads();
#pragma unroll
    for (int i = 0; i < 4; i++) {
      int kr = (tid >> 4) + 16 * i, nc = (tid & 15) * 4;
      float4 v = make_float4(0.f, 0.f, 0.f, 0.f);
      if (src != nullptr && k0 + kr < K && n0 + nc < N) {
        v = *(const float4*)(src + (size_t)(k0 + kr) * N + n0 + nc);
        if (scale) { float s = scale[k0 + kr]; v.x *= s; v.y *= s; v.z *= s; v.w *= s; }
      }
      sm[kr * 65 + nc + 0] = v.x; sm[kr * 65 + nc + 1] = v.y; sm[kr * 65 + nc + 2] = v.z; sm[kr * 65 + nc + 3] = v.w;
    }
    __syncthreads();
    const int n = tid >> 2, kb = (tid & 3) * 16;
    unsigned o[8];
#pragma unroll
    for (int i = 0; i < 8; i++) o[i] = pack2(sm[(kb + 2 * i) * 65 + n], sm[(kb + 2 * i + 1) * 65 + n]);
    uint4* dp = (uint4*)(dst + (size_t)(n0 + n) * ldd + koff + k0 + kb);
    dp[0] = make_uint4(o[0], o[1], o[2], o[3]);
    dp[1] = make_uint4(o[4], o[5], o[6], o[7]);
  }
  base += nt;
}

DI void phase_conv(const P& p, int layer, char* smem, int vb, int vg) {
  if (vb < 0) return;
  float* sm = (float*)smem;
  bf16_t* W = (bf16_t*)(p.ws + w_off(layer));
  int base = 0;
  const int j = layer / 2;
  if ((layer & 1) == 0) {
    for (int s = 0; s < 3; s++) {
      const float* src = p.rw_w_rkv + ((size_t)j * 3 + s) * 1048576;
      conv_mat(src, 1024, 1024, W + W_RKV + (size_t)s * 1024 * 2048, 2048, 0, nullptr, 1024, 1024, sm, base, vb, vg);
    }
    for (int pass = 0; pass < 2; pass++) {
      const int ko = pass * 1024;
      const float* m1 = pass ? p.rw_mix + ((size_t)j * 6 + 1) * 1024 : nullptr;
      const float* m4 = pass ? p.rw_mix + ((size_t)j * 6 + 4) * 1024 : nullptr;
      const float* m5 = pass ? p.rw_mix + ((size_t)j * 6 + 5) * 1024 : nullptr;
      const float* m3 = pass ? p.rw_mix + ((size_t)j * 6 + 3) * 1024 : nullptr;
      bf16_t* L1 = W + W_L1;
      conv_mat(p.rw_w1 + ((size_t)j * 2 + 0) * 65536, 1024, 64, L1 + 0ull * 2048, 2048, ko, m1, 1024, 64, sm, base, vb, vg);
      conv_mat(p.rw_w1 + ((size_t)j * 2 + 1) * 65536, 1024, 64, L1 + 64ull * 2048, 2048, ko, m1, 1024, 64, sm, base, vb, vg);
      conv_mat(p.rw_a1 + (size_t)j * 65536, 1024, 64, L1 + 128ull * 2048, 2048, ko, m4, 1024, 64, sm, base, vb, vg);
      conv_mat(p.rw_g1 + ((size_t)j * 2 + 0) * 163840, 1024, 160, L1 + 256ull * 2048, 2048, ko, m5, 1024, 192, sm, base, vb, vg);
      conv_mat(p.rw_g1 + ((size_t)j * 2 + 1) * 163840, 1024, 160, L1 + 448ull * 2048, 2048, ko, m5, 1024, 192, sm, base, vb, vg);
      conv_mat(j > 0 ? p.rw_v1 + (size_t)(j - 1) * 32768 : nullptr, 1024, 32, L1 + 192ull * 2048, 2048, ko, m3, 1024, 64, sm, base, vb, vg);
    }
    conv_mat(p.rw_w2 + ((size_t)j * 2 + 0) * 65536, 64, 1024, W + W_W2, 64, 0, nullptr, 64, 1024, sm, base, vb, vg);
    conv_mat(p.rw_w2 + ((size_t)j * 2 + 1) * 65536, 64, 1024, W + W_W2 + 65536, 64, 0, nullptr, 64, 1024, sm, base, vb, vg);
    conv_mat(p.rw_a2 + (size_t)j * 65536, 64, 1024, W + W_A2, 64, 0, nullptr, 64, 1024, sm, base, vb, vg);
    conv_mat(p.rw_g2 + ((size_t)j * 2 + 0) * 163840, 160, 1024, W + W_G2, 192, 0, nullptr, 192, 1024, sm, base, vb, vg);
    conv_mat(p.rw_g2 + ((size_t)j * 2 + 1) * 163840, 160, 1024, W + W_G2 + 196608, 192, 0, nullptr, 192, 1024, sm, base, vb, vg);
    conv_mat(j > 0 ? p.rw_v2 + (size_t)(j - 1) * 32768 : nullptr, 32, 1024, W + W_V2, 64, 0, nullptr, 64, 1024, sm, base, vb, vg);
    conv_mat(p.rw_w_o + (size_t)j * 1048576, 1024, 1024, W + W_WO, 1024, 0, nullptr, 1024, 1024, sm, base, vb, vg);
  } else {
    conv_mat(p.da_w_qkv + (size_t)j * 3145728, 1024, 3072, W + W_QKV, 1024, 0, nullptr, 1024, 3072, sm, base, vb, vg);
    conv_mat(p.da_w_o + (size_t)j * 1048576, 1024, 1024, W + W_WO, 1024, 0, nullptr, 1024, 1024, sm, base, vb, vg);
  }
  conv_mat(p.mlp_w1 + (size_t)layer * 4194304, 1024, 4096, W + W_M1, 1024, 0, nullptr, 1024, 4096, sm, base, vb, vg);
  conv_mat(p.mlp_w2 + (size_t)layer * 4194304, 4096, 1024, W + W_M2, 4096, 0, nullptr, 4096, 1024, sm, base, vb, vg);
}

DI void phase_prep(const P& p, int layer, int sub, int hf, bool shift, bf16_t* H, int ldh, bool skip_ctx) {
  const int tidx = opaque_tid();
  const int lane = tidx & 63, wv = tidx >> 6;
  const int nrows = hf < 0 ? (skip_ctx ? NLAT : NTOK) : HROWS;
  const int nseg = nrows / 8;
  const float* ng = p.norm_g + ((size_t)layer * 2 + sub) * 1024;
  for (int seg = blockIdx.x * 4 + wv; seg < nseg; seg += gridDim.x * 4) {
    const int lr0 = seg * 8;
    const int gr0 = hf < 0 ? lr0 : (lr0 < 16384 ? hf * 16384 + lr0 : NLAT + hf * 1024 + (lr0 - 16384));
    const bool lat = gr0 < NLAT;
    const int T = lat ? SL : CL;
    const int t0 = lat ? (gr0 % SL) : ((gr0 - NLAT) % CL);
    const float* xbase = (layer == 0 && sub == 0) ? input_row(p, gr0) : resid_row(p, gr0);
    const float* md = mods_ptr(p, layer, mod_row(gr0));
    float4 g4[4], sc4[4], sh4[4];
#pragma unroll
    for (int jx = 0; jx < 4; jx++) {
      int ch = jx * 256 + lane * 4;
      g4[jx] = *(const float4*)(ng + ch);
      sh4[jx] = *(const float4*)(md + sub * 3072 + ch);
      sc4[jx] = *(const float4*)(md + sub * 3072 + 1024 + ch);
      g4[jx].x *= (1.f + sc4[jx].x); g4[jx].y *= (1.f + sc4[jx].y); g4[jx].z *= (1.f + sc4[jx].z); g4[jx].w *= (1.f + sc4[jx].w);
    }
    float4 hp[4], hc[4], hn[4];
    const int tb = shift ? -1 : 0, te = shift ? 9 : 8;
    for (int tt = tb; tt < te; tt++) {
      const int t = t0 + tt;
      if (t >= 0 && t < T) {
        const float* xr = xbase + (ptrdiff_t)tt * D;
        float ss = 0.f;
#pragma unroll
        for (int jx = 0; jx < 4; jx++) {
          hn[jx] = *(const float4*)(xr + jx * 256 + lane * 4);
          ss += hn[jx].x * hn[jx].x + hn[jx].y * hn[jx].y + hn[jx].z * hn[jx].z + hn[jx].w * hn[jx].w;
        }
        ss = wave_sum(ss);
        const float rs = rsqrtf(ss * (1.f / 1024.f) + 1e-6f);
#pragma unroll
        for (int jx = 0; jx < 4; jx++) {
          hn[jx].x = hn[jx].x * rs * g4[jx].x + sh4[jx].x; hn[jx].y = hn[jx].y * rs * g4[jx].y + sh4[jx].y;
          hn[jx].z = hn[jx].z * rs * g4[jx].z + sh4[jx].z; hn[jx].w = hn[jx].w * rs * g4[jx].w + sh4[jx].w;
        }
      } else {
#pragma unroll
        for (int jx = 0; jx < 4; jx++) hn[jx] = make_float4(0.f, 0.f, 0.f, 0.f);
      }
      if (!shift) {
        bf16_t* hr = H + (size_t)(lr0 + tt) * ldh;
#pragma unroll
        for (int jx = 0; jx < 4; jx++) *(uint2*)(hr + jx * 256 + lane * 4) = make_uint2(pack2(hn[jx].x, hn[jx].y), pack2(hn[jx].z, hn[jx].w));
      } else if (tt >= 1) {
        bf16_t* hr = H + (size_t)(lr0 + tt - 1) * ldh;
#pragma unroll
        for (int jx = 0; jx < 4; jx++) {
          *(uint2*)(hr + jx * 256 + lane * 4) = make_uint2(pack2(hc[jx].x, hc[jx].y), pack2(hc[jx].z, hc[jx].w));
          float4 xx;
          xx.x = 0.5f * (hp[jx].x + hn[jx].x) - hc[jx].x; xx.y = 0.5f * (hp[jx].y + hn[jx].y) - hc[jx].y;
          xx.z = 0.5f * (hp[jx].z + hn[jx].z) - hc[jx].z; xx.w = 0.5f * (hp[jx].w + hn[jx].w) - hc[jx].w;
          *(uint2*)(hr + 1024 + jx * 256 + lane * 4) = make_uint2(pack2(xx.x, xx.y), pack2(xx.z, xx.w));
        }
      }
#pragma unroll
      for (int jx = 0; jx < 4; jx++) { hp[jx] = hc[jx]; hc[jx] = hn[jx]; }
    }
  }
}

constexpr int LDT = 72;
DI void gemm_mainloop(const bf16_t* __restrict__ A, int lda, const bf16_t* __restrict__ Bt, int ldb, int K, char* smem, f32x16 (&acc)[2][2]) {
  const int tidx = opaque_tid();
  bf16_t* sA = (bf16_t*)smem;
  bf16_t* sB = sA + 2 * 128 * LDT;
  const int tid = tidx, lane = tid & 63, w = tid >> 6, wm = w >> 1, wn = w & 1;
  const int lrow = tid >> 3, lkc = (tid & 7) * 8;
#pragma unroll
  for (int mi = 0; mi < 2; mi++)
#pragma unroll
    for (int ni = 0; ni < 2; ni++)
#pragma unroll
      for (int r = 0; r < 16; r++) acc[mi][ni][r] = 0.f;
  const unsigned ao = (unsigned)(lrow * lda + lkc), bo = (unsigned)(lrow * ldb + lkc);
  const unsigned a32 = (unsigned)(32 * lda), b32 = (unsigned)(32 * ldb);
  uint4 ra0, ra1, ra2, ra3, rb0, rb1, rb2, rb3;
#define G_LOAD(Ab, Bb)                                                                                   \
  {                                                                                                      \
    ra0 = *(const uint4*)((Ab) + ao); ra1 = *(const uint4*)((Ab) + (ao + a32));                          \
    ra2 = *(const uint4*)((Ab) + (ao + 2 * a32)); ra3 = *(const uint4*)((Ab) + (ao + 3 * a32));          \
    rb0 = *(const uint4*)((Bb) + bo); rb1 = *(const uint4*)((Bb) + (bo + b32));                          \
    rb2 = *(const uint4*)((Bb) + (bo + 2 * b32)); rb3 = *(const uint4*)((Bb) + (bo + 3 * b32));          \
  }
#define G_STORE(sa_, sb_)                                                                                \
  {                                                                                                      \
    bf16_t* a_w = (sa_) + lrow * LDT + lkc;                                                              \
    bf16_t* b_w = (sb_) + lrow * LDT + lkc;                                                              \
    *(uint4*)(a_w) = ra0; *(uint4*)(a_w + 32 * LDT) = ra1; *(uint4*)(a_w + 64 * LDT) = ra2; *(uint4*)(a_w + 96 * LDT) = ra3; \
    *(uint4*)(b_w) = rb0; *(uint4*)(b_w + 32 * LDT) = rb1; *(uint4*)(b_w + 64 * LDT) = rb2; *(uint4*)(b_w + 96 * LDT) = rb3; \
  }
  G_LOAD(A, Bt);
  G_STORE(sA, sB);
  __syncthreads();
  const int nk = K >> 6;
  const int aoff = (wm * 64 + (lane & 31)) * LDT + (lane >> 5) * 8;
  const int boff = (wn * 64 + (lane & 31)) * LDT + (lane >> 5) * 8;
  for (int kt = 0; kt < nk; kt++) {
    const int cur = kt & 1;
    if (kt + 1 < nk) {
      const bf16_t* A1 = A + (kt + 1) * 64;
      const bf16_t* B1 = Bt + (kt + 1) * 64;
      G_LOAD(A1, B1);
    }
    __builtin_amdgcn_sched_barrier(0);
    __builtin_amdgcn_s_setprio(1);
    const bf16_t* a_s = sA + cur * 128 * LDT + aoff;
    const bf16_t* b_s = sB + cur * 128 * LDT + boff;
#pragma unroll
    for (int kk = 0; kk < 4; kk++) {
      bf16x8 af[2], bq[2];
#pragma unroll
      for (int mi = 0; mi < 2; mi++) af[mi] = *(const bf16x8*)(a_s + mi * 32 * LDT + kk * 16);
#pragma unroll
      for (int ni = 0; ni < 2; ni++) bq[ni] = *(const bf16x8*)(b_s + ni * 32 * LDT + kk * 16);
#pragma unroll
      for (int mi = 0; mi < 2; mi++)
#pragma unroll
        for (int ni = 0; ni < 2; ni++) acc[mi][ni] = MFMA32(af[mi], bq[ni], acc[mi][ni]);
    }
    __builtin_amdgcn_s_setprio(0);
    __builtin_amdgcn_sched_barrier(0);
    if (kt + 1 < nk) G_STORE(sA + (cur ^ 1) * 128 * LDT, sB + (cur ^ 1) * 128 * LDT);
    __syncthreads();
  }
}
DI float fma_s(float a, float b, float c) { float r; asm("v_fma_f32 %0, %1, %2, %3" : "=v"(r) : "v"(a), "v"(b), "v"(c)); return r; }
DI uint4 mix8(const uint4 h, const uint4 x, const float4 m0, const float4 m1) {
  uint4 o;
  o.x = pack2(fma_s(lo_bf(x.x), m0.x, lo_bf(h.x)), fma_s(hi_bf(x.x), m0.y, hi_bf(h.x)));
  o.y = pack2(fma_s(lo_bf(x.y), m0.z, lo_bf(h.y)), fma_s(hi_bf(x.y), m0.w, hi_bf(h.y)));
  o.z = pack2(fma_s(lo_bf(x.z), m1.x, lo_bf(h.z)), fma_s(hi_bf(x.z), m1.y, hi_bf(h.z)));
  o.w = pack2(fma_s(lo_bf(x.w), m1.z, lo_bf(h.w)), fma_s(hi_bf(x.w), m1.w, hi_bf(h.w)));
  return o;
}
DI void gemm_mainloop_mix(const bf16_t* __restrict__ HX, const float* __restrict__ mix, const bf16_t* __restrict__ Bt, int ldb, char* smem, f32x16 (&acc)[2][2]) {
  const int tidx = opaque_tid();
  bf16_t* sA = (bf16_t*)smem;
  bf16_t* sB = sA + 2 * 128 * LDT;
  const int tid = tidx, lane = tid & 63, w = tid >> 6, wm = w >> 1, wn = w & 1;
  const int lrow = tid >> 3, lkc = (tid & 7) * 8;
#pragma unroll
  for (int mi = 0; mi < 2; mi++)
#pragma unroll
    for (int ni = 0; ni < 2; ni++)
#pragma unroll
      for (int r = 0; r < 16; r++) acc[mi][ni][r] = 0.f;
  const unsigned ao = (unsigned)(lrow * 2048 + lkc), bo = (unsigned)(lrow * ldb + lkc);
  const unsigned a32 = 32u * 2048u, b32 = (unsigned)(32 * ldb);
  uint4 h0, h1, h2, h3, x0, x1, x2, x3, rb0, rb1, rb2, rb3;
  float4 m0, m1;
#define GM_LOAD(kstep_)                                                                                  \
  {                                                                                                      \
    const bf16_t* Ab_ = HX + (kstep_) * 64;                                                              \
    const bf16_t* Bb_ = Bt + (kstep_) * 64;                                                              \
    h0 = *(const uint4*)(Ab_ + ao); h1 = *(const uint4*)(Ab_ + (ao + a32));                              \
    h2 = *(const uint4*)(Ab_ + (ao + 2 * a32)); h3 = *(const uint4*)(Ab_ + (ao + 3 * a32));              \
    x0 = *(const uint4*)(Ab_ + (ao + 1024u)); x1 = *(const uint4*)(Ab_ + (ao + a32 + 1024u));            \
    x2 = *(const uint4*)(Ab_ + (ao + 2 * a32 + 1024u)); x3 = *(const uint4*)(Ab_ + (ao + 3 * a32 + 1024u)); \
    rb0 = *(const uint4*)(Bb_ + bo); rb1 = *(const uint4*)(Bb_ + (bo + b32));                            \
    rb2 = *(const uint4*)(Bb_ + (bo + 2 * b32)); rb3 = *(const uint4*)(Bb_ + (bo + 3 * b32));            \
    m0 = *(const float4*)(mix + (kstep_) * 64 + lkc); m1 = *(const float4*)(mix + (kstep_) * 64 + lkc + 4); \
  }
#define GM_STORE(buf_)                                                                                   \
  {                                                                                                      \
    bf16_t* a_w = sA + (buf_) * 128 * LDT + lrow * LDT + lkc;                                            \
    bf16_t* b_w = sB + (buf_) * 128 * LDT + lrow * LDT + lkc;                                            \
    *(uint4*)(a_w) = mix8(h0, x0, m0, m1); *(uint4*)(a_w + 32 * LDT) = mix8(h1, x1, m0, m1);             \
    *(uint4*)(a_w + 64 * LDT) = mix8(h2, x2, m0, m1); *(uint4*)(a_w + 96 * LDT) = mix8(h3, x3, m0, m1);  \
    *(uint4*)(b_w) = rb0; *(uint4*)(b_w + 32 * LDT) = rb1; *(uint4*)(b_w + 64 * LDT) = rb2; *(uint4*)(b_w + 96 * LDT) = rb3; \
  }
  GM_LOAD(0);
  GM_STORE(0);
  __syncthreads();
  const int aoff = (wm * 64 + (lane & 31)) * LDT + (lane >> 5) * 8;
  const int boff = (wn * 64 + (lane & 31)) * LDT + (lane >> 5) * 8;
  for (int kt = 0; kt < 16; kt++) {
    const int cur = kt & 1;
    if (kt + 1 < 16) GM_LOAD(kt + 1);
    __builtin_amdgcn_sched_barrier(0);
    __builtin_amdgcn_s_setprio(1);
    const bf16_t* a_s = sA + cur * 128 * LDT + aoff;
    const bf16_t* b_s = sB + cur * 128 * LDT + boff;
#pragma unroll
    for (int kk = 0; kk < 4; kk++) {
      bf16x8 af[2], bq[2];
#pragma unroll
      for (int mi = 0; mi < 2; mi++) af[mi] = *(const bf16x8*)(a_s + mi * 32 * LDT + kk * 16);
#pragma unroll
      for (int ni = 0; ni < 2; ni++) bq[ni] = *(const bf16x8*)(b_s + ni * 32 * LDT + kk * 16);
#pragma unroll
      for (int mi = 0; mi < 2; mi++)
#pragma unroll
        for (int ni = 0; ni < 2; ni++) acc[mi][ni] = MFMA32(af[mi], bq[ni], acc[mi][ni]);
    }
    __builtin_amdgcn_s_setprio(0);
    __builtin_amdgcn_sched_barrier(0);
    if (kt + 1 < 16) GM_STORE(cur ^ 1);
    __syncthreads();
  }
}

constexpr int EST = 132;
DI void acc_to_lds(const f32x16 (&acc)[2][2], float* es) {
  const int tidx = opaque_tid();
  const int lane = tidx & 63, w = tidx >> 6, wm = w >> 1, wn = w & 1;
#pragma unroll
  for (int mi = 0; mi < 2; mi++)
#pragma unroll
    for (int ni = 0; ni < 2; ni++)
#pragma unroll
      for (int r = 0; r < 16; r++)
        es[(wm * 64 + mi * 32 + (r & 3) + 8 * (r >> 2) + 4 * (lane >> 5)) * EST + wn * 64 + ni * 32 + (lane & 31)] = acc[mi][ni][r];
}
#define EPI8_BEGIN                                                                   \
  {                                                                                  \
    float* es = (float*)smem;                                                        \
    acc_to_lds(acc, es);                                                             \
    __syncthreads();                                                                 \
    for (int pass = 0; pass < 8; pass++) {                                           \
      const int row = pass * 16 + (tidx >> 4), col = (tidx & 15) * 8;  \
      const float4 e_va = *(const float4*)(es + row * EST + col);                    \
      const float4 e_vb = *(const float4*)(es + row * EST + col + 4);                \
      float v[8] = {e_va.x, e_va.y, e_va.z, e_va.w, e_vb.x, e_vb.y, e_vb.z, e_vb.w};
#define EPI8_END                                                                     \
    }                                                                                \
    __syncthreads();                                                                 \
  }
DI uint4 pack8(const float (&v)[8]) { return make_uint4(pack2(v[0], v[1]), pack2(v[2], v[3]), pack2(v[4], v[5]), pack2(v[6], v[7])); }
DI void unpack8(const uint4 u, float (&v)[8]) {
  v[0] = lo_bf(u.x); v[1] = hi_bf(u.x); v[2] = lo_bf(u.y); v[3] = hi_bf(u.y); v[4] = lo_bf(u.z); v[5] = hi_bf(u.z); v[6] = lo_bf(u.w); v[7] = hi_bf(u.w);
}
DI void resid_update(float* xp, const float* xsrc, const float* gate, const float (&v)[8]) {
  float4 x0 = *(const float4*)xsrc, x1 = *(const float4*)(xsrc + 4);
  const float4 g0 = *(const float4*)gate, g1 = *(const float4*)(gate + 4);
  x0.x += g0.x * v[0]; x0.y += g0.y * v[1]; x0.z += g0.z * v[2]; x0.w += g0.w * v[3];
  x1.x += g1.x * v[4]; x1.y += g1.y * v[5]; x1.z += g1.z * v[6]; x1.w += g1.w * v[7];
  *(float4*)xp = x0; *(float4*)(xp + 4) = x1;
}

DI bool xcd_tile(int t, int Mt, int Nt, int& mt, int& nt) {
  const int G = gridDim.x;
  if ((G & 63) != 0 || (Nt % (G >> 6)) != 0 || (Mt & 7) != 0) {
    if (t >= Mt * Nt) return false;
    mt = t / Nt; nt = t % Nt;
    return true;
  }
  const int spx = G >> 3, tn = spx >> 3;
  const int r = t % G, round = t / G;
  const int xcd = r & 7, li = r >> 3;
  const int smn = Mt >> 3, snn = Nt / tn;
  const int st = round * 8 + xcd;
  if (st >= smn * snn) return false;
  const int smi = st % smn, sni = st / smn;
  mt = smi * 8 + (li & 7);
  nt = sni * tn + (li >> 3);
  return true;
}
DI int xcd_rounds(int Mt, int Nt) {
  const int G = gridDim.x;
  if ((G & 63) != 0 || (Nt % (G >> 6)) != 0 || (Mt & 7) != 0) return (Mt * Nt + G - 1) / G;
  const int tn = G >> 6;
  return ((Mt >> 3) * (Nt / tn) + 7) >> 3;
}

DI void phase_t1(const P& p, int layer, char* smem) {
  const int j = layer / 2;
  const int tidx = opaque_tid();
  const bf16_t* HX = (const bf16_t*)(p.ws + OFF_TR + TR_HX);
  const bf16_t* WL1 = (const bf16_t*)(p.ws + w_off(0)) + W_L1;
  bf16_t* T1 = (bf16_t*)(p.ws + OFF_TR + TR_T1);
  for (int t = blockIdx.x; t < 136 * 5; t += gridDim.x) {
    const int nt = t % 5, lt = t / 5;
    f32x16 acc[2][2];
    if (nt == 1) gemm_mainloop(HX + (size_t)lt * 128 * 2048, 2048, WL1 + (size_t)nt * 128 * 2048, 2048, 2048, smem, acc);
    else gemm_mainloop_mix(HX + (size_t)lt * 128 * 2048, p.rw_mix + ((size_t)j * 6 + (nt == 0 ? 1 : 5)) * 1024, WL1 + (size_t)nt * 128 * 2048, 2048, smem, acc);
    EPI8_BEGIN
      const int c = nt * 128 + col;
      if (c < 128) {
#pragma unroll
        for (int e = 0; e < 8; e++) v[e] = tanhf_(v[e]);
      } else if (c >= 256) {
#pragma unroll
        for (int e = 0; e < 8; e++) v[e] = sigmoidf_(v[e]);
      }
      *(uint4*)(T1 + (size_t)(lt * 128 + row) * 640 + c) = pack8(v);
    EPI8_END
  }
}

DI void phase_feat(const P& p, int layer, int hf, char* smem) {
  const int tidx = opaque_tid();
  const int j = layer / 2;
  const bf16_t* W = (const bf16_t*)(p.ws + w_off(layer));
  const bf16_t* HX = (const bf16_t*)(p.ws + OFF_TR + TR_HX);
  const bf16_t* T1 = (const bf16_t*)(p.ws + OFF_TR + TR_T1);
  bf16_t* VF = (bf16_t*)(p.ws + OFF_VF);
  for (int t = blockIdx.x; t < xcd_rounds(136, 24) * (int)gridDim.x; t += gridDim.x) {
    int lt, nt;
    if (!xcd_tile(t, 136, 24, lt, nt)) continue;
    const int s = nt / 8, n0 = (nt % 8) * 128;
    const int gt = half_gtile(hf, lt);
    f32x16 acc[2][2];
    bf16_t* outp = (bf16_t*)(p.ws + OFF_TR + (s == 0 ? TR_R : (s == 1 ? TR_K : TR_V)));
    if (s == 2 && j > 0) {
      gemm_mainloop(T1 + (size_t)lt * 128 * 640 + 192, 640, W + W_V2 + (size_t)n0 * 64, 64, 64, smem, acc);
      const float* v0 = p.rw_v0 + (size_t)(j - 1) * 1024;
      EPI8_BEGIN
        const int c = n0 + col;
#pragma unroll
        for (int e = 0; e < 8; e++) v[e] = sigmoidf_(v0[c + e] + v[e]);
        *(uint4*)(outp + (size_t)(lt * 128 + row) * 1024 + c) = pack8(v);
      EPI8_END
    }
    {
      const int mixsel = s == 0 ? 0 : (s == 1 ? 2 : 3);
      gemm_mainloop_mix(HX + (size_t)lt * 128 * 2048, p.rw_mix + ((size_t)j * 6 + mixsel) * 1024, W + W_RKV + ((size_t)s * 1024 + n0) * 2048, 2048, smem, acc);
    }
    if (s < 2) {
      EPI8_BEGIN
        *(uint4*)(outp + (size_t)(lt * 128 + row) * 1024 + n0 + col) = pack8(v);
      EPI8_END
    } else if (j == 0) {
      EPI8_BEGIN
        const uint4 u = pack8(v);
        *(uint4*)(outp + (size_t)(lt * 128 + row) * 1024 + n0 + col) = u;
        *(uint4*)(VF + (size_t)(gt * 128 + row) * 1024 + n0 + col) = u;
      EPI8_END
    } else {
      EPI8_BEGIN
        const size_t oi = (size_t)(lt * 128 + row) * 1024 + n0 + col;
        float sg[8], vf[8];
        unpack8(*(const uint4*)(outp + oi), sg);
        unpack8(*(const uint4*)(VF + (size_t)(gt * 128 + row) * 1024 + n0 + col), vf);
#pragma unroll
        for (int e = 0; e < 8; e++) v[e] = v[e] + (vf[e] - v[e]) * sg[e];
        *(uint4*)(outp + oi) = pack8(v);
      EPI8_END
    }
  }
  for (int t = blockIdx.x; t < xcd_rounds(136, 40) * (int)gridDim.x; t += gridDim.x) {
    int lt, nt;
    if (!xcd_tile(t, 136, 40, lt, nt)) continue;
    const int s = nt / 8, n0 = (nt % 8) * 128;
    f32x16 acc[2][2];
    if (s == 0) {
      gemm_mainloop(T1 + (size_t)lt * 128 * 640 + 128, 640, W + W_A2 + (size_t)n0 * 64, 64, 64, smem, acc);
      bf16_t* outp = (bf16_t*)(p.ws + OFF_TR + TR_A);
      const float* a0 = p.rw_a0 + (size_t)j * 1024;
      const float4 pa_ = *(const float4*)(a0 + n0 + (tidx & 15) * 8), pb_ = *(const float4*)(a0 + n0 + (tidx & 15) * 8 + 4);
      const float prm[8] = {pa_.x, pa_.y, pa_.z, pa_.w, pb_.x, pb_.y, pb_.z, pb_.w};
      EPI8_BEGIN
#pragma unroll
        for (int e = 0; e < 8; e++) v[e] = sigmoidf_(prm[e] + v[e]);
        *(uint4*)(outp + (size_t)(lt * 128 + row) * 1024 + n0 + col) = pack8(v);
      EPI8_END
    } else if (s < 3) {
      const int d = s - 1;
      gemm_mainloop(T1 + (size_t)lt * 128 * 640 + d * 64, 640, W + W_W2 + (size_t)d * 65536 + (size_t)n0 * 64, 64, 64, smem, acc);
      bf16_t* outp = (bf16_t*)(p.ws + OFF_TR + (d ? TR_WL1 : TR_WL0));
      const float* w0 = p.rw_w0 + ((size_t)j * 2 + d) * 1024;
      const float4 pa_ = *(const float4*)(w0 + n0 + (tidx & 15) * 8), pb_ = *(const float4*)(w0 + n0 + (tidx & 15) * 8 + 4);
      const float prm[8] = {pa_.x, pa_.y, pa_.z, pa_.w, pb_.x, pb_.y, pb_.z, pb_.w};
      EPI8_BEGIN
#pragma unroll
        for (int e = 0; e < 8; e++) v[e] = -0.60653065971263342f * sigmoidf_(prm[e] + v[e]);
        *(uint4*)(outp + (size_t)(lt * 128 + row) * 1024 + n0 + col) = pack8(v);
      EPI8_END
    } else {
      const int d = s - 3;
      gemm_mainloop(T1 + (size_t)lt * 128 * 640 + 256 + d * 192, 640, W + W_G2 + (size_t)d * 196608 + (size_t)n0 * 192, 192, 192, smem, acc);
      bf16_t* outp = (bf16_t*)(p.ws + OFF_TR + (d ? TR_G1 : TR_G0));
      EPI8_BEGIN
        *(uint4*)(outp + (size_t)(lt * 128 + row) * 1024 + n0 + col) = pack8(v);
      EPI8_END
    }
  }
}

DI int scan_row(int bl, int dir, int pos) {
  if (pos < CL) { int t = dir ? (CL - 1 - pos) : pos; return 16384 + bl * CL + t; }
  int t = pos - CL; if (dir) t = SL - 1 - t;
  return bl * SL + t;
}

DI void phase_scan(const P& p, int layer, char* smem) {
  const int tidx = opaque_tid();
  const int j = layer / 2;
  const int tid = tidx;
  const bf16_t* R = (const bf16_t*)(p.ws + OFF_TR + TR_R);
  const bf16_t* Kx = (const bf16_t*)(p.ws + OFF_TR + TR_K);
  const bf16_t* V = (const bf16_t*)(p.ws + OFF_TR + TR_V);
  const bf16_t* Aa = (const bf16_t*)(p.ws + OFF_TR + TR_A);
  float* sbuf = (float*)smem;
  constexpr int BUFF = 5 * 16 * 64 + 512;
  constexpr int POP = 144;
  float* pobuf = sbuf + 2 * BUFF;
  const int ss = tid >> 4, c4 = tid & 15;
  const int rl = tid >> 4, cg = tid & 15;
  for (int item = blockIdx.x; item < 256; item += gridDim.x) {
    const int q2 = item & 1, dir = (item >> 1) & 1, head = (item >> 2) & 15, bl = item >> 6;
    const bf16_t* WL = (const bf16_t*)(p.ws + OFF_TR + (dir ? TR_WL1 : TR_WL0));
    bf16_t* O = (bf16_t*)(p.ws + OFF_TR + TR_HX) + (dir ? (size_t)HROWS * 1024 : 0);
    const int ch = head * 64 + c4 * 4;
    const float4 kkw = *(const float4*)(p.rw_kk + (size_t)j * 1024 + ch);
    const float4 kaw = *(const float4*)(p.rw_ka + (size_t)j * 1024 + ch);
    fv2 SA01 = {0.f, 0.f}, SA23 = {0.f, 0.f}, SB01 = {0.f, 0.f}, SB23 = {0.f, 0.f};
    uint2 gr_, gk_, ga_, gw_, gv_;
    gv_ = make_uint2(0, 0);
#define SC_ISSUE(chunk_)                                                                   \
    {                                                                                      \
      const size_t ro = (size_t)scan_row(bl, dir, (chunk_) * 16 + ss) * 1024;              \
      gr_ = *(const uint2*)(R + ro + ch); gk_ = *(const uint2*)(Kx + ro + ch);             \
      ga_ = *(const uint2*)(Aa + ro + ch); gw_ = *(const uint2*)(WL + ro + ch);            \
      if (c4 < 8) gv_ = *(const uint2*)(V + ro + head * 64 + q2 * 32 + c4 * 4);            \
    }
#define SC_STAGE(buf_)                                                                     \
    {                                                                                      \
      float* sb_ = sbuf + (buf_) * BUFF;                                                   \
      float r0 = lo_bf(gr_.x), r1 = hi_bf(gr_.x), r2 = lo_bf(gr_.y), r3 = hi_bf(gr_.y);    \
      float k0 = lo_bf(gk_.x), k1 = hi_bf(gk_.x), k2 = lo_bf(gk_.y), k3 = hi_bf(gk_.y);    \
      float a0 = lo_bf(ga_.x), a1 = hi_bf(ga_.x), a2 = lo_bf(ga_.y), a3 = hi_bf(ga_.y);    \
      float w0 = lo_bf(gw_.x), w1 = hi_bf(gw_.x), w2 = lo_bf(gw_.y), w3 = hi_bf(gw_.y);    \
      float u0 = k0 * kkw.x, u1 = k1 * kkw.y, u2 = k2 * kkw.z, u3 = k3 * kkw.w;            \
      float sq = rowsum16(u0 * u0 + u1 * u1 + u2 * u2 + u3 * u3);                          \
      float inv = rsqrtf(fmaxf(sq, 1e-24f));                                               \
      u0 *= inv; u1 *= inv; u2 *= inv; u3 *= inv;                                          \
      const int o_ = ss * 64 + c4 * 4;                                                     \
      *(float4*)(sb_ + 0 * 1024 + o_) = make_float4(__expf(w0), __expf(w1), __expf(w2), __expf(w3)); \
      *(float4*)(sb_ + 1 * 1024 + o_) = make_float4(k0 * (1.f + (a0 - 1.f) * kaw.x), k1 * (1.f + (a1 - 1.f) * kaw.y), k2 * (1.f + (a2 - 1.f) * kaw.z), k3 * (1.f + (a3 - 1.f) * kaw.w)); \
      *(float4*)(sb_ + 2 * 1024 + o_) = make_float4(-u0, -u1, -u2, -u3);                   \
      *(float4*)(sb_ + 3 * 1024 + o_) = make_float4(u0 * a0, u1 * a1, u2 * a2, u3 * a3);   \
      *(float4*)(sb_ + 4 * 1024 + o_) = make_float4(r0, r1, r2, r3);                       \
      if (c4 < 8) *(float4*)(sb_ + 5 * 1024 + ss * 32 + c4 * 4) = make_float4(lo_bf(gv_.x), hi_bf(gv_.x), lo_bf(gv_.y), hi_bf(gv_.y)); \
    }
    __syncthreads();
    SC_ISSUE(0);
    SC_STAGE(0);
    __syncthreads();
    constexpr int NCH = TK / 16;
    float* po_wa = pobuf + rl * POP + cg;
    float* po_wb = pobuf + (rl + 16) * POP + cg;
    const float* po_r = pobuf + (rl + 16 * (cg >> 3)) * POP + (cg & 7) * 16;
    for (int chunk = 0; chunk < NCH; chunk++) {
      const int buf = chunk & 1;
      if (chunk + 1 < NCH) SC_ISSUE(chunk + 1);
      __builtin_amdgcn_sched_barrier(0);
      const float* sb = sbuf + buf * BUFF + cg * 4;
      const float* sv = sbuf + buf * BUFF + 5 * 1024 + rl;
      float4 w4 = *(const float4*)(sb + 0 * 1024), k4 = *(const float4*)(sb + 1 * 1024), n4 = *(const float4*)(sb + 2 * 1024);
      float4 b4 = *(const float4*)(sb + 3 * 1024), r4 = *(const float4*)(sb + 4 * 1024);
      float va = sv[0], vb = sv[16];
#pragma unroll
      for (int s = 0; s < 16; s++) {
        float4 w4n = w4, k4n = k4, n4n = n4, b4n = b4, r4n = r4;
        float van = va, vbn = vb;
        if (s + 1 < 16) {
          w4n = *(const float4*)(sb + 0 * 1024 + (s + 1) * 64); k4n = *(const float4*)(sb + 1 * 1024 + (s + 1) * 64);
          n4n = *(const float4*)(sb + 2 * 1024 + (s + 1) * 64); b4n = *(const float4*)(sb + 3 * 1024 + (s + 1) * 64);
          r4n = *(const float4*)(sb + 4 * 1024 + (s + 1) * 64); van = sv[(s + 1) * 32]; vbn = sv[(s + 1) * 32 + 16];
        }
        const fv2 w01 = {w4.x, w4.y}, w23 = {w4.z, w4.w}, k01 = {k4.x, k4.y}, k23 = {k4.z, k4.w}, n01 = {n4.x, n4.y}, n23 = {n4.z, n4.w};
        const fv2 b01 = {b4.x, b4.y}, b23 = {b4.z, b4.w}, r01 = {r4.x, r4.y}, r23 = {r4.z, r4.w};
        const fv2 va2 = {va, va}, vb2 = {vb, vb};
        const fv2 vka01 = va2 * k01, vka23 = va2 * k23, vkb01 = vb2 * k01, vkb23 = vb2 * k23;
        fv2 ppa = SA01 * n01, ppb = SB01 * n01;
        ppa = __builtin_elementwise_fma(SA23, n23, ppa);
        ppb = __builtin_elementwise_fma(SB23, n23, ppb);
        float saa = ppa.x + ppa.y, sab = ppb.x + ppb.y;
        saa = ror_add<8>(saa); sab = ror_add<8>(sab);
        saa = ror_add<4>(saa); sab = ror_add<4>(sab);
        saa = ror_add<2>(saa); sab = ror_add<2>(sab);
        saa = ror_add<1>(saa); sab = ror_add<1>(sab);
        const fv2 saa2 = {saa, saa}, sab2 = {sab, sab};
        const fv2 ta01 = __builtin_elementwise_fma(saa2, b01, vka01), ta23 = __builtin_elementwise_fma(saa2, b23, vka23);
        const fv2 tb01 = __builtin_elementwise_fma(sab2, b01, vkb01), tb23 = __builtin_elementwise_fma(sab2, b23, vkb23);
        SA01 = __builtin_elementwise_fma(SA01, w01, ta01);
        SA23 = __builtin_elementwise_fma(SA23, w23, ta23);
        SB01 = __builtin_elementwise_fma(SB01, w01, tb01);
        SB23 = __builtin_elementwise_fma(SB23, w23, tb23);
        fv2 qa = SA01 * r01, qb = SB01 * r01;
        qa = __builtin_elementwise_fma(SA23, r23, qa);
        qb = __builtin_elementwise_fma(SB23, r23, qb);
        po_wa[(s & 7) * 16] = qa.x + qa.y;
        po_wb[(s & 7) * 16] = qb.x + qb.y;
        w4 = w4n; k4 = k4n; n4 = n4n; b4 = b4n; r4 = r4n; va = van; vb = vbn;
        __builtin_amdgcn_sched_barrier(0);
        if ((s & 7) == 7) {
          const float4 p0 = *(const float4*)(po_r), p1 = *(const float4*)(po_r + 4), p2 = *(const float4*)(po_r + 8), p3 = *(const float4*)(po_r + 12);
          const float ov = ((p0.x + p0.y) + (p0.z + p0.w)) + ((p1.x + p1.y) + (p1.z + p1.w)) + ((p2.x + p2.y) + (p2.z + p2.w)) + ((p3.x + p3.y) + (p3.z + p3.w));
          const size_t ro = (size_t)scan_row(bl, dir, chunk * 16 + (s & 8) + (cg & 7)) * 1024;
          O[ro + head * 64 + q2 * 32 + rl + 16 * (cg >> 3)] = f2bf(ov);
          __builtin_amdgcn_sched_barrier(0);
        }
      }
      if (chunk + 1 < NCH) SC_STAGE(buf ^ 1);
      __syncthreads();
    }
  }
}

DI void phase_combine(const P& p, int layer) {
  const int tidx = opaque_tid();
  const int j = layer / 2;
  const bf16_t* Of = (const bf16_t*)(p.ws + OFF_TR + TR_HX);
  const bf16_t* Ob = Of + (size_t)HROWS * 1024;
  const bf16_t* R = (const bf16_t*)(p.ws + OFF_TR + TR_R);
  const bf16_t* Kx = (const bf16_t*)(p.ws + OFF_TR + TR_K);
  const bf16_t* V = (const bf16_t*)(p.ws + OFF_TR + TR_V);
  const bf16_t* Aa = (const bf16_t*)(p.ws + OFF_TR + TR_A);
  bf16_t* G0 = (bf16_t*)(p.ws + OFF_TR + TR_G0);
  const bf16_t* G1 = (const bf16_t*)(p.ws + OFF_TR + TR_G1);
  const size_t total = (size_t)HROWS * 128;
  for (size_t i = (size_t)blockIdx.x * 256 + tidx; i < total; i += (size_t)gridDim.x * 256) {
    const int c0 = (int)(i & 127) * 8;
    const size_t off = (i >> 7) * 1024 + c0;
    const uint4 uof = *(const uint4*)(Of + off), uob = *(const uint4*)(Ob + off), ur = *(const uint4*)(R + off), uk = *(const uint4*)(Kx + off);
    const uint4 ua = *(const uint4*)(Aa + off), uv = *(const uint4*)(V + off), ug0 = *(const uint4*)(G0 + off), ug1 = *(const uint4*)(G1 + off);
    const unsigned aof[4] = {uof.x, uof.y, uof.z, uof.w}, aob[4] = {uob.x, uob.y, uob.z, uob.w}, ar[4] = {ur.x, ur.y, ur.z, ur.w}, ak[4] = {uk.x, uk.y, uk.z, uk.w};
    const unsigned aa[4] = {ua.x, ua.y, ua.z, ua.w}, av[4] = {uv.x, uv.y, uv.z, uv.w}, ag0[4] = {ug0.x, ug0.y, ug0.z, ug0.w}, ag1[4] = {ug1.x, ug1.y, ug1.z, ug1.w};
    const float* ka = p.rw_ka + (size_t)j * 1024 + c0;
    const float* rk = p.rw_rk + (size_t)j * 1024 + c0;
    const float* lg = p.rw_ln_g + (size_t)j * 1024 + c0;
    const float* lb = p.rw_ln_b + (size_t)j * 1024 + c0;
    float of[8], obv[8];
    float sf = 0.f, sf2 = 0.f, sb = 0.f, sb2 = 0.f, br = 0.f;
#pragma unroll
    for (int e = 0; e < 8; e++) {
      const int w = e >> 1;
      of[e] = (e & 1) ? hi_bf(aof[w]) : lo_bf(aof[w]);
      obv[e] = (e & 1) ? hi_bf(aob[w]) : lo_bf(aob[w]);
      const float r = (e & 1) ? hi_bf(ar[w]) : lo_bf(ar[w]);
      const float k = (e & 1) ? hi_bf(ak[w]) : lo_bf(ak[w]);
      const float a = (e & 1) ? hi_bf(aa[w]) : lo_bf(aa[w]);
      sf += of[e]; sf2 += of[e] * of[e]; sb += obv[e]; sb2 += obv[e] * obv[e];
      br += r * k * (1.f + (a - 1.f) * ka[e]) * rk[e];
    }
#pragma unroll
    for (int o = 1; o < 8; o <<= 1) { sf += __shfl_xor(sf, o); sf2 += __shfl_xor(sf2, o); sb += __shfl_xor(sb, o); sb2 += __shfl_xor(sb2, o); br += __shfl_xor(br, o); }
    const float muf = sf * (1.f / 64.f), mub = sb * (1.f / 64.f);
    const float rsf = rsqrtf(fmaxf(sf2 * (1.f / 64.f) - muf * muf, 0.f) + 64e-5f);
    const float rsb = rsqrtf(fmaxf(sb2 * (1.f / 64.f) - mub * mub, 0.f) + 64e-5f);
    float y[8];
#pragma unroll
    for (int e = 0; e < 8; e++) {
      const int w = e >> 1;
      const float v = (e & 1) ? hi_bf(av[w]) : lo_bf(av[w]);
      const float g0 = (e & 1) ? hi_bf(ag0[w]) : lo_bf(ag0[w]);
      const float g1 = (e & 1) ? hi_bf(ag1[w]) : lo_bf(ag1[w]);
      const float bonus = br * v;
      y[e] = ((of[e] - muf) * rsf * lg[e] + lb[e] + bonus) * g0 + ((obv[e] - mub) * rsb * lg[e] + lb[e] + bonus) * g1;
    }
    *(uint4*)(G0 + off) = make_uint4(pack2(y[0], y[1]), pack2(y[2], y[3]), pack2(y[4], y[5]), pack2(y[6], y[7]));
  }
}

DI void phase_rw_out(const P& p, int layer, int hf, char* smem) {
  const int tidx = opaque_tid();
  const bf16_t* Y = (const bf16_t*)(p.ws + OFF_TR + TR_G0);
  const bf16_t* WO = (const bf16_t*)(p.ws + w_off(layer)) + W_WO;
  const int nlt = (layer == 3) ? 128 : 136;
  for (int t = blockIdx.x; t < xcd_rounds(nlt, 8) * (int)gridDim.x; t += gridDim.x) {
    int lt, nt_;
    if (!xcd_tile(t, nlt, 8, lt, nt_)) continue;
    const int n0 = nt_ * 128;
    const int gt = half_gtile(hf, lt);
    f32x16 acc[2][2];
    gemm_mainloop(Y + (size_t)lt * 128 * 1024, 1024, WO + (size_t)n0 * 1024, 1024, 1024, smem, acc);
    const float* gate = mods_ptr(p, layer, mod_row(gt * 128)) + 2048 + n0;
    float* xr = resid_row(p, gt * 128) + n0;
    const float* xs = layer == 0 ? input_row(p, gt * 128) + n0 : xr;
    EPI8_BEGIN
      resid_update(xr + (size_t)row * D + col, xs + (size_t)row * D + col, gate + col, v);
    EPI8_END
  }
}

DI void phase_mlp1(const P& p, int layer, char* smem) {
  const int tidx = opaque_tid();
  const bf16_t* H2 = (const bf16_t*)(p.ws + OFF_TR + TR_H2);
  const bf16_t* W1 = (const bf16_t*)(p.ws + w_off(layer)) + W_M1;
  bf16_t* HID = (bf16_t*)(p.ws + OFF_TR + TR_HID);
  const int nmt = (layer == 3) ? 256 : 272;
  const int ngrp = nmt / 16;
  (void)ngrp;
  for (int t = blockIdx.x; t < xcd_rounds(nmt, 32) * (int)gridDim.x; t += gridDim.x) {
    int gt, nt;
    if (!xcd_tile(t, nmt, 32, gt, nt)) continue;
    f32x16 acc[2][2];
    gemm_mainloop(H2 + (size_t)gt * 128 * 1024, 1024, W1 + (size_t)nt * 128 * 1024, 1024, 1024, smem, acc);
    EPI8_BEGIN
#pragma unroll
      for (int e = 0; e < 8; e++) { const float rl = fmaxf(v[e], 0.f); v[e] = rl * rl; }
      *(uint4*)(HID + (size_t)(gt * 128 + row) * 4096 + nt * 128 + col) = pack8(v);
    EPI8_END
  }
}
DI void phase_mlp2(const P& p, int layer, char* smem) {
  const int tidx = opaque_tid();
  const bf16_t* HID = (const bf16_t*)(p.ws + OFF_TR + TR_HID);
  const bf16_t* W2 = (const bf16_t*)(p.ws + w_off(layer)) + W_M2;
  const int nmt = (layer == 3) ? 256 : 272;
  for (int t = blockIdx.x; t < xcd_rounds(nmt, 8) * (int)gridDim.x; t += gridDim.x) {
    int gt, nt_;
    if (!xcd_tile(t, nmt, 8, gt, nt_)) continue;
    const int n0 = nt_ * 128;
    f32x16 acc[2][2];
    gemm_mainloop(HID + (size_t)gt * 128 * 4096, 4096, W2 + (size_t)n0 * 4096, 4096, 4096, smem, acc);
    const float* gate = mods_ptr(p, layer, mod_row(gt * 128)) + 5120 + n0;
    float* xr = resid_row(p, gt * 128) + n0;
    EPI8_BEGIN
      resid_update(xr + (size_t)row * D + col, xr + (size_t)row * D + col, gate + col, v);
    EPI8_END
  }
}

DI void phase_qkv(const P& p, int layer, char* smem) {
  const int tidx = opaque_tid();
  const bf16_t* H = (const bf16_t*)(p.ws + OFF_TR + TR_H);
  const bf16_t* WQ = (const bf16_t*)(p.ws + w_off(layer)) + W_QKV;
  bf16_t* Q = (bf16_t*)(p.ws + OFF_TR + TR_Q);
  bf16_t* Kb = (bf16_t*)(p.ws + OFF_TR + TR_KK);
  bf16_t* VT = (bf16_t*)(p.ws + OFF_TR + TR_VT);
  const float* cosT = (const float*)(p.ws + OFF_MISC);
  const float* sinT = cosT + 1024;
  for (int t = blockIdx.x; t < xcd_rounds(272, 24) * (int)gridDim.x; t += gridDim.x) {
    int gt, nt;
    if (!xcd_tile(t, 272, 24, gt, nt)) continue;
    f32x16 acc[2][2];
    gemm_mainloop(H + (size_t)gt * 128 * 1024, 1024, WQ + (size_t)nt * 128 * 1024, 1024, 1024, smem, acc);
    const bool lat = gt < 256;
    const int b = lat ? gt / 32 : (gt - 256) / 2;
    const int t0 = lat ? (gt % 32) * 128 : (gt - 256) % 2 * 128;
    const int tq0 = lat ? t0 : SL + t0;
    const int typ = nt / 8, h = nt % 8;
    if (typ < 2) {
      bf16_t* dst = typ == 0 ? Q : Kb;
      const float qs = typ == 0 ? 0.125f * 1.44269504088896f : 1.f;
      float kmx = 0.f;
      EPI8_BEGIN
        const int sidx = col >> 6, d0 = col & 63;
        if (lat) {
          const float4 pa = *(const float4*)(es + row * EST + (col ^ 16));
          const float4 pb = *(const float4*)(es + row * EST + (col ^ 16) + 4);
          const float pr[8] = {pa.x, pa.y, pa.z, pa.w, pb.x, pb.y, pb.z, pb.w};
          const int tt = t0 + row;
          const int pos = (d0 < 32) ? (tt >> 6) : (tt & 63);
          const float4 ca = *(const float4*)(cosT + pos * 16 + (d0 & 8)), cb = *(const float4*)(cosT + pos * 16 + (d0 & 8) + 4);
          const float4 sa = *(const float4*)(sinT + pos * 16 + (d0 & 8)), sb = *(const float4*)(sinT + pos * 16 + (d0 & 8) + 4);
          const float cs[8] = {ca.x, ca.y, ca.z, ca.w, cb.x, cb.y, cb.z, cb.w};
          const float sn[8] = {sa.x, sa.y, sa.z, sa.w, sb.x, sb.y, sb.z, sb.w};
          const float sgn = (d0 & 16) ? 1.f : -1.f;
#pragma unroll
          for (int e = 0; e < 8; e++) v[e] = v[e] * cs[e] + sgn * pr[e] * sn[e];
        }
#pragma unroll
        for (int e = 0; e < 8; e++) v[e] *= qs;
        const uint4 pk_ = pack8(v);
        *(uint4*)(dst + ((size_t)((b * 8 + h) * 2 + sidx) * TK + tq0 + row) * 64 + d0) = pk_;
        if (typ == 1) {
          float rv_[8];
          unpack8(pk_, rv_);
          float ssq_ = 0.f;
#pragma unroll
          for (int e = 0; e < 8; e++) ssq_ += rv_[e] * rv_[e];
          ssq_ += __shfl_xor(ssq_, 1); ssq_ += __shfl_xor(ssq_, 2); ssq_ += __shfl_xor(ssq_, 4);
          kmx = fmaxf(kmx, ssq_);
        }
      EPI8_END
      if (typ == 1) {
        kmx = fmaxf(kmx, __shfl_xor(kmx, 16));
        kmx = fmaxf(kmx, __shfl_xor(kmx, 32));
        if ((tidx & 55) == 0)
          atomicMax((unsigned*)(p.ws + OFF_MISC) + 4096 + (layer >> 1) * 128 + (b * 8 + h) * 2 + ((tidx >> 3) & 1), __float_as_uint(kmx));
      }
    } else {
      float* es = (float*)smem;
      acc_to_lds(acc, es);
      __syncthreads();
      for (int pass = 0; pass < 8; pass++) {
        const int d = tidx & 127, tg = pass * 2 + (tidx >> 7);
        float v[8];
#pragma unroll
        for (int e = 0; e < 8; e++) v[e] = es[(tg * 8 + e) * EST + d];
        *(uint4*)(VT + ((size_t)(b * 8 + h) * 128 + d) * TK + tq0 + tg * 8) = pack8(v);
      }
      __syncthreads();
    }
  }
}

typedef _Float16 hv2 __attribute__((ext_vector_type(2)));
DI unsigned packh2(float a, float b) { hv2 r = {(_Float16)a, (_Float16)b}; return __builtin_bit_cast(unsigned, r); }
DI float lo_h(unsigned u) { hv2 r = __builtin_bit_cast(hv2, u); return (float)r[0]; }
DI float hi_h(unsigned u) { hv2 r = __builtin_bit_cast(hv2, u); return (float)r[1]; }

DI void phase_attn(const P& p, int layer, char* smem) {
  const int tidx = opaque_tid();
  const int j = layer / 2;
  const bool ctxq = layer != 3;
  const bf16_t* Q = (const bf16_t*)(p.ws + OFF_TR + TR_Q);
  const bf16_t* Kb = (const bf16_t*)(p.ws + OFF_TR + TR_KK);
  const bf16_t* VT = (const bf16_t*)(p.ws + OFF_TR + TR_VT);
  bf16_t* O = (bf16_t*)(p.ws + OFF_TR + TR_H);
  const float lam = ((const float*)(p.ws + OFF_MISC))[2048 + j];
  const float* kmax2 = (const float*)(p.ws + OFF_MISC) + 4096 + j * 128;
  const float oml = 1.f - lambda_init(layer);
  const float* subg = p.da_subln_g + (size_t)j * 128;
  constexpr int LDV = 72;
  bf16_t* sK = (bf16_t*)smem;
  bf16_t* sV = sK + 2 * 64 * LDT;
  const int tid = tidx, lane = tid & 63, w = tid >> 6, g = lane >> 5, l31 = lane & 31;
  const int nitems = 2048 + (ctxq ? 128 : 0);
  const int spx = gridDim.x >> 3, gpr = spx >> 5;
  const bool xmap = (gridDim.x == 256u || gridDim.x == 512u);
  const int lat_rounds = xmap ? 64 / (8 * gpr) : (2048 + (int)gridDim.x - 1) / (int)gridDim.x;
  for (int it0 = blockIdx.x; it0 < lat_rounds * (int)gridDim.x + (ctxq ? 128 : 0); it0 += gridDim.x) {
    int item;
    if (!xmap) {
      item = it0 < lat_rounds * (int)gridDim.x ? it0 : 2048 + (it0 - lat_rounds * (int)gridDim.x);
      if (it0 < lat_rounds * (int)gridDim.x && it0 >= 2048) continue;
    } else if (it0 < lat_rounds * (int)gridDim.x) {
      const int r = it0 % (int)gridDim.x, round = it0 / (int)gridDim.x;
      const int xcd = r & 7, li = r >> 3;
      const int bh = (round * 8 + xcd) * gpr + (li >> 5);
      item = bh * 32 + (li & 31);
    } else {
      item = 2048 + (it0 - lat_rounds * (int)gridDim.x);
    }
    (void)nitems;
    int b, h, q0, kbeg, ntiles;
    if (item < 2048) { b = item >> 8; h = (item >> 5) & 7; q0 = (item & 31) * 128; kbeg = 0; ntiles = TK / 64; }
    else { const int it = item - 2048; b = it >> 4; h = (it >> 1) & 7; q0 = SL + (it & 1) * 128; kbeg = SL; ntiles = CL / 64; }
    const bf16_t* Vp0 = VT + (size_t)(b * 8 + h) * 128 * TK;
    const int tq = q0 + w * 32 + l31;
    const size_t grow = tq < SL ? (size_t)b * SL + tq : (size_t)NLAT + (size_t)b * CL + (tq - SL);
    bf16_t* op = O + grow * 1024 + h * 128;
    for (int s = 0; s < 2; s++) {
      const bf16_t* Kp0 = Kb + (size_t)((b * 8 + h) * 2 + s) * TK * 64;
      const bf16_t* Qp = Q + ((size_t)((b * 8 + h) * 2 + s) * TK + tq) * 64 + g * 8;
      bf16x8 qf[4];
      float qss = 0.f;
#pragma unroll
      for (int kk = 0; kk < 4; kk++) {
        const uint4 u = *(const uint4*)(Qp + kk * 16);
        qf[kk] = __builtin_bit_cast(bf16x8, u);
        float qv[8];
        unpack8(u, qv);
#pragma unroll
        for (int e = 0; e < 8; e++) qss += qv[e] * qv[e];
      }
      qss += __shfl_xor(qss, 32);
      const float nmq = -sqrtf(qss * kmax2[(b * 8 + h) * 2 + s]);
      f32x16 o[4];
#pragma unroll
      for (int db = 0; db < 4; db++)
#pragma unroll
        for (int r = 0; r < 16; r++) o[db][r] = 0.f;
      float l = 0.f;
      uint4 rk0, rk1, rv0, rv1, rv2, rv3;
      const unsigned kvo = (unsigned)((tid >> 3) * 64 + (tid & 7) * 8);
      const unsigned vvo = (unsigned)((tid >> 3) * TK + (tid & 7) * 8);
      const unsigned sko = (unsigned)((tid >> 3) * LDT + (tid & 7) * 8);
      const unsigned svo = (unsigned)((tid >> 3) * LDV + ((tid & 7) >> 1) * 16 + (tid & 1) * 4);
#define ISSUE_KV(kt_)                                                             \
      {                                                                           \
        const bf16_t* kb_ = Kp0 + (size_t)(kbeg + (kt_) * 64) * 64;               \
        const bf16_t* vb_ = Vp0 + (kbeg + (kt_) * 64);                            \
        unsigned kvo_ = kvo, vvo_ = vvo;                                          \
        asm volatile("" : "+v"(kvo_), "+v"(vvo_));     \
        rk0 = *(const uint4*)(kb_ + kvo_);                                        \
        rk1 = *(const uint4*)(kb_ + (kvo_ + 32u * 64u));                          \
        rv0 = *(const uint4*)(vb_ + vvo_);                                        \
        rv1 = *(const uint4*)(vb_ + (vvo_ + 32u * (unsigned)TK));                 \
        rv2 = *(const uint4*)(vb_ + (vvo_ + 64u * (unsigned)TK));                 \
        rv3 = *(const uint4*)(vb_ + (vvo_ + 96u * (unsigned)TK));                 \
      }
#define ST_V(ptr_, r_) { *(uint2*)(ptr_) = make_uint2(r_.x, r_.y); *(uint2*)((ptr_) + 8) = make_uint2(r_.z, r_.w); }
#define STAGE_KV(buf_)                                                            \
      {                                                                           \
        bf16_t* ks_ = sK + (buf_) * 64 * LDT + sko;                               \
        bf16_t* vs_ = sV + (buf_) * 128 * LDV + svo;                              \
        *(uint4*)(ks_) = rk0;                                                     \
        *(uint4*)(ks_ + 32 * LDT) = rk1;                                          \
        ST_V(vs_, rv0); ST_V(vs_ + 32 * LDV, rv1); ST_V(vs_ + 64 * LDV, rv2); ST_V(vs_ + 96 * LDV, rv3); \
      }
      __syncthreads();
      ISSUE_KV(0);
      STAGE_KV(0);
      __syncthreads();
      for (int kt = 0; kt < ntiles; kt++) {
        const int buf = kt & 1;
        const bool more = kt + 1 < ntiles;
        if (more) ISSUE_KV(kt + 1);
        __builtin_amdgcn_sched_barrier(0);
        const bf16_t* kS = sK + buf * 64 * LDT;
        const bf16_t* vS = sV + buf * 128 * LDV;
#pragma unroll
        for (int kb = 0; kb < 2; kb++) {
          bf16x8 kf[4];
#pragma unroll
          for (int kk = 0; kk < 4; kk++) kf[kk] = *(const bf16x8*)(kS + (kb * 32 + l31) * LDT + kk * 16 + g * 8);
          __builtin_amdgcn_sched_barrier(0);
          f32x16 st;
#pragma unroll
          for (int r = 0; r < 16; r++) st[r] = nmq;
#pragma unroll
          for (int kk = 0; kk < 4; kk++) st = MFMA32(kf[kk], qf[kk], st);
          uint4 vf0[4];
#pragma unroll
          for (int db = 0; db < 4; db++) {
            vf0[db] = *(const uint4*)(vS + (db * 32 + l31) * LDV + kb * 32 + 8 * g);
          }
          __builtin_amdgcn_sched_barrier(0);
          float ls = 0.f;
          bf16x8 pk[2];
#pragma unroll
          for (int hh = 0; hh < 2; hh++) {
            float e[8];
#pragma unroll
            for (int i = 0; i < 8; i++) { e[i] = __builtin_amdgcn_exp2f(st[hh * 8 + i]); ls += e[i]; }
            const uint4 u = make_uint4(pack2(e[0], e[1]), pack2(e[2], e[3]), pack2(e[4], e[5]), pack2(e[6], e[7]));
            pk[hh] = __builtin_bit_cast(bf16x8, u);
          }
          l += ls;
          uint4 vf1[4];
#pragma unroll
          for (int db = 0; db < 4; db++) {
            vf1[db] = *(const uint4*)(vS + (db * 32 + l31) * LDV + kb * 32 + 16 + 8 * g);
          }
          __builtin_amdgcn_sched_barrier(0);
#pragma unroll
          for (int db = 0; db < 4; db++) o[db] = MFMA32(__builtin_bit_cast(bf16x8, vf0[db]), pk[0], o[db]);
#pragma unroll
          for (int db = 0; db < 4; db++) o[db] = MFMA32(__builtin_bit_cast(bf16x8, vf1[db]), pk[1], o[db]);
        }
        __builtin_amdgcn_sched_barrier(0);
        if (more) STAGE_KV(buf ^ 1);
        __syncthreads();
      }
      const float lt = l + __shfl_xor(l, 32);
      if (s == 0) {
        const float inv = 1.f / lt;
#pragma unroll
        for (int db = 0; db < 4; db++)
#pragma unroll
          for (int rq = 0; rq < 4; rq++) {
            const int d = db * 32 + 8 * rq + 4 * g;
            *(uint2*)(op + d) = make_uint2(packh2(o[db][4 * rq] * inv, o[db][4 * rq + 1] * inv), packh2(o[db][4 * rq + 2] * inv, o[db][4 * rq + 3] * inv));
          }
      } else {
        const float inv = lam / lt;
        float ssq = 0.f;
#pragma unroll
        for (int db = 0; db < 4; db++)
#pragma unroll
          for (int rq = 0; rq < 4; rq++) {
            const int d = db * 32 + 8 * rq + 4 * g;
            const uint2 u0 = *(const uint2*)(op + d);
            const float a0 = lo_h(u0.x) - o[db][4 * rq] * inv, a1 = hi_h(u0.x) - o[db][4 * rq + 1] * inv;
            const float a2 = lo_h(u0.y) - o[db][4 * rq + 2] * inv, a3 = hi_h(u0.y) - o[db][4 * rq + 3] * inv;
            o[db][4 * rq] = a0; o[db][4 * rq + 1] = a1; o[db][4 * rq + 2] = a2; o[db][4 * rq + 3] = a3;
            ssq += a0 * a0 + a1 * a1 + a2 * a2 + a3 * a3;
          }
        ssq += __shfl_xor(ssq, 32);
        const float rs = rsqrtf(ssq * (1.f / 128.f) + 1e-5f) * oml;
#pragma unroll
        for (int db = 0; db < 4; db++)
#pragma unroll
          for (int rq = 0; rq < 4; rq++) {
            const int d = db * 32 + 8 * rq + 4 * g;
            const float4 sg = *(const float4*)(subg + d);
            *(uint2*)(op + d) = make_uint2(pack2(o[db][4 * rq] * rs * sg.x, o[db][4 * rq + 1] * rs * sg.y),
                                           pack2(o[db][4 * rq + 2] * rs * sg.z, o[db][4 * rq + 3] * rs * sg.w));
          }
      }
    }
  }
}

DI void phase_at_out(const P& p, int layer, char* smem) {
  const int tidx = opaque_tid();
  const bf16_t* O = (const bf16_t*)(p.ws + OFF_TR + TR_H);
  const bf16_t* WO = (const bf16_t*)(p.ws + w_off(layer)) + W_WO;
  const int nmt = (layer == 3) ? 256 : 272;
  for (int t = blockIdx.x; t < xcd_rounds(nmt, 8) * (int)gridDim.x; t += gridDim.x) {
    int gt, nt_;
    if (!xcd_tile(t, nmt, 8, gt, nt_)) continue;
    const int n0 = nt_ * 128;
    f32x16 acc[2][2];
    gemm_mainloop(O + (size_t)gt * 128 * 1024, 1024, WO + (size_t)n0 * 1024, 1024, 1024, smem, acc);
    const float* gate = mods_ptr(p, layer, mod_row(gt * 128)) + 2048 + n0;
    float* xr = resid_row(p, gt * 128) + n0;
    EPI8_BEGIN
      resid_update(xr + (size_t)row * D + col, xr + (size_t)row * D + col, gate + col, v);
    EPI8_END
  }
}

DI void phase_final(const P& p) {
  const int tidx = opaque_tid();
  const int lane = tidx & 63, wv = tidx >> 6;
  for (int row = blockIdx.x * 4 + wv; row < NLAT; row += gridDim.x * 4) {
    float* xr = p.out + (size_t)row * D;
    float4 v[4];
    float ss = 0.f;
#pragma unroll
    for (int jx = 0; jx < 4; jx++) { v[jx] = *(const float4*)(xr + jx * 256 + lane * 4); ss += v[jx].x * v[jx].x + v[jx].y * v[jx].y + v[jx].z * v[jx].z + v[jx].w * v[jx].w; }
    ss = wave_sum(ss);
    const float rs = rsqrtf(ss * (1.f / 1024.f) + 1e-6f);
#pragma unroll
    for (int jx = 0; jx < 4; jx++) {
      const float4 g = *(const float4*)(p.final_g + jx * 256 + lane * 4);
      *(float4*)(xr + jx * 256 + lane * 4) = make_float4(v[jx].x * rs * g.x, v[jx].y * rs * g.y, v[jx].z * rs * g.z, v[jx].w * rs * g.w);
    }
  }
}

#define XB_TMO      128
#define XB_XCNT(j)  (256  + 64 * (j))
#define XB_XSUB(j)  (1280 + 64 * (j))
#define XB_XGEN(j)  (2304 + 64 * (j))
#define XB_TOP      3328
#define XB_TOPGEN   3392
#define XCD_BAR_WORDS 3456
#define XB_SPIN_CAP (1u << 22)
#define LAS __attribute__((address_space(3)))
DI unsigned xb_ld(unsigned* p) { return __hip_atomic_load(p, __ATOMIC_RELAXED, __HIP_MEMORY_SCOPE_AGENT); }
DI unsigned xb_add(unsigned* p, unsigned v) { return __hip_atomic_fetch_add(p, v, __ATOMIC_RELAXED, __HIP_MEMORY_SCOPE_AGENT); }
DI unsigned xb_xcc_id() { return (unsigned)__builtin_amdgcn_s_getreg((3 << 11) | 20) & 0xFu; }
#define XB_SPIN(cond, bar) do { unsigned _sp = 0; while (cond) { __builtin_amdgcn_s_sleep(1); \
    if ((++_sp & 255u) == 0u) { if (xb_ld(&(bar)[XB_TMO])) break; if (_sp > XB_SPIN_CAP) { atomicAdd(&(bar)[XB_TMO], 1u); break; } } } } while (0)
struct XcdBarrier { unsigned* bar; unsigned x; volatile LAS unsigned* st; };
DI XcdBarrier xcd_barrier_post(unsigned* bar, volatile LAS unsigned* st) {
  XcdBarrier b; b.bar = bar; b.x = xb_xcc_id(); b.st = st;
  if (threadIdx.x == 0) (void)xb_add(&bar[XB_XCNT(b.x)], 1u);
  return b;
}
DI void xcd_barrier_complete(unsigned* bar, unsigned x, unsigned& nloc, unsigned& nx) {
  const unsigned G = gridDim.x * gridDim.y * gridDim.z;
  unsigned sum, cnt, mine, sp = 0u;
  for (;;) {
    sum = 0u; cnt = 0u; mine = 0u;
#pragma unroll
    for (unsigned j = 0; j < 16; ++j) { const unsigned c = xb_ld(&bar[XB_XCNT(j)]); sum += c; cnt += (c > 0u) ? 1u : 0u; mine = (j == x) ? c : mine; }
    if (sum == G) break;
    __builtin_amdgcn_s_sleep(1);
    if ((++sp & 255u) == 0u) { if (xb_ld(&bar[XB_TMO])) break; if (sp > XB_SPIN_CAP) { atomicAdd(&bar[XB_TMO], 1u); break; } }
  }
  nloc = mine > 0u ? mine : 1u; nx = cnt > 0u ? cnt : 1u;
}
DI void xcd_barrier(const XcdBarrier& b) {
  asm volatile("s_waitcnt vmcnt(0)" ::: "memory");
  __syncthreads();
  if (threadIdx.x == 0) {
    unsigned* bar = b.bar;
    __builtin_amdgcn_s_waitcnt(0);
    unsigned nloc = b.st[0], nx = b.st[1];
    if (nloc == 0u) { xcd_barrier_complete(bar, b.x, nloc, nx); b.st[0] = nloc; b.st[1] = nx; }
    const unsigned old = xb_add(&bar[XB_XSUB(b.x)], 1u);
    const unsigned gen = old / nloc;
    if (old + 1u == (gen + 1u) * nloc) {
      __builtin_amdgcn_fence(__ATOMIC_RELEASE, "agent");
      asm volatile("s_waitcnt vmcnt(0)" ::: "memory");
      const unsigned og = xb_add(&bar[XB_TOP], 1u);
      const unsigned tg = og / nx;
      if (og + 1u == (tg + 1u) * nx) xb_add(&bar[XB_TOPGEN], 1u);
      else XB_SPIN(xb_ld(&bar[XB_TOPGEN]) == tg, bar);
      __builtin_amdgcn_fence(__ATOMIC_ACQUIRE, "agent");
      xb_add(&bar[XB_XGEN(b.x)], 1u);
      asm volatile("s_waitcnt vmcnt(0)" ::: "memory");
    } else {
      XB_SPIN(xb_ld(&bar[XB_XGEN(b.x)]) == gen, bar);
      __builtin_amdgcn_fence(__ATOMIC_ACQUIRE, "agent");
      asm volatile("s_waitcnt vmcnt(0)" ::: "memory");
    }
  }
  __syncthreads();
}
constexpr size_t OFF_BAR = OFF_MISC + 65536;

typedef __attribute__((address_space(1))) const float GCF;
typedef __attribute__((address_space(1))) float GF;
typedef __attribute__((address_space(1))) char GC;
DI unsigned long long lds_word(const unsigned long long* tbl, int i) {
  int z = i;
  asm volatile("" : "+v"(z));
  const unsigned long long v = tbl[z];
  const unsigned lo = __builtin_amdgcn_readfirstlane((unsigned)v), hi = __builtin_amdgcn_readfirstlane((unsigned)(v >> 32));
  return ((unsigned long long)hi << 32) | lo;
}
DI void load_params(P& q, const unsigned long long* tbl) {
  const float** fp = (const float**)&q;
#pragma unroll
  for (int i = 0; i < 36; i++) fp[i] = (const float*)(GCF*)lds_word(tbl, i);
  q.out = (float*)(GF*)lds_word(tbl, 36);
  q.ws = (char*)(GC*)lds_word(tbl, 37);
  q.only = 0;
  q.pad = 0;
}
__global__ void __launch_bounds__(256, 2) mega(P p) {
  __shared__ __attribute__((aligned(16))) char smem[73728];
  __shared__ unsigned long long s_tbl[40];
  {
#if defined(__HIP_DEVICE_COMPILE__)
    typedef __attribute__((address_space(4))) const unsigned long long KW;
    KW* kp = (KW*)__builtin_amdgcn_kernarg_segment_ptr();
    if (threadIdx.x < 39) s_tbl[threadIdx.x] = kp[threadIdx.x];
#endif
    __syncthreads();
  }
  const int only = (int)(unsigned)lds_word(s_tbl, 38);
  cg::grid_group grid = cg::this_grid();
  __shared__ uint4 xb_words;
  if (threadIdx.x == 0) xb_words = make_uint4(0u, 0u, 0u, 0u);
  __syncthreads();
  XcdBarrier xb;
  {
    P q;
    load_params(q, s_tbl);
    xb = xcd_barrier_post((unsigned*)(q.ws + OFF_BAR), (volatile LAS unsigned*)&xb_words);
  }
  int step = 0;
#define GSYNC() { if (only == -2) grid.sync(); else xcd_barrier(xb); }
#define STEP(body)                                   \
  {                                                  \
    if (only < 0 || only == step) {              \
      P q;                                           \
      load_params(q, s_tbl);                         \
      body;                                          \
    }                                                \
    step++;                                          \
    if (only < 0) GSYNC();                         \
  }
#ifndef DUP
#define DUP 0
#endif
#define STEPD(id, body)                              \
  {                                                  \
    if (only < 0 || only == step) {                  \
      P q;                                           \
      load_params(q, s_tbl);                         \
      body;                                          \
      if (DUP == id) { __syncthreads(); body; }      \
    }                                                \
    step++;                                          \
    if (only < 0) GSYNC();                           \
  }
  STEP(phase_init(q, smem); __syncthreads(); phase_conv(q, 0, smem, blockIdx.x, gridDim.x));
  for (int layer = 0; layer < 4; layer++) {
    if ((layer & 1) == 0) {
      for (int hf = 0; hf < 2; hf++) {
        STEPD(2, phase_prep(q, layer, 0, hf, true, (bf16_t*)(q.ws + OFF_TR + TR_HX), 2048, false));
        STEPD(3, phase_t1(q, layer, smem));
        STEPD(4, phase_feat(q, layer, hf, smem));
        STEPD(5, phase_scan(q, layer, smem);
              if (hf == 0) { __syncthreads(); phase_conv(q, layer + 1, smem, gridDim.x > 256 ? (int)blockIdx.x - 256 : (int)blockIdx.x, gridDim.x > 256 ? (int)gridDim.x - 256 : (int)gridDim.x); });
        STEP(phase_combine(q, layer));
        STEP(phase_rw_out(q, layer, hf, smem));
      }
    } else {
      STEP(phase_prep(q, layer, 0, -1, false, (bf16_t*)(q.ws + OFF_TR + TR_H), 1024, false);
           if (layer + 1 < 4) { __syncthreads(); phase_conv(q, layer + 1, smem, blockIdx.x, gridDim.x); });
      STEPD(7, phase_qkv(q, layer, smem));
      STEPD(8, phase_attn(q, layer, smem));
      STEP(phase_at_out(q, layer, smem));
    }
    STEPD(2, phase_prep(q, layer, 1, -1, false, (bf16_t*)(q.ws + OFF_TR + TR_H2), 1024, layer == 3));
    STEPD(9, phase_mlp1(q, layer, smem));
    STEP(phase_mlp2(q, layer, smem));
  }
  STEP(phase_final(q));
}

#ifndef MULTI_LAUNCH
#define MULTI_LAUNCH 0
#endif
constexpr int NSTEPS = 1 + 2 * (12 + 3) + 2 * (4 + 3) + 1;

extern "C" void kernel_launch(void* const* d_in, const int* in_sizes, int n_in, void* d_out, int out_size, void* d_ws, size_t ws_size,
                              hipStream_t stream) {
  static int grid_blocks = 0;
  if (!grid_blocks) {
    int dev = 0, cus = 0, per_cu = 0;
    hipGetDevice(&dev);
    hipDeviceGetAttribute(&cus, hipDeviceAttributeMultiprocessorCount, dev);
    hipOccupancyMaxActiveBlocksPerMultiprocessor(&per_cu, mega, 256, 0);
    if (per_cu < 1) per_cu = 1;
    if (per_cu > 2) per_cu = 2;
    grid_blocks = cus * per_cu;
  }
  P p{};
  const float** fp = (const float**)&p;
  for (int i = 0; i < 36; i++) fp[i] = (const float*)d_in[i];
  p.out = (float*)d_out;
  p.ws = (char*)d_ws;
  p.pad = 0;
#if MULTI_LAUNCH
  for (int s = 0; s < NSTEPS; s++) {
    p.only = s;
    void* args[] = {&p};
    hipError_t e = hipLaunchCooperativeKernel((void*)mega, dim3(grid_blocks), dim3(256), args, 0, stream);
    if (e != hipSuccess) { fprintf(stderr, "launch failed: %s\n", hipGetErrorString(e)); break; }
  }
#else
  p.only = -1;
  hipMemsetAsync((char*)d_ws + OFF_BAR, 0, XCD_BAR_WORDS * 4, stream);
  void* args[] = {&p};
  hipError_t e = hipLaunchCooperativeKernel((void*)mega, dim3(grid_blocks), dim3(256), args, 0, stream);
  if (e != hipSuccess) fprintf(stderr, "cooperative launch failed: %s (grid %d)\n", hipGetErrorString(e), grid_blocks);
#endif
}
```
